# Optimizing an MI355X kernel written in HIP

```python
import math
import jax, jax.numpy as jnp
from jax import lax
import numpy as np

D_MODEL = 1024
BATCH = 4
SEQ = 4096
DEPTH = 2

BRANCH_WIDTH = D_MODEL // 2
NORM_EPS = 1e-6

RET_HEADS = 4
RET_DK = BRANCH_WIDTH // (2 * RET_HEADS)
RET_DV = BRANCH_WIDTH // RET_HEADS
RET_CHUNK = 128
ROPE_BASE = 10000.0
MAX_POS_OFFSET = 1024

GLA_HEADS = 4
GLA_DK = BRANCH_WIDTH // (2 * GLA_HEADS)
GLA_DV = BRANCH_WIDTH // GLA_HEADS
GLA_GATE_RANK = 16
GLA_GATE_NORMALIZER = 16.0
GLA_CHUNK = 64

SSD_HEAD_DIM = 64
SSD_HEADS = BRANCH_WIDTH // SSD_HEAD_DIM
SSD_GROUPS = 2
SSD_STATE = 128
SSD_CONV = 4
SSD_CHUNK = 128
SSD_CONV_CH = BRANCH_WIDTH + 2 * SSD_GROUPS * SSD_STATE

RWKV_HEAD_DIM = 64
RWKV_HEADS = BRANCH_WIDTH // RWKV_HEAD_DIM
RWKV_DECAY_RANK = 64
RWKV_ICL_RANK = 64
RWKV_SHIFT_WIDTH = 3 * BRANCH_WIDTH + RWKV_DECAY_RANK + RWKV_ICL_RANK
RWKV_LN_EPS = 64e-5

MEM_TOKENS = 256
MEM_HEADS = 4
MEM_HEAD_DIM = 64
MEM_WIDTH = MEM_HEADS * MEM_HEAD_DIM

N_BRANCHES = 5
IN_SIZES = (
    RET_HEADS * RET_DK, RET_HEADS * RET_DK, BRANCH_WIDTH, BRANCH_WIDTH,
    GLA_HEADS * GLA_DK, GLA_HEADS * GLA_DK, BRANCH_WIDTH, GLA_GATE_RANK, BRANCH_WIDTH,
    SSD_CONV_CH, SSD_HEADS, BRANCH_WIDTH,
    RWKV_SHIFT_WIDTH, BRANCH_WIDTH,
    MEM_WIDTH,
    N_BRANCHES * D_MODEL,
)
IN_TOTAL = sum(IN_SIZES)

kernel_name = 'hybrid_ret_gla_ssd_rwkv7_mem'


def split_cols(p, sizes):
    out, start = [], 0
    for s in sizes:
        out.append(p[..., start:start + s])
        start += s
    return out


def to_heads(t, n_heads):
    b, s, _ = t.shape
    return t.reshape(b, s, n_heads, -1).transpose(0, 2, 1, 3)


def from_heads(t):
    b, h, s, d = t.shape
    return t.transpose(0, 2, 1, 3).reshape(b, s, h * d)


def rms_norm(x, g):
    xf = x.astype(jnp.float32)
    y = xf * lax.rsqrt(jnp.mean(xf * xf, axis=-1, keepdims=True) + NORM_EPS)
    return (y * g.astype(jnp.float32)).astype(x.dtype)


def rms_unit(xf):
    return xf * lax.rsqrt(jnp.mean(xf * xf, axis=-1, keepdims=True) + NORM_EPS)


def rotate_interleaved(x, positions):
    dk = x.shape[-1]
    inv = 1.0 / (ROPE_BASE ** jnp.linspace(0.0, 1.0, dk // 2, dtype=jnp.float32))
    ang = positions.astype(jnp.float32)[:, None, :, None] * inv
    sin, cos = jnp.sin(ang), jnp.cos(ang)
    xp = x.reshape(*x.shape[:-1], dk // 2, 2)
    x1, x2 = xp[..., 0], xp[..., 1]
    return jnp.stack([x1 * cos - x2 * sin, x2 * cos + x1 * sin], axis=-1).reshape(x.shape)


def causal_depthwise_conv(x, w, bias):
    k, c = w.shape
    y = lax.conv_general_dilated(x, w[:, None, :], window_strides=(1,), padding=[(k - 1, 0)],
                                 dimension_numbers=('NWC', 'WIO', 'NWC'), feature_group_count=c)
    return y + bias


def chunked_scalar_decay(q, k, v, log_a, chunk):
    f32 = jnp.float32
    b, h, t, dk = q.shape
    dv = v.shape[-1]
    n = t // chunk
    qc = q.astype(f32).reshape(b, h, n, chunk, dk)
    kc = k.astype(f32).reshape(b, h, n, chunk, dk)
    vc = v.astype(f32).reshape(b, h, n, chunk, dv)
    cum = jnp.cumsum(log_a.astype(f32).reshape(b, h, n, chunk), axis=-1)
    causal = jnp.tril(jnp.ones((chunk, chunk), dtype=bool))
    seg = jnp.exp(jnp.where(causal, cum[..., :, None] - cum[..., None, :], -jnp.inf))
    scores = jnp.einsum('bhntd,bhnsd->bhnts', qc, kc) * seg
    y_intra = jnp.einsum('bhnts,bhnsv->bhntv', scores, vc)
    last = cum[..., -1:]
    chunk_state = jnp.einsum('bhnsd,bhnsv->bhndv', kc * jnp.exp(last - cum)[..., None], vc)
    chunk_decay = jnp.exp(last[..., 0])

    def step(state, inp):
        dec, cs = inp
        return state * dec[..., None, None] + cs, state

    init = jnp.zeros((b, h, dk, dv), f32)
    _, prev = lax.scan(step, init, (jnp.moveaxis(chunk_decay, 2, 0), jnp.moveaxis(chunk_state, 2, 0)))
    prev = jnp.moveaxis(prev, 0, 2)
    y_inter = jnp.einsum('bhntd,bhndv->bhntv', qc * jnp.exp(cum)[..., None], prev)
    return (y_intra + y_inter).reshape(b, h, t, dv)


def chunked_vector_decay(q, k, v, log_g, chunk):
    f32 = jnp.float32
    b, h, t, dk = q.shape
    dv = v.shape[-1]
    n = t // chunk
    qc = q.astype(f32).reshape(b, h, n, chunk, dk)
    kc = k.astype(f32).reshape(b, h, n, chunk, dk)
    vc = v.astype(f32).reshape(b, h, n, chunk, dv)
    cum = jnp.cumsum(log_g.astype(f32).reshape(b, h, n, chunk, dk), axis=3)
    ref = cum[:, :, :, chunk // 2:chunk // 2 + 1, :]
    q_in = qc * jnp.exp(cum - ref)
    k_in = kc * jnp.exp(ref - cum)
    causal = jnp.tril(jnp.ones((chunk, chunk), dtype=bool))
    scores = jnp.where(causal, jnp.einsum('bhntd,bhnsd->bhnts', q_in, k_in), 0.0)
    y_intra = jnp.einsum('bhnts,bhnsv->bhntv', scores, vc)
    last = cum[:, :, :, -1:, :]
    chunk_state = jnp.einsum('bhnsd,bhnsv->bhndv', kc * jnp.exp(last - cum), vc)
    chunk_decay = jnp.exp(last[:, :, :, 0, :])

    def step(state, inp):
        dec, cs = inp
        return state * dec[..., None] + cs, state

    init = jnp.zeros((b, h, dk, dv), f32)
    _, prev = lax.scan(step, init, (jnp.moveaxis(chunk_decay, 2, 0), jnp.moveaxis(chunk_state, 2, 0)))
    prev = jnp.moveaxis(prev, 0, 2)
    y_inter = jnp.einsum('bhntd,bhndv->bhntv', qc * jnp.exp(cum), prev)
    return (y_intra + y_inter).reshape(b, h, t, dv)


def retention_branch(q, k, v, positions):
    f32 = jnp.float32
    b, t, _ = q.shape
    qh = rotate_interleaved(to_heads(q.astype(f32), RET_HEADS), positions)
    kh = rotate_interleaved(to_heads(k.astype(f32), RET_HEADS) * RET_DK ** -0.5, positions)
    vh = to_heads(v.astype(f32), RET_HEADS)
    log_gamma = jnp.log(1.0 - 2.0 ** (-5.0 - jnp.arange(RET_HEADS, dtype=f32)))
    log_a = jnp.broadcast_to(log_gamma[None, :, None], (b, RET_HEADS, t))
    o = chunked_scalar_decay(qh, kh, vh, log_a, RET_CHUNK)
    return from_heads(rms_unit(o))


def gla_branch(q, k, v, gk_low, gk_w2, gk_b, norm_g):
    f32 = jnp.float32
    log_g = jax.nn.log_sigmoid((gk_low @ gk_w2 + gk_b).astype(f32)) / GLA_GATE_NORMALIZER
    qh = to_heads(q.astype(f32), GLA_HEADS) * GLA_DK ** -0.5
    kh = to_heads(k.astype(f32), GLA_HEADS)
    vh = to_heads(v.astype(f32), GLA_HEADS)
    o = chunked_vector_decay(qh, kh, vh, to_heads(log_g, GLA_HEADS), GLA_CHUNK)
    return from_heads(rms_unit(o) * norm_g.astype(f32))


def ssd_branch(xbc, dt_raw, z, conv_w, conv_b, dt_bias, a_log, d_skip, norm_g):
    f32 = jnp.float32
    xbc = jax.nn.silu(causal_depthwise_conv(xbc.astype(f32), conv_w.astype(f32), conv_b.astype(f32)))
    xs, bm, cm = split_cols(xbc, (BRANCH_WIDTH, SSD_GROUPS * SSD_STATE, SSD_GROUPS * SSD_STATE))
    rep = SSD_HEADS // SSD_GROUPS
    xh = to_heads(xs, SSD_HEADS)
    bh = jnp.repeat(to_heads(bm, SSD_GROUPS), rep, axis=1)
    ch = jnp.repeat(to_heads(cm, SSD_GROUPS), rep, axis=1)
    dt = jax.nn.softplus(dt_raw.astype(f32) + dt_bias.astype(f32)).transpose(0, 2, 1)
    a = -jnp.exp(a_log.astype(f32))
    y = chunked_scalar_decay(ch, bh, xh * dt[..., None], dt * a[None, :, None], SSD_CHUNK)
    y = from_heads(y + d_skip.astype(f32)[None, :, None, None] * xh)
    y = y * jax.nn.silu(z.astype(f32))
    b, t, _ = y.shape
    y = rms_unit(y.reshape(b, t, SSD_GROUPS, -1)).reshape(b, t, BRANCH_WIDTH)
    return y * norm_g.astype(f32)


def rwkv7_branch(u, mu, w0, w2, a0, a2, k_k, k_a, r_k, ln_g, ln_b):
    f32 = jnp.float32
    b, t, _ = u.shape
    u = u.astype(f32)
    u_prev = jnp.pad(u, ((0, 0), (1, 0), (0, 0)))[:, :-1]
    xs = u + (u_prev - u) * mu.astype(f32)
    r, k, v, wl, al = split_cols(xs, (BRANCH_WIDTH, BRANCH_WIDTH, BRANCH_WIDTH, RWKV_DECAY_RANK, RWKV_ICL_RANK))
    log_w = -jax.nn.softplus(-(w0.astype(f32) + jnp.tanh(wl) @ w2.astype(f32))) - 0.5
    decay = jnp.exp(-jnp.exp(log_w))
    a = jax.nn.sigmoid(a0.astype(f32) + al @ a2.astype(f32))
    kk = k * k_k.astype(f32)
    k = k * (1.0 + (a - 1.0) * k_a.astype(f32))
    shp = (b, t, RWKV_HEADS, RWKV_HEAD_DIM)
    r, decay, k, v, a, kk = [z_.reshape(shp) for z_ in (r, decay, k, v, a, kk)]
    kk = kk / jnp.maximum(jnp.sqrt(jnp.sum(kk * kk, axis=-1, keepdims=True)), 1e-12)

    def step(state, inp):
        r_t, w_t, k_t, v_t, a_t, b_t = inp
        sa = jnp.einsum('bhvk,bhk->bhv', state, a_t)
        state = (state * w_t[:, :, None, :] + sa[..., None] * b_t[:, :, None, :]
                 + v_t[..., None] * k_t[:, :, None, :])
        return state, jnp.einsum('bhvk,bhk->bhv', state, r_t)

    init = jnp.zeros((b, RWKV_HEADS, RWKV_HEAD_DIM, RWKV_HEAD_DIM), f32)
    xs_seq = tuple(jnp.moveaxis(z_, 1, 0) for z_ in (r, decay, k, v, -kk, kk * a))
    _, y = lax.scan(step, init, xs_seq)
    y = jnp.moveaxis(y, 0, 1)
    mean = jnp.mean(y, axis=-1, keepdims=True)
    var = jnp.mean(jnp.square(y - mean), axis=-1, keepdims=True)
    y = ((y - mean) * lax.rsqrt(var + RWKV_LN_EPS)).reshape(b, t, BRANCH_WIDTH)
    y = y * ln_g.astype(f32) + ln_b.astype(f32)
    bonus = jnp.sum(r * k * r_k.astype(f32), axis=-1, keepdims=True) * v
    return y + bonus.reshape(b, t, BRANCH_WIDTH)


def memory_branch(q, mem_n, w_kv):
    f32 = jnp.float32
    km, vm = split_cols(mem_n @ w_kv, (MEM_WIDTH, MEM_WIDTH))
    qh = to_heads(q.astype(f32), MEM_HEADS) * MEM_HEAD_DIM ** -0.5
    kh = to_heads(km.astype(f32), MEM_HEADS)
    vh = to_heads(vm.astype(f32), MEM_HEADS)
    p = jax.nn.softmax(jnp.einsum('bhtd,bhmd->bhtm', qh, kh), axis=-1)
    return from_heads(jnp.einsum('bhtm,bhmd->bhtd', p, vh))


def setup_inputs(seed: int = 0) -> dict:
    key = jax.random.key(seed)
    f32 = jnp.float32
    counter = [0]

    def nk():
        counter[0] += 1
        return jax.random.fold_in(key, counter[0])

    def nrm(shape, scale):
        return jax.random.normal(nk(), shape, f32) * scale

    def gain(shape):
        return 1.0 + nrm(shape, 0.05)

    L, D, W = DEPTH, D_MODEL, BRANCH_WIDTH
    x = nrm((BATCH, SEQ, D), 1.0)
    mem = nrm((BATCH, MEM_TOKENS, D), 1.0)
    offset = jax.random.randint(nk(), (BATCH, 1), 0, MAX_POS_OFFSET, dtype=jnp.int32)
    positions = offset + jnp.arange(SEQ, dtype=jnp.int32)[None, :]
    dt0 = jnp.exp(jax.random.uniform(nk(), (L, SSD_HEADS), f32, math.log(1e-3), math.log(1e-1)))
    return {
        'x': x,
        'mem': mem,
        'positions': positions,
        'norm_g': gain((L, D)),
        'w_in': nrm((L, D, IN_TOTAL), D ** -0.5),
        'gla_gk_w2': nrm((L, GLA_GATE_RANK, GLA_HEADS * GLA_DK), GLA_GATE_RANK ** -0.5),
        'gla_gk_b': nrm((L, GLA_HEADS * GLA_DK), 0.1),
        'gla_norm_g': gain((L, GLA_DV)),
        'ssd_conv_w': nrm((L, SSD_CONV, SSD_CONV_CH), SSD_CONV ** -0.5),
        'ssd_conv_b': nrm((L, SSD_CONV_CH), 0.02),
        'ssd_dt_bias': dt0 + jnp.log(-jnp.expm1(-dt0)),
        'ssd_a_log': jnp.log(jax.random.uniform(nk(), (L, SSD_HEADS), f32, 1.0, 16.0)),
        'ssd_d': gain((L, SSD_HEADS)),
        'ssd_norm_g': gain((L, W)),
        'rwkv_mu': jax.random.uniform(nk(), (L, RWKV_SHIFT_WIDTH), f32),
        'rwkv_w0': jnp.linspace(-6.0, -1.0, W, dtype=f32)[None, :] + nrm((L, W), 0.1),
        'rwkv_w2': nrm((L, RWKV_DECAY_RANK, W), 0.5 * RWKV_DECAY_RANK ** -0.5),
        'rwkv_a0': nrm((L, W), 0.1),
        'rwkv_a2': nrm((L, RWKV_ICL_RANK, W), 0.5 * RWKV_ICL_RANK ** -0.5),
        'rwkv_k_k': 0.85 + nrm((L, W), 0.05),
        'rwkv_k_a': gain((L, W)),
        'rwkv_r_k': nrm((L, RWKV_HEADS, RWKV_HEAD_DIM), 0.1),
        'rwkv_ln_g': gain((L, W)),
        'rwkv_ln_b': nrm((L, W), 0.02),
        'mem_norm_g': gain((L, D)),
        'w_mem_kv': nrm((L, D, 2 * MEM_WIDTH), D ** -0.5),
        'w_up_ret': nrm((L, W, D), W ** -0.5),
        'w_up_gla': nrm((L, W, D), W ** -0.5),
        'w_up_ssd': nrm((L, W, D), W ** -0.5),
        'w_up_rwkv': nrm((L, W, D), W ** -0.5),
        'w_up_mem': nrm((L, MEM_WIDTH, D), MEM_WIDTH ** -0.5),
        'w_out': nrm((L, D, D), D ** -0.5),
        'final_norm_g': gain((D,)),
    }


def reference(x, mem, positions, norm_g, w_in, gla_gk_w2, gla_gk_b, gla_norm_g,
              ssd_conv_w, ssd_conv_b, ssd_dt_bias, ssd_a_log, ssd_d, ssd_norm_g,
              rwkv_mu, rwkv_w0, rwkv_w2, rwkv_a0, rwkv_a2, rwkv_k_k, rwkv_k_a, rwkv_r_k,
              rwkv_ln_g, rwkv_ln_b, mem_norm_g, w_mem_kv,
              w_up_ret, w_up_gla, w_up_ssd, w_up_rwkv, w_up_mem, w_out, final_norm_g):
    f32 = jnp.float32
    b, t, d = x.shape
    for l in range(DEPTH):
        h = rms_norm(x, norm_g[l])
        p = h @ w_in[l]
        (ret_q, ret_k, ret_v, ret_g, gla_q, gla_k, gla_v, gla_gk, gla_g,
         ssd_xbc, ssd_dt, ssd_z, rwkv_in, rwkv_g, mem_q, gates) = split_cols(p, IN_SIZES)

        o_ret = retention_branch(ret_q, ret_k, ret_v, positions) * jax.nn.silu(ret_g.astype(f32))
        o_gla = gla_branch(gla_q, gla_k, gla_v, gla_gk, gla_gk_w2[l], gla_gk_b[l],
                           gla_norm_g[l]) * jax.nn.silu(gla_g.astype(f32))
        o_ssd = ssd_branch(ssd_xbc, ssd_dt, ssd_z, ssd_conv_w[l], ssd_conv_b[l], ssd_dt_bias[l],
                           ssd_a_log[l], ssd_d[l], ssd_norm_g[l])
        o_rwkv = rwkv7_branch(rwkv_in, rwkv_mu[l], rwkv_w0[l], rwkv_w2[l], rwkv_a0[l], rwkv_a2[l],
                              rwkv_k_k[l], rwkv_k_a[l], rwkv_r_k[l], rwkv_ln_g[l],
                              rwkv_ln_b[l]) * jax.nn.silu(rwkv_g.astype(f32))
        o_mem = memory_branch(mem_q, rms_norm(mem, mem_norm_g[l]), w_mem_kv[l])

        g = jax.nn.sigmoid(gates.astype(f32)).reshape(b, t, N_BRANCHES, d)
        branches = (o_ret.astype(x.dtype) @ w_up_ret[l], o_gla.astype(x.dtype) @ w_up_gla[l],
                    o_ssd.astype(x.dtype) @ w_up_ssd[l], o_rwkv.astype(x.dtype) @ w_up_rwkv[l],
                    o_mem.astype(x.dtype) @ w_up_mem[l])
        merged = g[:, :, 0] * branches[0].astype(f32)
        for i in range(1, N_BRANCHES):
            merged = merged + g[:, :, i] * branches[i].astype(f32)
        x = x + merged.astype(x.dtype) @ w_out[l]
    return rms_norm(x, final_norm_g)
```

```cpp
#include <hip/hip_runtime.h>
#include <hip/hip_cooperative_groups.h>
#include <cstdio>
#include <cstdint>
namespace cg = cooperative_groups;
namespace pg8 {
#define PG8_LAS __attribute__((address_space(3)))
typedef unsigned short bf16_t;
typedef short bf16x8 __attribute__((ext_vector_type(8)));
typedef float f32x4 __attribute__((ext_vector_type(4)));
typedef unsigned u32x4 __attribute__((ext_vector_type(4)));
constexpr int BM = 256, BK = 64, HALF = 128, HTB = HALF * BK * 2  , STAGE_BYTES = 8 * HTB, NXCD = 8, WGM = 8;

__host__ __device__ __forceinline__ int lds_byte(int r, int c) { const int st = (r >> 4) * 2 + (c >> 5), rr = r & 15, cc = c & 31, ob = rr * 64 + cc * 2; return st * 1024 + (ob ^ (((ob >> 9) & 1) << 5)); }
__host__ __device__ __forceinline__ void stage_rc(int b, int& R, int& C) { const int st = b / 1024, sb = b % 1024, swz = sb ^ (((sb >> 9) & 1) << 5); R = (st >> 1) * 16 + swz / 64; C = (st & 1) * 32 + (swz % 64) / 2; }
__host__ __device__ __forceinline__ int perm32(int rho) { const int n = rho >> 4, i = rho & 15; return 8 * (i >> 2) + 4 * n + (i & 3); }

struct Unit { int pm, pn, kind, aux; int nt, lda, ldb; int pad_; const char* A; const char* B; };
struct Gemm { int K, lda; };


template <class Epi, class Sched, bool ALIGN_EPI = false, bool SP2 = false>
__device__ __forceinline__ void gemm_phase(PG8_LAS unsigned char* lds, const Gemm g, const Sched& S, const Epi& E) {
    int tid = threadIdx.x; asm volatile("" : "+v"(tid));
    const int wid = __builtin_amdgcn_readfirstlane(tid >> 6), lane = tid & 63, wr = wid >> 2, wc = wid & 3, fr = lane & 15, fq = lane >> 4;
    int Rv[2], Rbv[2], Cv[2];
#pragma unroll
    for (int i = 0; i < 2; ++i) { int R, C; stage_rc(tid * 16 + i * 8192, R, C); Rv[i] = R; Cv[i] = C; Rbv[i] = Epi::PERM ? ((R & ~31) + perm32(R & 31)) : R; }
    unsigned voffA[2], voffB[2], voffAn[2], voffBn[2];
    const size_t kstep = (size_t)(BK * 2);
    size_t hstepA, hstepB, hstepAn, hstepBn;
#define PG8_STRIDES(u_, vA_, vB_, hA_, hB_) do { _Pragma("unroll") for (int _i = 0; _i < 2; ++_i) { vA_[_i] = (unsigned)(Rv[_i] * (u_).lda + Cv[_i]) * 2u; vB_[_i] = (unsigned)(Rbv[_i] * (u_).ldb + Cv[_i]) * 2u; } \
        hA_ = (size_t)HALF * (u_).lda * 2; hB_ = (size_t)HALF * (u_).ldb * 2; } while (0)
    const unsigned ldsw = (unsigned)wid * 1024u;
    const int aoff = lds_byte(wr * 64 + fr, fq * 8), boff = lds_byte(wc * 32 + fr, fq * 8);
#define PG8_SA(b, h) (((b) * 2 + (h)) * HTB)
#define PG8_SB(b, h) ((4 + (b) * 2 + (h)) * HTB)
#define PG8_STAGE(bufoff, gbase, voff) do { _Pragma("unroll") for (int _i = 0; _i < 2; ++_i) \
        __builtin_amdgcn_global_load_lds((const unsigned*)((const char*)(gbase) + (voff)[_i]), (PG8_LAS unsigned*)(lds + (bufoff) + ldsw + _i * 8192), 16, 0, 0); } while (0)
#define PG8_LDA(dst, b, h) do { _Pragma("unroll") for (int m = 0; m < 4; ++m) _Pragma("unroll") for (int k = 0; k < 2; ++k) dst[m][k] = *(const PG8_LAS bf16x8*)(lds + PG8_SA(b, h) + aoff + m * 2048 + k * 1024); } while (0)
#define PG8_LDB(dst, b, h) do { _Pragma("unroll") for (int n = 0; n < 2; ++n) _Pragma("unroll") for (int k = 0; k < 2; ++k) dst[n][k] = *(const PG8_LAS bf16x8*)(lds + PG8_SB(b, h) + boff + n * 2048 + k * 1024); } while (0)
#define PG8_MMA(ai, bj, At, Bt) do { __builtin_amdgcn_s_setprio(1); _Pragma("unroll") for (int m = 0; m < 4; ++m) _Pragma("unroll") for (int n = 0; n < 2; ++n) _Pragma("unroll") for (int k = 0; k < 2; ++k) \
        acc[ai][bj][m][n] = __builtin_amdgcn_mfma_f32_16x16x32_bf16(Bt[n][k], At[m][k], acc[ai][bj][m][n], 0, 0, 0); __builtin_amdgcn_s_setprio(0); } while (0)
#define PG8_WAIT_V(n) asm volatile("s_waitcnt vmcnt(" #n ")" ::: "memory")
#define PG8_WAIT_L(n) asm volatile("s_waitcnt lgkmcnt(" #n ")" ::: "memory")
#define PG8_BAR __builtin_amdgcn_s_barrier()
#define PG8_SCHED __builtin_amdgcn_sched_barrier(0)
    Unit cur, nxt; int ui = 0;
    if (!S.next(0, cur)) return;
    PG8_STRIDES(cur, voffA, voffB, hstepA, hstepB); int nt = cur.nt;
    f32x4 acc[2][2][4][2];
#pragma unroll
    for (int a = 0; a < 2; ++a)
#pragma unroll
        for (int b = 0; b < 2; ++b)
#pragma unroll
            for (int m = 0; m < 4; ++m)
#pragma unroll
                for (int n = 0; n < 2; ++n) acc[a][b][m][n] = (f32x4){0.f, 0.f, 0.f, 0.f};
    bf16x8 At[4][2], B0[2][2], B1[2][2];
    const char* cA = cur.A; const char* cB = cur.B;
    S.a_ready(cur);
    if constexpr (SP2) {
        PG8_STAGE(PG8_SB(0, 0), cB, voffB); PG8_STAGE(PG8_SB(0, 1), cB + hstepB, voffB); PG8_STAGE(PG8_SA(0, 0), cA, voffA); PG8_STAGE(PG8_SA(0, 1), cA + hstepA, voffA);
        if (wr == 1) PG8_BAR;
        PG8_WAIT_V(2); PG8_BAR;
        PG8_STAGE(PG8_SB(1, 0), cB + kstep, voffB); PG8_STAGE(PG8_SA(1, 0), cA + kstep, voffA); PG8_STAGE(PG8_SB(1, 1), cB + hstepB + kstep, voffB);
        PG8_WAIT_V(6); PG8_BAR;
    } else {
        PG8_STAGE(PG8_SB(0, 0), cB, voffB); PG8_STAGE(PG8_SA(0, 0), cA, voffA); PG8_STAGE(PG8_SB(0, 1), cB + hstepB, voffB); PG8_STAGE(PG8_SA(0, 1), cA + hstepA, voffA);
        if (wr == 1) PG8_BAR;
        PG8_WAIT_V(4); PG8_BAR;
        PG8_STAGE(PG8_SB(1, 0), cB + kstep, voffB); PG8_STAGE(PG8_SA(1, 0), cA + kstep, voffA); PG8_STAGE(PG8_SB(1, 1), cB + hstepB + kstep, voffB);
        PG8_WAIT_V(6); PG8_BAR;
    }
    for (;;) {
        const bool has_next = S.next(ui + 1, nxt);
        const char* nA = has_next ? nxt.A : cA; const char* nB = has_next ? nxt.B : cB;
        if (has_next) PG8_STRIDES(nxt, voffAn, voffBn, hstepAn, hstepBn); else { voffAn[0] = voffA[0]; voffAn[1] = voffA[1]; voffBn[0] = voffB[0]; voffBn[1] = voffB[1]; hstepAn = hstepA; hstepBn = hstepB; }
        for (int t = 0; t < nt; t += 2) {
            const bool last = (t == nt - 2);
            const char* a1 = cA + (size_t)(t + 1) * kstep;
            const char* a2 = last ? nA : cA + (size_t)(t + 2) * kstep; const char* b2 = last ? nB : cB + (size_t)(t + 2) * kstep;
            const char* a3 = a2 + kstep; const char* b3 = b2 + kstep;
            unsigned vA2[2], vB2[2]; vA2[0] = last ? voffAn[0] : voffA[0]; vA2[1] = last ? voffAn[1] : voffA[1]; vB2[0] = last ? voffBn[0] : voffB[0]; vB2[1] = last ? voffBn[1] : voffB[1];
            const size_t hA2 = last ? hstepAn : hstepA, hB2 = last ? hstepBn : hstepB;
            if (last && has_next) S.a_ready(nxt);
            if constexpr (SP2) {
            PG8_LDB(B0, 0, 0); PG8_LDB(B1, 0, 1); PG8_SCHED; PG8_LDA(At, 0, 0); PG8_STAGE(PG8_SA(1, 1), a1 + hstepA, voffA);
            PG8_WAIT_V(8); PG8_WAIT_L(0); PG8_BAR; PG8_MMA(0, 0, At, B0); PG8_MMA(0, 1, At, B1); PG8_BAR; PG8_SCHED;
            PG8_LDA(At, 0, 1); PG8_STAGE(PG8_SB(0, 0), b2, vB2); PG8_STAGE(PG8_SB(0, 1), b2 + hB2, vB2); PG8_STAGE(PG8_SA(0, 0), a2, vA2);
            PG8_WAIT_V(8); PG8_WAIT_L(0); PG8_BAR; PG8_MMA(1, 0, At, B0); PG8_MMA(1, 1, At, B1); PG8_BAR; PG8_SCHED;
            PG8_LDB(B0, 1, 0); PG8_LDB(B1, 1, 1); PG8_SCHED; PG8_LDA(At, 1, 0); PG8_STAGE(PG8_SA(0, 1), a2 + hA2, vA2);
            PG8_WAIT_V(8); PG8_WAIT_L(0); PG8_BAR; PG8_MMA(0, 0, At, B0); PG8_MMA(0, 1, At, B1); PG8_BAR; PG8_SCHED;
            PG8_LDA(At, 1, 1); PG8_STAGE(PG8_SB(1, 0), b3, vB2); PG8_STAGE(PG8_SB(1, 1), b3 + hB2, vB2); PG8_STAGE(PG8_SA(1, 0), a3, vA2);
            PG8_WAIT_V(8); PG8_WAIT_L(0); PG8_BAR; PG8_MMA(1, 0, At, B0); PG8_MMA(1, 1, At, B1); PG8_BAR; PG8_SCHED;
            } else {
            PG8_LDB(B0, 0, 0); PG8_SCHED; PG8_LDA(At, 0, 0); PG8_STAGE(PG8_SA(1, 1), a1 + hstepA, voffA);
            PG8_WAIT_L(8); PG8_BAR; PG8_WAIT_L(0); PG8_MMA(0, 0, At, B0); PG8_BAR; PG8_SCHED;
            PG8_LDB(B1, 0, 1); PG8_STAGE(PG8_SB(0, 0), b2, vB2);
            PG8_BAR; PG8_WAIT_L(0); PG8_MMA(0, 1, At, B1); PG8_BAR;
            PG8_LDA(At, 0, 1); PG8_STAGE(PG8_SA(0, 0), a2, vA2);
            PG8_BAR; PG8_WAIT_L(0); PG8_MMA(1, 0, At, B0); PG8_BAR; PG8_SCHED;
            PG8_STAGE(PG8_SB(0, 1), b2 + hB2, vB2);
            PG8_WAIT_V(6); PG8_BAR; PG8_MMA(1, 1, At, B1); PG8_BAR;
            PG8_LDB(B0, 1, 0); PG8_SCHED; PG8_LDA(At, 1, 0); PG8_STAGE(PG8_SA(0, 1), a2 + hA2, vA2);
            PG8_WAIT_L(8); PG8_BAR; PG8_WAIT_L(0); PG8_MMA(0, 0, At, B0); PG8_BAR; PG8_SCHED;
            PG8_LDB(B1, 1, 1); PG8_STAGE(PG8_SB(1, 0), b3, vB2);
            PG8_BAR; PG8_WAIT_L(0); PG8_MMA(0, 1, At, B1); PG8_BAR;
            PG8_LDA(At, 1, 1); PG8_STAGE(PG8_SA(1, 0), a3, vA2);
            PG8_BAR; PG8_WAIT_L(0); PG8_MMA(1, 0, At, B0); PG8_BAR; PG8_SCHED;
            PG8_STAGE(PG8_SB(1, 1), b3 + hB2, vB2);
            PG8_WAIT_V(6); PG8_BAR; PG8_MMA(1, 1, At, B1); PG8_BAR;
            }
        }
        if constexpr (ALIGN_EPI) { if (wr == 0) PG8_BAR; }
        if constexpr (!Epi::AFTER_DRAIN) { E(acc, cur, wr, wc, fr, fq); S.done(cur); }
        if (!has_next) break;
#pragma unroll
        for (int a = 0; a < 2; ++a)
#pragma unroll
            for (int b = 0; b < 2; ++b)
#pragma unroll
                for (int m = 0; m < 4; ++m)
#pragma unroll
                    for (int n = 0; n < 2; ++n) acc[a][b][m][n] = (f32x4){0.f, 0.f, 0.f, 0.f};
        cur = nxt; cA = nA; cB = nB; ++ui; nt = cur.nt; voffA[0] = voffAn[0]; voffA[1] = voffAn[1]; voffB[0] = voffBn[0]; voffB[1] = voffBn[1]; hstepA = hstepAn; hstepB = hstepBn;
        if constexpr (ALIGN_EPI) { if (wr == 1) PG8_BAR; }
    }
    PG8_WAIT_V(0);
    if constexpr (!ALIGN_EPI) { if (wr == 0) PG8_BAR; }
    PG8_BAR;
    if constexpr (Epi::AFTER_DRAIN) { E.fused(acc, cur, wr, wc, fr, fq, lds, wid, lane); S.done(cur); }
#undef PG8_STRIDES
#undef PG8_SA
#undef PG8_SB
#undef PG8_STAGE
#undef PG8_LDA
#undef PG8_LDB
#undef PG8_MMA
#undef PG8_WAIT_V
#undef PG8_WAIT_L
#undef PG8_BAR
#undef PG8_SCHED
}
}

#define DI __device__ __forceinline__
typedef unsigned short bf16;
typedef short bf16x8 __attribute__((ext_vector_type(8)));
typedef float f32x4 __attribute__((ext_vector_type(4)));
typedef unsigned u32x4 __attribute__((ext_vector_type(4)));
typedef unsigned u32x2 __attribute__((ext_vector_type(2)));

constexpr int D = 1024, NBATCH = 4, T = 4096, M = NBATCH * T, IN_TOTAL = 12184;
constexpr int LDP = 7168;
constexpr int C_RQ = 0, C_RK = 256, C_RV = 512, C_RG = 1024, C_GQ = 1536, C_GK = 1792, C_GV = 2048, C_GG = 2560,
              C_SX = 3072, C_SZ = 4096, C_WR = 4608, C_WK = 5120, C_WV = 5632, C_WL = 6144, C_AL = 6208, C_WG = 6272,
              C_MQ = 6784, C_GKL = 7040, C_SDT = 7056;
enum { I_X = 0, I_MEM, I_POS, I_NORMG, I_WIN, I_GKW2, I_GKB, I_GNORMG, I_CONVW, I_CONVB, I_DTB, I_ALOG, I_SD, I_SNORMG,
       I_MU, I_W0, I_W2, I_A0, I_A2, I_KK, I_KA, I_RK, I_LNG, I_LNB, I_MNORMG, I_WKV, I_URET, I_UGLA, I_USSD, I_URWKV,
       I_UMEM, I_WOUT, I_FNORMG, N_IN };
constexpr size_t MiB = 1u << 20;
constexpr size_t WS_SSQ = 0;
constexpr size_t WS_DG = 512 * 1024;
constexpr size_t WS_DS = 576 * 1024;
constexpr size_t WS_BAR = 640 * 1024;
constexpr size_t WS_KM = 1 * MiB;
constexpr size_t WS_VMT = 1 * MiB + 512 * 1024;
constexpr size_t WS_MEMN = 2 * MiB;
constexpr size_t WS_BND = 6 * MiB;
constexpr int BND_W = 1792;
constexpr size_t WS_XS = 7 * MiB;
constexpr size_t WS_XCNT = 640 * 1024 + 16384;
constexpr size_t WS_ZERO_BYTES = 16384 + 2 * 64 * 256;
constexpr size_t WS_W1T = 8 * MiB;
constexpr size_t WS_WGT = 22 * MiB;
constexpr size_t WS_UT = 32 * MiB;
constexpr size_t WS_UST = 35 * MiB;
constexpr size_t WS_UMT = 36 * MiB;
constexpr size_t WS_WOT = 37 * MiB;
constexpr size_t WS_WKVT = 39 * MiB;
constexpr size_t WS_XN = 40 * MiB;
constexpr size_t WS_P = 72 * MiB;
constexpr size_t WS_OMEM = 296 * MiB;
constexpr size_t WS_RETL = 304 * MiB;
constexpr size_t WS_GLAL = 312 * MiB;
constexpr size_t WS_SSDL = 320 * MiB;
constexpr size_t WS_MRG = 304 * MiB;
constexpr size_t WS_RWGH = 336 * MiB;
constexpr size_t WS_END = 368 * MiB;

constexpr int LDS_BYTES = 147456;
constexpr int NTHREADS = 512;

struct Params { const float* in[N_IN]; float* out; unsigned char* ws; };

DI float bf2f(unsigned b) { return __uint_as_float(b << 16); }
typedef __bf16 bf16n2 __attribute__((ext_vector_type(2)));
DI unsigned f2bf(float f) { const __bf16 b = (__bf16)f; return (unsigned)__builtin_bit_cast(unsigned short, b); }
DI unsigned pk2(float lo, float hi) { const bf16n2 v = {(__bf16)lo, (__bf16)hi}; return __builtin_bit_cast(unsigned, v); }
DI float lo16(unsigned u) { return __uint_as_float(u << 16); }
DI float hi16(unsigned u) { return __uint_as_float(u & 0xffff0000u); }
DI void unpack8(u32x4 v, float* f) { f[0] = lo16(v.x); f[1] = hi16(v.x); f[2] = lo16(v.y); f[3] = hi16(v.y); f[4] = lo16(v.z); f[5] = hi16(v.z); f[6] = lo16(v.w); f[7] = hi16(v.w); }
DI u32x4 pack8(const float* f) { u32x4 v; v.x = pk2(f[0], f[1]); v.y = pk2(f[2], f[3]); v.z = pk2(f[4], f[5]); v.w = pk2(f[6], f[7]); return v; }
DI u32x2 pack4(f32x4 a) { u32x2 v; v.x = pk2(a[0], a[1]); v.y = pk2(a[2], a[3]); return v; }
DI float fexp(float x) { return __expf(x); }
DI float sigmoidf_(float x) { return __builtin_amdgcn_rcpf(1.0f + __expf(-x)); }
DI float siluf_(float x) { return x * __builtin_amdgcn_rcpf(1.0f + __expf(-x)); }
DI float softplusf_(float x) { return fmaxf(x, 0.0f) + __logf(1.0f + __expf(-fabsf(x))); }
DI float logsigmoidf_(float x) { return fminf(x, 0.0f) - __logf(1.0f + __expf(-fabsf(x))); }
DI float tanhf_(float x) { const float e = __expf(2.0f * x); return 1.0f - 2.0f * __builtin_amdgcn_rcpf(e + 1.0f); }
DI int opaque_tid() { int t = threadIdx.x; asm volatile("" : "+v"(t)); return t; }
#define WAVE_LDS_SYNC() asm volatile("s_waitcnt lgkmcnt(0)" ::: "memory")
DI float wave_sum(float v) {
#pragma unroll
    for (int o = 1; o < 64; o <<= 1) v += __shfl_xor(v, o);
    return v;
}
DI bf16x8 frag(const bf16* base, int ld, int r0, int k0, int lane) { return *(const bf16x8*)(base + (r0 + (lane & 15)) * ld + k0 + ((lane >> 4) << 3)); }
DI f32x4 mfma16(bf16x8 a, bf16x8 b, f32x4 c) { return __builtin_amdgcn_mfma_f32_16x16x32_bf16(a, b, c, 0, 0, 0); }

DI void tile_map(int L, int nM, int nN, int& pm, int& pn) {
    const int nwg = nM * nN; int wgid = L;
    { const int q = nwg / 8, r = nwg % 8, xcd = wgid % 8, off = wgid / 8; wgid = (xcd < r ? xcd * (q + 1) : r * (q + 1) + (xcd - r) * q) + off; }
    const int nig = 8 * nN, gid = wgid / nig, fm = gid * 8, gsz = (nM - fm) < 8 ? (nM - fm) : 8;
    pm = fm + ((wgid % nig) % gsz); pn = (wgid % nig) / gsz;
}

using pg8::Unit;
struct SchedP1 {
    int G, c; const char* A; const char* B;
    DI bool next(int i, Unit& u) const {
        const long L = (long)i * G + c; if (L >= 64 * 28) return false;
        tile_map((int)L, 64, 28, u.pm, u.pn); u.kind = 0; u.aux = 0; u.nt = 16; u.lda = 1024; u.ldb = 1024; u.pad_ = 0;
        u.A = A + (size_t)u.pm * 256 * 1024 * 2; u.B = B + (size_t)u.pn * 256 * 1024 * 2; return true;
    }
    DI void a_ready(const Unit&) const {}
    DI void done(const Unit&) const {}
};
struct EpiP {
    static constexpr bool PERM = true, AFTER_DRAIN = false;
    bf16* O; bf16* BND;
    DI void operator()(const f32x4 (&acc)[2][2][4][2], const Unit& u, int wr, int wc, int fr, int fq) const {
        const int row0 = u.pm * 256 + wr * 64 + fr, col0 = u.pn * 256 + wc * 32 + 8 * fq;
#pragma unroll
        for (int ai = 0; ai < 2; ++ai)
#pragma unroll
            for (int m = 0; m < 4; ++m) { bf16* rowp = O + (size_t)(row0 + ai * 128 + m * 16) * LDP + col0;
#pragma unroll
                for (int bj = 0; bj < 2; ++bj) { const f32x4 v0 = acc[ai][bj][m][0], v1 = acc[ai][bj][m][1];
                    u32x4 w; w.x = pk2(v0[0], v0[1]); w.y = pk2(v0[2], v0[3]); w.z = pk2(v1[0], v1[1]); w.w = pk2(v1[2], v1[3]);
                    *(u32x4*)(rowp + bj * 128) = w;
                    if (m == 3 && fr == 15 && u.pn >= 18 && u.pn <= 24) *(u32x4*)(BND + (size_t)((row0 + ai * 128 + m * 16) >> 6) * BND_W + (col0 - 4608) + bj * 128) = w; } }
    }
};
DI int gate_slot_col(int s) { return s < 8 ? 128 * s : s < 16 ? 1536 + 128 * (s - 8) : s < 24 ? 3072 + 128 * (s - 16) : s < 37 ? 4608 + 128 * (s - 24) : 6784 + 128 * (s - 37); }
struct SchedP3 {
    int pm, pn; const unsigned char* ws;
    DI bool next(int i0, Unit& u) const {
        if (i0 >= 11) return false;
        const int i = i0 == 0 ? 0 : i0 == 1 ? 5 : i0 == 2 ? 1 : i0 == 3 ? 6 : i0 == 4 ? 3 : i0 == 5 ? 7 : i0 == 6 ? 2 : i0 == 7 ? 8 : i0 == 8 ? 9 : i0 == 9 ? 4 : 10;
        u.pm = pm; u.pn = pn; u.pad_ = 0;
        if (i < 5) { u.kind = i; u.aux = 16; u.nt = 16; u.lda = 1024; u.ldb = 1024; u.A = (const char*)ws + WS_XN + (size_t)pm * 256 * 1024 * 2;
            u.B = (const char*)ws + WS_WGT + ((size_t)i * 1024 + (size_t)pn * 256) * 1024 * 2; }
        else if (i < 8) { const int j = i - 5; const int col = j == 0 ? C_RG : j == 1 ? C_GG : C_WG; u.kind = j == 0 ? 0 : j == 1 ? 1 : 3; u.aux = (j == 0) ? 1 : 0; u.nt = 8; u.lda = LDP; u.ldb = 512;
            u.A = (const char*)ws + WS_P + ((size_t)pm * 256 * LDP + col) * 2;
            u.B = (const char*)ws + WS_UT + ((size_t)j * 1024 + (size_t)pn * 256) * 512 * 2; }
        else if (i < 10) { const int j = i - 8; u.kind = 2; u.aux = (j + 1) << 1; u.nt = 4; u.lda = LDP; u.ldb = 256;
            u.A = (const char*)ws + WS_P + ((size_t)pm * 256 * LDP + C_SZ + j * 256) * 2;
            u.B = (const char*)ws + WS_UST + ((size_t)j * 1024 + (size_t)pn * 256) * 256 * 2; }
        else { u.kind = 4; u.aux = 0; u.nt = 4; u.lda = 256; u.ldb = 256; u.A = (const char*)ws + WS_OMEM + (size_t)pm * 256 * 256 * 2;
            u.B = (const char*)ws + WS_UMT + ((size_t)pn * 256) * 256 * 2; }
        return true;
    }
    DI void a_ready(const Unit&) const {}
    DI void done(const Unit&) const {}
};
typedef float f32x2 __attribute__((ext_vector_type(2)));
DI f32x2 sig255_pk(f32x2 x) {
    x = __builtin_elementwise_min(__builtin_elementwise_max(x, (f32x2){-7.0f, -7.0f}), (f32x2){7.0f, 7.0f});
    const f32x2 x2 = x * x;
    f32x2 q = x2 * 9.362619013e-11f + (-1.716749942e-08f);
    q = q * x2 + 1.283517804e-06f; q = q * x2 + (-5.098115798e-05f); q = q * x2 + 1.195220742e-03f; q = q * x2 + (-1.824038848e-02f); q = q * x2 + 2.476293743e-01f;
    return (x * q) * 255.0f + 128.0f;
}
DI f32x2 sig_pk(f32x2 x) { return (sig255_pk(x) - 128.0f) * (1.0f / 255.0f) + 0.5f; }
struct EpiGate {
    static constexpr bool PERM = true, AFTER_DRAIN = false;
    bf16* P;
    DI void operator()(const f32x4 (&acc)[2][2][4][2], const Unit& u, int wr, int wc, int fr, int fq) const {
        const int row0 = u.pm * 256 + wr * 64 + fr;
#pragma unroll
        for (int bj = 0; bj < 2; ++bj) { const int col = gate_slot_col((u.kind * 4 + u.pn) * 2 + bj);
#pragma unroll
            for (int ai = 0; ai < 2; ++ai)
#pragma unroll
                for (int m = 0; m < 4; ++m) { const f32x4 v0 = acc[ai][bj][m][0], v1 = acc[ai][bj][m][1];
                    const f32x2 a = sig255_pk((f32x2){v0[0], v0[1]}), b = sig255_pk((f32x2){v0[2], v0[3]}), c = sig255_pk((f32x2){v1[0], v1[1]}), d = sig255_pk((f32x2){v1[2], v1[3]});
                    u32x2 w; w.x = (unsigned)a.x | ((unsigned)a.y << 8) | ((unsigned)b.x << 16) | ((unsigned)b.y << 24);
                    w.y = (unsigned)c.x | ((unsigned)c.y << 8) | ((unsigned)d.x << 16) | ((unsigned)d.y << 24);
                    *(u32x2*)((unsigned char*)(P + (size_t)(row0 + ai * 128 + m * 16) * LDP + col) + wc * 32 + 8 * fq) = w; } }
    }
};
struct EpiBranch {
    static constexpr bool PERM = true, AFTER_DRAIN = false;
    const bf16* P; bf16* MG; const float* ssq;
    DI void operator()(const f32x4 (&acc)[2][2][4][2], const Unit& u, int wr, int wc, int fr, int fq) const {
        const int row0 = u.pm * 256 + wr * 64 + fr; const bool first = (u.aux & 1) != 0; const int grp = (u.aux >> 1) - 1;
        const int gc0 = gate_slot_col((u.kind * 4 + u.pn) * 2 + 0), gc1 = gate_slot_col((u.kind * 4 + u.pn) * 2 + 1);
#pragma unroll
        for (int ai = 0; ai < 2; ++ai) {
            u32x2 g8[4][2]; u32x4 o8[4][2]; f32x4 s4[4];
#pragma unroll
            for (int m = 0; m < 4; ++m) { const int row = row0 + ai * 128 + m * 16;
                s4[m] = *(const f32x4*)(ssq + (size_t)row * 8 + (grp > 0 ? 4 : 0));
#pragma unroll
                for (int bj = 0; bj < 2; ++bj) {
                    g8[m][bj] = *(const u32x2*)((const unsigned char*)(P + (size_t)row * LDP + (bj ? gc1 : gc0)) + wc * 32 + 8 * fq);
                    o8[m][bj] = *(const u32x4*)(MG + (size_t)row * 1024 + u.pn * 256 + bj * 128 + wc * 32 + 8 * fq); } }
            __builtin_amdgcn_sched_barrier(0);
#pragma unroll
            for (int m = 0; m < 4; ++m) { const int row = row0 + ai * 128 + m * 16;
                const float sc = (grp >= 0) ? __builtin_amdgcn_rsqf(((s4[m][0] + s4[m][1]) + (s4[m][2] + s4[m][3])) * (1.0f / 256.0f) + 1e-6f) : 1.0f;
#pragma unroll
                for (int bj = 0; bj < 2; ++bj) { float g[8], pv[8];
#pragma unroll
                    for (int j = 0; j < 4; ++j) { g[j] = (float)((g8[m][bj].x >> (8 * j)) & 0xffu) * (1.0f / 255.0f); g[4 + j] = (float)((g8[m][bj].y >> (8 * j)) & 0xffu) * (1.0f / 255.0f); }
                    unpack8(o8[m][bj], pv);
                    if (first) {
#pragma unroll
                        for (int j = 0; j < 8; ++j) pv[j] = 0.f; }
                    const f32x4 v0 = acc[ai][bj][m][0], v1 = acc[ai][bj][m][1];
                    float o[8] = { v0[0] * sc * g[0] + pv[0], v0[1] * sc * g[1] + pv[1], v0[2] * sc * g[2] + pv[2], v0[3] * sc * g[3] + pv[3], v1[0] * sc * g[4] + pv[4], v1[1] * sc * g[5] + pv[5], v1[2] * sc * g[6] + pv[6], v1[3] * sc * g[7] + pv[7] };
                    *(u32x4*)(MG + (size_t)row * 1024 + u.pn * 256 + bj * 128 + wc * 32 + 8 * fq) = pack8(o); } }
        }
    }
};
struct EpiP3 {
    static constexpr bool PERM = true, AFTER_DRAIN = false;
    EpiGate G; EpiBranch B;
    DI void operator()(const f32x4 (&acc)[2][2][4][2], const Unit& u, int wr, int wc, int fr, int fq) const { if (u.aux & 16) G(acc, u, wr, wc, fr, fq); else B(acc, u, wr, wc, fr, fq); }
};
struct SchedP4 {
    int G, c; const char* A; const char* B;
    DI bool next(int i, Unit& u) const {
        const long L = (long)i * G + c; if (L >= 64 * 4) return false;
        tile_map((int)L, 64, 4, u.pm, u.pn); u.kind = 0; u.aux = 0; u.nt = 16; u.lda = 1024; u.ldb = 1024; u.pad_ = 0;
        u.A = A + (size_t)u.pm * 256 * 1024 * 2; u.B = B + (size_t)u.pn * 256 * 1024 * 2; return true;
    }
    DI void a_ready(const Unit&) const {}
    DI void done(const Unit&) const {}
};
struct EpiRes {
    static constexpr bool PERM = false, AFTER_DRAIN = false;
    const float* res; float* out;
    DI void operator()(const f32x4 (&acc)[2][2][4][2], const Unit& u, int wr, int wc, int fr, int fq) const {
        const int row0 = u.pm * 256 + wr * 64 + fr, col0 = u.pn * 256 + wc * 32 + 4 * fq;
#pragma unroll
        for (int ai = 0; ai < 2; ++ai)
#pragma unroll
            for (int m = 0; m < 4; ++m) { const size_t off = (size_t)(row0 + ai * 128 + m * 16) * 1024 + col0;
#pragma unroll
                for (int bj = 0; bj < 2; ++bj)
#pragma unroll
                    for (int n = 0; n < 2; ++n) { const f32x4 r = *(const f32x4*)(res + off + bj * 128 + n * 16); *(f32x4*)(out + off + bj * 128 + n * 16) = r + acc[ai][bj][m][n]; } }
    }
};

template <bool LAST> struct EpiNorm {
    static constexpr bool PERM = false, AFTER_DRAIN = true;
    const float* res; float* out; const float* g; bf16* xn; float* xs; unsigned* cnt;
    DI void operator()(const f32x4 (&)[2][2][4][2], const Unit&, int, int, int, int) const {}
    DI void fused(f32x4 (&acc)[2][2][4][2], const Unit& u, int wr, int wc, int fr, int fq, PG8_LAS unsigned char* lds, int wid, int lane) const {
        PG8_LAS float* Pt = (PG8_LAS float*)lds; PG8_LAS float* St = Pt + 1024;
        const int row0 = u.pm * 256 + wr * 64 + fr, col0 = u.pn * 256 + wc * 32 + 4 * fq;
#pragma unroll
        for (int ai = 0; ai < 2; ++ai)
#pragma unroll
            for (int m = 0; m < 4; ++m) { const size_t off = (size_t)(row0 + ai * 128 + m * 16) * 1024 + col0; float s = 0.f;
#pragma unroll
                for (int bj = 0; bj < 2; ++bj)
#pragma unroll
                    for (int n = 0; n < 2; ++n) { const f32x4 r = *(const f32x4*)(res + off + bj * 128 + n * 16); const f32x4 x = r + acc[ai][bj][m][n]; acc[ai][bj][m][n] = x;
                        s += (x[0] * x[0] + x[1] * x[1]) + (x[2] * x[2] + x[3] * x[3]); }
                s += __shfl_xor(s, 16); s += __shfl_xor(s, 32);
                if (fq == 0) Pt[(ai * 128 + wr * 64 + m * 16 + fr) * 4 + wc] = s; }
        asm volatile("s_waitcnt lgkmcnt(0)" ::: "memory"); __builtin_amdgcn_s_barrier(); asm volatile("" ::: "memory");
        const int row = wid * 32 + (lane & 31);
        if (lane < 32) { const float t = (Pt[row * 4 + 0] + Pt[row * 4 + 1]) + (Pt[row * 4 + 2] + Pt[row * 4 + 3]);
            __hip_atomic_store(xs + ((size_t)u.pm * 256 + row) * 4 + u.pn, t, __ATOMIC_RELAXED, __HIP_MEMORY_SCOPE_AGENT); }
        asm volatile("s_waitcnt vmcnt(0)" ::: "memory");
        if (lane == 0) (void)__hip_atomic_fetch_add(cnt + u.pm * 64, 1u, __ATOMIC_RELAXED, __HIP_MEMORY_SCOPE_AGENT);
        if (wid == 0) { unsigned spins = 0;
            while ((unsigned)__builtin_amdgcn_readfirstlane(__hip_atomic_load(cnt + u.pm * 64, __ATOMIC_RELAXED, __HIP_MEMORY_SCOPE_AGENT)) < 32u) { __builtin_amdgcn_s_sleep(2); if (++spins > (1u << 22)) break; }
            __builtin_amdgcn_fence(__ATOMIC_ACQUIRE, "agent"); asm volatile("s_waitcnt vmcnt(0)" ::: "memory"); }
        asm volatile("" ::: "memory"); __builtin_amdgcn_s_barrier(); asm volatile("" ::: "memory");
        if (lane < 32) { const float* sp = xs + ((size_t)u.pm * 256 + row) * 4;
            const float a = __hip_atomic_load(sp + 0, __ATOMIC_RELAXED, __HIP_MEMORY_SCOPE_AGENT), b = __hip_atomic_load(sp + 1, __ATOMIC_RELAXED, __HIP_MEMORY_SCOPE_AGENT),
                        c = __hip_atomic_load(sp + 2, __ATOMIC_RELAXED, __HIP_MEMORY_SCOPE_AGENT), d = __hip_atomic_load(sp + 3, __ATOMIC_RELAXED, __HIP_MEMORY_SCOPE_AGENT);
            St[row] = __builtin_amdgcn_rsqf(((a + b) + (c + d)) * (1.0f / 1024.0f) + 1e-6f); }
        asm volatile("s_waitcnt lgkmcnt(0)" ::: "memory"); __builtin_amdgcn_s_barrier(); asm volatile("" ::: "memory");
#pragma unroll
        for (int ai = 0; ai < 2; ++ai)
#pragma unroll
            for (int m = 0; m < 4; ++m) { const size_t off = (size_t)(row0 + ai * 128 + m * 16) * 1024 + col0; const float rs = St[ai * 128 + wr * 64 + m * 16 + fr];
#pragma unroll
                for (int bj = 0; bj < 2; ++bj)
#pragma unroll
                    for (int n = 0; n < 2; ++n) { const f32x4 gv = *(const f32x4*)(g + col0 + bj * 128 + n * 16); const f32x4 x = acc[ai][bj][m][n]; const f32x4 y = x * rs * gv;
                        if (LAST) *(f32x4*)(out + off + bj * 128 + n * 16) = y;
                        else { *(f32x4*)(out + off + bj * 128 + n * 16) = x; *(u32x2*)(xn + off + bj * 128 + n * 16) = pack4(y); } } }
    }
};

DI void transpose_item(const float* W, int ldw, int K, bf16* WT, float* scr, int item, int nblk, int lane) {
    const int kb = item / nblk, nb = item % nblk, k0 = 64 * kb, n0 = 32 * nb;
#pragma unroll 16
    for (int i = 0; i < 32; ++i) { const int kk = 2 * i + (lane >> 5); scr[kk * 33 + (lane & 31)] = W[(size_t)(k0 + kk) * ldw + n0 + (lane & 31)]; }
    WAVE_LDS_SYNC();
    const int c = lane & 7;
#pragma unroll
    for (int j = 0; j < 4; ++j) { const int n = (lane >> 3) + 8 * j; const float* s = scr + (8 * c) * 33 + n;
        u32x4 o; o.x = pk2(s[0 * 33], s[1 * 33]); o.y = pk2(s[2 * 33], s[3 * 33]); o.z = pk2(s[4 * 33], s[5 * 33]); o.w = pk2(s[6 * 33], s[7 * 33]);
        *(u32x4*)(WT + (size_t)(n0 + n) * K + k0 + 8 * c) = o; }
    WAVE_LDS_SYNC();
}
struct TSeg { int inp, lstride, src0, ldw, K, nblk; unsigned dst_q, dst_rows0; };
DI void rms_row_bf16(const float* xrow, const float* g, bf16* orow, int lane) {
    const f32x4* xr = (const f32x4*)xrow + lane; const f32x4* gr = (const f32x4*)g + lane;
    f32x4 v[4]; float s = 0.f;
#pragma unroll
    for (int j = 0; j < 4; ++j) { v[j] = xr[64 * j]; s += (v[j][0] * v[j][0] + v[j][1] * v[j][1]) + (v[j][2] * v[j][2] + v[j][3] * v[j][3]); }
    const float rstd = __builtin_amdgcn_rsqf(wave_sum(s) * (1.0f / 1024.0f) + 1e-6f);
    u32x2* o8 = (u32x2*)orow + lane;
#pragma unroll
    for (int j = 0; j < 4; ++j) { const f32x4 gg = gr[64 * j]; u32x2 o; o.x = pk2(v[j][0] * rstd * gg[0], v[j][1] * rstd * gg[1]); o.y = pk2(v[j][2] * rstd * gg[2], v[j][3] * rstd * gg[3]); o8[64 * j] = o; }
}
DI void convert_weights(const Params& p, int l, unsigned char* lds) {
    const int tid = opaque_tid(), lane = tid & 63, wave = tid >> 6;
    const int gw = blockIdx.x * 8 + wave, NGW = gridDim.x * 8;
    float* scr = (float*)(lds + wave * 16384);
    static constexpr TSeg segs[] = {
        {I_WIN, 1024 * IN_TOTAL, 0,    IN_TOTAL, 1024, 2560 / 32, 32, 0},
        {I_WIN, 1024 * IN_TOTAL, 2576, IN_TOTAL, 1024, 512 / 32,  32, 2560},
        {I_WIN, 1024 * IN_TOTAL, 3088, IN_TOTAL, 1024, 1024 / 32, 32, 3072},
        {I_WIN, 1024 * IN_TOTAL, 4120, IN_TOTAL, 1024, 512 / 32,  32, 4096},
        {I_WIN, 1024 * IN_TOTAL, 4632, IN_TOTAL, 1024, 1664 / 32, 32, 4608},
        {I_WIN, 1024 * IN_TOTAL, 6296, IN_TOTAL, 1024, 512 / 32,  32, 6272},
        {I_WIN, 1024 * IN_TOTAL, 6808, IN_TOTAL, 1024, 256 / 32,  32, 6784},
        {I_WIN, 1024 * IN_TOTAL, 7064, IN_TOTAL, 1024, 5120 / 32, 88, 0},
        {I_URET,  512 * 1024, 0, 1024, 512, 32, 128, 0},
        {I_UGLA,  512 * 1024, 0, 1024, 512, 32, 128, 1024},
        {I_URWKV, 512 * 1024, 0, 1024, 512, 32, 128, 2048},
        {I_USSD,  512 * 1024, 0,          1024, 256, 32, 140, 0},
        {I_USSD,  512 * 1024, 256 * 1024, 1024, 256, 32, 140, 1024},
        {I_UMEM,  256 * 1024, 0, 1024, 256, 32, 144, 0},
        {I_WOUT, 1024 * 1024, 0, 1024, 1024, 32, 148, 0},
        {I_WKV,  1024 * 512,  0, 512,  1024, 16, 156, 0},
    };
    constexpr int NSEG = sizeof(segs) / sizeof(segs[0]);
    int base = 0;
    for (int s = 0; s < NSEG; ++s) {
        const TSeg sg = segs[s]; const int nitems = (sg.K / 64) * sg.nblk;
        int it = gw - (base % NGW); if (it < 0) it += NGW;
        const float* W = p.in[sg.inp] + (size_t)l * sg.lstride + sg.src0;
        bf16* WT = (bf16*)(p.ws + (size_t)sg.dst_q * 262144) + (size_t)sg.dst_rows0 * sg.K;
        for (; it < nitems; it += NGW) transpose_item(W, sg.ldw, sg.K, WT, scr, it, sg.nblk, lane);
        base += nitems;
    }
    for (int idx = blockIdx.x * NTHREADS + tid; idx < 128 * 1024; idx += gridDim.x * NTHREADS) {
        const int r = (idx >> 10) & 127, k = idx & 1023;
        const float* W = p.in[I_WIN] + (size_t)l * 1024 * IN_TOTAL + (size_t)k * IN_TOTAL;
        const float v = r < 16 ? W[2560 + r] : r < 24 ? W[4112 + (r - 16)] : 0.0f;
        ((bf16*)(p.ws + WS_W1T))[((size_t)7040 + r) * 1024 + k] = (bf16)f2bf(v);
    }
}
DI void rms_rows2_bf16(const float* x0, const float* x1, const float* g, bf16* o0, bf16* o1, int lane) {
    const f32x4* xa = (const f32x4*)x0 + lane; const f32x4* xb = (const f32x4*)x1 + lane; const f32x4* gr = (const f32x4*)g + lane;
    f32x4 va[4], vb[4]; float sa = 0.f, sb = 0.f;
#pragma unroll
    for (int j = 0; j < 4; ++j) { va[j] = xa[64 * j]; vb[j] = xb[64 * j]; }
#pragma unroll
    for (int j = 0; j < 4; ++j) { sa += (va[j][0] * va[j][0] + va[j][1] * va[j][1]) + (va[j][2] * va[j][2] + va[j][3] * va[j][3]); sb += (vb[j][0] * vb[j][0] + vb[j][1] * vb[j][1]) + (vb[j][2] * vb[j][2] + vb[j][3] * vb[j][3]); }
    const float ra = __builtin_amdgcn_rsqf(wave_sum(sa) * (1.0f / 1024.0f) + 1e-6f), rb = __builtin_amdgcn_rsqf(wave_sum(sb) * (1.0f / 1024.0f) + 1e-6f);
    u32x2* pa = (u32x2*)o0 + lane; u32x2* pb = (u32x2*)o1 + lane;
#pragma unroll
    for (int j = 0; j < 4; ++j) { const f32x4 gg = gr[64 * j]; u32x2 o; o.x = pk2(va[j][0] * ra * gg[0], va[j][1] * ra * gg[1]); o.y = pk2(va[j][2] * ra * gg[2], va[j][3] * ra * gg[3]); pa[64 * j] = o;
        o.x = pk2(vb[j][0] * rb * gg[0], vb[j][1] * rb * gg[1]); o.y = pk2(vb[j][2] * rb * gg[2], vb[j][3] * rb * gg[3]); pb[64 * j] = o; }
}
DI void phase_prologue(const Params& p, unsigned char* lds) {
    const int tid = opaque_tid(), lane = tid & 63, wave = tid >> 6;
    const int gw = blockIdx.x * 8 + wave, NGW = gridDim.x * 8;
    convert_weights(p, 0, lds);
    for (int m = gw; m < M; m += 2 * NGW) { const int m1 = m + NGW;
        if (m1 < M) rms_rows2_bf16(p.in[I_X] + (size_t)m * 1024, p.in[I_X] + (size_t)m1 * 1024, p.in[I_NORMG], (bf16*)(p.ws + WS_XN) + (size_t)m * 1024, (bf16*)(p.ws + WS_XN) + (size_t)m1 * 1024, lane);
        else rms_row_bf16(p.in[I_X] + (size_t)m * 1024, p.in[I_NORMG], (bf16*)(p.ws + WS_XN) + (size_t)m * 1024, lane); }
    for (int m = gw; m < 2048; m += NGW) { const int l = m >> 10, r = m & 1023;
        rms_row_bf16(p.in[I_MEM] + (size_t)r * 1024, p.in[I_MNORMG] + l * 1024, (bf16*)(p.ws + WS_MEMN) + (size_t)m * 1024, lane); }
}
DI void phase_norm(const Params& p, int l, float oscale, unsigned char* lds) {
    const int tid = opaque_tid(), lane = tid & 63, wave = tid >> 6;
    const int gw = blockIdx.x * 8 + wave, NGW = gridDim.x * 8;
    if (l == 0) { convert_weights(p, 1, lds); for (int m = gw; m < M; m += NGW) rms_row_bf16(p.out + (size_t)m * 1024, p.in[I_NORMG] + 1024, (bf16*)(p.ws + WS_XN) + (size_t)m * 1024, lane); }
    else {
        for (int m = gw; m < M; m += NGW) {
            f32x4* xr = (f32x4*)(p.out + (size_t)m * 1024) + lane; const f32x4* gr = (const f32x4*)p.in[I_FNORMG] + lane;
            f32x4 v[4]; float s = 0.f;
#pragma unroll
            for (int j = 0; j < 4; ++j) { v[j] = xr[64 * j]; s += (v[j][0] * v[j][0] + v[j][1] * v[j][1]) + (v[j][2] * v[j][2] + v[j][3] * v[j][3]); }
            const float rstd = __builtin_amdgcn_rsqf(wave_sum(s) * (1.0f / 1024.0f) + 1e-6f);
#pragma unroll
            for (int j = 0; j < 4; ++j) xr[64 * j] = v[j] * (rstd * oscale) * gr[64 * j];
        }
    }
}

#define XB_TMO      128
#define XB_XCNT(j)  (256  + 64 * (j))
#define XB_XSUB(j)  (1280 + 64 * (j))
#define XB_XGEN(j)  (2304 + 64 * (j))
#define XB_TOP      3328
#define XB_TOPGEN   3392
#define XCD_BAR_WORDS 3456
#define XB_SPIN_CAP (1u << 18)

__device__ __forceinline__ unsigned xb_ld(unsigned* p)              { return __hip_atomic_load(p, __ATOMIC_RELAXED, __HIP_MEMORY_SCOPE_AGENT); }
__device__ __forceinline__ unsigned xb_add(unsigned* p, unsigned v) { return __hip_atomic_fetch_add(p, v, __ATOMIC_RELAXED, __HIP_MEMORY_SCOPE_AGENT); }
__device__ __forceinline__ unsigned xb_xcc_id() { return (unsigned)__builtin_amdgcn_s_getreg((3 << 11) | 20) & 0xFu; }
#define XB_SPIN(cond, bar) do { unsigned _sp = 0; while (cond) { __builtin_amdgcn_s_sleep(1); \
    if ((++_sp & 255u) == 0u) { if (xb_ld(&(bar)[XB_TMO])) break; if (_sp > XB_SPIN_CAP) { atomicAdd(&(bar)[XB_TMO], 1u); break; } } } } while (0)

struct XcdBarrier {
    unsigned* bar; unsigned x;
    volatile unsigned* st;
};

__device__ __forceinline__ XcdBarrier xcd_barrier_post(unsigned* bar, volatile unsigned* st) {
    XcdBarrier b; b.bar = bar; b.x = xb_xcc_id(); b.st = st;
    if (threadIdx.x == 0) (void)xb_add(&bar[XB_XCNT(b.x)], 1u);
    return b;
}
__device__ __forceinline__ void xcd_barrier_complete(unsigned* bar, unsigned x, unsigned& nloc, unsigned& nx) {
    const unsigned G = gridDim.x * gridDim.y * gridDim.z;
    unsigned sum, cnt, mine, sp = 0u;
    for (;;) {
        sum = 0u; cnt = 0u; mine = 0u;
#pragma unroll
        for (unsigned j = 0; j < 16; ++j) { const unsigned c = xb_ld(&bar[XB_XCNT(j)]); sum += c; cnt += (c > 0u) ? 1u : 0u; mine = (j == x) ? c : mine; }
        if (sum == G) break;
        __builtin_amdgcn_s_sleep(1);
        if ((++sp & 255u) == 0u) { if (xb_ld(&bar[XB_TMO])) break; if (sp > XB_SPIN_CAP) { atomicAdd(&bar[XB_TMO], 1u); break; } }
    }
    nloc = mine > 0u ? mine : 1u; nx = cnt > 0u ? cnt : 1u;
}

__device__ __forceinline__ void xcd_barrier(const XcdBarrier& b) {
    asm volatile("s_waitcnt vmcnt(0)" ::: "memory");
    __syncthreads();
    if (threadIdx.x == 0) {
        unsigned* bar = b.bar;
        __builtin_amdgcn_s_waitcnt(0);
        unsigned nloc = b.st[0], nx = b.st[1];
        if (nloc == 0u) { xcd_barrier_complete(bar, b.x, nloc, nx); b.st[0] = nloc; b.st[1] = nx; }
        const unsigned old = xb_add(&bar[XB_XSUB(b.x)], 1u);
        const unsigned gen = old / nloc;
        if (old + 1u == (gen + 1u) * nloc) {
            __builtin_amdgcn_fence(__ATOMIC_RELEASE, "agent");
            asm volatile("s_waitcnt vmcnt(0)" ::: "memory");
            const unsigned og = xb_add(&bar[XB_TOP], 1u);
            const unsigned tg = og / nx;
            if (og + 1u == (tg + 1u) * nx) xb_add(&bar[XB_TOPGEN], 1u);
            else XB_SPIN(xb_ld(&bar[XB_TOPGEN]) == tg, bar);
            __builtin_amdgcn_fence(__ATOMIC_ACQUIRE, "agent");
            xb_add(&bar[XB_XGEN(b.x)], 1u);
            asm volatile("s_waitcnt vmcnt(0)" ::: "memory");
        } else {
            XB_SPIN(xb_ld(&bar[XB_XGEN(b.x)]) == gen, bar);
            __builtin_amdgcn_fence(__ATOMIC_ACQUIRE, "agent");
            asm volatile("s_waitcnt vmcnt(0)" ::: "memory");
        }
    }
    __syncthreads();
}

DI void sincos_red(float ang, float& s, float& c) {
    const float n = rintf(ang * 0.15915494309189535f); float r = fmaf(-n, 6.28318548202514648f, ang); r = fmaf(-n, -1.7484555e-7f, r);
    s = __sinf(r); c = __cosf(r);
}

typedef short s16x4 __attribute__((ext_vector_type(4)));
DI s16x4 lds_tr(const bf16* p) { return __builtin_amdgcn_ds_read_tr16_b64_v4i16((__attribute__((address_space(3))) s16x4*)p); }
DI bf16x8 frag_tr(const bf16* base, int ld, int r0, int k0, int lane) {
    const bf16* p = base + (k0 + 8 * (lane >> 4) + ((lane & 15) >> 2)) * ld + r0 + 4 * (lane & 3);
    const s16x4 lo = lds_tr(p), hi = lds_tr(p + 4 * ld);
    return (bf16x8){lo[0], lo[1], lo[2], lo[3], hi[0], hi[1], hi[2], hi[3]};
}
DI bf16x8 frag_tr_perm(const bf16* base, int ld, int r0, int k0, int lane) {
    const bf16* p = base + (k0 + 4 * (lane >> 4) + ((lane & 15) >> 2)) * ld + r0 + 4 * (lane & 3);
    const s16x4 lo = lds_tr(p), hi = lds_tr(p + 16 * ld);
    return (bf16x8){lo[0], lo[1], lo[2], lo[3], hi[0], hi[1], hi[2], hi[3]};
}
constexpr int QK_QIN = 0, QK_KIN = 9216, QK_QC = 18432, QK_KST = 27648, QK_VT = 36864, QK_GKL = 55296, QK_INV = 59392, QK_ST = 64512, QK_CUM = 82944, QK_TOT = 99328, QK_RED = 101376, QK_ELAST = 103424;
template <bool GLA>
DI void qkv_item(const Params& p, int l, unsigned char* lds, int b, int h, int sc, bool full, bool dry = false) {
    const int tid = opaque_tid(), lane = tid & 63, w = tid >> 6, q4 = lane >> 4, l15 = lane & 15;
    bf16* P = (bf16*)(p.ws + WS_P);
    bf16* QIN = (bf16*)(lds + QK_QIN); bf16* KIN = (bf16*)(lds + QK_KIN); bf16* QC = (bf16*)(lds + QK_QC); bf16* KST = (bf16*)(lds + QK_KST);
    bf16* VT = (bf16*)(lds + QK_VT); bf16* ST = (bf16*)(lds + QK_ST);
    float* GKL = (float*)(lds + QK_GKL); float* INV = (float*)(lds + QK_INV);
    float* CUM = (float*)(lds + QK_CUM); float* TOT = (float*)(lds + QK_TOT); float* RED = (float*)(lds + QK_RED); float* ELAST = (float*)(lds + QK_ELAST);
    const int cq = GLA ? C_GQ : C_RQ, ck = GLA ? C_GK : C_RK, cv = GLA ? C_GV : C_RV, cgate = GLA ? C_GG : C_RG;
    const int bh = b * 4 + h;
    float* Lst = (float*)(p.ws + (GLA ? WS_GLAL : WS_RETL)) + (size_t)(bh * 16 + sc) * 8192;
    const float lgam = __logf(1.0f - exp2f(-5.0f - (float)h));
    const int st_t = tid >> 3, st_cg = tid & 7;
    f32x4 sacc[4];
#pragma unroll
    for (int mt = 0; mt < 4; ++mt) {
        if (full) { for (int j = 0; j < 4; ++j) sacc[mt][j] = Lst[(16 * mt + 4 * q4 + j) * 128 + 16 * w + l15]; *(u32x2*)(ST + (16 * w + l15) * 72 + 16 * mt + 4 * q4) = pack4(sacc[mt]); }
        else sacc[mt] = (f32x4){0.f, 0.f, 0.f, 0.f};
    }
    f32x4 gng = (f32x4){1.f, 1.f, 1.f, 1.f}; if (GLA) gng = *(const f32x4*)(p.in[I_GNORMG] + l * 128 + 16 * w + 4 * q4);
    float w2c[16], gb = 0.f;
    if (GLA) { const int ch = h * 64 + lane;
#pragma unroll
        for (int j = 0; j < 16; ++j) w2c[j] = p.in[I_GKW2][(size_t)l * 16 * 256 + j * 256 + ch];
        gb = p.in[I_GKB][l * 256 + ch]; }
    else if (tid < 32) INV[tid] = 1.0f / powf(10000.0f, (float)tid * (1.0f / 31.0f));
    u32x4 pq, pk, pv0, pv1, pg = (u32x4){0u, 0u, 0u, 0u}; int ipos = 0;
    {   const size_t ro = (size_t)(b * T + sc * 256 + st_t) * LDP;
        pq = *(const u32x4*)(P + ro + cq + h * 64 + 8 * st_cg); pk = *(const u32x4*)(P + ro + ck + h * 64 + 8 * st_cg);
        pv0 = *(const u32x4*)(P + ro + cv + h * 128 + 8 * st_cg); pv1 = *(const u32x4*)(P + ro + cv + h * 128 + 64 + 8 * st_cg);
        if (GLA) { if (st_cg < 2) { float g8[8]; unpack8(*(const u32x4*)(P + ro + C_GKL + 8 * st_cg), g8);
                *(f32x4*)(GKL + st_t * 16 + 8 * st_cg) = (f32x4){g8[0], g8[1], g8[2], g8[3]}; *(f32x4*)(GKL + st_t * 16 + 8 * st_cg + 4) = (f32x4){g8[4], g8[5], g8[6], g8[7]}; } }
        else ipos = ((const int*)p.in[I_POS])[b * T + sc * 256 + st_t]; }
    __syncthreads();
    float dtot = 0.f;
    for (int c = 0; c < 4; ++c) {
        const int t0 = sc * 256 + c * 64, m0 = b * T + t0;
        if (GLA) {
            float cumv[8]; float run = 0.f;
#pragma unroll
            for (int i = 0; i < 8; ++i) { const float* gp = GKL + (8 * w + i) * 16; float x = gb;
#pragma unroll
                for (int j4 = 0; j4 < 4; ++j4) { const f32x4 g = *(const f32x4*)(gp + 4 * j4); x += g[0] * w2c[4 * j4] + g[1] * w2c[4 * j4 + 1] + g[2] * w2c[4 * j4 + 2] + g[3] * w2c[4 * j4 + 3]; }
                run += logsigmoidf_(x) * (1.0f / 16.0f); cumv[i] = run; }
            TOT[w * 64 + lane] = run;
            __syncthreads();
            float off = 0.f;
            for (int ww = 0; ww < w; ++ww) off += TOT[ww * 64 + lane];
#pragma unroll
            for (int i = 0; i < 8; ++i) CUM[(8 * w + i) * 64 + lane] = cumv[i] + off;
            __syncthreads();
        }
        {
            const int t = st_t, cg = st_cg;
            float qf[8], kf[8]; unpack8(pq, qf); unpack8(pk, kf);
            float fqin[8], fkin[8], fqc[8], fkst[8];
            if (GLA) {
#pragma unroll
                for (int i = 0; i < 8; ++i) { const float cu = CUM[t * 64 + 8 * cg + i], rf = CUM[32 * 64 + 8 * cg + i], la = CUM[63 * 64 + 8 * cg + i];
                    qf[i] *= 0.125f; fqin[i] = fexp(cu - rf); fkin[i] = fexp(rf - cu); fqc[i] = fexp(cu); fkst[i] = fexp(la - cu); }
            } else {
                const float ppos = (float)ipos;
#pragma unroll
                for (int i = 0; i < 4; ++i) { float sn, cs; sincos_red(ppos * INV[4 * cg + i], sn, cs);
                    const float q1 = qf[2 * i], q2 = qf[2 * i + 1], k1 = kf[2 * i], k2 = kf[2 * i + 1];
                    qf[2 * i] = q1 * cs - q2 * sn; qf[2 * i + 1] = q2 * cs + q1 * sn;
                    kf[2 * i] = (k1 * cs - k2 * sn) * 0.125f; kf[2 * i + 1] = (k2 * cs + k1 * sn) * 0.125f; }
                const float e = (float)(t + 1); const float a = fexp((e - 33.0f) * lgam), bq = fexp((33.0f - e) * lgam), cc = fexp(e * lgam), dd = fexp((64.0f - e) * lgam);
#pragma unroll
                for (int i = 0; i < 8; ++i) { fqin[i] = a; fkin[i] = bq; fqc[i] = cc; fkst[i] = dd; }
            }
            if (full) { float o1[8], o2[8], o3[8];
#pragma unroll
                for (int i = 0; i < 8; ++i) { o1[i] = qf[i] * fqin[i]; o2[i] = qf[i] * fqc[i]; o3[i] = kf[i] * fkin[i]; }
                *(u32x4*)(QIN + t * 72 + 8 * cg) = pack8(o1); *(u32x4*)(QC + t * 72 + 8 * cg) = pack8(o2); *(u32x4*)(KIN + t * 72 + 8 * cg) = pack8(o3); }
            { float o4[8];
#pragma unroll
              for (int i = 0; i < 8; ++i) o4[i] = kf[i] * fkst[i];
              *(u32x4*)(KST + t * 72 + 8 * cg) = pack8(o4); }
            *(u32x4*)(VT + t * 136 + 8 * cg) = pv0; *(u32x4*)(VT + t * 136 + 64 + 8 * cg) = pv1;
            if (tid < 64) { const float la = GLA ? CUM[63 * 64 + tid] : 64.0f * lgam; ELAST[tid] = fexp(la); dtot += la; }
            if (c < 3) {
                const size_t ro = (size_t)(m0 + 64 + t) * LDP;
                pq = *(const u32x4*)(P + ro + cq + h * 64 + 8 * cg); pk = *(const u32x4*)(P + ro + ck + h * 64 + 8 * cg);
                pv0 = *(const u32x4*)(P + ro + cv + h * 128 + 8 * cg); pv1 = *(const u32x4*)(P + ro + cv + h * 128 + 64 + 8 * cg);
                if (GLA) pg = *(const u32x4*)(P + ro + C_GKL + 8 * (cg & 1));
                else ipos = ((const int*)p.in[I_POS])[b * T + t0 + 64 + t]; }
        }
        __syncthreads();
        if (full) {
            u32x2 g2[4];
#pragma unroll
            for (int tt = 0; tt < 4; ++tt) g2[tt] = *(const u32x2*)(P + (size_t)(m0 + 16 * tt + l15) * LDP + cgate + h * 128 + 16 * w + 4 * q4);
            f32x4 oacc[4];
#pragma unroll
            for (int tt = 0; tt < 4; ++tt) {
                oacc[tt] = (f32x4){0.f, 0.f, 0.f, 0.f};
#pragma unroll
                for (int kk = 0; kk < 2; ++kk) oacc[tt] = mfma16(frag(ST, 72, 16 * w, 32 * kk, lane), frag(QC, 72, 16 * tt, 32 * kk, lane), oacc[tt]);
                const bf16x8 qa = frag(QIN, 72, 16 * tt, 0, lane), qb = frag(QIN, 72, 16 * tt, 32, lane);
                u32x2 pp[4];
#pragma unroll
                for (int st = 0; st < 4; ++st) {
                    if (st <= tt) { f32x4 a = (f32x4){0.f, 0.f, 0.f, 0.f};
                        a = mfma16(frag(KIN, 72, 16 * st, 0, lane), qa, a); a = mfma16(frag(KIN, 72, 16 * st, 32, lane), qb, a);
                        if (st == tt) {
#pragma unroll
                            for (int j = 0; j < 4; ++j) if (4 * q4 + j > l15) a[j] = 0.f; }
                        pp[st] = pack4(a); }
                    else pp[st] = (u32x2){0u, 0u}; }
#pragma unroll
                for (int kk2 = 0; kk2 < 2; ++kk2) { if (2 * kk2 <= tt) {
                        u32x4 pw; pw.x = pp[2 * kk2].x; pw.y = pp[2 * kk2].y; pw.z = pp[2 * kk2 + 1].x; pw.w = pp[2 * kk2 + 1].y;
                        oacc[tt] = mfma16(frag_tr_perm(VT, 136, 16 * w, 32 * kk2, lane), __builtin_bit_cast(bf16x8, pw), oacc[tt]); } }
                float ss = (oacc[tt][0] * oacc[tt][0] + oacc[tt][1] * oacc[tt][1]) + (oacc[tt][2] * oacc[tt][2] + oacc[tt][3] * oacc[tt][3]);
                ss += __shfl_xor(ss, 16); ss += __shfl_xor(ss, 32);
                if (q4 == 0) RED[(16 * tt + l15) * 8 + w] = ss; }
            __syncthreads();
#pragma unroll
            for (int tt = 0; tt < 4; ++tt) { const f32x4 r0 = *(const f32x4*)(RED + (16 * tt + l15) * 8), r1 = *(const f32x4*)(RED + (16 * tt + l15) * 8 + 4);
                const float rstd = __builtin_amdgcn_rsqf(((r0[0] + r0[1]) + (r0[2] + r0[3]) + (r1[0] + r1[1]) + (r1[2] + r1[3])) * (1.0f / 128.0f) + 1e-6f);
                bf16* gp = P + (size_t)(m0 + 16 * tt + l15) * LDP + cgate + h * 128 + 16 * w + 4 * q4;
                const float g[4] = {lo16(g2[tt].x), hi16(g2[tt].x), lo16(g2[tt].y), hi16(g2[tt].y)};
                f32x4 o;
#pragma unroll
                for (int j = 0; j < 4; ++j) { float v = oacc[tt][j] * rstd; if (GLA) v *= gng[j]; o[j] = v * siluf_(g[j]); }
                if (!dry) *(u32x2*)gp = pack4(o); }
        }
#pragma unroll
        for (int mt = 0; mt < 4; ++mt) {
            const f32x4 el = *(const f32x4*)(ELAST + 16 * mt + 4 * q4);
            sacc[mt] = sacc[mt] * el;
#pragma unroll
            for (int kk = 0; kk < 2; ++kk) sacc[mt] = mfma16(frag_tr(KST, 72, 16 * mt, 32 * kk, lane), frag_tr(VT, 136, 16 * w, 32 * kk, lane), sacc[mt]);
            if (full) *(u32x2*)(ST + (16 * w + l15) * 72 + 16 * mt + 4 * q4) = pack4(sacc[mt]);
        }
        if (GLA && c < 3 && st_cg < 2) { float g8[8]; unpack8(pg, g8);
            *(f32x4*)(GKL + st_t * 16 + 8 * st_cg) = (f32x4){g8[0], g8[1], g8[2], g8[3]}; *(f32x4*)(GKL + st_t * 16 + 8 * st_cg + 4) = (f32x4){g8[4], g8[5], g8[6], g8[7]}; }
        __syncthreads();
    }
    if (!full) {
#pragma unroll
        for (int mt = 0; mt < 4; ++mt)
#pragma unroll
            for (int j = 0; j < 4; ++j) Lst[(16 * mt + 4 * q4 + j) * 128 + 16 * w + l15] = sacc[mt][j];
        if (GLA && tid < 64) ((float*)(p.ws + WS_DG))[(bh * 16 + sc) * 64 + tid] = fexp(dtot);
    }
}

constexpr int SD_CS = 0, SD_BS = 17408, SD_BT = 34816, SD_XT = 53248, SD_XST = 62464, SD_PS = 71680, SD_ST = 80896, SD_DT = 98304, SD_CUM = 98560, SD_RED = 98816, SD_CW = 99840;
DI void conv8(const Params& p, int l, const bf16* P, int b, int tpos, int ch, float* y) {
    const float* cw = p.in[I_CONVW] + (size_t)l * 4 * 1024; const float* cb = p.in[I_CONVB] + l * 1024;
    const f32x4 b0 = *(const f32x4*)(cb + ch), b1 = *(const f32x4*)(cb + ch + 4);
    float acc[8] = {b0[0], b0[1], b0[2], b0[3], b1[0], b1[1], b1[2], b1[3]};
#pragma unroll
    for (int j = 0; j < 4; ++j) { const int tp = tpos - 3 + j;
        if (tp >= 0) { float x[8]; unpack8(*(const u32x4*)(P + (size_t)(b * T + tp) * LDP + C_SX + ch), x);
            const f32x4 w0 = *(const f32x4*)(cw + j * 1024 + ch), w1 = *(const f32x4*)(cw + j * 1024 + ch + 4);
            acc[0] += w0[0] * x[0]; acc[1] += w0[1] * x[1]; acc[2] += w0[2] * x[2]; acc[3] += w0[3] * x[3];
            acc[4] += w1[0] * x[4]; acc[5] += w1[1] * x[5]; acc[6] += w1[2] * x[6]; acc[7] += w1[3] * x[7]; } }
#pragma unroll
    for (int i = 0; i < 8; ++i) y[i] = siluf_(acc[i]);
}
DI void conv_rows(const bf16* P, int b, int tpos, int ch, u32x4 (&xr)[7]) {
#pragma unroll
    for (int r = 0; r < 7; ++r) { const int tp = tpos - 3 + r; xr[r] = *(const u32x4*)(P + (size_t)(b * T + (tp < 0 ? 0 : tp)) * LDP + C_SX + ch); }
}
DI void conv_apply(const float* cwl, int lc, const u32x4 (&xr)[7], int tpos, float (&y)[4][8]) {
    { const f32x4 b0 = *(const f32x4*)(cwl + 4 * 320 + lc), b1 = *(const f32x4*)(cwl + 4 * 320 + lc + 4);
#pragma unroll
        for (int o = 0; o < 4; ++o) { y[o][0] = b0[0]; y[o][1] = b0[1]; y[o][2] = b0[2]; y[o][3] = b0[3]; y[o][4] = b1[0]; y[o][5] = b1[1]; y[o][6] = b1[2]; y[o][7] = b1[3]; } }
#pragma unroll
    for (int j = 0; j < 4; ++j) { const f32x4 w0 = *(const f32x4*)(cwl + j * 320 + lc), w1 = *(const f32x4*)(cwl + j * 320 + lc + 4);
        const float wv[8] = {w0[0], w0[1], w0[2], w0[3], w1[0], w1[1], w1[2], w1[3]};
#pragma unroll
        for (int o = 0; o < 4; ++o) { float x[8]; unpack8(xr[o + j], x);
            if (tpos - 3 + o + j < 0) {
#pragma unroll
                for (int i = 0; i < 8; ++i) x[i] = 0.f; }
#pragma unroll
            for (int i = 0; i < 8; ++i) y[o][i] += wv[i] * x[i]; } }
#pragma unroll
    for (int o = 0; o < 4; ++o)
#pragma unroll
        for (int i = 0; i < 8; i += 2) { const f32x2 v = {y[o][i], y[o][i + 1]}; const f32x2 r = v * sig_pk(v); y[o][i] = r.x; y[o][i + 1] = r.y; }
}
DI void ssd_item(const Params& p, int l, unsigned char* lds, int b, int h, int sc, bool full, bool dry = false) {
    const int tid = opaque_tid(), lane = tid & 63, w = tid >> 6, q4 = lane >> 4, l15 = lane & 15;
    bf16* P = (bf16*)(p.ws + WS_P);
    bf16* CS = (bf16*)(lds + SD_CS); bf16* BS = (bf16*)(lds + SD_BS); bf16* XT = (bf16*)(lds + SD_XT); bf16* XST = (bf16*)(lds + SD_XST);
    bf16* ST = (bf16*)(lds + SD_ST);
    float* DTL = (float*)(lds + SD_DT); float* CUMS = (float*)(lds + SD_CUM); float* RED = (float*)(lds + SD_RED);
    const int g = h >> 2, bh = b * 8 + h;
    float* Lst = (float*)(p.ws + WS_SSDL) + (size_t)(bh * 16 + sc) * 8192;
    const float a_h = -fexp(p.in[I_ALOG][l * 8 + h]), dtb = p.in[I_DTB][l * 8 + h], dsk = p.in[I_SD][l * 8 + h];
    const int pt = w & 3, wh = w >> 2;
    const f32x4 sng = *(const f32x4*)(p.in[I_SNORMG] + l * 512 + h * 64 + 16 * pt + 4 * q4);
    const int r_cgi = tid & 31, r_seg = tid >> 5; const bool r_isB = r_cgi >= 16; const int r_cg = r_cgi & 15;
    const int r_ch = (r_isB ? 512 : 768) + g * 128 + 8 * r_cg, r_lc = (r_isB ? 128 : 0) + 8 * r_cg;
    f32x4 sacc[4];
#pragma unroll
    for (int i = 0; i < 4; ++i) { const int nt = 4 * wh + i;
        if (full) { for (int j = 0; j < 4; ++j) sacc[i][j] = Lst[(16 * nt + 4 * q4 + j) * 64 + 16 * pt + l15]; *(u32x2*)(ST + (16 * pt + l15) * 136 + 16 * nt + 4 * q4) = pack4(sacc[i]); }
        else sacc[i] = (f32x4){0.f, 0.f, 0.f, 0.f}; }
    float* CWL = (float*)(lds + SD_CW);
    {
        float cwv[4];
#pragma unroll
        for (int r4 = 0; r4 < 4; ++r4) { const int idx0 = tid + r4 * NTHREADS, idx = idx0 < 1600 ? idx0 : 1599; const int row = idx / 320, ci = idx - row * 320;
            const int gch = ci < 128 ? 768 + g * 128 + ci : ci < 256 ? 512 + g * 128 + (ci - 128) : h * 64 + (ci - 256);
            const float* src = row < 4 ? p.in[I_CONVW] + (size_t)l * 4096 + row * 1024 + gch : p.in[I_CONVB] + l * 1024 + gch;
            cwv[r4] = *src; }
#pragma unroll
        for (int r4 = 0; r4 < 4; ++r4) { const int idx0 = tid + r4 * NTHREADS; if (idx0 < 1600) CWL[idx0] = cwv[r4]; }
    }
    u32x4 xbc[7]; conv_rows(P, b, sc * 256 + 4 * r_seg, r_ch, xbc);
    unsigned dtraw = (unsigned)P[(size_t)(b * T + sc * 256 + lane) * LDP + C_SDT + h];
    float ltot = 0.f;
    for (int c = 0; c < 4; ++c) {
        const int t0 = sc * 256 + c * 64, m0 = b * T + t0;
        if (w == 0) {
            const float dt = softplusf_(bf2f(dtraw) + dtb); float cu = dt * a_h;
#pragma unroll
            for (int o = 1; o < 64; o <<= 1) { const float n = __shfl_up(cu, o); if (lane >= o) cu += n; }
            DTL[lane] = dt; CUMS[lane] = cu;
        }
        if (c < 3) dtraw = (unsigned)P[(size_t)(m0 + 64 + lane) * LDP + C_SDT + h];
        __syncthreads();
        const float clast = CUMS[63];
        ltot += clast;
        {
            u32x4 xx[7];
            conv_rows(P, b, t0 + 4 * ((tid & 127) >> 3), h * 64 + 8 * (tid & 7), xx);
            { float y[4][8]; conv_apply(CWL, r_lc, xbc, t0 + 4 * r_seg, y);
#pragma unroll
                for (int o = 0; o < 4; ++o) { const int t = 4 * r_seg + o; *(u32x4*)((r_isB ? BS : CS) + t * 136 + 8 * r_cg) = pack8(y[o]); }
            }
            if (tid < 128) { const int cg = tid & 7, seg = tid >> 3; float y[4][8]; conv_apply(CWL, 256 + 8 * cg, xx, t0 + 4 * seg, y);
                float coef[4];
#pragma unroll
                for (int o = 0; o < 4; ++o) coef[o] = fexp(clast - CUMS[4 * seg + o]) * DTL[4 * seg + o];
#pragma unroll
                for (int o = 0; o < 4; ++o) { float ys[8];
#pragma unroll
                    for (int i = 0; i < 8; ++i) ys[i] = y[o][i] * coef[o];
                    *(u32x4*)(XT + (4 * seg + o) * 72 + 8 * cg) = pack8(y[o]); *(u32x4*)(XST + (4 * seg + o) * 72 + 8 * cg) = pack8(ys); } }
            if (c < 3) conv_rows(P, b, t0 + 64 + 4 * r_seg, r_ch, xbc);
        }
        __syncthreads();
        if (full) {
#pragma unroll
            for (int i = 0; i < 2; ++i) { const int tt = 2 * wh + i, t = 16 * tt + l15;
                bf16* zp = P + (size_t)(m0 + t) * LDP + C_SZ + h * 64 + 16 * pt + 4 * q4;
                const u32x2 z2 = *(const u32x2*)zp;
                bf16x8 cf[4];
#pragma unroll
                for (int kk = 0; kk < 4; ++kk) cf[kk] = frag(CS, 136, 16 * tt, 32 * kk, lane);
                f32x4 oacc = (f32x4){0.f, 0.f, 0.f, 0.f};
#pragma unroll
                for (int kk = 0; kk < 4; ++kk) oacc = mfma16(frag(ST, 136, 16 * pt, 32 * kk, lane), cf[kk], oacc);
                const float ct = CUMS[t];
                oacc = oacc * fexp(ct);
                u32x2 pp[4];
#pragma unroll
                for (int st = 0; st < 4; ++st) {
                    if (st <= tt) { f32x4 a = (f32x4){0.f, 0.f, 0.f, 0.f};
#pragma unroll
                        for (int kk = 0; kk < 4; ++kk) a = mfma16(frag(BS, 136, 16 * st, 32 * kk, lane), cf[kk], a);
                        const f32x4 cs4 = *(const f32x4*)(CUMS + 16 * st + 4 * q4), dt4 = *(const f32x4*)(DTL + 16 * st + 4 * q4);
#pragma unroll
                        for (int j = 0; j < 4; ++j) a[j] = (16 * st + 4 * q4 + j <= t) ? a[j] * fexp(ct - cs4[j]) * dt4[j] : 0.f;
                        pp[st] = pack4(a); }
                    else pp[st] = (u32x2){0u, 0u}; }
#pragma unroll
                for (int kk2 = 0; kk2 < 2; ++kk2) { if (2 * kk2 <= tt) {
                        u32x4 pw; pw.x = pp[2 * kk2].x; pw.y = pp[2 * kk2].y; pw.z = pp[2 * kk2 + 1].x; pw.w = pp[2 * kk2 + 1].y;
                        oacc = mfma16(frag_tr_perm(XT, 72, 16 * pt, 32 * kk2, lane), __builtin_bit_cast(bf16x8, pw), oacc); } }
                const float z[4] = {lo16(z2.x), hi16(z2.x), lo16(z2.y), hi16(z2.y)};
                f32x4 o; float ss = 0.f;
                const u32x2 xv2 = *(const u32x2*)(XT + t * 72 + 16 * pt + 4 * q4); const float xvv[4] = {lo16(xv2.x), hi16(xv2.x), lo16(xv2.y), hi16(xv2.y)};
#pragma unroll
                for (int j = 0; j < 4; ++j) { const float xv = xvv[j]; const float v = (oacc[j] + dsk * xv) * siluf_(z[j]); ss += v * v;
                    o[j] = v * sng[j]; }
                if (!dry) *(u32x2*)zp = pack4(o);
                ss += __shfl_xor(ss, 16); ss += __shfl_xor(ss, 32);
                if (q4 == 0) RED[t * 4 + pt] = ss; }
        }
        const float el = fexp(clast);
#pragma unroll
        for (int i = 0; i < 4; ++i) { const int nt = 4 * wh + i;
            sacc[i] = sacc[i] * el;
#pragma unroll
            for (int kk = 0; kk < 2; ++kk) sacc[i] = mfma16(frag_tr(BS, 136, 16 * nt, 32 * kk, lane), frag_tr(XST, 72, 16 * pt, 32 * kk, lane), sacc[i]);
            if (full) *(u32x2*)(ST + (16 * pt + l15) * 136 + 16 * nt + 4 * q4) = pack4(sacc[i]); }
        __syncthreads();
        if (full && tid < 64) { const f32x4 r = *(const f32x4*)(RED + tid * 4); ((float*)(p.ws + WS_SSQ))[(size_t)(m0 + tid) * 8 + h] = (r[0] + r[1]) + (r[2] + r[3]); }
    }
    if (!full) {
#pragma unroll
        for (int i = 0; i < 4; ++i)
#pragma unroll
            for (int j = 0; j < 4; ++j) Lst[(16 * (4 * wh + i) + 4 * q4 + j) * 64 + 16 * pt + l15] = sacc[i][j];
        if (tid == 0) ((float*)(p.ws + WS_DS))[bh * 16 + sc] = fexp(ltot);
    }
}

DI void phase_scan(const Params& p, int vb, int nb, bool dry = false) {
    const int gt = vb * NTHREADS + opaque_tid(), NT = nb * NTHREADS;
    for (int idx0 = gt; idx0 < 4 * 131072; idx0 += 2 * NT) {
        float lv[2][16], dv[2][16]; float* Lp[2]; bool ok[2];
#pragma unroll
        for (int e = 0; e < 2; ++e) { const int idx = idx0 + e * NT; ok[e] = idx < 4 * 131072; const int which = idx >> 17, r = idx & 131071;
            float* L = nullptr; const float* dec = nullptr; int dstride = 0; float cdec = 0.f;
            if (ok[e]) {
                if (which == 0) { const int bh = r >> 13, el = r & 8191; L = (float*)(p.ws + WS_RETL) + (size_t)bh * 16 * 8192 + el; cdec = fexp(256.0f * __logf(1.0f - exp2f(-5.0f - (float)(bh & 3)))); }
                else if (which == 1) { const int bh = r >> 13, el = r & 8191; L = (float*)(p.ws + WS_GLAL) + (size_t)bh * 16 * 8192 + el; dec = (const float*)(p.ws + WS_DG) + bh * 16 * 64 + (el >> 7); dstride = 64; }
                else { const int rr = (which - 2) * 131072 + r, bh = rr >> 13, el = rr & 8191; L = (float*)(p.ws + WS_SSDL) + (size_t)bh * 16 * 8192 + el; dec = (const float*)(p.ws + WS_DS) + bh * 16; dstride = 1; } }
            Lp[e] = L;
#pragma unroll
            for (int sc = 0; sc < 16; ++sc) { lv[e][sc] = ok[e] ? L[(size_t)sc * 8192] : 0.f; dv[e][sc] = (ok[e] && dec) ? dec[sc * dstride] : cdec; } }
#pragma unroll
        for (int e = 0; e < 2; ++e) { float prev = 0.f;
#pragma unroll
            for (int sc = 0; sc < 16; ++sc) { if (ok[e] && !dry) Lp[e][(size_t)sc * 8192] = prev; prev = dv[e][sc] * prev + lv[e][sc]; } }
    }
}

DI void memkv_item(const Params& p, int l, int item) {
    const int tid = opaque_tid(), lane = tid & 63, w = tid >> 6, q4 = lane >> 4, l15 = lane & 15;
    const int rb = item >> 4, cb = item & 15;
    const bf16* A = (const bf16*)(p.ws + WS_MEMN) + (size_t)l * 1024 * 1024; const bf16* Bw = (const bf16*)(p.ws + WS_WKVT);
    const int r0 = 64 * rb + 16 * (w >> 1), c0 = 32 * cb + 16 * (w & 1); const bool isV = cb >= 8; const int hh = (c0 >> 6) & 3, dd = c0 & 63;
    f32x4 acc = (f32x4){0.f, 0.f, 0.f, 0.f};
#pragma unroll 1
    for (int k16 = 0; k16 < 32; k16 += 16) {
        bf16x8 fa[16], fb[16];
#pragma unroll
        for (int u = 0; u < 16; ++u) { fa[u] = frag(A, 1024, r0, 32 * (k16 + u), lane); fb[u] = frag(Bw, 1024, c0, 32 * (k16 + u), lane); }
#pragma unroll
        for (int u = 0; u < 16; ++u) acc = isV ? mfma16(fa[u], fb[u], acc) : mfma16(fb[u], fa[u], acc);
    }
    if (!isV) { const int m = r0 + l15, bb = m >> 8, mm = m & 255;
        *(u32x2*)((bf16*)(p.ws + WS_KM) + ((size_t)(bb * 4 + hh) * 256 + mm) * 64 + dd + 4 * q4) = pack4(acc); }
    else { const int m = r0 + 4 * q4, bb = m >> 8, mm = m & 255;
        *(u32x2*)((bf16*)(p.ws + WS_VMT) + ((size_t)(bb * 4 + hh) * 64 + dd + l15) * 256 + mm) = pack4(acc); }
}
constexpr int MA_K = 0, MA_VT = 36864;
DI void memattn_item(const Params& p, unsigned char* lds, int b, int h, int blk) {
    const int tid = opaque_tid(), lane = tid & 63, w = tid >> 6, q4 = lane >> 4, l15 = lane & 15;
    bf16* KS = (bf16*)(lds + MA_K); bf16* VS = (bf16*)(lds + MA_VT);
    const bf16* KM = (const bf16*)(p.ws + WS_KM) + (size_t)(b * 4 + h) * 256 * 64; const bf16* VM = (const bf16*)(p.ws + WS_VMT) + (size_t)(b * 4 + h) * 64 * 256;
    const bf16* P = (const bf16*)(p.ws + WS_P); bf16* OM = (bf16*)(p.ws + WS_OMEM);
#pragma unroll
    for (int r = 0; r < 4; ++r) { const int idx = tid + 512 * r;
        { const int m = idx >> 3, c8 = idx & 7; *(u32x4*)(KS + m * 72 + 8 * c8) = *(const u32x4*)(KM + m * 64 + 8 * c8); }
        { const int d = idx >> 5, c8 = idx & 31; *(u32x4*)(VS + d * 264 + 8 * c8) = *(const u32x4*)(VM + d * 256 + 8 * c8); } }
    __syncthreads();
    bf16x8 qn[2];
#pragma unroll
    for (int kk = 0; kk < 2; ++kk) qn[kk] = *(const bf16x8*)(P + (size_t)(b * T + blk * 256 + w * 16 + l15) * LDP + C_MQ + h * 64 + 32 * kk + 8 * q4);
    for (int rnd = 0; rnd < 2; ++rnd) {
        const int m0 = b * T + blk * 256 + rnd * 128 + w * 16;
        bf16x8 qf[2];
#pragma unroll
        for (int kk = 0; kk < 2; ++kk) { qf[kk] = qn[kk]; if (rnd == 0) qn[kk] = *(const bf16x8*)(P + (size_t)(m0 + 128 + l15) * LDP + C_MQ + h * 64 + 32 * kk + 8 * q4); }
        f32x4 s[16]; float mx = -3.0e38f;
#pragma unroll
        for (int mt = 0; mt < 16; ++mt) { s[mt] = (f32x4){0.f, 0.f, 0.f, 0.f};
#pragma unroll
            for (int kk = 0; kk < 2; ++kk) s[mt] = mfma16(frag(KS, 72, 16 * mt, 32 * kk, lane), qf[kk], s[mt]);
            s[mt] = s[mt] * 0.125f; mx = fmaxf(mx, fmaxf(fmaxf(s[mt][0], s[mt][1]), fmaxf(s[mt][2], s[mt][3]))); __builtin_amdgcn_sched_barrier(0); }
        mx = fmaxf(mx, __shfl_xor(mx, 16)); mx = fmaxf(mx, __shfl_xor(mx, 32));
        float sum = 0.f;
#pragma unroll
        for (int mt = 0; mt < 16; ++mt) {
#pragma unroll
            for (int j = 0; j < 4; ++j) { s[mt][j] = fexp(s[mt][j] - mx); sum += s[mt][j]; } }
        sum += __shfl_xor(sum, 16); sum += __shfl_xor(sum, 32);
        const float rs = __builtin_amdgcn_rcpf(sum);
        f32x4 o[4];
#pragma unroll
        for (int dt = 0; dt < 4; ++dt) o[dt] = (f32x4){0.f, 0.f, 0.f, 0.f};
#pragma unroll
        for (int k2 = 0; k2 < 8; ++k2) {
            u32x4 pw; pw.x = pk2(s[2 * k2][0], s[2 * k2][1]); pw.y = pk2(s[2 * k2][2], s[2 * k2][3]); pw.z = pk2(s[2 * k2 + 1][0], s[2 * k2 + 1][1]); pw.w = pk2(s[2 * k2 + 1][2], s[2 * k2 + 1][3]);
            const bf16x8 pf = __builtin_bit_cast(bf16x8, pw);
#pragma unroll
            for (int dt = 0; dt < 4; ++dt) { const bf16* vp = VS + (16 * dt + l15) * 264 + 32 * k2 + 4 * q4;
                const u32x2 v0 = *(const u32x2*)vp, v1 = *(const u32x2*)(vp + 16); u32x4 vw; vw.x = v0.x; vw.y = v0.y; vw.z = v1.x; vw.w = v1.y;
                o[dt] = mfma16(__builtin_bit_cast(bf16x8, vw), pf, o[dt]); }
            __builtin_amdgcn_sched_barrier(0); }
#pragma unroll
        for (int dt = 0; dt < 4; ++dt) *(u32x2*)(OM + (size_t)(m0 + l15) * 256 + h * 64 + 16 * dt + 4 * q4) = pack4(o[dt] * rs);
    }
    __syncthreads();
}

constexpr int RC_ARL = 0, RC_RRL = 9216, RC_BRL = 18432, RC_KRL = 27648, RC_XT = 0, RC_BHT = 36864, RC_KHT = 46080, RC_VT = 55296, RC_AAK = 64512, RC_LRB = 73728, RC_LRK = 82944,
              RC_AAB = 92160, RC_RHS = 108544, RC_WLAST = 141312, RC_TB = 141568,
              RC_TW = 64512, RC_ALS = 73728, RC_W2T = 82944, RC_A2T = 92160, RC_TOT = 101376, RC_CUM = 108544, RC_AICL = 124928;
#ifdef RW_STOP
#define RW_STOP_AT(k) do { if (dry && RW_STOP == (k)) return; } while (0)
#else
#define RW_STOP_AT(k) do {} while (0)
#endif
DI void rwkv_chunk_item(const Params& p, int l, unsigned char* lds, int b, int h, int c, bool dry = false) {
    const int tid = opaque_tid(), lane = tid & 63, w = tid >> 6, q4 = lane >> 4, l15 = lane & 15;
    bf16* P = (bf16*)(p.ws + WS_P);
    bf16* ARL = (bf16*)(lds + RC_ARL); bf16* RRL = (bf16*)(lds + RC_RRL); bf16* BRL = (bf16*)(lds + RC_BRL); bf16* KRL = (bf16*)(lds + RC_KRL); bf16* XT = (bf16*)(lds + RC_XT);
    bf16* BHT = (bf16*)(lds + RC_BHT); bf16* KHT = (bf16*)(lds + RC_KHT); bf16* VT = (bf16*)(lds + RC_VT); bf16* AAK = (bf16*)(lds + RC_AAK); bf16* LRB = (bf16*)(lds + RC_LRB); bf16* LRK = (bf16*)(lds + RC_LRK);
    float* AAB = (float*)(lds + RC_AAB); float* RHS = (float*)(lds + RC_RHS); float* WLAST = (float*)(lds + RC_WLAST); float* TB = (float*)(lds + RC_TB);
    bf16* TW = (bf16*)(lds + RC_TW); bf16* ALS = (bf16*)(lds + RC_ALS); bf16* W2T = (bf16*)(lds + RC_W2T); bf16* A2T = (bf16*)(lds + RC_A2T);
    float* TOT = (float*)(lds + RC_TOT); float* CUM = (float*)(lds + RC_CUM); float* AICL = (float*)(lds + RC_AICL);
    const float* mu = p.in[I_MU] + l * 1664;
    const int t0 = c * 64, m0 = b * T + t0;
    const int t_ = tid >> 3, cg = tid & 7, chh = h * 64 + 8 * cg;
    float xr[8], xk[8], xv[8];
    float pkk[8], pka[8], prk[8];
    { const f32x4 a0 = *(const f32x4*)(p.in[I_KK] + l * 512 + chh), a1 = *(const f32x4*)(p.in[I_KK] + l * 512 + chh + 4), b0 = *(const f32x4*)(p.in[I_KA] + l * 512 + chh), b1 = *(const f32x4*)(p.in[I_KA] + l * 512 + chh + 4),
          c0 = *(const f32x4*)(p.in[I_RK] + l * 512 + chh), c1 = *(const f32x4*)(p.in[I_RK] + l * 512 + chh + 4);
#pragma unroll
      for (int i = 0; i < 4; ++i) { pkk[i] = a0[i]; pkk[4 + i] = a1[i]; pka[i] = b0[i]; pka[4 + i] = b1[i]; prk[i] = c0[i]; prk[4 + i] = c1[i]; } }
    f32x4 pw0[4];
#pragma unroll
    for (int ct = 0; ct < 4; ++ct) pw0[ct] = *(const f32x4*)(p.in[(w >> 2) ? I_A0 : I_W0] + l * 512 + h * 64 + 16 * ct + 4 * q4);
    {
        { const int j = tid >> 3;
            const float* s2 = p.in[I_W2] + (size_t)l * 64 * 512 + j * 512 + chh; const float* sa = p.in[I_A2] + (size_t)l * 64 * 512 + j * 512 + chh;
#pragma unroll
            for (int i = 0; i < 8; ++i) { }
            *(u32x4*)(W2T + j * 72 + 8 * cg) = pack8(s2); *(u32x4*)(A2T + j * 72 + 8 * cg) = pack8(sa); }
        const size_t ro = (size_t)(m0 + t_) * LDP; const bool first = (t_ == 0);
        const bf16* prow = first ? (bf16*)(p.ws + WS_BND) + (size_t)(((m0) >> 6) - 1) * BND_W - 4608 : P + ro - LDP;
        const bool hp = (t0 + t_) > 0;
#pragma unroll
        for (int which = 0; which < 5; ++which) {
            const int col = which == 0 ? C_WR + chh : which == 1 ? C_WK + chh : which == 2 ? C_WV + chh : which == 3 ? C_WL + 8 * cg : C_AL + 8 * cg;
            const int mi = which == 0 ? chh : which == 1 ? 512 + chh : which == 2 ? 1024 + chh : which == 3 ? 1536 + 8 * cg : 1600 + 8 * cg;
            float cur[8], prv[8], xs[8];
            unpack8(*(const u32x4*)(P + ro + col), cur);
            unpack8(*(const u32x4*)((hp ? prow : P + ro) + col), prv);
            if (!hp) {
#pragma unroll
                for (int i = 0; i < 8; ++i) prv[i] = 0.f; }
#pragma unroll
            for (int i = 0; i < 8; ++i) xs[i] = cur[i] + (prv[i] - cur[i]) * mu[mi + i];
            if (which == 0) {
#pragma unroll
                for (int i = 0; i < 8; ++i) xr[i] = xs[i]; }
            else if (which == 1) {
#pragma unroll
                for (int i = 0; i < 8; ++i) xk[i] = xs[i]; }
            else if (which == 2) {
#pragma unroll
                for (int i = 0; i < 8; ++i) xv[i] = xs[i]; }
            else if (which == 3) { float tw[8];
#pragma unroll
                for (int i = 0; i < 8; ++i) tw[i] = tanhf_(xs[i]);
                *(u32x4*)(TW + t_ * 72 + 8 * cg) = pack8(tw); }
            else *(u32x4*)(ALS + t_ * 72 + 8 * cg) = pack8(xs);
        }
    }
    __syncthreads();
    RW_STOP_AT(0);
    {
        const int which = w >> 2, tt = w & 3; const bf16* Wm = which ? A2T : W2T; const bf16* Xm = which ? ALS : TW;
#pragma unroll
        for (int ct = 0; ct < 4; ++ct) { f32x4 a = (f32x4){0.f, 0.f, 0.f, 0.f};
#pragma unroll
            for (int kk = 0; kk < 2; ++kk) a = mfma16(frag_tr(Wm, 72, 16 * ct, 32 * kk, lane), frag(Xm, 72, 16 * tt, 32 * kk, lane), a);
            const int ch = 16 * ct + 4 * q4, t = 16 * tt + l15; f32x4 o;
            if (which == 0) { const f32x4 w0 = pw0[ct];
#pragma unroll
                for (int j = 0; j < 4; ++j) o[j] = -0.60653065971f * sigmoidf_(w0[j] + a[j]);
                *(f32x4*)(CUM + t * 64 + ch) = o; }
            else { const f32x4 a0 = pw0[ct];
#pragma unroll
                for (int j = 0; j < 4; ++j) o[j] = sigmoidf_(a0[j] + a[j]);
                *(f32x4*)(AICL + t * 64 + ch) = o; }
        }
    }
    __syncthreads();
    RW_STOP_AT(1);
    {
        float cumv[8]; float run = 0.f;
#pragma unroll
        for (int i = 0; i < 8; ++i) { run += CUM[(8 * w + i) * 64 + lane]; cumv[i] = run; }
        TOT[w * 64 + lane] = run;
        __syncthreads();
        float off = 0.f;
        for (int ww = 0; ww < w; ++ww) off += TOT[ww * 64 + lane];
#pragma unroll
        for (int i = 0; i < 8; ++i) CUM[(8 * w + i) * 64 + lane] = cumv[i] + off;
    }
    __syncthreads();
    RW_STOP_AT(2);
    float aabs[8];
    {
        float kk[8], ai[8], ss = 0.f;
#pragma unroll
        for (int i = 0; i < 8; ++i) { ai[i] = AICL[t_ * 64 + 8 * cg + i]; kk[i] = xk[i] * pkk[i]; ss += kk[i] * kk[i]; }
        ss += __shfl_xor(ss, 1); ss += __shfl_xor(ss, 2); ss += __shfl_xor(ss, 4);
        const float inv = __builtin_amdgcn_rsqf(fmaxf(ss, 1e-24f));
        float bon = 0.f, o_arl[8], o_rrl[8], o_brl[8], o_krl[8], o_rabs[8], o_bh[8], o_kh[8];
#pragma unroll
        for (int i = 0; i < 8; ++i) {
            const float kn = kk[i] * inv, av = -kn, bv = kn * ai[i], km = xk[i] * (1.0f + (ai[i] - 1.0f) * pka[i]);
            bon += xr[i] * km * prk[i];
            const int k = 8 * cg + i;
            const float cu = CUM[t_ * 64 + k], cx = t_ > 0 ? CUM[(t_ - 1) * 64 + k] : 0.f, rf = CUM[32 * 64 + k], la = CUM[63 * 64 + k];
            o_arl[i] = av * fexp(cx - rf); aabs[i] = av * fexp(cx);
            o_rrl[i] = xr[i] * fexp(cu - rf); o_rabs[i] = xr[i] * fexp(cu);
            const float eb = fexp(rf - cu), eh = fexp(la - cu);
            o_brl[i] = bv * eb; o_krl[i] = km * eb;
            o_bh[i] = bv * eh; o_kh[i] = km * eh;
        }
        bon += __shfl_xor(bon, 1); bon += __shfl_xor(bon, 2); bon += __shfl_xor(bon, 4);
        *(u32x4*)(ARL + t_ * 72 + 8 * cg) = pack8(o_arl); *(u32x4*)(RRL + t_ * 72 + 8 * cg) = pack8(o_rrl);
        *(u32x4*)(BRL + t_ * 72 + 8 * cg) = pack8(o_brl); *(u32x4*)(KRL + t_ * 72 + 8 * cg) = pack8(o_krl);
        *(u32x4*)(BHT + t_ * 72 + 8 * cg) = pack8(o_bh); *(u32x4*)(KHT + t_ * 72 + 8 * cg) = pack8(o_kh); *(u32x4*)(VT + t_ * 72 + 8 * cg) = pack8(xv);
        const size_t ro = (size_t)(m0 + t_) * LDP;
        if (!dry) *(u32x4*)(P + ro + C_WR + chh) = pack8(o_rabs);
        float bvv[8];
#pragma unroll
        for (int i = 0; i < 8; ++i) bvv[i] = bon * xv[i];
        if (!dry) *(u32x4*)(P + ro + C_WV + chh) = pack8(bvv);
        if (tid < 64) WLAST[tid] = fexp(CUM[63 * 64 + tid]);
    }
    __syncthreads();
    RW_STOP_AT(3);
    *(f32x4*)(RHS + t_ * 128 + 8 * cg) = (f32x4){aabs[0], aabs[1], aabs[2], aabs[3]}; *(f32x4*)(RHS + t_ * 128 + 8 * cg + 4) = (f32x4){aabs[4], aabs[5], aabs[6], aabs[7]};
    {
        const int prod = w >> 1, half = w & 1; const bf16* Lm = (prod < 2) ? ARL : RRL; const bf16* Rm = (prod & 1) ? KRL : BRL; const int strict = prod < 2 ? 1 : 0;
#pragma unroll
        for (int i8 = 0; i8 < 8; ++i8) { const int id = half * 8 + i8, tt = id >> 2, st = id & 3;
            f32x4 a = (f32x4){0.f, 0.f, 0.f, 0.f};
            if (st <= tt) {
#pragma unroll
                for (int kk = 0; kk < 2; ++kk) a = mfma16(frag(Rm, 72, 16 * st, 32 * kk, lane), frag(Lm, 72, 16 * tt, 32 * kk, lane), a);
                if (st == tt) {
#pragma unroll
                    for (int j = 0; j < 4; ++j) if (4 * q4 + j + strict > l15) a[j] = 0.f; }
            }
            if (prod == 0) *(f32x4*)(AAB + (16 * tt + l15) * 64 + 16 * st + 4 * q4) = a;
            else { bf16* O = prod == 1 ? AAK : prod == 2 ? LRB : LRK; *(u32x2*)(O + (16 * tt + l15) * 72 + 16 * st + 4 * q4) = pack4(a); }
        }
        if (prod == 0) {
            asm volatile("s_waitcnt lgkmcnt(0)" ::: "memory");
            const int bb = 2 * half + ((lane >> 4) & 1), cc = lane & 15; float x[16];
#pragma unroll
            for (int i = 0; i < 16; ++i) { float s0 = (i == cc) ? 1.0f : 0.0f;
#pragma unroll
                for (int s4 = 0; s4 < (i + 3) / 4; ++s4) { const f32x4 av = *(const f32x4*)(AAB + (16 * bb + i) * 64 + 16 * bb + 4 * s4);
#pragma unroll
                    for (int n = 0; n < 4; ++n) if (4 * s4 + n < i) s0 += av[n] * x[4 * s4 + n]; }
                x[i] = s0; if (lane < 32) TB[(bb * 16 + i) * 16 + cc] = s0; }
        }
    }
    __syncthreads();
    RW_STOP_AT(4);
    {
        f32x4 X[4];
#pragma unroll
        for (int bb = 0; bb < 4; ++bb) {
            f32x4 acc;
            if (w < 4) {
#pragma unroll
                for (int j = 0; j < 4; ++j) acc[j] = RHS[(16 * bb + 4 * q4 + j) * 128 + 16 * w + l15]; }
            else {
                acc = (f32x4){0.f, 0.f, 0.f, 0.f};
#pragma unroll
                for (int kk = 0; kk < 2; ++kk) acc = mfma16(frag(AAK, 72, 16 * bb, 32 * kk, lane), frag_tr(VT, 72, 16 * (w - 4), 32 * kk, lane), acc); }
#pragma unroll
            for (int bp = 0; bp < bb; ++bp) { const f32x4 a4 = *(const f32x4*)(AAB + (16 * bb + l15) * 64 + 16 * bp + 4 * q4);
#pragma unroll
                for (int j = 0; j < 4; ++j) acc = __builtin_amdgcn_mfma_f32_16x16x4f32(a4[j], X[bp][j], acc, 0, 0, 0); }
            const f32x4 t4 = *(const f32x4*)(TB + (bb * 16 + l15) * 16 + 4 * q4);
            f32x4 xb = (f32x4){0.f, 0.f, 0.f, 0.f};
#pragma unroll
            for (int j = 0; j < 4; ++j) xb = __builtin_amdgcn_mfma_f32_16x16x4f32(t4[j], acc[j], xb, 0, 0, 0);
            X[bb] = xb;
            *(u32x2*)(XT + (16 * w + l15) * 72 + 16 * bb + 4 * q4) = pack4(xb);
        }
    }
    __syncthreads();
    RW_STOP_AT(6);
    {
        const int prod = w >> 1, half = w & 1;
        bf16* GH = (bf16*)(p.ws + WS_RWGH) + ((size_t)((b * 8 + h) * 64 + c) * 2) * 4096;
#pragma unroll
        for (int i8 = 0; i8 < 8; ++i8) { const int id = half * 8 + i8, rt = id >> 2, ct = id & 3;
            f32x4 a = (f32x4){0.f, 0.f, 0.f, 0.f};
            if (prod == 0) {
#pragma unroll
                for (int kk = 0; kk < 2; ++kk) a = mfma16(frag(XT, 72, 16 * ct, 32 * kk, lane), frag(LRB, 72, 16 * rt, 32 * kk, lane), a);
                bf16* qp = P + (size_t)(m0 + 16 * rt + l15) * LDP + C_WR + h * 64 + 16 * ct + 4 * q4;
                const u32x2 r2 = *(const u32x2*)qp; a[0] += lo16(r2.x); a[1] += hi16(r2.x); a[2] += lo16(r2.y); a[3] += hi16(r2.y);
                if (!dry) *(u32x2*)qp = pack4(a);
            } else if (prod == 1) {
#pragma unroll
                for (int kk = 0; kk < 2; ++kk) a = mfma16(frag(XT, 72, 64 + 16 * ct, 32 * kk, lane), frag(LRB, 72, 16 * rt, 32 * kk, lane), a);
#pragma unroll
                for (int kk = 0; kk < 2; ++kk) a = mfma16(frag_tr(VT, 72, 16 * ct, 32 * kk, lane), frag(LRK, 72, 16 * rt, 32 * kk, lane), a);
                if (!dry) *(u32x2*)(P + (size_t)(m0 + 16 * rt + l15) * LDP + C_WK + h * 64 + 16 * ct + 4 * q4) = pack4(a);
            } else if (prod == 2) {
#pragma unroll
                for (int kk = 0; kk < 2; ++kk) a = mfma16(frag(XT, 72, 16 * ct, 32 * kk, lane), frag_tr(BHT, 72, 16 * rt, 32 * kk, lane), a);
                if (rt == ct) { const float wl = WLAST[16 * rt + l15];
#pragma unroll
                    for (int j = 0; j < 4; ++j) if (4 * q4 + j == l15) a[j] += wl; }
                *(u32x2*)(GH + (16 * rt + l15) * 64 + 16 * ct + 4 * q4) = pack4(a);
            } else {
#pragma unroll
                for (int kk = 0; kk < 2; ++kk) a = mfma16(frag_tr(BHT, 72, 16 * ct, 32 * kk, lane), frag(XT, 72, 64 + 16 * rt, 32 * kk, lane), a);
#pragma unroll
                for (int kk = 0; kk < 2; ++kk) a = mfma16(frag_tr(KHT, 72, 16 * ct, 32 * kk, lane), frag_tr(VT, 72, 16 * rt, 32 * kk, lane), a);
                *(u32x2*)(GH + 4096 + (16 * rt + l15) * 64 + 16 * ct + 4 * q4) = pack4(a);
            }
        }
    }
    __syncthreads();
}
DI void rwkv_scan_chain(const Params& p, unsigned char* lds, int bh, bool dry = false) {
    const int tid = opaque_tid(), lane = tid & 63, w = tid >> 6, q4 = lane >> 4, l15 = lane & 15;
    bf16* ZB = (bf16*)lds;
    bf16* GH = (bf16*)(p.ws + WS_RWGH) + (size_t)bh * 64 * 2 * 4096;
    const int vt = w & 3, kh = w >> 2;
    u32x2 zp[2];
#pragma unroll
    for (int i = 0; i < 2; ++i) { zp[i] = (u32x2){0u, 0u}; *(u32x2*)(ZB + (16 * vt + l15) * 72 + 16 * (2 * kh + i) + 4 * q4) = zp[i]; }
    bf16x8 gf[4][2][2]; u32x2 hv[4][2];
#define RW_LOAD(slot, cc) do { const bf16* G_ = GH + (size_t)(cc) * 2 * 4096; _Pragma("unroll") for (int i = 0; i < 2; ++i) { const int kt = 2 * kh + i; \
        _Pragma("unroll") for (int kk = 0; kk < 2; ++kk) gf[slot][i][kk] = frag(G_, 64, 16 * kt, 32 * kk, lane); \
        hv[slot][i] = *(const u32x2*)(G_ + 4096 + (16 * vt + l15) * 64 + 16 * kt + 4 * q4); } } while (0)
    RW_LOAD(0, 0); RW_LOAD(1, 1); RW_LOAD(2, 2); RW_LOAD(3, 3);
    __syncthreads();
    for (int c4 = 0; c4 < 64; c4 += 4) {
#pragma unroll
        for (int u = 0; u < 4; ++u) { const int c = c4 + u;
            bf16* HT = GH + (size_t)c * 2 * 4096 + 4096;
            const bf16* Zc = ZB + (c & 1) * 64 * 72; bf16* Zn = ZB + ((c + 1) & 1) * 64 * 72;
#pragma unroll
            for (int i = 0; i < 2; ++i) { const int kt = 2 * kh + i;
                f32x4 a = (f32x4){lo16(hv[u][i].x), hi16(hv[u][i].x), lo16(hv[u][i].y), hi16(hv[u][i].y)};
                if (!dry) *(u32x2*)(HT + (16 * vt + l15) * 64 + 16 * kt + 4 * q4) = zp[i];
#pragma unroll
                for (int kk = 0; kk < 2; ++kk) a = mfma16(gf[u][i][kk], frag(Zc, 72, 16 * vt, 32 * kk, lane), a);
                zp[i] = pack4(a);
                *(u32x2*)(Zn + (16 * vt + l15) * 72 + 16 * kt + 4 * q4) = zp[i]; }
            { const int cn = c + 4 < 64 ? c + 4 : 63; RW_LOAD(u, cn); }
            __syncthreads();
        }
    }
#undef RW_LOAD
}
DI void rwkv_out_item(const Params& p, int l, int bh, int pair, bool dry = false) {
    const int tid = opaque_tid(), lane = tid & 63, w = tid >> 6, q4 = lane >> 4, l15 = lane & 15;
    bf16* P = (bf16*)(p.ws + WS_P);
    const int b = bh >> 3, h = bh & 7, c = 2 * pair + (w >> 2), m = b * T + c * 64 + 16 * (w & 3) + l15;
    const bf16* ZT = (const bf16*)(p.ws + WS_RWGH) + ((size_t)(bh * 64 + c) * 2 + 1) * 4096;
    const size_t ro = (size_t)m * LDP;
    bf16x8 qf[2];
#pragma unroll
    for (int kk = 0; kk < 2; ++kk) qf[kk] = *(const bf16x8*)(P + ro + C_WR + h * 64 + 32 * kk + 8 * q4);
    f32x4 y[4]; float s = 0.f;
#pragma unroll
    for (int vt = 0; vt < 4; ++vt) {
        const u32x2 yl = *(const u32x2*)(P + ro + C_WK + h * 64 + 16 * vt + 4 * q4);
        y[vt] = (f32x4){lo16(yl.x), hi16(yl.x), lo16(yl.y), hi16(yl.y)};
#pragma unroll
        for (int kk = 0; kk < 2; ++kk) y[vt] = mfma16(frag(ZT, 64, 16 * vt, 32 * kk, lane), qf[kk], y[vt]);
        s += (y[vt][0] + y[vt][1]) + (y[vt][2] + y[vt][3]); }
    s += __shfl_xor(s, 16); s += __shfl_xor(s, 32);
    const float mean = s * (1.0f / 64.0f); float vr = 0.f;
#pragma unroll
    for (int vt = 0; vt < 4; ++vt) { y[vt] = y[vt] - mean; vr += (y[vt][0] * y[vt][0] + y[vt][1] * y[vt][1]) + (y[vt][2] * y[vt][2] + y[vt][3] * y[vt][3]); }
    vr += __shfl_xor(vr, 16); vr += __shfl_xor(vr, 32);
    const float rstd = __builtin_amdgcn_rsqf(vr * (1.0f / 64.0f) + 64e-5f);
#pragma unroll
    for (int vt = 0; vt < 4; ++vt) { const int ch = h * 64 + 16 * vt + 4 * q4;
        const f32x4 lg = *(const f32x4*)(p.in[I_LNG] + l * 512 + ch), lb = *(const f32x4*)(p.in[I_LNB] + l * 512 + ch);
        const u32x2 bv = *(const u32x2*)(P + ro + C_WV + ch); bf16* gp = P + ro + C_WG + ch; const u32x2 g2 = *(const u32x2*)gp;
        const float bvf[4] = {lo16(bv.x), hi16(bv.x), lo16(bv.y), hi16(bv.y)}, g[4] = {lo16(g2.x), hi16(g2.x), lo16(g2.y), hi16(g2.y)};
        f32x4 o;
#pragma unroll
        for (int j = 0; j < 4; ++j) o[j] = (y[vt][j] * rstd * lg[j] + lb[j] + bvf[j]) * siluf_(g[j]);
        if (!dry) *(u32x2*)gp = pack4(o); }
}

DI void phase_A(const Params& p, int l, unsigned char* lds, bool dry = false) {
    const int G = gridDim.x, bid = blockIdx.x;
#ifndef DUP_AMASK
#define DUP_AMASK 0xff
#endif
    for (int it = bid; it < 3328; it += G) {
        if (dry) { const int ty = it < 2048 ? 1 : it < 2560 ? 2 : it < 2816 ? 4 : it < 3072 ? 8 : 16; if (!(DUP_AMASK & ty)) continue; }
        if (it < 2048) rwkv_chunk_item(p, l, lds, it >> 9, (it >> 6) & 7, it & 63, dry);
        else if (it < 2560) { const int i = it - 2048; ssd_item(p, l, lds, i >> 7, (i >> 4) & 7, i & 15, false); }
        else if (it < 2816) { const int i = it - 2560; qkv_item<false>(p, l, lds, i >> 6, (i >> 4) & 3, i & 15, false); }
        else if (it < 3072) { const int i = it - 2816; qkv_item<true>(p, l, lds, i >> 6, (i >> 4) & 3, i & 15, false); }
        else memkv_item(p, l, it - 3072);
    }
}
DI void phase_B(const Params& p, unsigned char* lds, bool dry = false) {
    (void)lds; phase_scan(p, blockIdx.x, gridDim.x, dry);
}
DI void rwkv_flag_publish(unsigned* flag) {
    asm volatile("s_waitcnt vmcnt(0)" ::: "memory"); __syncthreads();
    if (threadIdx.x == 0) { __builtin_amdgcn_fence(__ATOMIC_RELEASE, "agent"); asm volatile("s_waitcnt vmcnt(0)" ::: "memory"); __hip_atomic_store(flag, 1u, __ATOMIC_RELAXED, __HIP_MEMORY_SCOPE_AGENT); }
}
DI void rwkv_flag_wait(unsigned* flag) {
    if (threadIdx.x == 0) { unsigned spins = 0;
        while (__hip_atomic_load(flag, __ATOMIC_RELAXED, __HIP_MEMORY_SCOPE_AGENT) == 0u) { __builtin_amdgcn_s_sleep(8); if (++spins > (1u << 22)) break; }
        __builtin_amdgcn_fence(__ATOMIC_ACQUIRE, "agent"); asm volatile("s_waitcnt vmcnt(0)" ::: "memory"); }
    __syncthreads();
}
DI void phase_C(const Params& p, int l, unsigned char* lds, bool dry = false) {
    const int G = gridDim.x, bid = blockIdx.x;
    unsigned* flags = (unsigned*)(p.ws + WS_BAR + 14336) + (dry ? 128 : 0) + l * 32;
    for (int bh = bid; bh < 32; bh += G) { rwkv_scan_chain(p, lds, bh, dry); rwkv_flag_publish(flags + bh); }
    unsigned have = 0u;
#define C_SSD(it)  ssd_item(p, l, lds, (it) >> 7, ((it) >> 4) & 7, (it) & 15, true, dry)
#define C_RET(it)  qkv_item<false>(p, l, lds, (it) >> 6, ((it) >> 4) & 3, (it) & 15, true, dry)
#define C_GLA(it)  qkv_item<true>(p, l, lds, (it) >> 6, ((it) >> 4) & 3, (it) & 15, true, dry)
#define C_MEM(it)  memattn_item(p, lds, (it) >> 6, ((it) >> 4) & 3, (it) & 15)
#define C_RWO(it)  do { const int bh_ = (it) >> 5; if (!((have >> bh_) & 1u)) { rwkv_flag_wait(flags + bh_); have |= 1u << bh_; } rwkv_out_item(p, l, bh_, (it) & 31, dry); } while (0)
    const int nslot = (G == 256) ? 13 : (2304 + G - 1) / G;
    for (int k = 0; k < nslot; ++k) {
        int it = -1;
        if (G == 256) {
            if (bid < 32) { it = k == 0 ? bid : k == 1 ? 768 + bid : k == 2 ? 512 + bid : -1; }
            else { const int j = bid - 32;
                if (k == 0) it = 32 + j; else if (k == 1) it = 256 + j; else if (k == 2) it = (j < 32) ? 480 + j : -1;
                else if (k == 3) it = 768 + 32 + j; else if (k == 4) it = 512 + 32 + j; else if (k == 5) it = 1024 + j;
                else if (k == 6) it = (j >= 32 && j < 64) ? 1024 + 224 + (j - 32) : -1;
                else { const int r = (j - 32) + 192 * (k - 7); it = (j >= 32 && r < 1024) ? 1280 + r : -1; } }
        } else { it = bid + k * G; if (it >= 2304) it = -1; }
        if (it < 0) continue;
        if (it < 512) C_SSD(it); else if (it < 768) C_RET(it - 512); else if (it < 1024) C_GLA(it - 768); else if (it < 1280) C_MEM(it - 1024); else C_RWO(it - 1280);
    }
#undef C_SSD
#undef C_RET
#undef C_GLA
#undef C_MEM
#undef C_RWO
}
typedef PG8_LAS unsigned char* lds3_t;
DI void phase_P1(const Params& p, int l, unsigned char* lds) {
    pg8::Gemm g{1024, 1024};
    SchedP1 S{(int)gridDim.x, (int)blockIdx.x, (const char*)p.ws + WS_XN, (const char*)p.ws + WS_W1T};
    EpiP E{(bf16*)(p.ws + WS_P), (bf16*)(p.ws + WS_BND)};
    pg8::gemm_phase<EpiP, SchedP1, true, true>((lds3_t)lds, g, S, E);
}
DI void phase_P3(const Params& p, int l, unsigned char* lds) {
    (void)l;
    for (int L = blockIdx.x; L < 256; L += gridDim.x) {
        int pm, pn; tile_map(L, 64, 4, pm, pn);
        pg8::Gemm g{0, 0}; SchedP3 S{pm, pn, p.ws};
        EpiP3 E{EpiGate{(bf16*)(p.ws + WS_P)}, EpiBranch{(const bf16*)(p.ws + WS_P), (bf16*)(p.ws + WS_MRG), (const float*)(p.ws + WS_SSQ)}};
        pg8::gemm_phase<EpiP3, SchedP3, true, true>((lds3_t)lds, g, S, E);
    }
}
DI void phase_P4(const Params& p, int l, unsigned char* lds) {
    pg8::Gemm g{1024, 1024};
    SchedP4 S{(int)gridDim.x, (int)blockIdx.x, (const char*)p.ws + WS_MRG, (const char*)p.ws + WS_WOT};
    if (gridDim.x == 256) {
        float* xs = (float*)(p.ws + WS_XS) + (size_t)l * 64 * 256 * 4; unsigned* cnt = (unsigned*)(p.ws + WS_XCNT) + l * 64 * 64;
        if (l == 0) { EpiNorm<false> E{p.in[I_X], p.out, p.in[I_NORMG] + 1024, (bf16*)(p.ws + WS_XN), xs, cnt}; pg8::gemm_phase<EpiNorm<false>, SchedP4, true, true>((lds3_t)lds, g, S, E); }
        else { EpiNorm<true> E{p.out, p.out, p.in[I_FNORMG], nullptr, xs, cnt}; pg8::gemm_phase<EpiNorm<true>, SchedP4, true, true>((lds3_t)lds, g, S, E); }
    } else { EpiRes E{l == 0 ? p.in[I_X] : p.out, p.out}; pg8::gemm_phase<EpiRes, SchedP4, true, true>((lds3_t)lds, g, S, E); }
}
DI void phase_post(const Params& p, int l, unsigned char* lds) {
    if (gridDim.x == 256) { if (l == 0) convert_weights(p, 1, lds); }
    else phase_norm(p, l, 1.0f, lds);
}

#ifndef MK_LAUNCHES
#define MK_LAUNCHES 1
#endif
struct KArgs { Params p; int lo, hi; };
constexpr int N_PHASES = 15;
#ifdef NVGPR
__global__ void __launch_bounds__(NTHREADS, 2) __attribute__((amdgpu_num_vgpr(NVGPR))) fwd_kernel(KArgs a) {
#else
__global__ void __launch_bounds__(NTHREADS, 2) fwd_kernel(KArgs a) {
#endif
    extern __shared__ __attribute__((aligned(16))) unsigned char lds[];
    cg::grid_group grid = cg::this_grid();
    const Params& p = a.p;
    volatile unsigned* bst = (volatile unsigned*)(lds + LDS_BYTES - 64);
    if (threadIdx.x < 2) bst[threadIdx.x] = 0u;
    __syncthreads();
    XcdBarrier xbar = xcd_barrier_post((unsigned*)(p.ws + WS_BAR), bst);
    if (a.hi == 12345) grid.sync();
#define GRID_SYNC() xcd_barrier(xbar)
#ifndef DUP_N
#define DUP_N 1
#endif
#ifndef PHMASK
#define PHMASK 0xff
#endif
#ifdef DUP_S
#define NREP(ty, l) (((ty) == DUP_S && !(((ty) == 6 || (ty) == 7) && (l) != 0)) ? 1 + DUP_N : 1)
#else
#define NREP(ty, l) 1
#endif
#define RUN_PHASE(ty, l, more) do { const int nrep = NREP(ty, l); \
        for (int rep = 0; rep < nrep; ++rep) { const bool dry = (rep + 1 < nrep) && (a.hi != 12345); (void)dry; \
            if (!((PHMASK >> (ty)) & 1)) {} \
            else if ((ty) == 0) phase_prologue(p, lds); \
            else if ((ty) == 1) phase_P1(p, l, lds); \
            else if ((ty) == 2) phase_A(p, l, lds, dry); \
            else if ((ty) == 3) phase_B(p, lds, dry); \
            else if ((ty) == 4) phase_C(p, l, lds, dry); \
            else if ((ty) == 5) phase_P3(p, l, lds); \
            else if ((ty) == 6) phase_P4(p, l, lds); \
            else phase_post(p, l, lds); \
            if ((more) || rep + 1 < nrep) GRID_SYNC(); } } while (0)
#if MK_LAUNCHES == 1
#if defined(DUP_S) && DUP_S == 100
    for (int rep = 0; rep < DUP_N; ++rep) GRID_SYNC();
#endif
    RUN_PHASE(0, 0, true);
    RUN_PHASE(1, 0, true); RUN_PHASE(2, 0, true); RUN_PHASE(3, 0, true); RUN_PHASE(4, 0, true); RUN_PHASE(5, 0, true); RUN_PHASE(6, 0, true); RUN_PHASE(7, 0, true);
    RUN_PHASE(1, 1, true); RUN_PHASE(2, 1, true); RUN_PHASE(3, 1, true); RUN_PHASE(4, 1, true); RUN_PHASE(5, 1, true); RUN_PHASE(6, 1, gridDim.x != 256); RUN_PHASE(7, 1, false);
#else
    for (int ph = a.lo; ph < a.hi; ++ph) { const int ty = (ph == 0) ? 0 : ((ph - 1) % 7 + 1), l = (ph - 1) / 7; RUN_PHASE(ty, l, ph + 1 < a.hi); }
#endif
}

extern "C" void kernel_launch(void* const* d_in, const int* in_sizes, int n_in, void* d_out, int out_size, void* d_ws, size_t ws_size, hipStream_t stream) {
    static int grid = 0;
    if (grid == 0) {
        if (n_in != N_IN || out_size != M * D || ws_size < WS_END) { fprintf(stderr, "kernel_launch: unexpected shapes (n_in %d, out %d, ws %zu < %zu)\n", n_in, out_size, ws_size, (size_t)WS_END); grid = -1; return; }
        int dev = 0, cus = 0, per_cu = 0;
        hipGetDevice(&dev); hipDeviceGetAttribute(&cus, hipDeviceAttributeMultiprocessorCount, dev);
        hipFuncSetAttribute((const void*)fwd_kernel, hipFuncAttributeMaxDynamicSharedMemorySize, LDS_BYTES);
        hipOccupancyMaxActiveBlocksPerMultiprocessor(&per_cu, (const void*)fwd_kernel, NTHREADS, LDS_BYTES);
        if (per_cu < 1 || cus < 1) { fprintf(stderr, "kernel_launch: occupancy query gave %d blocks/CU on %d CUs\n", per_cu, cus); grid = -1; return; }
        grid = cus * per_cu; if (grid > 256) grid = 256;
    }
    if (grid < 0) return;
    KArgs a{}; for (int i = 0; i < N_IN; ++i) a.p.in[i] = (const float*)d_in[i];
    a.p.out = (float*)d_out; a.p.ws = (unsigned char*)d_ws;
    if (hipMemsetAsync((char*)d_ws + WS_BAR, 0, WS_ZERO_BYTES, stream) != hipSuccess) { fprintf(stderr, "kernel_launch: memset of the barrier words failed\n"); return; }
    if (MK_LAUNCHES == 1) {
        a.lo = 0; a.hi = N_PHASES; void* args[] = {&a};
        hipError_t e = hipLaunchCooperativeKernel((const void*)fwd_kernel, dim3(grid), dim3(NTHREADS), args, LDS_BYTES, stream);
        if (e != hipSuccess) fprintf(stderr, "kernel_launch: cooperative launch failed: %s (grid %d)\n", hipGetErrorString(e), grid);
    } else {
        for (int ph = 0; ph < N_PHASES; ++ph) { a.lo = ph; a.hi = ph + 1; hipLaunchKernelGGL(fwd_kernel, dim3(grid), dim3(NTHREADS), LDS_BYTES, stream, a); }
    }
}
```

```cpp
#include <hip/hip_runtime.h>
#include <hip/hip_cooperative_groups.h>
#include <cstdio>
#include <cstdint>
namespace cg = cooperative_groups;
namespace pg8 {
#define PG8_LAS __attribute__((address_space(3)))
typedef unsigned short bf16_t;
typedef short bf16x8 __attribute__((ext_vector_type(8)));
typedef float f32x4 __attribute__((ext_vector_type(4)));
typedef unsigned u32x4 __attribute__((ext_vector_type(4)));
constexpr int BM = 256, BK = 64, HALF = 128, HTB = HALF * BK * 2  , STAGE_BYTES = 8 * HTB, NXCD = 8, WGM = 8;

__host__ __device__ __forceinline__ int lds_byte(int r, int c) { const int st = (r >> 4) * 2 + (c >> 5), rr = r & 15, cc = c & 31, ob = rr * 64 + cc * 2; return st * 1024 + (ob ^ (((ob >> 9) & 1) << 5)); }
__host__ __device__ __forceinline__ void stage_rc(int b, int& R, int& C) { const int st = b / 1024, sb = b % 1024, swz = sb ^ (((sb >> 9) & 1) << 5); R = (st >> 1) * 16 + swz / 64; C = (st & 1) * 32 + (swz % 64) / 2; }
__host__ __device__ __forceinline__ int perm32(int rho) { const int n = rho >> 4, i = rho & 15; return 8 * (i >> 2) + 4 * n + (i & 3); }

struct Unit { int pm, pn, kind, aux; int nt, lda, ldb; int pad_; const char* A; const char* B; };
struct Gemm { int K, lda; };


template <class Epi, class Sched, bool ALIGN_EPI = false, bool SP2 = false>
__device__ __forceinline__ void gemm_phase(PG8_LAS unsigned char* lds, const Gemm g, const Sched& S, const Epi& E) {
    int tid = threadIdx.x; asm volatile("" : "+v"(tid));
    const int wid = __builtin_amdgcn_readfirstlane(tid >> 6), lane = tid & 63, wr = wid >> 2, wc = wid & 3, fr = lane & 15, fq = lane >> 4;
    int Rv[2], Rbv[2], Cv[2];
#pragma unroll
    for (int i = 0; i < 2; ++i) { int R, C; stage_rc(tid * 16 + i * 8192, R, C); Rv[i] = R; Cv[i] = C; Rbv[i] = Epi::PERM ? ((R & ~31) + perm32(R & 31)) : R; }
    unsigned voffA[2], voffB[2], voffAn[2], voffBn[2];
    const size_t kstep = (size_t)(BK * 2);
    size_t hstepA, hstepB, hstepAn, hstepBn;
#define PG8_STRIDES(u_, vA_, vB_, hA_, hB_) do { _Pragma("unroll") for (int _i = 0; _i < 2; ++_i) { vA_[_i] = (unsigned)(Rv[_i] * (u_).lda + Cv[_i]) * 2u; vB_[_i] = (unsigned)(Rbv[_i] * (u_).ldb + Cv[_i]) * 2u; } \
        hA_ = (size_t)HALF * (u_).lda * 2; hB_ = (size_t)HALF * (u_).ldb * 2; } while (0)
    const unsigned ldsw = (unsigned)wid * 1024u;
    const int aoff = lds_byte(wr * 64 + fr, fq * 8), boff = lds_byte(wc * 32 + fr, fq * 8);
#define PG8_SA(b, h) (((b) * 2 + (h)) * HTB)
#define PG8_SB(b, h) ((4 + (b) * 2 + (h)) * HTB)
#define PG8_STAGE(bufoff, gbase, voff) do { _Pragma("unroll") for (int _i = 0; _i < 2; ++_i) \
        __builtin_amdgcn_global_load_lds((const unsigned*)((const char*)(gbase) + (voff)[_i]), (PG8_LAS unsigned*)(lds + (bufoff) + ldsw + _i * 8192), 16, 0, 0); } while (0)
#define PG8_LDA(dst, b, h) do { _Pragma("unroll") for (int m = 0; m < 4; ++m) _Pragma("unroll") for (int k = 0; k < 2; ++k) dst[m][k] = *(const PG8_LAS bf16x8*)(lds + PG8_SA(b, h) + aoff + m * 2048 + k * 1024); } while (0)
#define PG8_LDB(dst, b, h) do { _Pragma("unroll") for (int n = 0; n < 2; ++n) _Pragma("unroll") for (int k = 0; k < 2; ++k) dst[n][k] = *(const PG8_LAS bf16x8*)(lds + PG8_SB(b, h) + boff + n * 2048 + k * 1024); } while (0)
#define PG8_MMA(ai, bj, At, Bt) do { __builtin_amdgcn_s_setprio(1); _Pragma("unroll") for (int m = 0; m < 4; ++m) _Pragma("unroll") for (int n = 0; n < 2; ++n) _Pragma("unroll") for (int k = 0; k < 2; ++k) \
        acc[ai][bj][m][n] = __builtin_amdgcn_mfma_f32_16x16x32_bf16(Bt[n][k], At[m][k], acc[ai][bj][m][n], 0, 0, 0); __builtin_amdgcn_s_setprio(0); } while (0)
#define PG8_WAIT_V(n) asm volatile("s_waitcnt vmcnt(" #n ")" ::: "memory")
#define PG8_WAIT_L(n) asm volatile("s_waitcnt lgkmcnt(" #n ")" ::: "memory")
#define PG8_BAR __builtin_amdgcn_s_barrier()
#define PG8_SCHED __builtin_amdgcn_sched_barrier(0)
    Unit cur, nxt; int ui = 0;
    if (!S.next(0, cur)) return;
    PG8_STRIDES(cur, voffA, voffB, hstepA, hstepB); int nt = cur.nt;
    f32x4 acc[2][2][4][2];
#pragma unroll
    for (int a = 0; a < 2; ++a)
#pragma unroll
        for (int b = 0; b < 2; ++b)
#pragma unroll
            for (int m = 0; m < 4; ++m)
#pragma unroll
                for (int n = 0; n < 2; ++n) acc[a][b][m][n] = (f32x4){0.f, 0.f, 0.f, 0.f};
    bf16x8 At[4][2], B0[2][2], B1[2][2];
    const char* cA = cur.A; const char* cB = cur.B;
    S.a_ready(cur);
    if constexpr (SP2) {
        PG8_STAGE(PG8_SB(0, 0), cB, voffB); PG8_STAGE(PG8_SB(0, 1), cB + hstepB, voffB); PG8_STAGE(PG8_SA(0, 0), cA, voffA); PG8_STAGE(PG8_SA(0, 1), cA + hstepA, voffA);
        if (wr == 1) PG8_BAR;
        PG8_WAIT_V(2); PG8_BAR;
        PG8_STAGE(PG8_SB(1, 0), cB + kstep, voffB); PG8_STAGE(PG8_SA(1, 0), cA + kstep, voffA); PG8_STAGE(PG8_SB(1, 1), cB + hstepB + kstep, voffB);
        PG8_WAIT_V(6); PG8_BAR;
    } else {
        PG8_STAGE(PG8_SB(0, 0), cB, voffB); PG8_STAGE(PG8_SA(0, 0), cA, voffA); PG8_STAGE(PG8_SB(0, 1), cB + hstepB, voffB); PG8_STAGE(PG8_SA(0, 1), cA + hstepA, voffA);
        if (wr == 1) PG8_BAR;
        PG8_WAIT_V(4); PG8_BAR;
        PG8_STAGE(PG8_SB(1, 0), cB + kstep, voffB); PG8_STAGE(PG8_SA(1, 0), cA + kstep, voffA); PG8_STAGE(PG8_SB(1, 1), cB + hstepB + kstep, voffB);
        PG8_WAIT_V(6); PG8_BAR;
    }
    for (;;) {
        const bool has_next = S.next(ui + 1, nxt);
        const char* nA = has_next ? nxt.A : cA; const char* nB = has_next ? nxt.B : cB;
        if (has_next) PG8_STRIDES(nxt, voffAn, voffBn, hstepAn, hstepBn); else { voffAn[0] = voffA[0]; voffAn[1] = voffA[1]; voffBn[0] = voffB[0]; voffBn[1] = voffB[1]; hstepAn = hstepA; hstepBn = hstepB; }
        for (int t = 0; t < nt; t += 2) {
            const bool last = (t == nt - 2);
            const char* a1 = cA + (size_t)(t + 1) * kstep;
            const char* a2 = last ? nA : cA + (size_t)(t + 2) * kstep; const char* b2 = last ? nB : cB + (size_t)(t + 2) * kstep;
            const char* a3 = a2 + kstep; const char* b3 = b2 + kstep;
            unsigned vA2[2], vB2[2]; vA2[0] = last ? voffAn[0] : voffA[0]; vA2[1] = last ? voffAn[1] : voffA[1]; vB2[0] = last ? voffBn[0] : voffB[0]; vB2[1] = last ? voffBn[1] : voffB[1];
            const size_t hA2 = last ? hstepAn : hstepA, hB2 = last ? hstepBn : hstepB;
            if (last && has_next) S.a_ready(nxt);
            if constexpr (SP2) {
            PG8_LDB(B0, 0, 0); PG8_LDB(B1, 0, 1); PG8_SCHED; PG8_LDA(At, 0, 0); PG8_STAGE(PG8_SA(1, 1), a1 + hstepA, voffA);
            PG8_WAIT_V(8); PG8_WAIT_L(0); PG8_BAR; PG8_MMA(0, 0, At, B0); PG8_MMA(0, 1, At, B1); PG8_BAR; PG8_SCHED;
            PG8_LDA(At, 0, 1); PG8_STAGE(PG8_SB(0, 0), b2, vB2); PG8_STAGE(PG8_SB(0, 1), b2 + hB2, vB2); PG8_STAGE(PG8_SA(0, 0), a2, vA2);
            PG8_WAIT_V(8); PG8_WAIT_L(0); PG8_BAR; PG8_MMA(1, 0, At, B0); PG8_MMA(1, 1, At, B1); PG8_BAR; PG8_SCHED;
            PG8_LDB(B0, 1, 0); PG8_LDB(B1, 1, 1); PG8_SCHED; PG8_LDA(At, 1, 0); PG8_STAGE(PG8_SA(0, 1), a2 + hA2, vA2);
            PG8_WAIT_V(8); PG8_WAIT_L(0); PG8_BAR; PG8_MMA(0, 0, At, B0); PG8_MMA(0, 1, At, B1); PG8_BAR; PG8_SCHED;
            PG8_LDA(At, 1, 1); PG8_STAGE(PG8_SB(1, 0), b3, vB2); PG8_STAGE(PG8_SB(1, 1), b3 + hB2, vB2); PG8_STAGE(PG8_SA(1, 0), a3, vA2);
            PG8_WAIT_V(8); PG8_WAIT_L(0); PG8_BAR; PG8_MMA(1, 0, At, B0); PG8_MMA(1, 1, At, B1); PG8_BAR; PG8_SCHED;
            } else {
            PG8_LDB(B0, 0, 0); PG8_SCHED; PG8_LDA(At, 0, 0); PG8_STAGE(PG8_SA(1, 1), a1 + hstepA, voffA);
            PG8_WAIT_L(8); PG8_BAR; PG8_WAIT_L(0); PG8_MMA(0, 0, At, B0); PG8_BAR; PG8_SCHED;
            PG8_LDB(B1, 0, 1); PG8_STAGE(PG8_SB(0, 0), b2, vB2);
            PG8_BAR; PG8_WAIT_L(0); PG8_MMA(0, 1, At, B1); PG8_BAR;
            PG8_LDA(At, 0, 1); PG8_STAGE(PG8_SA(0, 0), a2, vA2);
            PG8_BAR; PG8_WAIT_L(0); PG8_MMA(1, 0, At, B0); PG8_BAR; PG8_SCHED;
            PG8_STAGE(PG8_SB(0, 1), b2 + hB2, vB2);
            PG8_WAIT_V(6); PG8_BAR; PG8_MMA(1, 1, At, B1); PG8_BAR;
            PG8_LDB(B0, 1, 0); PG8_SCHED; PG8_LDA(At, 1, 0); PG8_STAGE(PG8_SA(0, 1), a2 + hA2, vA2);
            PG8_WAIT_L(8); PG8_BAR; PG8_WAIT_L(0); PG8_MMA(0, 0, At, B0); PG8_BAR; PG8_SCHED;
            PG8_LDB(B1, 1, 1); PG8_STAGE(PG8_SB(1, 0), b3, vB2);
            PG8_BAR; PG8_WAIT_L(0); PG8_MMA(0, 1, At, B1); PG8_BAR;
            PG8_LDA(At, 1, 1); PG8_STAGE(PG8_SA(1, 0), a3, vA2);
            PG8_BAR; PG8_WAIT_L(0); PG8_MMA(1, 0, At, B0); PG8_BAR; PG8_SCHED;
            PG8_STAGE(PG8_SB(1, 1), b3 + hB2, vB2);
            PG8_WAIT_V(6); PG8_BAR; PG8_MMA(1, 1, At, B1); PG8_BAR;
            }
        }
        if constexpr (ALIGN_EPI) { if (wr == 0) PG8_BAR; }
        if constexpr (!Epi::AFTER_DRAIN) { E(acc, cur, wr, wc, fr, fq); S.done(cur); }
        if (!has_next) break;
#pragma unroll
        for (int a = 0; a < 2; ++a)
#pragma unroll
            for (int b = 0; b < 2; ++b)
#pragma unroll
                for (int m = 0; m < 4; ++m)
#pragma unroll
                    for (int n = 0; n < 2; ++n) acc[a][b][m][n] = (f32x4){0.f, 0.f, 0.f, 0.f};
        cur = nxt; cA = nA; cB = nB; ++ui; nt = cur.nt; voffA[0] = voffAn[0]; voffA[1] = voffAn[1]; voffB[0] = voffBn[0]; voffB[1] = voffBn[1]; hstepA = hstepAn; hstepB = hstepBn;
        if constexpr (ALIGN_EPI) { if (wr == 1) PG8_BAR; }
    }
    PG8_WAIT_V(0);
    if constexpr (!ALIGN_EPI) { if (wr == 0) PG8_BAR; }
    PG8_BAR;
    if constexpr (Epi::AFTER_DRAIN) { E.fused(acc, cur, wr, wc, fr, fq, lds, wid, lane); S.done(cur); }
#undef PG8_STRIDES
#undef PG8_SA
#undef PG8_SB
#undef PG8_STAGE
#undef PG8_LDA
#undef PG8_LDB
#undef PG8_MMA
#undef PG8_WAIT_V
#undef PG8_WAIT_L
#undef PG8_BAR
#undef PG8_SCHED
}
}

#define DI __device__ __forceinline__
typedef unsigned short bf16;
typedef short bf16x8 __attribute__((ext_vector_type(8)));
typedef float f32x4 __attribute__((ext_vector_type(4)));
typedef unsigned u32x4 __attribute__((ext_vector_type(4)));
typedef unsigned u32x2 __attribute__((ext_vector_type(2)));

constexpr int D = 1024, NBATCH = 4, T = 4096, M = NBATCH * T, IN_TOTAL = 12184;
constexpr int LDP = 7168;
constexpr int C_RQ = 0, C_RK = 256, C_RV = 512, C_RG = 1024, C_GQ = 1536, C_GK = 1792, C_GV = 2048, C_GG = 2560,
              C_SX = 3072, C_SZ = 4096, C_WR = 4608, C_WK = 5120, C_WV = 5632, C_WL = 6144, C_AL = 6208, C_WG = 6272,
              C_MQ = 6784, C_GKL = 7040, C_SDT = 7056;
enum { I_X = 0, I_MEM, I_POS, I_NORMG, I_WIN, I_GKW2, I_GKB, I_GNORMG, I_CONVW, I_CONVB, I_DTB, I_ALOG, I_SD, I_SNORMG,
       I_MU, I_W0, I_W2, I_A0, I_A2, I_KK, I_KA, I_RK, I_LNG, I_LNB, I_MNORMG, I_WKV, I_URET, I_UGLA, I_USSD, I_URWKV,
       I_UMEM, I_WOUT, I_FNORMG, N_IN };
constexpr size_t MiB = 1u << 20;
constexpr size_t WS_SSQ = 0;
constexpr size_t WS_DG = 512 * 1024;
constexpr size_t WS_DS = 576 * 1024;
constexpr size_t WS_BAR = 640 * 1024;
constexpr size_t WS_KM = 1 * MiB;
constexpr size_t WS_VMT = 1 * MiB + 512 * 1024;
constexpr size_t WS_MEMN = 2 * MiB;
constexpr size_t WS_BND = 6 * MiB;
constexpr int BND_W = 1792;
constexpr size_t WS_XS = 7 * MiB;
constexpr size_t WS_XCNT = 640 * 1024 + 16384;
constexpr size_t WS_ZERO_BYTES = 16384 + 2 * 64 * 256;
constexpr size_t WS_W1T = 8 * MiB;
constexpr size_t WS_WGT = 22 * MiB;
constexpr size_t WS_UT = 32 * MiB;
constexpr size_t WS_UST = 35 * MiB;
constexpr size_t WS_UMT = 36 * MiB;
constexpr size_t WS_WOT = 37 * MiB;
constexpr size_t WS_WKVT = 39 * MiB;
constexpr size_t WS_XN = 40 * MiB;
constexpr size_t WS_P = 72 * MiB;
constexpr size_t WS_OMEM = 296 * MiB;
constexpr size_t WS_RETL = 304 * MiB;
constexpr size_t WS_GLAL = 312 * MiB;
constexpr size_t WS_SSDL = 320 * MiB;
constexpr size_t WS_MRG = 304 * MiB;
constexpr size_t WS_RWGH = 336 * MiB;
constexpr size_t WS_END = 368 * MiB;

constexpr int LDS_BYTES = 147456;
constexpr int NTHREADS = 512;

struct Params { const float* in[N_IN]; float* out; unsigned char* ws; };

DI float bf2f(unsigned b) { return __uint_as_float(b << 16); }
typedef __bf16 bf16n2 __attribute__((ext_vector_type(2)));
DI unsigned f2bf(float f) { const __bf16 b = (__bf16)f; return (unsigned)__builtin_bit_cast(unsigned short, b); }
DI unsigned pk2(float lo, float hi) { const bf16n2 v = {(__bf16)lo, (__bf16)hi}; return __builtin_bit_cast(unsigned, v); }
DI float lo16(unsigned u) { return __uint_as_float(u << 16); }
DI float hi16(unsigned u) { return __uint_as_float(u & 0xffff0000u); }
DI void unpack8(u32x4 v, float* f) { f[0] = lo16(v.x); f[1] = hi16(v.x); f[2] = lo16(v.y); f[3] = hi16(v.y); f[4] = lo16(v.z); f[5] = hi16(v.z); f[6] = lo16(v.w); f[7] = hi16(v.w); }
DI u32x4 pack8(const float* f) { u32x4 v; v.x = pk2(f[0], f[1]); v.y = pk2(f[2], f[3]); v.z = pk2(f[4], f[5]); v.w = pk2(f[6], f[7]); return v; }
DI u32x2 pack4(f32x4 a) { u32x2 v; v.x = pk2(a[0], a[1]); v.y = pk2(a[2], a[3]); return v; }
DI float fexp(float x) { return __expf(x); }
DI float sigmoidf_(float x) { return __builtin_amdgcn_rcpf(1.0f + __expf(-x)); }
DI float siluf_(float x) { return x * __builtin_amdgcn_rcpf(1.0f + __expf(-x)); }
DI float softplusf_(float x) { return fmaxf(x, 0.0f) + __logf(1.0f + __expf(-fabsf(x))); }
DI float logsigmoidf_(float x) { return fminf(x, 0.0f) - __logf(1.0f + __expf(-fabsf(x))); }
DI float tanhf_(float x) { const float e = __expf(2.0f * x); return 1.0f - 2.0f * __builtin_amdgcn_rcpf(e + 1.0f); }
DI int opaque_tid() { int t = threadIdx.x; asm volatile("" : "+v"(t)); return t; }
#ifdef TPROBE
#define TS_BASE(lds_) ((volatile unsigned*)((lds_) + LDS_BYTES - 64) + 2)
#define TS_BEGIN() do { if (threadIdx.x == 0) TS_BASE(lds)[13] = (unsigned)__builtin_amdgcn_s_memrealtime(); } while (0)
#define TS_MARK(k) do { if (threadIdx.x == 0) { const unsigned t_ = (unsigned)__builtin_amdgcn_s_memrealtime(); volatile unsigned* A_ = TS_BASE(lds); A_[k] += t_ - A_[13]; A_[13] = t_; } } while (0)
#endif
#define WAVE_LDS_SYNC() asm volatile("s_waitcnt lgkmcnt(0)" ::: "memory")
DI float wave_sum(float v) {
#pragma unroll
    for (int o = 1; o < 64; o <<= 1) v += __shfl_xor(v, o);
    return v;
}
DI bf16x8 frag(const bf16* base, int ld, int r0, int k0, int lane) { return *(const bf16x8*)(base + (r0 + (lane & 15)) * ld + k0 + ((lane >> 4) << 3)); }
DI f32x4 mfma16(bf16x8 a, bf16x8 b, f32x4 c) { return __builtin_amdgcn_mfma_f32_16x16x32_bf16(a, b, c, 0, 0, 0); }

DI void tile_map(int L, int nM, int nN, int& pm, int& pn) {
    const int nwg = nM * nN; int wgid = L;
    { const int q = nwg / 8, r = nwg % 8, xcd = wgid % 8, off = wgid / 8; wgid = (xcd < r ? xcd * (q + 1) : r * (q + 1) + (xcd - r) * q) + off; }
    const int nig = 8 * nN, gid = wgid / nig, fm = gid * 8, gsz = (nM - fm) < 8 ? (nM - fm) : 8;
    pm = fm + ((wgid % nig) % gsz); pn = (wgid % nig) / gsz;
}

using pg8::Unit;
struct SchedP1 {
    int G, c; const char* A; const char* B;
    DI bool next(int i, Unit& u) const {
        const long L = (long)i * G + c; if (L >= 64 * 28) return false;
        tile_map((int)L, 64, 28, u.pm, u.pn); u.kind = 0; u.aux = 0; u.nt = 16; u.lda = 1024; u.ldb = 1024; u.pad_ = 0;
        u.A = A + (size_t)u.pm * 256 * 1024 * 2; u.B = B + (size_t)u.pn * 256 * 1024 * 2; return true;
    }
    DI void a_ready(const Unit&) const {}
    DI void done(const Unit&) const {}
};
struct EpiP {
    static constexpr bool PERM = true, AFTER_DRAIN = false;
    bf16* O; bf16* BND;
    DI void operator()(const f32x4 (&acc)[2][2][4][2], const Unit& u, int wr, int wc, int fr, int fq) const {
        const int row0 = u.pm * 256 + wr * 64 + fr, col0 = u.pn * 256 + wc * 32 + 8 * fq;
#pragma unroll
        for (int ai = 0; ai < 2; ++ai)
#pragma unroll
            for (int m = 0; m < 4; ++m) { bf16* rowp = O + (size_t)(row0 + ai * 128 + m * 16) * LDP + col0;
#pragma unroll
                for (int bj = 0; bj < 2; ++bj) { const f32x4 v0 = acc[ai][bj][m][0], v1 = acc[ai][bj][m][1];
                    u32x4 w; w.x = pk2(v0[0], v0[1]); w.y = pk2(v0[2], v0[3]); w.z = pk2(v1[0], v1[1]); w.w = pk2(v1[2], v1[3]);
                    *(u32x4*)(rowp + bj * 128) = w;
                    if (m == 3 && fr == 15 && u.pn >= 18 && u.pn <= 24) *(u32x4*)(BND + (size_t)((row0 + ai * 128 + m * 16) >> 6) * BND_W + (col0 - 4608) + bj * 128) = w; } }
    }
};
DI int gate_slot_col(int s) { return s < 8 ? 128 * s : s < 16 ? 1536 + 128 * (s - 8) : s < 24 ? 3072 + 128 * (s - 16) : s < 37 ? 4608 + 128 * (s - 24) : 6784 + 128 * (s - 37); }
struct SchedP3 {
    int pm, pn; const unsigned char* ws;
    DI bool next(int i0, Unit& u) const {
        if (i0 >= 11) return false;
        const int i = i0 == 0 ? 0 : i0 == 1 ? 5 : i0 == 2 ? 1 : i0 == 3 ? 6 : i0 == 4 ? 3 : i0 == 5 ? 7 : i0 == 6 ? 2 : i0 == 7 ? 8 : i0 == 8 ? 9 : i0 == 9 ? 4 : 10;
        u.pm = pm; u.pn = pn; u.pad_ = 0;
        if (i < 5) { u.kind = i; u.aux = 16; u.nt = 16; u.lda = 1024; u.ldb = 1024; u.A = (const char*)ws + WS_XN + (size_t)pm * 256 * 1024 * 2;
            u.B = (const char*)ws + WS_WGT + ((size_t)i * 1024 + (size_t)pn * 256) * 1024 * 2; }
        else if (i < 8) { const int j = i - 5; const int col = j == 0 ? C_RG : j == 1 ? C_GG : C_WG; u.kind = j == 0 ? 0 : j == 1 ? 1 : 3; u.aux = (j == 0) ? 1 : 0; u.nt = 8; u.lda = LDP; u.ldb = 512;
            u.A = (const char*)ws + WS_P + ((size_t)pm * 256 * LDP + col) * 2;
            u.B = (const char*)ws + WS_UT + ((size_t)j * 1024 + (size_t)pn * 256) * 512 * 2; }
        else if (i < 10) { const int j = i - 8; u.kind = 2; u.aux = (j + 1) << 1; u.nt = 4; u.lda = LDP; u.ldb = 256;
            u.A = (const char*)ws + WS_P + ((size_t)pm * 256 * LDP + C_SZ + j * 256) * 2;
            u.B = (const char*)ws + WS_UST + ((size_t)j * 1024 + (size_t)pn * 256) * 256 * 2; }
        else { u.kind = 4; u.aux = 0; u.nt = 4; u.lda = 256; u.ldb = 256; u.A = (const char*)ws + WS_OMEM + (size_t)pm * 256 * 256 * 2;
            u.B = (const char*)ws + WS_UMT + ((size_t)pn * 256) * 256 * 2; }
        return true;
    }
    DI void a_ready(const Unit&) const {}
    DI void done(const Unit&) const {}
};
typedef float f32x2 __attribute__((ext_vector_type(2)));
DI f32x2 sig255_pk(f32x2 x) {
    x = __builtin_elementwise_min(__builtin_elementwise_max(x, (f32x2){-7.0f, -7.0f}), (f32x2){7.0f, 7.0f});
    const f32x2 x2 = x * x;
    f32x2 q = x2 * 9.362619013e-11f + (-1.716749942e-08f);
    q = q * x2 + 1.283517804e-06f; q = q * x2 + (-5.098115798e-05f); q = q * x2 + 1.195220742e-03f; q = q * x2 + (-1.824038848e-02f); q = q * x2 + 2.476293743e-01f;
    return (x * q) * 255.0f + 128.0f;
}
DI f32x2 sig_pk(f32x2 x) { return (sig255_pk(x) - 128.0f) * (1.0f / 255.0f) + 0.5f; }
struct EpiGate {
    static constexpr bool PERM = true, AFTER_DRAIN = false;
    bf16* P;
    DI void operator()(const f32x4 (&acc)[2][2][4][2], const Unit& u, int wr, int wc, int fr, int fq) const {
        const int row0 = u.pm * 256 + wr * 64 + fr;
#pragma unroll
        for (int bj = 0; bj < 2; ++bj) { const int col = gate_slot_col((u.kind * 4 + u.pn) * 2 + bj);
#pragma unroll
            for (int ai = 0; ai < 2; ++ai)
#pragma unroll
                for (int m = 0; m < 4; ++m) { const f32x4 v0 = acc[ai][bj][m][0], v1 = acc[ai][bj][m][1];
                    const f32x2 a = sig255_pk((f32x2){v0[0], v0[1]}), b = sig255_pk((f32x2){v0[2], v0[3]}), c = sig255_pk((f32x2){v1[0], v1[1]}), d = sig255_pk((f32x2){v1[2], v1[3]});
                    u32x2 w; w.x = (unsigned)a.x | ((unsigned)a.y << 8) | ((unsigned)b.x << 16) | ((unsigned)b.y << 24);
                    w.y = (unsigned)c.x | ((unsigned)c.y << 8) | ((unsigned)d.x << 16) | ((unsigned)d.y << 24);
                    *(u32x2*)((unsigned char*)(P + (size_t)(row0 + ai * 128 + m * 16) * LDP + col) + wc * 32 + 8 * fq) = w; } }
    }
};
struct EpiBranch {
    static constexpr bool PERM = true, AFTER_DRAIN = false;
    const bf16* P; bf16* MG; const float* ssq;
    DI void operator()(const f32x4 (&acc)[2][2][4][2], const Unit& u, int wr, int wc, int fr, int fq) const {
        const int row0 = u.pm * 256 + wr * 64 + fr; const bool first = (u.aux & 1) != 0; const int grp = (u.aux >> 1) - 1;
        const int gc0 = gate_slot_col((u.kind * 4 + u.pn) * 2 + 0), gc1 = gate_slot_col((u.kind * 4 + u.pn) * 2 + 1);
#pragma unroll
        for (int ai = 0; ai < 2; ++ai) {
            u32x2 g8[4][2]; u32x4 o8[4][2]; f32x4 s4[4];
#pragma unroll
            for (int m = 0; m < 4; ++m) { const int row = row0 + ai * 128 + m * 16;
                s4[m] = *(const f32x4*)(ssq + (size_t)row * 8 + (grp > 0 ? 4 : 0));
#pragma unroll
                for (int bj = 0; bj < 2; ++bj) {
                    g8[m][bj] = *(const u32x2*)((const unsigned char*)(P + (size_t)row * LDP + (bj ? gc1 : gc0)) + wc * 32 + 8 * fq);
                    o8[m][bj] = *(const u32x4*)(MG + (size_t)row * 1024 + u.pn * 256 + bj * 128 + wc * 32 + 8 * fq); } }
            __builtin_amdgcn_sched_barrier(0);
#pragma unroll
            for (int m = 0; m < 4; ++m) { const int row = row0 + ai * 128 + m * 16;
                const float sc = (grp >= 0) ? __builtin_amdgcn_rsqf(((s4[m][0] + s4[m][1]) + (s4[m][2] + s4[m][3])) * (1.0f / 256.0f) + 1e-6f) : 1.0f;
#pragma unroll
                for (int bj = 0; bj < 2; ++bj) { float g[8], pv[8];
#pragma unroll
                    for (int j = 0; j < 4; ++j) { g[j] = (float)((g8[m][bj].x >> (8 * j)) & 0xffu) * (1.0f / 255.0f); g[4 + j] = (float)((g8[m][bj].y >> (8 * j)) & 0xffu) * (1.0f / 255.0f); }
                    unpack8(o8[m][bj], pv);
                    if (first) {
#pragma unroll
                        for (int j = 0; j < 8; ++j) pv[j] = 0.f; }
                    const f32x4 v0 = acc[ai][bj][m][0], v1 = acc[ai][bj][m][1];
                    float o[8] = { v0[0] * sc * g[0] + pv[0], v0[1] * sc * g[1] + pv[1], v0[2] * sc * g[2] + pv[2], v0[3] * sc * g[3] + pv[3], v1[0] * sc * g[4] + pv[4], v1[1] * sc * g[5] + pv[5], v1[2] * sc * g[6] + pv[6], v1[3] * sc * g[7] + pv[7] };
                    *(u32x4*)(MG + (size_t)row * 1024 + u.pn * 256 + bj * 128 + wc * 32 + 8 * fq) = pack8(o); } }
        }
    }
};
struct EpiP3 {
    static constexpr bool PERM = true, AFTER_DRAIN = false;
    EpiGate G; EpiBranch B;
    DI void operator()(const f32x4 (&acc)[2][2][4][2], const Unit& u, int wr, int wc, int fr, int fq) const { if (u.aux & 16) G(acc, u, wr, wc, fr, fq); else B(acc, u, wr, wc, fr, fq); }
};
struct SchedP4 {
    int G, c; const char* A; const char* B;
    DI bool next(int i, Unit& u) const {
        const long L = (long)i * G + c; if (L >= 64 * 4) return false;
        tile_map((int)L, 64, 4, u.pm, u.pn); u.kind = 0; u.aux = 0; u.nt = 16; u.lda = 1024; u.ldb = 1024; u.pad_ = 0;
        u.A = A + (size_t)u.pm * 256 * 1024 * 2; u.B = B + (size_t)u.pn * 256 * 1024 * 2; return true;
    }
    DI void a_ready(const Unit&) const {}
    DI void done(const Unit&) const {}
};
struct EpiRes {
    static constexpr bool PERM = false, AFTER_DRAIN = false;
    const float* res; float* out;
    DI void operator()(const f32x4 (&acc)[2][2][4][2], const Unit& u, int wr, int wc, int fr, int fq) const {
        const int row0 = u.pm * 256 + wr * 64 + fr, col0 = u.pn * 256 + wc * 32 + 4 * fq;
#pragma unroll
        for (int ai = 0; ai < 2; ++ai)
#pragma unroll
            for (int m = 0; m < 4; ++m) { const size_t off = (size_t)(row0 + ai * 128 + m * 16) * 1024 + col0;
#pragma unroll
                for (int bj = 0; bj < 2; ++bj)
#pragma unroll
                    for (int n = 0; n < 2; ++n) { const f32x4 r = *(const f32x4*)(res + off + bj * 128 + n * 16); *(f32x4*)(out + off + bj * 128 + n * 16) = r + acc[ai][bj][m][n]; } }
    }
};

template <bool LAST> struct EpiNorm {
    static constexpr bool PERM = false, AFTER_DRAIN = true;
    const float* res; float* out; const float* g; bf16* xn; float* xs; unsigned* cnt;
    DI void operator()(const f32x4 (&)[2][2][4][2], const Unit&, int, int, int, int) const {}
    DI void fused(f32x4 (&acc)[2][2][4][2], const Unit& u, int wr, int wc, int fr, int fq, PG8_LAS unsigned char* lds, int wid, int lane) const {
        PG8_LAS float* Pt = (PG8_LAS float*)lds; PG8_LAS float* St = Pt + 1024;
        const int row0 = u.pm * 256 + wr * 64 + fr, col0 = u.pn * 256 + wc * 32 + 4 * fq;
#pragma unroll
        for (int ai = 0; ai < 2; ++ai)
#pragma unroll
            for (int m = 0; m < 4; ++m) { const size_t off = (size_t)(row0 + ai * 128 + m * 16) * 1024 + col0; float s = 0.f;
#pragma unroll
                for (int bj = 0; bj < 2; ++bj)
#pragma unroll
                    for (int n = 0; n < 2; ++n) { const f32x4 r = *(const f32x4*)(res + off + bj * 128 + n * 16); const f32x4 x = r + acc[ai][bj][m][n]; acc[ai][bj][m][n] = x;
                        s += (x[0] * x[0] + x[1] * x[1]) + (x[2] * x[2] + x[3] * x[3]); }
                s += __shfl_xor(s, 16); s += __shfl_xor(s, 32);
                if (fq == 0) Pt[(ai * 128 + wr * 64 + m * 16 + fr) * 4 + wc] = s; }
        asm volatile("s_waitcnt lgkmcnt(0)" ::: "memory"); __builtin_amdgcn_s_barrier(); asm volatile("" ::: "memory");
        const int row = wid * 32 + (lane & 31);
        if (lane < 32) { const float t = (Pt[row * 4 + 0] + Pt[row * 4 + 1]) + (Pt[row * 4 + 2] + Pt[row * 4 + 3]);
            __hip_atomic_store(xs + ((size_t)u.pm * 256 + row) * 4 + u.pn, t, __ATOMIC_RELAXED, __HIP_MEMORY_SCOPE_AGENT); }
        asm volatile("s_waitcnt vmcnt(0)" ::: "memory");
        if (lane == 0) (void)__hip_atomic_fetch_add(cnt + u.pm * 64, 1u, __ATOMIC_RELAXED, __HIP_MEMORY_SCOPE_AGENT);
        if (wid == 0) { unsigned spins = 0;
            while ((unsigned)__builtin_amdgcn_readfirstlane(__hip_atomic_load(cnt + u.pm * 64, __ATOMIC_RELAXED, __HIP_MEMORY_SCOPE_AGENT)) < 32u) { __builtin_amdgcn_s_sleep(2); if (++spins > (1u << 22)) break; }
            __builtin_amdgcn_fence(__ATOMIC_ACQUIRE, "agent"); asm volatile("s_waitcnt vmcnt(0)" ::: "memory"); }
        asm volatile("" ::: "memory"); __builtin_amdgcn_s_barrier(); asm volatile("" ::: "memory");
        if (lane < 32) { const float* sp = xs + ((size_t)u.pm * 256 + row) * 4;
            const float a = __hip_atomic_load(sp + 0, __ATOMIC_RELAXED, __HIP_MEMORY_SCOPE_AGENT), b = __hip_atomic_load(sp + 1, __ATOMIC_RELAXED, __HIP_MEMORY_SCOPE_AGENT),
                        c = __hip_atomic_load(sp + 2, __ATOMIC_RELAXED, __HIP_MEMORY_SCOPE_AGENT), d = __hip_atomic_load(sp + 3, __ATOMIC_RELAXED, __HIP_MEMORY_SCOPE_AGENT);
            St[row] = __builtin_amdgcn_rsqf(((a + b) + (c + d)) * (1.0f / 1024.0f) + 1e-6f); }
        asm volatile("s_waitcnt lgkmcnt(0)" ::: "memory"); __builtin_amdgcn_s_barrier(); asm volatile("" ::: "memory");
#pragma unroll
        for (int ai = 0; ai < 2; ++ai)
#pragma unroll
            for (int m = 0; m < 4; ++m) { const size_t off = (size_t)(row0 + ai * 128 + m * 16) * 1024 + col0; const float rs = St[ai * 128 + wr * 64 + m * 16 + fr];
#pragma unroll
                for (int bj = 0; bj < 2; ++bj)
#pragma unroll
                    for (int n = 0; n < 2; ++n) { const f32x4 gv = *(const f32x4*)(g + col0 + bj * 128 + n * 16); const f32x4 x = acc[ai][bj][m][n]; const f32x4 y = x * rs * gv;
                        if (LAST) *(f32x4*)(out + off + bj * 128 + n * 16) = y;
                        else { *(f32x4*)(out + off + bj * 128 + n * 16) = x; *(u32x2*)(xn + off + bj * 128 + n * 16) = pack4(y); } } }
    }
};

DI void transpose_item(const float* W, int ldw, int K, bf16* WT, float* scr, int item, int nblk, int lane) {
    const int kb = item / nblk, nb = item % nblk, k0 = 64 * kb, n0 = 32 * nb;
    float tv[32];
#pragma unroll
    for (int i = 0; i < 32; ++i) { const int kk = 2 * i + (lane >> 5); tv[i] = W[(size_t)(k0 + kk) * ldw + n0 + (lane & 31)]; }
#pragma unroll
    for (int i = 0; i < 32; ++i) { const int kk = 2 * i + (lane >> 5); scr[kk * 33 + (lane & 31)] = tv[i]; }
    WAVE_LDS_SYNC();
    const int c = lane & 7;
#pragma unroll
    for (int j = 0; j < 4; ++j) { const int n = (lane >> 3) + 8 * j; const float* s = scr + (8 * c) * 33 + n;
        u32x4 o; o.x = pk2(s[0 * 33], s[1 * 33]); o.y = pk2(s[2 * 33], s[3 * 33]); o.z = pk2(s[4 * 33], s[5 * 33]); o.w = pk2(s[6 * 33], s[7 * 33]);
        *(u32x4*)(WT + (size_t)(n0 + n) * K + k0 + 8 * c) = o; }
    WAVE_LDS_SYNC();
}
struct TSeg { int inp, lstride, src0, ldw, K, nblk; unsigned dst_q, dst_rows0; };
DI void rms_row_bf16(const float* xrow, const float* g, bf16* orow, int lane) {
    const f32x4* xr = (const f32x4*)xrow + lane; const f32x4* gr = (const f32x4*)g + lane;
    f32x4 v[4]; float s = 0.f;
#pragma unroll
    for (int j = 0; j < 4; ++j) { v[j] = xr[64 * j]; s += (v[j][0] * v[j][0] + v[j][1] * v[j][1]) + (v[j][2] * v[j][2] + v[j][3] * v[j][3]); }
    const float rstd = __builtin_amdgcn_rsqf(wave_sum(s) * (1.0f / 1024.0f) + 1e-6f);
    u32x2* o8 = (u32x2*)orow + lane;
#pragma unroll
    for (int j = 0; j < 4; ++j) { const f32x4 gg = gr[64 * j]; u32x2 o; o.x = pk2(v[j][0] * rstd * gg[0], v[j][1] * rstd * gg[1]); o.y = pk2(v[j][2] * rstd * gg[2], v[j][3] * rstd * gg[3]); o8[64 * j] = o; }
}
DI void convert_weights(const Params& p, int l, unsigned char* lds) {
    const int tid = opaque_tid(), lane = tid & 63, wave = tid >> 6;
    const int gw = blockIdx.x * 8 + wave, NGW = gridDim.x * 8;
    float* scr = (float*)(lds + wave * 16384);
    static constexpr TSeg segs[] = {
        {I_WIN, 1024 * IN_TOTAL, 0,    IN_TOTAL, 1024, 2560 / 32, 32, 0},
        {I_WIN, 1024 * IN_TOTAL, 2576, IN_TOTAL, 1024, 512 / 32,  32, 2560},
        {I_WIN, 1024 * IN_TOTAL, 3088, IN_TOTAL, 1024, 1024 / 32, 32, 3072},
        {I_WIN, 1024 * IN_TOTAL, 4120, IN_TOTAL, 1024, 512 / 32,  32, 4096},
        {I_WIN, 1024 * IN_TOTAL, 4632, IN_TOTAL, 1024, 1664 / 32, 32, 4608},
        {I_WIN, 1024 * IN_TOTAL, 6296, IN_TOTAL, 1024, 512 / 32,  32, 6272},
        {I_WIN, 1024 * IN_TOTAL, 6808, IN_TOTAL, 1024, 256 / 32,  32, 6784},
        {I_WIN, 1024 * IN_TOTAL, 7064, IN_TOTAL, 1024, 5120 / 32, 88, 0},
        {I_URET,  512 * 1024, 0, 1024, 512, 32, 128, 0},
        {I_UGLA,  512 * 1024, 0, 1024, 512, 32, 128, 1024},
        {I_URWKV, 512 * 1024, 0, 1024, 512, 32, 128, 2048},
        {I_USSD,  512 * 1024, 0,          1024, 256, 32, 140, 0},
        {I_USSD,  512 * 1024, 256 * 1024, 1024, 256, 32, 140, 1024},
        {I_UMEM,  256 * 1024, 0, 1024, 256, 32, 144, 0},
        {I_WOUT, 1024 * 1024, 0, 1024, 1024, 32, 148, 0},
        {I_WKV,  1024 * 512,  0, 512,  1024, 16, 156, 0},
    };
    constexpr int NSEG = sizeof(segs) / sizeof(segs[0]);
    int base = 0;
    for (int s = 0; s < NSEG; ++s) {
        const TSeg sg = segs[s]; const int nitems = (sg.K / 64) * sg.nblk;
        int it = gw - (base % NGW); if (it < 0) it += NGW;
        const float* W = p.in[sg.inp] + (size_t)l * sg.lstride + sg.src0;
        bf16* WT = (bf16*)(p.ws + (size_t)sg.dst_q * 262144) + (size_t)sg.dst_rows0 * sg.K;
        for (; it < nitems; it += NGW) transpose_item(W, sg.ldw, sg.K, WT, scr, it, sg.nblk, lane);
        base += nitems;
    }
    for (int idx = blockIdx.x * NTHREADS + tid; idx < 128 * 1024; idx += gridDim.x * NTHREADS) {
        const int r = (idx >> 10) & 127, k = idx & 1023;
        const float* W = p.in[I_WIN] + (size_t)l * 1024 * IN_TOTAL + (size_t)k * IN_TOTAL;
        const float v = r < 16 ? W[2560 + r] : r < 24 ? W[4112 + (r - 16)] : 0.0f;
        ((bf16*)(p.ws + WS_W1T))[((size_t)7040 + r) * 1024 + k] = (bf16)f2bf(v);
    }
}
DI void rms_rows2_bf16(const float* x0, const float* x1, const float* g, bf16* o0, bf16* o1, int lane) {
    const f32x4* xa = (const f32x4*)x0 + lane; const f32x4* xb = (const f32x4*)x1 + lane; const f32x4* gr = (const f32x4*)g + lane;
    f32x4 va[4], vb[4]; float sa = 0.f, sb = 0.f;
#pragma unroll
    for (int j = 0; j < 4; ++j) { va[j] = xa[64 * j]; vb[j] = xb[64 * j]; }
#pragma unroll
    for (int j = 0; j < 4; ++j) { sa += (va[j][0] * va[j][0] + va[j][1] * va[j][1]) + (va[j][2] * va[j][2] + va[j][3] * va[j][3]); sb += (vb[j][0] * vb[j][0] + vb[j][1] * vb[j][1]) + (vb[j][2] * vb[j][2] + vb[j][3] * vb[j][3]); }
    const float ra = __builtin_amdgcn_rsqf(wave_sum(sa) * (1.0f / 1024.0f) + 1e-6f), rb = __builtin_amdgcn_rsqf(wave_sum(sb) * (1.0f / 1024.0f) + 1e-6f);
    u32x2* pa = (u32x2*)o0 + lane; u32x2* pb = (u32x2*)o1 + lane;
#pragma unroll
    for (int j = 0; j < 4; ++j) { const f32x4 gg = gr[64 * j]; u32x2 o; o.x = pk2(va[j][0] * ra * gg[0], va[j][1] * ra * gg[1]); o.y = pk2(va[j][2] * ra * gg[2], va[j][3] * ra * gg[3]); pa[64 * j] = o;
        o.x = pk2(vb[j][0] * rb * gg[0], vb[j][1] * rb * gg[1]); o.y = pk2(vb[j][2] * rb * gg[2], vb[j][3] * rb * gg[3]); pb[64 * j] = o; }
}
DI void phase_prologue(const Params& p, unsigned char* lds) {
    const int tid = opaque_tid(), lane = tid & 63, wave = tid >> 6;
    const int gw = blockIdx.x * 8 + wave, NGW = gridDim.x * 8;
    convert_weights(p, 0, lds);
    for (int m = gw; m < M; m += 2 * NGW) { const int m1 = m + NGW;
        if (m1 < M) rms_rows2_bf16(p.in[I_X] + (size_t)m * 1024, p.in[I_X] + (size_t)m1 * 1024, p.in[I_NORMG], (bf16*)(p.ws + WS_XN) + (size_t)m * 1024, (bf16*)(p.ws + WS_XN) + (size_t)m1 * 1024, lane);
        else rms_row_bf16(p.in[I_X] + (size_t)m * 1024, p.in[I_NORMG], (bf16*)(p.ws + WS_XN) + (size_t)m * 1024, lane); }
    for (int m = gw; m < 2048; m += NGW) { const int l = m >> 10, r = m & 1023;
        rms_row_bf16(p.in[I_MEM] + (size_t)r * 1024, p.in[I_MNORMG] + l * 1024, (bf16*)(p.ws + WS_MEMN) + (size_t)m * 1024, lane); }
}
DI void phase_norm(const Params& p, int l, float oscale, unsigned char* lds) {
    const int tid = opaque_tid(), lane = tid & 63, wave = tid >> 6;
    const int gw = blockIdx.x * 8 + wave, NGW = gridDim.x * 8;
    if (l == 0) { convert_weights(p, 1, lds); for (int m = gw; m < M; m += NGW) rms_row_bf16(p.out + (size_t)m * 1024, p.in[I_NORMG] + 1024, (bf16*)(p.ws + WS_XN) + (size_t)m * 1024, lane); }
    else {
        for (int m = gw; m < M; m += NGW) {
            f32x4* xr = (f32x4*)(p.out + (size_t)m * 1024) + lane; const f32x4* gr = (const f32x4*)p.in[I_FNORMG] + lane;
            f32x4 v[4]; float s = 0.f;
#pragma unroll
            for (int j = 0; j < 4; ++j) { v[j] = xr[64 * j]; s += (v[j][0] * v[j][0] + v[j][1] * v[j][1]) + (v[j][2] * v[j][2] + v[j][3] * v[j][3]); }
            const float rstd = __builtin_amdgcn_rsqf(wave_sum(s) * (1.0f / 1024.0f) + 1e-6f);
#pragma unroll
            for (int j = 0; j < 4; ++j) xr[64 * j] = v[j] * (rstd * oscale) * gr[64 * j];
        }
    }
}

#define XB_TMO      128
#define XB_XCNT(j)  (256  + 64 * (j))
#define XB_XSUB(j)  (1280 + 64 * (j))
#define XB_XGEN(j)  (2304 + 64 * (j))
#define XB_TOP      3328
#define XB_TOPGEN   3392
#define XCD_BAR_WORDS 3456
#define XB_SPIN_CAP (1u << 18)

__device__ __forceinline__ unsigned xb_ld(unsigned* p)              { return __hip_atomic_load(p, __ATOMIC_RELAXED, __HIP_MEMORY_SCOPE_AGENT); }
__device__ __forceinline__ unsigned xb_add(unsigned* p, unsigned v) { return __hip_atomic_fetch_add(p, v, __ATOMIC_RELAXED, __HIP_MEMORY_SCOPE_AGENT); }
__device__ __forceinline__ unsigned xb_xcc_id() { return (unsigned)__builtin_amdgcn_s_getreg((3 << 11) | 20) & 0xFu; }
#define XB_SPIN(cond, bar) do { unsigned _sp = 0; while (cond) { __builtin_amdgcn_s_sleep(1); \
    if ((++_sp & 255u) == 0u) { if (xb_ld(&(bar)[XB_TMO])) break; if (_sp > XB_SPIN_CAP) { atomicAdd(&(bar)[XB_TMO], 1u); break; } } } } while (0)

struct XcdBarrier {
    unsigned* bar; unsigned x;
    volatile unsigned* st;
};

__device__ __forceinline__ XcdBarrier xcd_barrier_post(unsigned* bar, volatile unsigned* st) {
    XcdBarrier b; b.bar = bar; b.x = xb_xcc_id(); b.st = st;
    if (threadIdx.x == 0) (void)xb_add(&bar[XB_XCNT(b.x)], 1u);
    return b;
}
__device__ __forceinline__ void xcd_barrier_complete(unsigned* bar, unsigned x, unsigned& nloc, unsigned& nx) {
    const unsigned G = gridDim.x * gridDim.y * gridDim.z;
    unsigned sum, cnt, mine, sp = 0u;
    for (;;) {
        sum = 0u; cnt = 0u; mine = 0u;
#pragma unroll
        for (unsigned j = 0; j < 16; ++j) { const unsigned c = xb_ld(&bar[XB_XCNT(j)]); sum += c; cnt += (c > 0u) ? 1u : 0u; mine = (j == x) ? c : mine; }
        if (sum == G) break;
        __builtin_amdgcn_s_sleep(1);
        if ((++sp & 255u) == 0u) { if (xb_ld(&bar[XB_TMO])) break; if (sp > XB_SPIN_CAP) { atomicAdd(&bar[XB_TMO], 1u); break; } }
    }
    nloc = mine > 0u ? mine : 1u; nx = cnt > 0u ? cnt : 1u;
}

__device__ __forceinline__ void xcd_barrier(const XcdBarrier& b) {
    asm volatile("s_waitcnt vmcnt(0)" ::: "memory");
    __syncthreads();
    if (threadIdx.x == 0) {
        unsigned* bar = b.bar;
        __builtin_amdgcn_s_waitcnt(0);
        unsigned nloc = b.st[0], nx = b.st[1];
        if (nloc == 0u) { xcd_barrier_complete(bar, b.x, nloc, nx); b.st[0] = nloc; b.st[1] = nx; }
        const unsigned old = xb_add(&bar[XB_XSUB(b.x)], 1u);
        const unsigned gen = old / nloc;
        if (old + 1u == (gen + 1u) * nloc) {
            __builtin_amdgcn_fence(__ATOMIC_RELEASE, "agent");
            asm volatile("s_waitcnt vmcnt(0)" ::: "memory");
            const unsigned og = xb_add(&bar[XB_TOP], 1u);
            const unsigned tg = og / nx;
            if (og + 1u == (tg + 1u) * nx) xb_add(&bar[XB_TOPGEN], 1u);
            else XB_SPIN(xb_ld(&bar[XB_TOPGEN]) == tg, bar);
            __builtin_amdgcn_fence(__ATOMIC_ACQUIRE, "agent");
            xb_add(&bar[XB_XGEN(b.x)], 1u);
            asm volatile("s_waitcnt vmcnt(0)" ::: "memory");
        } else {
            XB_SPIN(xb_ld(&bar[XB_XGEN(b.x)]) == gen, bar);
            __builtin_amdgcn_fence(__ATOMIC_ACQUIRE, "agent");
            asm volatile("s_waitcnt vmcnt(0)" ::: "memory");
        }
    }
    __syncthreads();
}

DI void sincos_red(float ang, float& s, float& c) {
    const float n = rintf(ang * 0.15915494309189535f); float r = fmaf(-n, 6.28318548202514648f, ang); r = fmaf(-n, -1.7484555e-7f, r);
    s = __sinf(r); c = __cosf(r);
}

typedef short s16x4 __attribute__((ext_vector_type(4)));
DI s16x4 lds_tr(const bf16* p) { return __builtin_amdgcn_ds_read_tr16_b64_v4i16((__attribute__((address_space(3))) s16x4*)p); }
DI bf16x8 frag_tr(const bf16* base, int ld, int r0, int k0, int lane) {
    const bf16* p = base + (k0 + 8 * (lane >> 4) + ((lane & 15) >> 2)) * ld + r0 + 4 * (lane & 3);
    const s16x4 lo = lds_tr(p), hi = lds_tr(p + 4 * ld);
    return (bf16x8){lo[0], lo[1], lo[2], lo[3], hi[0], hi[1], hi[2], hi[3]};
}
DI bf16x8 frag_tr_perm(const bf16* base, int ld, int r0, int k0, int lane) {
    const bf16* p = base + (k0 + 4 * (lane >> 4) + ((lane & 15) >> 2)) * ld + r0 + 4 * (lane & 3);
    const s16x4 lo = lds_tr(p), hi = lds_tr(p + 16 * ld);
    return (bf16x8){lo[0], lo[1], lo[2], lo[3], hi[0], hi[1], hi[2], hi[3]};
}
constexpr int QK_QIN = 0, QK_KIN = 9216, QK_QC = 18432, QK_KST = 27648, QK_VT = 36864, QK_GKL = 55296, QK_INV = 59392, QK_ST = 64512, QK_CUM = 82944, QK_TOT = 99328, QK_RED = 101376, QK_ELAST = 103424;
#if defined(TPROBE) && defined(QTS_SEL)
#define QTS_ON() (((QTS_SEL) & 1) == (GLA ? 1 : 0) && (((QTS_SEL) >> 1) == (full ? 0 : 1)))
#define QTS_BEGIN() do { if (QTS_ON() && threadIdx.x == 0) TS_BASE(lds)[13] = (unsigned)__builtin_amdgcn_s_memrealtime(); } while (0)
#define QTS_MARK(k) do { if (QTS_ON() && threadIdx.x == 0) { const unsigned t_ = (unsigned)__builtin_amdgcn_s_memrealtime(); volatile unsigned* A_ = TS_BASE(lds); A_[k] += t_ - A_[13]; A_[13] = t_; } } while (0)
#else
#define QTS_BEGIN() do {} while (0)
#define QTS_MARK(k) do {} while (0)
#endif
template <bool GLA>
DI void qkv_item(const Params& p, int l, unsigned char* lds, int b, int h, int sc, bool full, bool dry = false) {
    QTS_BEGIN();
    const int tid = opaque_tid(), lane = tid & 63, w = tid >> 6, q4 = lane >> 4, l15 = lane & 15;
    bf16* P = (bf16*)(p.ws + WS_P);
    bf16* QIN = (bf16*)(lds + QK_QIN); bf16* KIN = (bf16*)(lds + QK_KIN); bf16* QC = (bf16*)(lds + QK_QC); bf16* KST = (bf16*)(lds + QK_KST);
    bf16* VT = (bf16*)(lds + QK_VT); bf16* ST = (bf16*)(lds + QK_ST);
    float* GKL = (float*)(lds + QK_GKL); float* INV = (float*)(lds + QK_INV);
    float* CUM = (float*)(lds + QK_CUM); float* TOT = (float*)(lds + QK_TOT); float* RED = (float*)(lds + QK_RED); float* ELAST = (float*)(lds + QK_ELAST);
    const int cq = GLA ? C_GQ : C_RQ, ck = GLA ? C_GK : C_RK, cv = GLA ? C_GV : C_RV, cgate = GLA ? C_GG : C_RG;
    const int bh = b * 4 + h;
    float* Lst = (float*)(p.ws + (GLA ? WS_GLAL : WS_RETL)) + (size_t)(bh * 16 + sc) * 8192;
    const float lgam = __logf(1.0f - exp2f(-5.0f - (float)h));
    const int st_t = tid >> 3, st_cg = tid & 7;
    f32x4 sacc[4];
#pragma unroll
    for (int mt = 0; mt < 4; ++mt) {
        if (full) { for (int j = 0; j < 4; ++j) sacc[mt][j] = Lst[(16 * mt + 4 * q4 + j) * 128 + 16 * w + l15]; *(u32x2*)(ST + (16 * w + l15) * 72 + 16 * mt + 4 * q4) = pack4(sacc[mt]); }
        else sacc[mt] = (f32x4){0.f, 0.f, 0.f, 0.f};
    }
    f32x4 gng = (f32x4){1.f, 1.f, 1.f, 1.f}; if (GLA) gng = *(const f32x4*)(p.in[I_GNORMG] + l * 128 + 16 * w + 4 * q4);
    float w2c[16], gb = 0.f;
    if (GLA) { const int ch = h * 64 + lane;
#pragma unroll
        for (int j = 0; j < 16; ++j) w2c[j] = p.in[I_GKW2][(size_t)l * 16 * 256 + j * 256 + ch];
        gb = p.in[I_GKB][l * 256 + ch]; }
    else if (tid < 32) INV[tid] = 1.0f / powf(10000.0f, (float)tid * (1.0f / 31.0f));
    u32x4 pq, pk, pv0, pv1, pg = (u32x4){0u, 0u, 0u, 0u}; int ipos = 0;
    {   const size_t ro = (size_t)(b * T + sc * 256 + st_t) * LDP;
        pq = *(const u32x4*)(P + ro + cq + h * 64 + 8 * st_cg); pk = *(const u32x4*)(P + ro + ck + h * 64 + 8 * st_cg);
        pv0 = *(const u32x4*)(P + ro + cv + h * 128 + 8 * st_cg); pv1 = *(const u32x4*)(P + ro + cv + h * 128 + 64 + 8 * st_cg);
        if (GLA) { if (st_cg < 2) { float g8[8]; unpack8(*(const u32x4*)(P + ro + C_GKL + 8 * st_cg), g8);
                *(f32x4*)(GKL + st_t * 16 + 8 * st_cg) = (f32x4){g8[0], g8[1], g8[2], g8[3]}; *(f32x4*)(GKL + st_t * 16 + 8 * st_cg + 4) = (f32x4){g8[4], g8[5], g8[6], g8[7]}; } }
        else ipos = ((const int*)p.in[I_POS])[b * T + sc * 256 + st_t]; }
    __syncthreads();
    QTS_MARK(4);
    float dtot = 0.f;
    for (int c = 0; c < 4; ++c) {
        const int t0 = sc * 256 + c * 64, m0 = b * T + t0;
        if (GLA) {
            float cumv[8]; float run = 0.f;
#pragma unroll
            for (int i = 0; i < 8; ++i) { const float* gp = GKL + (8 * w + i) * 16; float x = gb;
#pragma unroll
                for (int j4 = 0; j4 < 4; ++j4) { const f32x4 g = *(const f32x4*)(gp + 4 * j4); x += g[0] * w2c[4 * j4] + g[1] * w2c[4 * j4 + 1] + g[2] * w2c[4 * j4 + 2] + g[3] * w2c[4 * j4 + 3]; }
                run += logsigmoidf_(x) * (1.0f / 16.0f); cumv[i] = run; }
            TOT[w * 64 + lane] = run;
            __syncthreads();
            float off = 0.f;
            for (int ww = 0; ww < w; ++ww) off += TOT[ww * 64 + lane];
#pragma unroll
            for (int i = 0; i < 8; ++i) CUM[(8 * w + i) * 64 + lane] = cumv[i] + off;
            __syncthreads();
            QTS_MARK(0);
        }
        {
            const int t = st_t, cg = st_cg;
            float qf[8], kf[8]; unpack8(pq, qf); unpack8(pk, kf);
            float fqin[8], fkin[8], fqc[8], fkst[8];
            if (GLA) {
#pragma unroll
                for (int i = 0; i < 8; ++i) { const float cu = CUM[t * 64 + 8 * cg + i], rf = CUM[32 * 64 + 8 * cg + i], la = CUM[63 * 64 + 8 * cg + i];
                    qf[i] *= 0.125f; fqin[i] = fexp(cu - rf); fkin[i] = fexp(rf - cu); fqc[i] = fexp(cu); fkst[i] = fexp(la - cu); }
            } else {
                const float ppos = (float)ipos;
#pragma unroll
                for (int i = 0; i < 4; ++i) { float sn, cs; sincos_red(ppos * INV[4 * cg + i], sn, cs);
                    const float q1 = qf[2 * i], q2 = qf[2 * i + 1], k1 = kf[2 * i], k2 = kf[2 * i + 1];
                    qf[2 * i] = q1 * cs - q2 * sn; qf[2 * i + 1] = q2 * cs + q1 * sn;
                    kf[2 * i] = (k1 * cs - k2 * sn) * 0.125f; kf[2 * i + 1] = (k2 * cs + k1 * sn) * 0.125f; }
                const float e = (float)(t + 1); const float a = fexp((e - 33.0f) * lgam), bq = fexp((33.0f - e) * lgam), cc = fexp(e * lgam), dd = fexp((64.0f - e) * lgam);
#pragma unroll
                for (int i = 0; i < 8; ++i) { fqin[i] = a; fkin[i] = bq; fqc[i] = cc; fkst[i] = dd; }
            }
            if (full) { float o1[8], o2[8], o3[8];
#pragma unroll
                for (int i = 0; i < 8; ++i) { o1[i] = qf[i] * fqin[i]; o2[i] = qf[i] * fqc[i]; o3[i] = kf[i] * fkin[i]; }
                *(u32x4*)(QIN + t * 72 + 8 * cg) = pack8(o1); *(u32x4*)(QC + t * 72 + 8 * cg) = pack8(o2); *(u32x4*)(KIN + t * 72 + 8 * cg) = pack8(o3); }
            { float o4[8];
#pragma unroll
              for (int i = 0; i < 8; ++i) o4[i] = kf[i] * fkst[i];
              *(u32x4*)(KST + t * 72 + 8 * cg) = pack8(o4); }
            *(u32x4*)(VT + t * 136 + 8 * cg) = pv0; *(u32x4*)(VT + t * 136 + 64 + 8 * cg) = pv1;
            if (tid < 64) { const float la = GLA ? CUM[63 * 64 + tid] : 64.0f * lgam; ELAST[tid] = fexp(la); dtot += la; }
            if (c < 3) {
                const size_t ro = (size_t)(m0 + 64 + t) * LDP;
                pq = *(const u32x4*)(P + ro + cq + h * 64 + 8 * cg); pk = *(const u32x4*)(P + ro + ck + h * 64 + 8 * cg);
                pv0 = *(const u32x4*)(P + ro + cv + h * 128 + 8 * cg); pv1 = *(const u32x4*)(P + ro + cv + h * 128 + 64 + 8 * cg);
                if (GLA) pg = *(const u32x4*)(P + ro + C_GKL + 8 * (cg & 1));
                else ipos = ((const int*)p.in[I_POS])[b * T + t0 + 64 + t]; }
        }
        __syncthreads();
        QTS_MARK(1);
        if (full) {
            u32x2 g2[4];
#pragma unroll
            for (int tt = 0; tt < 4; ++tt) g2[tt] = *(const u32x2*)(P + (size_t)(m0 + 16 * tt + l15) * LDP + cgate + h * 128 + 16 * w + 4 * q4);
            f32x4 oacc[4];
#pragma unroll
            for (int tt = 0; tt < 4; ++tt) {
                oacc[tt] = (f32x4){0.f, 0.f, 0.f, 0.f};
#pragma unroll
                for (int kk = 0; kk < 2; ++kk) oacc[tt] = mfma16(frag(ST, 72, 16 * w, 32 * kk, lane), frag(QC, 72, 16 * tt, 32 * kk, lane), oacc[tt]);
                const bf16x8 qa = frag(QIN, 72, 16 * tt, 0, lane), qb = frag(QIN, 72, 16 * tt, 32, lane);
                u32x2 pp[4];
#pragma unroll
                for (int st = 0; st < 4; ++st) {
                    if (st <= tt) { f32x4 a = (f32x4){0.f, 0.f, 0.f, 0.f};
                        a = mfma16(frag(KIN, 72, 16 * st, 0, lane), qa, a); a = mfma16(frag(KIN, 72, 16 * st, 32, lane), qb, a);
                        if (st == tt) {
#pragma unroll
                            for (int j = 0; j < 4; ++j) if (4 * q4 + j > l15) a[j] = 0.f; }
                        pp[st] = pack4(a); }
                    else pp[st] = (u32x2){0u, 0u}; }
#pragma unroll
                for (int kk2 = 0; kk2 < 2; ++kk2) { if (2 * kk2 <= tt) {
                        u32x4 pw; pw.x = pp[2 * kk2].x; pw.y = pp[2 * kk2].y; pw.z = pp[2 * kk2 + 1].x; pw.w = pp[2 * kk2 + 1].y;
                        oacc[tt] = mfma16(frag_tr_perm(VT, 136, 16 * w, 32 * kk2, lane), __builtin_bit_cast(bf16x8, pw), oacc[tt]); } }
                float ss = (oacc[tt][0] * oacc[tt][0] + oacc[tt][1] * oacc[tt][1]) + (oacc[tt][2] * oacc[tt][2] + oacc[tt][3] * oacc[tt][3]);
                ss += __shfl_xor(ss, 16); ss += __shfl_xor(ss, 32);
                if (q4 == 0) RED[(16 * tt + l15) * 8 + w] = ss; }
            __syncthreads();
            QTS_MARK(2);
#pragma unroll
            for (int tt = 0; tt < 4; ++tt) { const f32x4 r0 = *(const f32x4*)(RED + (16 * tt + l15) * 8), r1 = *(const f32x4*)(RED + (16 * tt + l15) * 8 + 4);
                const float rstd = __builtin_amdgcn_rsqf(((r0[0] + r0[1]) + (r0[2] + r0[3]) + (r1[0] + r1[1]) + (r1[2] + r1[3])) * (1.0f / 128.0f) + 1e-6f);
                bf16* gp = P + (size_t)(m0 + 16 * tt + l15) * LDP + cgate + h * 128 + 16 * w + 4 * q4;
                const float g[4] = {lo16(g2[tt].x), hi16(g2[tt].x), lo16(g2[tt].y), hi16(g2[tt].y)};
                f32x4 o;
#pragma unroll
                for (int j = 0; j < 4; ++j) { float v = oacc[tt][j] * rstd; if (GLA) v *= gng[j]; o[j] = v * siluf_(g[j]); }
                if (!dry) *(u32x2*)gp = pack4(o); }
        }
#pragma unroll
        for (int mt = 0; mt < 4; ++mt) {
            const f32x4 el = *(const f32x4*)(ELAST + 16 * mt + 4 * q4);
            sacc[mt] = sacc[mt] * el;
#pragma unroll
            for (int kk = 0; kk < 2; ++kk) sacc[mt] = mfma16(frag_tr(KST, 72, 16 * mt, 32 * kk, lane), frag_tr(VT, 136, 16 * w, 32 * kk, lane), sacc[mt]);
            if (full) *(u32x2*)(ST + (16 * w + l15) * 72 + 16 * mt + 4 * q4) = pack4(sacc[mt]);
        }
        if (GLA && c < 3 && st_cg < 2) { float g8[8]; unpack8(pg, g8);
            *(f32x4*)(GKL + st_t * 16 + 8 * st_cg) = (f32x4){g8[0], g8[1], g8[2], g8[3]}; *(f32x4*)(GKL + st_t * 16 + 8 * st_cg + 4) = (f32x4){g8[4], g8[5], g8[6], g8[7]}; }
        __syncthreads();
        QTS_MARK(3);
    }
    if (!full) {
#pragma unroll
        for (int mt = 0; mt < 4; ++mt)
#pragma unroll
            for (int j = 0; j < 4; ++j) Lst[(16 * mt + 4 * q4 + j) * 128 + 16 * w + l15] = sacc[mt][j];
        if (GLA && tid < 64) ((float*)(p.ws + WS_DG))[(bh * 16 + sc) * 64 + tid] = fexp(dtot);
    }
}

constexpr int SD_CS = 0, SD_BS = 17408, SD_BT = 34816, SD_XT = 53248, SD_XST = 62464, SD_PS = 71680, SD_ST = 80896, SD_DT = 98304, SD_CUM = 98560, SD_RED = 98816, SD_CW = 99840;
DI void conv8(const Params& p, int l, const bf16* P, int b, int tpos, int ch, float* y) {
    const float* cw = p.in[I_CONVW] + (size_t)l * 4 * 1024; const float* cb = p.in[I_CONVB] + l * 1024;
    const f32x4 b0 = *(const f32x4*)(cb + ch), b1 = *(const f32x4*)(cb + ch + 4);
    float acc[8] = {b0[0], b0[1], b0[2], b0[3], b1[0], b1[1], b1[2], b1[3]};
#pragma unroll
    for (int j = 0; j < 4; ++j) { const int tp = tpos - 3 + j;
        if (tp >= 0) { float x[8]; unpack8(*(const u32x4*)(P + (size_t)(b * T + tp) * LDP + C_SX + ch), x);
            const f32x4 w0 = *(const f32x4*)(cw + j * 1024 + ch), w1 = *(const f32x4*)(cw + j * 1024 + ch + 4);
            acc[0] += w0[0] * x[0]; acc[1] += w0[1] * x[1]; acc[2] += w0[2] * x[2]; acc[3] += w0[3] * x[3];
            acc[4] += w1[0] * x[4]; acc[5] += w1[1] * x[5]; acc[6] += w1[2] * x[6]; acc[7] += w1[3] * x[7]; } }
#pragma unroll
    for (int i = 0; i < 8; ++i) y[i] = siluf_(acc[i]);
}
DI void conv_rows(const bf16* P, int b, int tpos, int ch, u32x4 (&xr)[7]) {
#pragma unroll
    for (int r = 0; r < 7; ++r) { const int tp = tpos - 3 + r; xr[r] = *(const u32x4*)(P + (size_t)(b * T + (tp < 0 ? 0 : tp)) * LDP + C_SX + ch); }
}
DI void conv_apply(const float* cwl, int lc, const u32x4 (&xr)[7], int tpos, float (&y)[4][8]) {
    { const f32x4 b0 = *(const f32x4*)(cwl + 4 * 320 + lc), b1 = *(const f32x4*)(cwl + 4 * 320 + lc + 4);
#pragma unroll
        for (int o = 0; o < 4; ++o) { y[o][0] = b0[0]; y[o][1] = b0[1]; y[o][2] = b0[2]; y[o][3] = b0[3]; y[o][4] = b1[0]; y[o][5] = b1[1]; y[o][6] = b1[2]; y[o][7] = b1[3]; } }
#pragma unroll
    for (int j = 0; j < 4; ++j) { const f32x4 w0 = *(const f32x4*)(cwl + j * 320 + lc), w1 = *(const f32x4*)(cwl + j * 320 + lc + 4);
        const float wv[8] = {w0[0], w0[1], w0[2], w0[3], w1[0], w1[1], w1[2], w1[3]};
#pragma unroll
        for (int o = 0; o < 4; ++o) { float x[8]; unpack8(xr[o + j], x);
            if (tpos - 3 + o + j < 0) {
#pragma unroll
                for (int i = 0; i < 8; ++i) x[i] = 0.f; }
#pragma unroll
            for (int i = 0; i < 8; ++i) y[o][i] += wv[i] * x[i]; } }
#pragma unroll
    for (int o = 0; o < 4; ++o)
#pragma unroll
        for (int i = 0; i < 8; i += 2) { const f32x2 v = {y[o][i], y[o][i + 1]}; const f32x2 r = v * sig_pk(v); y[o][i] = r.x; y[o][i + 1] = r.y; }
}
DI void ssd_item(const Params& p, int l, unsigned char* lds, int b, int h, int sc, bool full, bool dry = false) {
    const int tid = opaque_tid(), lane = tid & 63, w = tid >> 6, q4 = lane >> 4, l15 = lane & 15;
    bf16* P = (bf16*)(p.ws + WS_P);
    bf16* CS = (bf16*)(lds + SD_CS); bf16* BS = (bf16*)(lds + SD_BS); bf16* XT = (bf16*)(lds + SD_XT); bf16* XST = (bf16*)(lds + SD_XST);
    bf16* ST = (bf16*)(lds + SD_ST);
    float* DTL = (float*)(lds + SD_DT); float* CUMS = (float*)(lds + SD_CUM); float* RED = (float*)(lds + SD_RED);
    const int g = h >> 2, bh = b * 8 + h;
    float* Lst = (float*)(p.ws + WS_SSDL) + (size_t)(bh * 16 + sc) * 8192;
    const float a_h = -fexp(p.in[I_ALOG][l * 8 + h]), dtb = p.in[I_DTB][l * 8 + h], dsk = p.in[I_SD][l * 8 + h];
    const int pt = w & 3, wh = w >> 2;
    const f32x4 sng = *(const f32x4*)(p.in[I_SNORMG] + l * 512 + h * 64 + 16 * pt + 4 * q4);
    const int r_cgi = tid & 31, r_seg = tid >> 5; const bool r_isB = r_cgi >= 16; const int r_cg = r_cgi & 15;
    const int r_ch = (r_isB ? 512 : 768) + g * 128 + 8 * r_cg, r_lc = (r_isB ? 128 : 0) + 8 * r_cg;
    f32x4 sacc[4];
#pragma unroll
    for (int i = 0; i < 4; ++i) { const int nt = 4 * wh + i;
        if (full) { for (int j = 0; j < 4; ++j) sacc[i][j] = Lst[(16 * nt + 4 * q4 + j) * 64 + 16 * pt + l15]; *(u32x2*)(ST + (16 * pt + l15) * 136 + 16 * nt + 4 * q4) = pack4(sacc[i]); }
        else sacc[i] = (f32x4){0.f, 0.f, 0.f, 0.f}; }
    float* CWL = (float*)(lds + SD_CW);
    {
        float cwv[4];
#pragma unroll
        for (int r4 = 0; r4 < 4; ++r4) { const int idx0 = tid + r4 * NTHREADS, idx = idx0 < 1600 ? idx0 : 1599; const int row = idx / 320, ci = idx - row * 320;
            const int gch = ci < 128 ? 768 + g * 128 + ci : ci < 256 ? 512 + g * 128 + (ci - 128) : h * 64 + (ci - 256);
            const float* src = row < 4 ? p.in[I_CONVW] + (size_t)l * 4096 + row * 1024 + gch : p.in[I_CONVB] + l * 1024 + gch;
            cwv[r4] = *src; }
#pragma unroll
        for (int r4 = 0; r4 < 4; ++r4) { const int idx0 = tid + r4 * NTHREADS; if (idx0 < 1600) CWL[idx0] = cwv[r4]; }
    }
    u32x4 xbc[7]; conv_rows(P, b, sc * 256 + 4 * r_seg, r_ch, xbc);
    unsigned dtraw = (unsigned)P[(size_t)(b * T + sc * 256 + lane) * LDP + C_SDT + h];
    float ltot = 0.f;
    for (int c = 0; c < 4; ++c) {
        const int t0 = sc * 256 + c * 64, m0 = b * T + t0;
        if (w == 0) {
            const float dt = softplusf_(bf2f(dtraw) + dtb); float cu = dt * a_h;
#pragma unroll
            for (int o = 1; o < 64; o <<= 1) { const float n = __shfl_up(cu, o); if (lane >= o) cu += n; }
            DTL[lane] = dt; CUMS[lane] = cu;
        }
        if (c < 3) dtraw = (unsigned)P[(size_t)(m0 + 64 + lane) * LDP + C_SDT + h];
        __syncthreads();
        const float clast = CUMS[63];
        ltot += clast;
        {
            u32x4 xx[7];
            conv_rows(P, b, t0 + 4 * ((tid & 127) >> 3), h * 64 + 8 * (tid & 7), xx);
            { float y[4][8]; conv_apply(CWL, r_lc, xbc, t0 + 4 * r_seg, y);
#pragma unroll
                for (int o = 0; o < 4; ++o) { const int t = 4 * r_seg + o; *(u32x4*)((r_isB ? BS : CS) + t * 136 + 8 * r_cg) = pack8(y[o]); }
            }
            if (tid < 128) { const int cg = tid & 7, seg = tid >> 3; float y[4][8]; conv_apply(CWL, 256 + 8 * cg, xx, t0 + 4 * seg, y);
                float coef[4];
#pragma unroll
                for (int o = 0; o < 4; ++o) coef[o] = fexp(clast - CUMS[4 * seg + o]) * DTL[4 * seg + o];
#pragma unroll
                for (int o = 0; o < 4; ++o) { float ys[8];
#pragma unroll
                    for (int i = 0; i < 8; ++i) ys[i] = y[o][i] * coef[o];
                    *(u32x4*)(XT + (4 * seg + o) * 72 + 8 * cg) = pack8(y[o]); *(u32x4*)(XST + (4 * seg + o) * 72 + 8 * cg) = pack8(ys); } }
            if (c < 3) conv_rows(P, b, t0 + 64 + 4 * r_seg, r_ch, xbc);
        }
        __syncthreads();
        if (full) {
#pragma unroll
            for (int i = 0; i < 2; ++i) { const int tt = 2 * wh + i, t = 16 * tt + l15;
                bf16* zp = P + (size_t)(m0 + t) * LDP + C_SZ + h * 64 + 16 * pt + 4 * q4;
                const u32x2 z2 = *(const u32x2*)zp;
                bf16x8 cf[4];
#pragma unroll
                for (int kk = 0; kk < 4; ++kk) cf[kk] = frag(CS, 136, 16 * tt, 32 * kk, lane);
                f32x4 oacc = (f32x4){0.f, 0.f, 0.f, 0.f};
#pragma unroll
                for (int kk = 0; kk < 4; ++kk) oacc = mfma16(frag(ST, 136, 16 * pt, 32 * kk, lane), cf[kk], oacc);
                const float ct = CUMS[t];
                oacc = oacc * fexp(ct);
                u32x2 pp[4];
#pragma unroll
                for (int st = 0; st < 4; ++st) {
                    if (st <= tt) { f32x4 a = (f32x4){0.f, 0.f, 0.f, 0.f};
#pragma unroll
                        for (int kk = 0; kk < 4; ++kk) a = mfma16(frag(BS, 136, 16 * st, 32 * kk, lane), cf[kk], a);
                        const f32x4 cs4 = *(const f32x4*)(CUMS + 16 * st + 4 * q4), dt4 = *(const f32x4*)(DTL + 16 * st + 4 * q4);
#pragma unroll
                        for (int j = 0; j < 4; ++j) a[j] = (16 * st + 4 * q4 + j <= t) ? a[j] * fexp(ct - cs4[j]) * dt4[j] : 0.f;
                        pp[st] = pack4(a); }
                    else pp[st] = (u32x2){0u, 0u}; }
#pragma unroll
                for (int kk2 = 0; kk2 < 2; ++kk2) { if (2 * kk2 <= tt) {
                        u32x4 pw; pw.x = pp[2 * kk2].x; pw.y = pp[2 * kk2].y; pw.z = pp[2 * kk2 + 1].x; pw.w = pp[2 * kk2 + 1].y;
                        oacc = mfma16(frag_tr_perm(XT, 72, 16 * pt, 32 * kk2, lane), __builtin_bit_cast(bf16x8, pw), oacc); } }
                const float z[4] = {lo16(z2.x), hi16(z2.x), lo16(z2.y), hi16(z2.y)};
                f32x4 o; float ss = 0.f;
                const u32x2 xv2 = *(const u32x2*)(XT + t * 72 + 16 * pt + 4 * q4); const float xvv[4] = {lo16(xv2.x), hi16(xv2.x), lo16(xv2.y), hi16(xv2.y)};
#pragma unroll
                for (int j = 0; j < 4; ++j) { const float xv = xvv[j]; const float v = (oacc[j] + dsk * xv) * siluf_(z[j]); ss += v * v;
                    o[j] = v * sng[j]; }
                if (!dry) *(u32x2*)zp = pack4(o);
                ss += __shfl_xor(ss, 16); ss += __shfl_xor(ss, 32);
                if (q4 == 0) RED[t * 4 + pt] = ss; }
        }
        const float el = fexp(clast);
#pragma unroll
        for (int i = 0; i < 4; ++i) { const int nt = 4 * wh + i;
            sacc[i] = sacc[i] * el;
#pragma unroll
            for (int kk = 0; kk < 2; ++kk) sacc[i] = mfma16(frag_tr(BS, 136, 16 * nt, 32 * kk, lane), frag_tr(XST, 72, 16 * pt, 32 * kk, lane), sacc[i]);
            if (full) *(u32x2*)(ST + (16 * pt + l15) * 136 + 16 * nt + 4 * q4) = pack4(sacc[i]); }
        __syncthreads();
        if (full && tid < 64) { const f32x4 r = *(const f32x4*)(RED + tid * 4); ((float*)(p.ws + WS_SSQ))[(size_t)(m0 + tid) * 8 + h] = (r[0] + r[1]) + (r[2] + r[3]); }
    }
    if (!full) {
#pragma unroll
        for (int i = 0; i < 4; ++i)
#pragma unroll
            for (int j = 0; j < 4; ++j) Lst[(16 * (4 * wh + i) + 4 * q4 + j) * 64 + 16 * pt + l15] = sacc[i][j];
        if (tid == 0) ((float*)(p.ws + WS_DS))[bh * 16 + sc] = fexp(ltot);
    }
}

DI void phase_scan(const Params& p, int vb, int nb, bool dry = false) {
    const int gt = vb * NTHREADS + opaque_tid(), NT = nb * NTHREADS;
    for (int idx0 = gt; idx0 < 4 * 131072; idx0 += 2 * NT) {
        float lv[2][16], dv[2][16]; float* Lp[2]; bool ok[2];
#pragma unroll
        for (int e = 0; e < 2; ++e) { const int idx = idx0 + e * NT; ok[e] = idx < 4 * 131072; const int which = idx >> 17, r = idx & 131071;
            float* L = nullptr; const float* dec = nullptr; int dstride = 0; float cdec = 0.f;
            if (ok[e]) {
                if (which == 0) { const int bh = r >> 13, el = r & 8191; L = (float*)(p.ws + WS_RETL) + (size_t)bh * 16 * 8192 + el; cdec = fexp(256.0f * __logf(1.0f - exp2f(-5.0f - (float)(bh & 3)))); }
                else if (which == 1) { const int bh = r >> 13, el = r & 8191; L = (float*)(p.ws + WS_GLAL) + (size_t)bh * 16 * 8192 + el; dec = (const float*)(p.ws + WS_DG) + bh * 16 * 64 + (el >> 7); dstride = 64; }
                else { const int rr = (which - 2) * 131072 + r, bh = rr >> 13, el = rr & 8191; L = (float*)(p.ws + WS_SSDL) + (size_t)bh * 16 * 8192 + el; dec = (const float*)(p.ws + WS_DS) + bh * 16; dstride = 1; } }
            Lp[e] = L;
#pragma unroll
            for (int sc = 0; sc < 16; ++sc) { lv[e][sc] = ok[e] ? L[(size_t)sc * 8192] : 0.f; dv[e][sc] = (ok[e] && dec) ? dec[sc * dstride] : cdec; } }
#pragma unroll
        for (int e = 0; e < 2; ++e) { float prev = 0.f;
#pragma unroll
            for (int sc = 0; sc < 16; ++sc) { if (ok[e] && !dry) Lp[e][(size_t)sc * 8192] = prev; prev = dv[e][sc] * prev + lv[e][sc]; } }
    }
}

DI void memkv_item(const Params& p, int l, int item) {
    const int tid = opaque_tid(), lane = tid & 63, w = tid >> 6, q4 = lane >> 4, l15 = lane & 15;
    const int rb = item >> 4, cb = item & 15;
    const bf16* A = (const bf16*)(p.ws + WS_MEMN) + (size_t)l * 1024 * 1024; const bf16* Bw = (const bf16*)(p.ws + WS_WKVT);
    const int r0 = 64 * rb + 16 * (w >> 1), c0 = 32 * cb + 16 * (w & 1); const bool isV = cb >= 8; const int hh = (c0 >> 6) & 3, dd = c0 & 63;
    f32x4 acc = (f32x4){0.f, 0.f, 0.f, 0.f};
#pragma unroll 1
    for (int k16 = 0; k16 < 32; k16 += 16) {
        bf16x8 fa[16], fb[16];
#pragma unroll
        for (int u = 0; u < 16; ++u) { fa[u] = frag(A, 1024, r0, 32 * (k16 + u), lane); fb[u] = frag(Bw, 1024, c0, 32 * (k16 + u), lane); }
#pragma unroll
        for (int u = 0; u < 16; ++u) acc = isV ? mfma16(fa[u], fb[u], acc) : mfma16(fb[u], fa[u], acc);
    }
    if (!isV) { const int m = r0 + l15, bb = m >> 8, mm = m & 255;
        *(u32x2*)((bf16*)(p.ws + WS_KM) + ((size_t)(bb * 4 + hh) * 256 + mm) * 64 + dd + 4 * q4) = pack4(acc); }
    else { const int m = r0 + 4 * q4, bb = m >> 8, mm = m & 255;
        *(u32x2*)((bf16*)(p.ws + WS_VMT) + ((size_t)(bb * 4 + hh) * 64 + dd + l15) * 256 + mm) = pack4(acc); }
}
constexpr int MA_K = 0, MA_VT = 36864;
DI void memattn_item(const Params& p, unsigned char* lds, int b, int h, int blk) {
    const int tid = opaque_tid(), lane = tid & 63, w = tid >> 6, q4 = lane >> 4, l15 = lane & 15;
    bf16* KS = (bf16*)(lds + MA_K); bf16* VS = (bf16*)(lds + MA_VT);
    const bf16* KM = (const bf16*)(p.ws + WS_KM) + (size_t)(b * 4 + h) * 256 * 64; const bf16* VM = (const bf16*)(p.ws + WS_VMT) + (size_t)(b * 4 + h) * 64 * 256;
    const bf16* P = (const bf16*)(p.ws + WS_P); bf16* OM = (bf16*)(p.ws + WS_OMEM);
#pragma unroll
    for (int r = 0; r < 4; ++r) { const int idx = tid + 512 * r;
        { const int m = idx >> 3, c8 = idx & 7; *(u32x4*)(KS + m * 72 + 8 * c8) = *(const u32x4*)(KM + m * 64 + 8 * c8); }
        { const int d = idx >> 5, c8 = idx & 31; *(u32x4*)(VS + d * 264 + 8 * c8) = *(const u32x4*)(VM + d * 256 + 8 * c8); } }
    __syncthreads();
    bf16x8 qn[2];
#pragma unroll
    for (int kk = 0; kk < 2; ++kk) qn[kk] = *(const bf16x8*)(P + (size_t)(b * T + blk * 256 + w * 16 + l15) * LDP + C_MQ + h * 64 + 32 * kk + 8 * q4);
    for (int rnd = 0; rnd < 2; ++rnd) {
        const int m0 = b * T + blk * 256 + rnd * 128 + w * 16;
        bf16x8 qf[2];
#pragma unroll
        for (int kk = 0; kk < 2; ++kk) { qf[kk] = qn[kk]; if (rnd == 0) qn[kk] = *(const bf16x8*)(P + (size_t)(m0 + 128 + l15) * LDP + C_MQ + h * 64 + 32 * kk + 8 * q4); }
        f32x4 s[16]; float mx = -3.0e38f;
#pragma unroll
        for (int mt = 0; mt < 16; ++mt) { s[mt] = (f32x4){0.f, 0.f, 0.f, 0.f};
#pragma unroll
            for (int kk = 0; kk < 2; ++kk) s[mt] = mfma16(frag(KS, 72, 16 * mt, 32 * kk, lane), qf[kk], s[mt]);
            s[mt] = s[mt] * 0.125f; mx = fmaxf(mx, fmaxf(fmaxf(s[mt][0], s[mt][1]), fmaxf(s[mt][2], s[mt][3]))); __builtin_amdgcn_sched_barrier(0); }
        mx = fmaxf(mx, __shfl_xor(mx, 16)); mx = fmaxf(mx, __shfl_xor(mx, 32));
        float sum = 0.f;
#pragma unroll
        for (int mt = 0; mt < 16; ++mt) {
#pragma unroll
            for (int j = 0; j < 4; ++j) { s[mt][j] = fexp(s[mt][j] - mx); sum += s[mt][j]; } }
        sum += __shfl_xor(sum, 16); sum += __shfl_xor(sum, 32);
        const float rs = __builtin_amdgcn_rcpf(sum);
        f32x4 o[4];
#pragma unroll
        for (int dt = 0; dt < 4; ++dt) o[dt] = (f32x4){0.f, 0.f, 0.f, 0.f};
#pragma unroll
        for (int k2 = 0; k2 < 8; ++k2) {
            u32x4 pw; pw.x = pk2(s[2 * k2][0], s[2 * k2][1]); pw.y = pk2(s[2 * k2][2], s[2 * k2][3]); pw.z = pk2(s[2 * k2 + 1][0], s[2 * k2 + 1][1]); pw.w = pk2(s[2 * k2 + 1][2], s[2 * k2 + 1][3]);
            const bf16x8 pf = __builtin_bit_cast(bf16x8, pw);
#pragma unroll
            for (int dt = 0; dt < 4; ++dt) { const bf16* vp = VS + (16 * dt + l15) * 264 + 32 * k2 + 4 * q4;
                const u32x2 v0 = *(const u32x2*)vp, v1 = *(const u32x2*)(vp + 16); u32x4 vw; vw.x = v0.x; vw.y = v0.y; vw.z = v1.x; vw.w = v1.y;
                o[dt] = mfma16(__builtin_bit_cast(bf16x8, vw), pf, o[dt]); }
            __builtin_amdgcn_sched_barrier(0); }
#pragma unroll
        for (int dt = 0; dt < 4; ++dt) *(u32x2*)(OM + (size_t)(m0 + l15) * 256 + h * 64 + 16 * dt + 4 * q4) = pack4(o[dt] * rs);
    }
    __syncthreads();
}

constexpr int RC_ARL = 0, RC_RRL = 9216, RC_BRL = 18432, RC_KRL = 27648, RC_XT = 0, RC_BHT = 36864, RC_KHT = 46080, RC_VT = 55296, RC_AAK = 64512, RC_LRB = 73728, RC_LRK = 82944,
              RC_AAB = 92160, RC_RHS = 108544, RC_WLAST = 141312, RC_TB = 141568,
              RC_TW = 64512, RC_ALS = 73728, RC_W2T = 82944, RC_A2T = 92160, RC_TOT = 101376, RC_CUM = 108544, RC_AICL = 124928;
#if defined(TPROBE) && !defined(QTS_SEL)
#define RW_STOP_AT(k) TS_MARK(k)
#define RW_TS_BEGIN() TS_BEGIN()
#define RW_TS_END() TS_MARK(7)
#else
#define RW_TS_BEGIN() do {} while (0)
#define RW_TS_END() do {} while (0)
#ifdef RW_STOP
#define RW_STOP_AT(k) do { if (dry && RW_STOP == (k)) return; } while (0)
#else
#define RW_STOP_AT(k) do {} while (0)
#endif
#endif
DI void rwkv_chunk_item(const Params& p, int l, unsigned char* lds, int b, int h, int c, bool dry = false) {
    const int tid = opaque_tid(), lane = tid & 63, w = tid >> 6, q4 = lane >> 4, l15 = lane & 15;
    bf16* P = (bf16*)(p.ws + WS_P);
    bf16* ARL = (bf16*)(lds + RC_ARL); bf16* RRL = (bf16*)(lds + RC_RRL); bf16* BRL = (bf16*)(lds + RC_BRL); bf16* KRL = (bf16*)(lds + RC_KRL); bf16* XT = (bf16*)(lds + RC_XT);
    bf16* BHT = (bf16*)(lds + RC_BHT); bf16* KHT = (bf16*)(lds + RC_KHT); bf16* VT = (bf16*)(lds + RC_VT); bf16* AAK = (bf16*)(lds + RC_AAK); bf16* LRB = (bf16*)(lds + RC_LRB); bf16* LRK = (bf16*)(lds + RC_LRK);
    float* AAB = (float*)(lds + RC_AAB); float* RHS = (float*)(lds + RC_RHS); float* WLAST = (float*)(lds + RC_WLAST); float* TB = (float*)(lds + RC_TB);
    bf16* TW = (bf16*)(lds + RC_TW); bf16* ALS = (bf16*)(lds + RC_ALS); bf16* W2T = (bf16*)(lds + RC_W2T); bf16* A2T = (bf16*)(lds + RC_A2T);
    float* TOT = (float*)(lds + RC_TOT); float* CUM = (float*)(lds + RC_CUM); float* AICL = (float*)(lds + RC_AICL);
    const float* mu = p.in[I_MU] + l * 1664;
    const int t0 = c * 64, m0 = b * T + t0;
    RW_TS_BEGIN();
    const int t_ = tid >> 3, cg = tid & 7, chh = h * 64 + 8 * cg;
    float xr[8], xk[8], xv[8];
    float pkk[8], pka[8], prk[8];
    { const f32x4 a0 = *(const f32x4*)(p.in[I_KK] + l * 512 + chh), a1 = *(const f32x4*)(p.in[I_KK] + l * 512 + chh + 4), b0 = *(const f32x4*)(p.in[I_KA] + l * 512 + chh), b1 = *(const f32x4*)(p.in[I_KA] + l * 512 + chh + 4),
          c0 = *(const f32x4*)(p.in[I_RK] + l * 512 + chh), c1 = *(const f32x4*)(p.in[I_RK] + l * 512 + chh + 4);
#pragma unroll
      for (int i = 0; i < 4; ++i) { pkk[i] = a0[i]; pkk[4 + i] = a1[i]; pka[i] = b0[i]; pka[4 + i] = b1[i]; prk[i] = c0[i]; prk[4 + i] = c1[i]; } }
    f32x4 pw0[4];
#pragma unroll
    for (int ct = 0; ct < 4; ++ct) pw0[ct] = *(const f32x4*)(p.in[(w >> 2) ? I_A0 : I_W0] + l * 512 + h * 64 + 16 * ct + 4 * q4);
    {
        { const int j = tid >> 3;
            const float* s2 = p.in[I_W2] + (size_t)l * 64 * 512 + j * 512 + chh; const float* sa = p.in[I_A2] + (size_t)l * 64 * 512 + j * 512 + chh;
#pragma unroll
            for (int i = 0; i < 8; ++i) { }
            *(u32x4*)(W2T + j * 72 + 8 * cg) = pack8(s2); *(u32x4*)(A2T + j * 72 + 8 * cg) = pack8(sa); }
        const size_t ro = (size_t)(m0 + t_) * LDP; const bool first = (t_ == 0);
        const bf16* prow = first ? (bf16*)(p.ws + WS_BND) + (size_t)(((m0) >> 6) - 1) * BND_W - 4608 : P + ro - LDP;
        const bool hp = (t0 + t_) > 0;
#pragma unroll
        for (int which = 0; which < 5; ++which) {
            const int col = which == 0 ? C_WR + chh : which == 1 ? C_WK + chh : which == 2 ? C_WV + chh : which == 3 ? C_WL + 8 * cg : C_AL + 8 * cg;
            const int mi = which == 0 ? chh : which == 1 ? 512 + chh : which == 2 ? 1024 + chh : which == 3 ? 1536 + 8 * cg : 1600 + 8 * cg;
            float cur[8], prv[8], xs[8];
            unpack8(*(const u32x4*)(P + ro + col), cur);
            unpack8(*(const u32x4*)((hp ? prow : P + ro) + col), prv);
            if (!hp) {
#pragma unroll
                for (int i = 0; i < 8; ++i) prv[i] = 0.f; }
#pragma unroll
            for (int i = 0; i < 8; ++i) xs[i] = cur[i] + (prv[i] - cur[i]) * mu[mi + i];
            if (which == 0) {
#pragma unroll
                for (int i = 0; i < 8; ++i) xr[i] = xs[i]; }
            else if (which == 1) {
#pragma unroll
                for (int i = 0; i < 8; ++i) xk[i] = xs[i]; }
            else if (which == 2) {
#pragma unroll
                for (int i = 0; i < 8; ++i) xv[i] = xs[i]; }
            else if (which == 3) { float tw[8];
#pragma unroll
                for (int i = 0; i < 8; ++i) tw[i] = tanhf_(xs[i]);
                *(u32x4*)(TW + t_ * 72 + 8 * cg) = pack8(tw); }
            else *(u32x4*)(ALS + t_ * 72 + 8 * cg) = pack8(xs);
        }
    }
    __syncthreads();
    RW_STOP_AT(0);
    {
        const int which = w >> 2, tt = w & 3; const bf16* Wm = which ? A2T : W2T; const bf16* Xm = which ? ALS : TW;
#pragma unroll
        for (int ct = 0; ct < 4; ++ct) { f32x4 a = (f32x4){0.f, 0.f, 0.f, 0.f};
#pragma unroll
            for (int kk = 0; kk < 2; ++kk) a = mfma16(frag_tr(Wm, 72, 16 * ct, 32 * kk, lane), frag(Xm, 72, 16 * tt, 32 * kk, lane), a);
            const int ch = 16 * ct + 4 * q4, t = 16 * tt + l15; f32x4 o;
            if (which == 0) { const f32x4 w0 = pw0[ct];
#pragma unroll
                for (int j = 0; j < 4; ++j) o[j] = -0.60653065971f * sigmoidf_(w0[j] + a[j]);
                *(f32x4*)(CUM + t * 64 + ch) = o; }
            else { const f32x4 a0 = pw0[ct];
#pragma unroll
                for (int j = 0; j < 4; ++j) o[j] = sigmoidf_(a0[j] + a[j]);
                *(f32x4*)(AICL + t * 64 + ch) = o; }
        }
    }
    __syncthreads();
    RW_STOP_AT(1);
    {
        float cumv[8]; float run = 0.f;
#pragma unroll
        for (int i = 0; i < 8; ++i) { run += CUM[(8 * w + i) * 64 + lane]; cumv[i] = run; }
        TOT[w * 64 + lane] = run;
        __syncthreads();
        float off = 0.f;
        for (int ww = 0; ww < w; ++ww) off += TOT[ww * 64 + lane];
#pragma unroll
        for (int i = 0; i < 8; ++i) CUM[(8 * w + i) * 64 + lane] = cumv[i] + off;
    }
    __syncthreads();
    RW_STOP_AT(2);
    float aabs[8];
    {
        float kk[8], ai[8], ss = 0.f;
#pragma unroll
        for (int i = 0; i < 8; ++i) { ai[i] = AICL[t_ * 64 + 8 * cg + i]; kk[i] = xk[i] * pkk[i]; ss += kk[i] * kk[i]; }
        ss += __shfl_xor(ss, 1); ss += __shfl_xor(ss, 2); ss += __shfl_xor(ss, 4);
        const float inv = __builtin_amdgcn_rsqf(fmaxf(ss, 1e-24f));
        float bon = 0.f, o_arl[8], o_rrl[8], o_brl[8], o_krl[8], o_rabs[8], o_bh[8], o_kh[8];
#pragma unroll
        for (int i = 0; i < 8; ++i) {
            const float kn = kk[i] * inv, av = -kn, bv = kn * ai[i], km = xk[i] * (1.0f + (ai[i] - 1.0f) * pka[i]);
            bon += xr[i] * km * prk[i];
            const int k = 8 * cg + i;
            const float cu = CUM[t_ * 64 + k], cx = t_ > 0 ? CUM[(t_ - 1) * 64 + k] : 0.f, rf = CUM[32 * 64 + k], la = CUM[63 * 64 + k];
            o_arl[i] = av * fexp(cx - rf); aabs[i] = av * fexp(cx);
            o_rrl[i] = xr[i] * fexp(cu - rf); o_rabs[i] = xr[i] * fexp(cu);
            const float eb = fexp(rf - cu), eh = fexp(la - cu);
            o_brl[i] = bv * eb; o_krl[i] = km * eb;
            o_bh[i] = bv * eh; o_kh[i] = km * eh;
        }
        bon += __shfl_xor(bon, 1); bon += __shfl_xor(bon, 2); bon += __shfl_xor(bon, 4);
        *(u32x4*)(ARL + t_ * 72 + 8 * cg) = pack8(o_arl); *(u32x4*)(RRL + t_ * 72 + 8 * cg) = pack8(o_rrl);
        *(u32x4*)(BRL + t_ * 72 + 8 * cg) = pack8(o_brl); *(u32x4*)(KRL + t_ * 72 + 8 * cg) = pack8(o_krl);
        *(u32x4*)(BHT + t_ * 72 + 8 * cg) = pack8(o_bh); *(u32x4*)(KHT + t_ * 72 + 8 * cg) = pack8(o_kh); *(u32x4*)(VT + t_ * 72 + 8 * cg) = pack8(xv);
        const size_t ro = (size_t)(m0 + t_) * LDP;
        if (!dry) *(u32x4*)(P + ro + C_WR + chh) = pack8(o_rabs);
        float bvv[8];
#pragma unroll
        for (int i = 0; i < 8; ++i) bvv[i] = bon * xv[i];
        if (!dry) *(u32x4*)(P + ro + C_WV + chh) = pack8(bvv);
        if (tid < 64) WLAST[tid] = fexp(CUM[63 * 64 + tid]);
    }
    __syncthreads();
    RW_STOP_AT(3);
    *(f32x4*)(RHS + t_ * 128 + 8 * cg) = (f32x4){aabs[0], aabs[1], aabs[2], aabs[3]}; *(f32x4*)(RHS + t_ * 128 + 8 * cg + 4) = (f32x4){aabs[4], aabs[5], aabs[6], aabs[7]};
    {
        const int prod = w >> 1, half = w & 1; const bf16* Lm = (prod < 2) ? ARL : RRL; const bf16* Rm = (prod & 1) ? KRL : BRL; const int strict = prod < 2 ? 1 : 0;
#pragma unroll
        for (int i8 = 0; i8 < 8; ++i8) { const int id = half * 8 + i8, tt = id >> 2, st = id & 3;
            f32x4 a = (f32x4){0.f, 0.f, 0.f, 0.f};
            if (st <= tt) {
#pragma unroll
                for (int kk = 0; kk < 2; ++kk) a = mfma16(frag(Rm, 72, 16 * st, 32 * kk, lane), frag(Lm, 72, 16 * tt, 32 * kk, lane), a);
                if (st == tt) {
#pragma unroll
                    for (int j = 0; j < 4; ++j) if (4 * q4 + j + strict > l15) a[j] = 0.f; }
            }
            if (prod == 0) *(f32x4*)(AAB + (16 * tt + l15) * 64 + 16 * st + 4 * q4) = a;
            else { bf16* O = prod == 1 ? AAK : prod == 2 ? LRB : LRK; *(u32x2*)(O + (16 * tt + l15) * 72 + 16 * st + 4 * q4) = pack4(a); }
        }
        if (prod == 0) {
            asm volatile("s_waitcnt lgkmcnt(0)" ::: "memory");
            const int bb = 2 * half + ((lane >> 4) & 1), cc = lane & 15; float x[16];
#pragma unroll
            for (int i = 0; i < 16; ++i) { float s0 = (i == cc) ? 1.0f : 0.0f;
#pragma unroll
                for (int s4 = 0; s4 < (i + 3) / 4; ++s4) { const f32x4 av = *(const f32x4*)(AAB + (16 * bb + i) * 64 + 16 * bb + 4 * s4);
#pragma unroll
                    for (int n = 0; n < 4; ++n) if (4 * s4 + n < i) s0 += av[n] * x[4 * s4 + n]; }
                x[i] = s0; if (lane < 32) TB[(bb * 16 + i) * 16 + cc] = s0; }
        }
    }
    __syncthreads();
    RW_STOP_AT(4);
    {
        f32x4 X[4];
#pragma unroll
        for (int bb = 0; bb < 4; ++bb) {
            f32x4 acc;
            if (w < 4) {
#pragma unroll
                for (int j = 0; j < 4; ++j) acc[j] = RHS[(16 * bb + 4 * q4 + j) * 128 + 16 * w + l15]; }
            else {
                acc = (f32x4){0.f, 0.f, 0.f, 0.f};
#pragma unroll
                for (int kk = 0; kk < 2; ++kk) acc = mfma16(frag(AAK, 72, 16 * bb, 32 * kk, lane), frag_tr(VT, 72, 16 * (w - 4), 32 * kk, lane), acc); }
#pragma unroll
            for (int bp = 0; bp < bb; ++bp) { const f32x4 a4 = *(const f32x4*)(AAB + (16 * bb + l15) * 64 + 16 * bp + 4 * q4);
#pragma unroll
                for (int j = 0; j < 4; ++j) acc = __builtin_amdgcn_mfma_f32_16x16x4f32(a4[j], X[bp][j], acc, 0, 0, 0); }
            const f32x4 t4 = *(const f32x4*)(TB + (bb * 16 + l15) * 16 + 4 * q4);
            f32x4 xb = (f32x4){0.f, 0.f, 0.f, 0.f};
#pragma unroll
            for (int j = 0; j < 4; ++j) xb = __builtin_amdgcn_mfma_f32_16x16x4f32(t4[j], acc[j], xb, 0, 0, 0);
            X[bb] = xb;
            *(u32x2*)(XT + (16 * w + l15) * 72 + 16 * bb + 4 * q4) = pack4(xb);
        }
    }
    __syncthreads();
    RW_STOP_AT(6);
    {
        const int prod = w >> 1, half = w & 1;
        bf16* GH = (bf16*)(p.ws + WS_RWGH) + ((size_t)((b * 8 + h) * 64 + c) * 2) * 4096;
#pragma unroll
        for (int i8 = 0; i8 < 8; ++i8) { const int id = half * 8 + i8, rt = id >> 2, ct = id & 3;
            f32x4 a = (f32x4){0.f, 0.f, 0.f, 0.f};
            if (prod == 0) {
#pragma unroll
                for (int kk = 0; kk < 2; ++kk) a = mfma16(frag(XT, 72, 16 * ct, 32 * kk, lane), frag(LRB, 72, 16 * rt, 32 * kk, lane), a);
                bf16* qp = P + (size_t)(m0 + 16 * rt + l15) * LDP + C_WR + h * 64 + 16 * ct + 4 * q4;
                const u32x2 r2 = *(const u32x2*)qp; a[0] += lo16(r2.x); a[1] += hi16(r2.x); a[2] += lo16(r2.y); a[3] += hi16(r2.y);
                if (!dry) *(u32x2*)qp = pack4(a);
            } else if (prod == 1) {
#pragma unroll
                for (int kk = 0; kk < 2; ++kk) a = mfma16(frag(XT, 72, 64 + 16 * ct, 32 * kk, lane), frag(LRB, 72, 16 * rt, 32 * kk, lane), a);
#pragma unroll
                for (int kk = 0; kk < 2; ++kk) a = mfma16(frag_tr(VT, 72, 16 * ct, 32 * kk, lane), frag(LRK, 72, 16 * rt, 32 * kk, lane), a);
                if (!dry) *(u32x2*)(P + (size_t)(m0 + 16 * rt + l15) * LDP + C_WK + h * 64 + 16 * ct + 4 * q4) = pack4(a);
            } else if (prod == 2) {
#pragma unroll
                for (int kk = 0; kk < 2; ++kk) a = mfma16(frag(XT, 72, 16 * ct, 32 * kk, lane), frag_tr(BHT, 72, 16 * rt, 32 * kk, lane), a);
                if (rt == ct) { const float wl = WLAST[16 * rt + l15];
#pragma unroll
                    for (int j = 0; j < 4; ++j) if (4 * q4 + j == l15) a[j] += wl; }
                *(u32x2*)(GH + (16 * rt + l15) * 64 + 16 * ct + 4 * q4) = pack4(a);
            } else {
#pragma unroll
                for (int kk = 0; kk < 2; ++kk) a = mfma16(frag_tr(BHT, 72, 16 * ct, 32 * kk, lane), frag(XT, 72, 64 + 16 * rt, 32 * kk, lane), a);
#pragma unroll
                for (int kk = 0; kk < 2; ++kk) a = mfma16(frag_tr(KHT, 72, 16 * ct, 32 * kk, lane), frag_tr(VT, 72, 16 * rt, 32 * kk, lane), a);
                *(u32x2*)(GH + 4096 + (16 * rt + l15) * 64 + 16 * ct + 4 * q4) = pack4(a);
            }
        }
    }
    __syncthreads();
    RW_TS_END();
}
DI void rwkv_scan_chain(const Params& p, unsigned char* lds, int bh, bool dry = false) {
    const int tid = opaque_tid(), lane = tid & 63, w = tid >> 6, q4 = lane >> 4, l15 = lane & 15;
    bf16* ZB = (bf16*)lds;
    bf16* GH = (bf16*)(p.ws + WS_RWGH) + (size_t)bh * 64 * 2 * 4096;
    const int vt = w & 3, kh = w >> 2;
    u32x2 zp[2];
#pragma unroll
    for (int i = 0; i < 2; ++i) { zp[i] = (u32x2){0u, 0u}; *(u32x2*)(ZB + (16 * vt + l15) * 72 + 16 * (2 * kh + i) + 4 * q4) = zp[i]; }
    bf16x8 gf[4][2][2]; u32x2 hv[4][2];
#define RW_LOAD(slot, cc) do { const bf16* G_ = GH + (size_t)(cc) * 2 * 4096; _Pragma("unroll") for (int i = 0; i < 2; ++i) { const int kt = 2 * kh + i; \
        _Pragma("unroll") for (int kk = 0; kk < 2; ++kk) gf[slot][i][kk] = frag(G_, 64, 16 * kt, 32 * kk, lane); \
        hv[slot][i] = *(const u32x2*)(G_ + 4096 + (16 * vt + l15) * 64 + 16 * kt + 4 * q4); } } while (0)
    RW_LOAD(0, 0); RW_LOAD(1, 1); RW_LOAD(2, 2); RW_LOAD(3, 3);
    __syncthreads();
    for (int c4 = 0; c4 < 64; c4 += 4) {
#pragma unroll
        for (int u = 0; u < 4; ++u) { const int c = c4 + u;
            bf16* HT = GH + (size_t)c * 2 * 4096 + 4096;
            const bf16* Zc = ZB + (c & 1) * 64 * 72; bf16* Zn = ZB + ((c + 1) & 1) * 64 * 72;
#pragma unroll
            for (int i = 0; i < 2; ++i) { const int kt = 2 * kh + i;
                f32x4 a = (f32x4){lo16(hv[u][i].x), hi16(hv[u][i].x), lo16(hv[u][i].y), hi16(hv[u][i].y)};
                if (!dry) *(u32x2*)(HT + (16 * vt + l15) * 64 + 16 * kt + 4 * q4) = zp[i];
#pragma unroll
                for (int kk = 0; kk < 2; ++kk) a = mfma16(gf[u][i][kk], frag(Zc, 72, 16 * vt, 32 * kk, lane), a);
                zp[i] = pack4(a);
                *(u32x2*)(Zn + (16 * vt + l15) * 72 + 16 * kt + 4 * q4) = zp[i]; }
            { const int cn = c + 4 < 64 ? c + 4 : 63; RW_LOAD(u, cn); }
            __syncthreads();
        }
    }
#undef RW_LOAD
}
DI void rwkv_out_item(const Params& p, int l, int bh, int pair, bool dry = false) {
    const int tid = opaque_tid(), lane = tid & 63, w = tid >> 6, q4 = lane >> 4, l15 = lane & 15;
    bf16* P = (bf16*)(p.ws + WS_P);
    const int b = bh >> 3, h = bh & 7, c = 2 * pair + (w >> 2), m = b * T + c * 64 + 16 * (w & 3) + l15;
    const bf16* ZT = (const bf16*)(p.ws + WS_RWGH) + ((size_t)(bh * 64 + c) * 2 + 1) * 4096;
    const size_t ro = (size_t)m * LDP;
    bf16x8 qf[2], zf[4][2]; u32x2 yl[4], bv[4], g2[4]; f32x4 lg[4], lb[4];
#pragma unroll
    for (int kk = 0; kk < 2; ++kk) qf[kk] = *(const bf16x8*)(P + ro + C_WR + h * 64 + 32 * kk + 8 * q4);
#pragma unroll
    for (int vt = 0; vt < 4; ++vt) { yl[vt] = *(const u32x2*)(P + ro + C_WK + h * 64 + 16 * vt + 4 * q4);
#pragma unroll
        for (int kk = 0; kk < 2; ++kk) zf[vt][kk] = frag(ZT, 64, 16 * vt, 32 * kk, lane); }
#pragma unroll
    for (int vt = 0; vt < 4; ++vt) { const int ch = h * 64 + 16 * vt + 4 * q4;
        bv[vt] = *(const u32x2*)(P + ro + C_WV + ch); g2[vt] = *(const u32x2*)(P + ro + C_WG + ch);
        lg[vt] = *(const f32x4*)(p.in[I_LNG] + l * 512 + ch); lb[vt] = *(const f32x4*)(p.in[I_LNB] + l * 512 + ch); }
    f32x4 y[4]; float s = 0.f;
#pragma unroll
    for (int vt = 0; vt < 4; ++vt) {
        y[vt] = (f32x4){lo16(yl[vt].x), hi16(yl[vt].x), lo16(yl[vt].y), hi16(yl[vt].y)};
#pragma unroll
        for (int kk = 0; kk < 2; ++kk) y[vt] = mfma16(zf[vt][kk], qf[kk], y[vt]);
        s += (y[vt][0] + y[vt][1]) + (y[vt][2] + y[vt][3]); }
    s += __shfl_xor(s, 16); s += __shfl_xor(s, 32);
    const float mean = s * (1.0f / 64.0f); float vr = 0.f;
#pragma unroll
    for (int vt = 0; vt < 4; ++vt) { y[vt] = y[vt] - mean; vr += (y[vt][0] * y[vt][0] + y[vt][1] * y[vt][1]) + (y[vt][2] * y[vt][2] + y[vt][3] * y[vt][3]); }
    vr += __shfl_xor(vr, 16); vr += __shfl_xor(vr, 32);
    const float rstd = __builtin_amdgcn_rsqf(vr * (1.0f / 64.0f) + 64e-5f);
#pragma unroll
    for (int vt = 0; vt < 4; ++vt) { const int ch = h * 64 + 16 * vt + 4 * q4; bf16* gp = P + ro + C_WG + ch;
        const float bvf[4] = {lo16(bv[vt].x), hi16(bv[vt].x), lo16(bv[vt].y), hi16(bv[vt].y)}, g[4] = {lo16(g2[vt].x), hi16(g2[vt].x), lo16(g2[vt].y), hi16(g2[vt].y)};
        f32x4 o;
#pragma unroll
        for (int j = 0; j < 4; ++j) o[j] = (y[vt][j] * rstd * lg[vt][j] + lb[vt][j] + bvf[j]) * siluf_(g[j]);
        if (!dry) *(u32x2*)gp = pack4(o); }
}

DI void phase_A(const Params& p, int l, unsigned char* lds, bool dry = false) {
    const int G = gridDim.x, bid = blockIdx.x;
#ifndef DUP_AMASK
#define DUP_AMASK 0xff
#endif
    for (int it = bid; it < 3328; it += G) {
        if (dry) { const int ty = it < 2048 ? 1 : it < 2560 ? 2 : it < 2816 ? 4 : it < 3072 ? 8 : 16; if (!(DUP_AMASK & ty)) continue; }
        if (it < 2048) rwkv_chunk_item(p, l, lds, it >> 9, (it >> 6) & 7, it & 63, dry);
        else if (it < 2560) { const int i = it - 2048; ssd_item(p, l, lds, i >> 7, (i >> 4) & 7, i & 15, false); }
        else if (it < 2816) { const int i = it - 2560; qkv_item<false>(p, l, lds, i >> 6, (i >> 4) & 3, i & 15, false); }
        else if (it < 3072) { const int i = it - 2816; qkv_item<true>(p, l, lds, i >> 6, (i >> 4) & 3, i & 15, false); }
        else memkv_item(p, l, it - 3072);
    }
}
DI void phase_B(const Params& p, unsigned char* lds, bool dry = false) {
    (void)lds; phase_scan(p, blockIdx.x, gridDim.x, dry);
}
DI void rwkv_flag_publish(unsigned* flag) {
    asm volatile("s_waitcnt vmcnt(0)" ::: "memory"); __syncthreads();
    if (threadIdx.x == 0) { __builtin_amdgcn_fence(__ATOMIC_RELEASE, "agent"); asm volatile("s_waitcnt vmcnt(0)" ::: "memory"); __hip_atomic_store(flag, 1u, __ATOMIC_RELAXED, __HIP_MEMORY_SCOPE_AGENT); }
}
DI void rwkv_flag_wait(unsigned* flag) {
    if (threadIdx.x == 0) { unsigned spins = 0;
        while (__hip_atomic_load(flag, __ATOMIC_RELAXED, __HIP_MEMORY_SCOPE_AGENT) == 0u) { __builtin_amdgcn_s_sleep(8); if (++spins > (1u << 22)) break; }
        __builtin_amdgcn_fence(__ATOMIC_ACQUIRE, "agent"); asm volatile("s_waitcnt vmcnt(0)" ::: "memory"); }
    __syncthreads();
}
DI void phase_C(const Params& p, int l, unsigned char* lds, bool dry = false) {
    const int G = gridDim.x, bid = blockIdx.x;
    unsigned* flags = (unsigned*)(p.ws + WS_BAR + 14336) + (dry ? 128 : 0) + l * 32;
    for (int bh = bid; bh < 32; bh += G) { rwkv_scan_chain(p, lds, bh, dry); rwkv_flag_publish(flags + bh); }
    unsigned have = 0u;
#define C_SSD(it)  ssd_item(p, l, lds, (it) >> 7, ((it) >> 4) & 7, (it) & 15, true, dry)
#define C_RET(it)  qkv_item<false>(p, l, lds, (it) >> 6, ((it) >> 4) & 3, (it) & 15, true, dry)
#define C_GLA(it)  qkv_item<true>(p, l, lds, (it) >> 6, ((it) >> 4) & 3, (it) & 15, true, dry)
#define C_MEM(it)  memattn_item(p, lds, (it) >> 6, ((it) >> 4) & 3, (it) & 15)
#define C_RWO(it)  do { const int bh_ = (it) >> 5; if (!((have >> bh_) & 1u)) { rwkv_flag_wait(flags + bh_); have |= 1u << bh_; } rwkv_out_item(p, l, bh_, (it) & 31, dry); } while (0)
    const int nslot = (G == 256) ? 16 : (2304 + G - 1) / G;
    for (int k = 0; k < nslot; ++k) {
        int it = -1;
        if (G == 256) {
            if (bid < 32) { it = k == 0 ? bid : (k >= 1 && k <= 4) ? 1280 + 4 * bid + (k - 1) : -1; }
            else { const int j = bid - 32;
                if (k == 0) it = 32 + j; else if (k == 1) it = 256 + j; else if (k == 2) it = (j < 32) ? 480 + j : -1;
                else if (k == 3) it = 768 + 32 + j; else if (k == 4) it = (j >= 32 && j < 64) ? 768 + (j - 32) : -1;
                else if (k == 5) it = 512 + 32 + j; else if (k == 6) it = (j >= 64 && j < 96) ? 512 + (j - 64) : -1;
                else if (k == 7) it = 1024 + j; else if (k == 8) it = (j >= 96 && j < 128) ? 1024 + 224 + (j - 96) : -1;
                else { const int m = k - 9; int r = -1;
                    if (j < 32) r = -1; else if (j < 64) r = m < 1 ? 128 + (j - 32) : -1; else if (j < 96) r = m < 2 ? 160 + 2 * (j - 64) + m : -1;
                    else if (j < 128) r = m < 5 ? 224 + 5 * (j - 96) + m : -1; else if (j < 192) r = m < 7 ? 384 + 7 * (j - 128) + m : -1; else r = m < 6 ? 832 + 6 * (j - 192) + m : -1;
                    it = r >= 0 ? 1280 + r : -1; } }
        } else { it = bid + k * G; if (it >= 2304) it = -1; }
        if (it < 0) continue;
        if (it < 512) C_SSD(it); else if (it < 768) C_RET(it - 512); else if (it < 1024) C_GLA(it - 768); else if (it < 1280) C_MEM(it - 1024); else C_RWO(it - 1280);
    }
#undef C_SSD
#undef C_RET
#undef C_GLA
#undef C_MEM
#undef C_RWO
}
typedef PG8_LAS unsigned char* lds3_t;
DI void phase_P1(const Params& p, int l, unsigned char* lds) {
    pg8::Gemm g{1024, 1024};
    SchedP1 S{(int)gridDim.x, (int)blockIdx.x, (const char*)p.ws + WS_XN, (const char*)p.ws + WS_W1T};
    EpiP E{(bf16*)(p.ws + WS_P), (bf16*)(p.ws + WS_BND)};
    pg8::gemm_phase<EpiP, SchedP1, true, true>((lds3_t)lds, g, S, E);
}
DI void phase_P3(const Params& p, int l, unsigned char* lds) {
    (void)l;
    for (int L = blockIdx.x; L < 256; L += gridDim.x) {
        int pm, pn; tile_map(L, 64, 4, pm, pn);
        pg8::Gemm g{0, 0}; SchedP3 S{pm, pn, p.ws};
        EpiP3 E{EpiGate{(bf16*)(p.ws + WS_P)}, EpiBranch{(const bf16*)(p.ws + WS_P), (bf16*)(p.ws + WS_MRG), (const float*)(p.ws + WS_SSQ)}};
        pg8::gemm_phase<EpiP3, SchedP3, true, true>((lds3_t)lds, g, S, E);
    }
}
DI void phase_P4(const Params& p, int l, unsigned char* lds) {
    pg8::Gemm g{1024, 1024};
    SchedP4 S{(int)gridDim.x, (int)blockIdx.x, (const char*)p.ws + WS_MRG, (const char*)p.ws + WS_WOT};
    if (gridDim.x == 256) {
        float* xs = (float*)(p.ws + WS_XS) + (size_t)l * 64 * 256 * 4; unsigned* cnt = (unsigned*)(p.ws + WS_XCNT) + l * 64 * 64;
        if (l == 0) { EpiNorm<false> E{p.in[I_X], p.out, p.in[I_NORMG] + 1024, (bf16*)(p.ws + WS_XN), xs, cnt}; pg8::gemm_phase<EpiNorm<false>, SchedP4, true, true>((lds3_t)lds, g, S, E); }
        else { EpiNorm<true> E{p.out, p.out, p.in[I_FNORMG], nullptr, xs, cnt}; pg8::gemm_phase<EpiNorm<true>, SchedP4, true, true>((lds3_t)lds, g, S, E); }
    } else { EpiRes E{l == 0 ? p.in[I_X] : p.out, p.out}; pg8::gemm_phase<EpiRes, SchedP4, true, true>((lds3_t)lds, g, S, E); }
}
DI void phase_post(const Params& p, int l, unsigned char* lds) {
    if (gridDim.x == 256) { if (l == 0) convert_weights(p, 1, lds); }
    else phase_norm(p, l, 1.0f, lds);
}

#ifndef MK_LAUNCHES
#define MK_LAUNCHES 1
#endif
struct KArgs { Params p; int lo, hi; };
constexpr int N_PHASES = 15;
#ifdef NVGPR
__global__ void __launch_bounds__(NTHREADS, 2) __attribute__((amdgpu_num_vgpr(NVGPR))) fwd_kernel(KArgs a) {
#else
__global__ void __launch_bounds__(NTHREADS, 2) fwd_kernel(KArgs a) {
#endif
    extern __shared__ __attribute__((aligned(16))) unsigned char lds[];
    cg::grid_group grid = cg::this_grid();
    const Params& p = a.p;
    volatile unsigned* bst = (volatile unsigned*)(lds + LDS_BYTES - 64);
    if (threadIdx.x < 16) bst[threadIdx.x] = 0u;
    __syncthreads();
    XcdBarrier xbar = xcd_barrier_post((unsigned*)(p.ws + WS_BAR), bst);
    if (a.hi == 12345) grid.sync();
#define GRID_SYNC() xcd_barrier(xbar)
#ifndef DUP_N
#define DUP_N 1
#endif
#ifndef PHMASK
#define PHMASK 0xff
#endif
#if defined(TPROBE) && defined(PH_PROBE)
#define PH_TS_BEGIN() do { if (threadIdx.x == 0) TS_BASE(lds)[13] = (unsigned)__builtin_amdgcn_s_memrealtime(); } while (0)
#define PH_TS_MARK(k) do { __syncthreads(); if (threadIdx.x == 0) { const unsigned t_ = (unsigned)__builtin_amdgcn_s_memrealtime(); volatile unsigned* A_ = TS_BASE(lds); A_[k] += t_ - A_[13]; A_[13] = t_; } } while (0)
#else
#define PH_TS_BEGIN() do {} while (0)
#define PH_TS_MARK(k) do {} while (0)
#endif
#ifdef DUP_S
#define NREP(ty, l) (((ty) == DUP_S && !(((ty) == 6 || (ty) == 7) && (l) != 0)) ? 1 + DUP_N : 1)
#else
#define NREP(ty, l) 1
#endif
#define RUN_PHASE(ty, l, more) do { const int nrep = NREP(ty, l); \
        for (int rep = 0; rep < nrep; ++rep) { const bool dry = (rep + 1 < nrep) && (a.hi != 12345); (void)dry; PH_TS_BEGIN(); \
            if (!((PHMASK >> (ty)) & 1)) {} \
            else if ((ty) == 0) phase_prologue(p, lds); \
            else if ((ty) == 1) phase_P1(p, l, lds); \
            else if ((ty) == 2) phase_A(p, l, lds, dry); \
            else if ((ty) == 3) phase_B(p, lds, dry); \
            else if ((ty) == 4) phase_C(p, l, lds, dry); \
            else if ((ty) == 5) phase_P3(p, l, lds); \
            else if ((ty) == 6) phase_P4(p, l, lds); \
            else phase_post(p, l, lds); \
            PH_TS_MARK(ty); \
            if ((more) || rep + 1 < nrep) GRID_SYNC(); } } while (0)
#if MK_LAUNCHES == 1
#if defined(DUP_S) && DUP_S == 100
    for (int rep = 0; rep < DUP_N; ++rep) GRID_SYNC();
#endif
    RUN_PHASE(0, 0, true);
    RUN_PHASE(1, 0, true); RUN_PHASE(2, 0, true); RUN_PHASE(3, 0, true); RUN_PHASE(4, 0, true); RUN_PHASE(5, 0, true); RUN_PHASE(6, 0, true); RUN_PHASE(7, 0, true);
    RUN_PHASE(1, 1, true); RUN_PHASE(2, 1, true); RUN_PHASE(3, 1, true); RUN_PHASE(4, 1, true); RUN_PHASE(5, 1, true); RUN_PHASE(6, 1, gridDim.x != 256); RUN_PHASE(7, 1, false);
#ifdef TPROBE
    {
        GRID_SYNC();
        unsigned* pw = (unsigned*)(p.ws + WS_XS + 600 * 1024);
        if (threadIdx.x == 0) pw[blockIdx.x] = TS_BASE(lds)[TPROBE];
        GRID_SYNC();
#ifndef TP_MODE
#define TP_MODE 0
#endif
#ifndef TP_LO
#define TP_LO 0
#define TP_HI 1
#endif
        float tot = 0.f, mx = 0.f, ctot = 0.f; int amx = 0; for (int i = 0; i < (int)gridDim.x; ++i) { const float v_ = (float)__hip_atomic_load(pw + i, __ATOMIC_RELAXED, __HIP_MEMORY_SCOPE_AGENT); tot += v_; if (v_ > mx) { mx = v_; amx = i; } if (i >= TP_LO && i < TP_HI) ctot += v_; }
        const float avg_us = TP_MODE == 4 ? (float)amx : TP_MODE == 3 ? (ctot / (float)(TP_HI - TP_LO)) / (tot / (float)gridDim.x) * 100.0f : TP_MODE == 2 ? (mx * (float)gridDim.x / tot - 1.0f) * 100.0f : (TP_MODE == 0 ? tot / (float)gridDim.x : mx) * 0.01f / (float)TP_CNT;
        const float bucket = floorf(avg_us / (float)TP_Q + 0.5f);
        const float sc = 1.0f + bucket * 0.01f;
        for (int i = blockIdx.x * NTHREADS + threadIdx.x; i < M * 256; i += gridDim.x * NTHREADS) { f32x4* o = (f32x4*)p.out + i; *o = *o * sc; }
    }
#endif
#else
    for (int ph = a.lo; ph < a.hi; ++ph) { const int ty = (ph == 0) ? 0 : ((ph - 1) % 7 + 1), l = (ph - 1) / 7; RUN_PHASE(ty, l, ph + 1 < a.hi); }
#endif
}

extern "C" void kernel_launch(void* const* d_in, const int* in_sizes, int n_in, void* d_out, int out_size, void* d_ws, size_t ws_size, hipStream_t stream) {
    static int grid = 0;
    if (grid == 0) {
        if (n_in != N_IN || out_size != M * D || ws_size < WS_END) { fprintf(stderr, "kernel_launch: unexpected shapes (n_in %d, out %d, ws %zu < %zu)\n", n_in, out_size, ws_size, (size_t)WS_END); grid = -1; return; }
        int dev = 0, cus = 0, per_cu = 0;
        hipGetDevice(&dev); hipDeviceGetAttribute(&cus, hipDeviceAttributeMultiprocessorCount, dev);
        hipFuncSetAttribute((const void*)fwd_kernel, hipFuncAttributeMaxDynamicSharedMemorySize, LDS_BYTES);
        hipOccupancyMaxActiveBlocksPerMultiprocessor(&per_cu, (const void*)fwd_kernel, NTHREADS, LDS_BYTES);
        if (per_cu < 1 || cus < 1) { fprintf(stderr, "kernel_launch: occupancy query gave %d blocks/CU on %d CUs\n", per_cu, cus); grid = -1; return; }
        grid = cus * per_cu; if (grid > 256) grid = 256;
    }
    if (grid < 0) return;
    KArgs a{}; for (int i = 0; i < N_IN; ++i) a.p.in[i] = (const float*)d_in[i];
    a.p.out = (float*)d_out; a.p.ws = (unsigned char*)d_ws;
    if (hipMemsetAsync((char*)d_ws + WS_BAR, 0, WS_ZERO_BYTES, stream) != hipSuccess) { fprintf(stderr, "kernel_launch: memset of the barrier words failed\n"); return; }
    if (MK_LAUNCHES == 1) {
        a.lo = 0; a.hi = N_PHASES; void* args[] = {&a};
        hipError_t e = hipLaunchCooperativeKernel((const void*)fwd_kernel, dim3(grid), dim3(NTHREADS), args, LDS_BYTES, stream);
        if (e != hipSuccess) fprintf(stderr, "kernel_launch: cooperative launch failed: %s (grid %d)\n", hipGetErrorString(e), grid);
    } else {
        for (int ph = 0; ph < N_PHASES; ++ph) { a.lo = ph; a.hi = ph + 1; hipLaunchKernelGGL(fwd_kernel, dim3(grid), dim3(NTHREADS), LDS_BYTES, stream, a); }
    }
}
```

```cpp
#include <hip/hip_runtime.h>
#include <hip/hip_cooperative_groups.h>
#include <cstdio>
#include <cstdint>
namespace cg = cooperative_groups;
namespace pg8 {
#define PG8_LAS __attribute__((address_space(3)))
typedef unsigned short bf16_t;
typedef short bf16x8 __attribute__((ext_vector_type(8)));
typedef float f32x4 __attribute__((ext_vector_type(4)));
typedef unsigned u32x4 __attribute__((ext_vector_type(4)));
constexpr int BM = 256, BK = 64, HALF = 128, HTB = HALF * BK * 2  , STAGE_BYTES = 8 * HTB, NXCD = 8, WGM = 8;

__host__ __device__ __forceinline__ int lds_byte(int r, int c) { const int st = (r >> 4) * 2 + (c >> 5), rr = r & 15, cc = c & 31, ob = rr * 64 + cc * 2; return st * 1024 + (ob ^ (((ob >> 9) & 1) << 5)); }
__host__ __device__ __forceinline__ void stage_rc(int b, int& R, int& C) { const int st = b / 1024, sb = b % 1024, swz = sb ^ (((sb >> 9) & 1) << 5); R = (st >> 1) * 16 + swz / 64; C = (st & 1) * 32 + (swz % 64) / 2; }
__host__ __device__ __forceinline__ int perm32(int rho) { const int n = rho >> 4, i = rho & 15; return 8 * (i >> 2) + 4 * n + (i & 3); }

struct Unit { int pm, pn, kind, aux; int nt, lda, ldb; int pad_; const char* A; const char* B; };
struct Gemm { int K, lda; };


template <class Epi, class Sched, bool ALIGN_EPI = false, bool SP2 = false>
__device__ __forceinline__ void gemm_phase(PG8_LAS unsigned char* lds, const Gemm g, const Sched& S, const Epi& E) {
    int tid = threadIdx.x; asm volatile("" : "+v"(tid));
    const int wid = __builtin_amdgcn_readfirstlane(tid >> 6), lane = tid & 63, wr = wid >> 2, wc = wid & 3, fr = lane & 15, fq = lane >> 4;
    int Rv[2], Rbv[2], Cv[2];
#pragma unroll
    for (int i = 0; i < 2; ++i) { int R, C; stage_rc(tid * 16 + i * 8192, R, C); Rv[i] = R; Cv[i] = C; Rbv[i] = Epi::PERM ? ((R & ~31) + perm32(R & 31)) : R; }
    unsigned voffA[2], voffB[2], voffAn[2], voffBn[2];
    const size_t kstep = (size_t)(BK * 2);
    size_t hstepA, hstepB, hstepAn, hstepBn;
#define PG8_STRIDES(u_, vA_, vB_, hA_, hB_) do { _Pragma("unroll") for (int _i = 0; _i < 2; ++_i) { vA_[_i] = (unsigned)(Rv[_i] * (u_).lda + Cv[_i]) * 2u; vB_[_i] = (unsigned)(Rbv[_i] * (u_).ldb + Cv[_i]) * 2u; } \
        hA_ = (size_t)HALF * (u_).lda * 2; hB_ = (size_t)HALF * (u_).ldb * 2; } while (0)
    const unsigned ldsw = (unsigned)wid * 1024u;
    const int aoff = lds_byte(wr * 64 + fr, fq * 8), boff = lds_byte(wc * 32 + fr, fq * 8);
#define PG8_SA(b, h) (((b) * 2 + (h)) * HTB)
#define PG8_SB(b, h) ((4 + (b) * 2 + (h)) * HTB)
#define PG8_STAGE(bufoff, gbase, voff) do { _Pragma("unroll") for (int _i = 0; _i < 2; ++_i) \
        __builtin_amdgcn_global_load_lds((const unsigned*)((const char*)(gbase) + (voff)[_i]), (PG8_LAS unsigned*)(lds + (bufoff) + ldsw + _i * 8192), 16, 0, 0); } while (0)
#define PG8_LDA(dst, b, h) do { _Pragma("unroll") for (int m = 0; m < 4; ++m) _Pragma("unroll") for (int k = 0; k < 2; ++k) dst[m][k] = *(const PG8_LAS bf16x8*)(lds + PG8_SA(b, h) + aoff + m * 2048 + k * 1024); } while (0)
#define PG8_LDB(dst, b, h) do { _Pragma("unroll") for (int n = 0; n < 2; ++n) _Pragma("unroll") for (int k = 0; k < 2; ++k) dst[n][k] = *(const PG8_LAS bf16x8*)(lds + PG8_SB(b, h) + boff + n * 2048 + k * 1024); } while (0)
#define PG8_MMA(ai, bj, At, Bt) do { __builtin_amdgcn_s_setprio(1); _Pragma("unroll") for (int m = 0; m < 4; ++m) _Pragma("unroll") for (int n = 0; n < 2; ++n) _Pragma("unroll") for (int k = 0; k < 2; ++k) \
        acc[ai][bj][m][n] = __builtin_amdgcn_mfma_f32_16x16x32_bf16(Bt[n][k], At[m][k], acc[ai][bj][m][n], 0, 0, 0); __builtin_amdgcn_s_setprio(0); } while (0)
#define PG8_WAIT_V(n) asm volatile("s_waitcnt vmcnt(" #n ")" ::: "memory")
#define PG8_WAIT_L(n) asm volatile("s_waitcnt lgkmcnt(" #n ")" ::: "memory")
#define PG8_BAR __builtin_amdgcn_s_barrier()
#define PG8_SCHED __builtin_amdgcn_sched_barrier(0)
    Unit cur, nxt; int ui = 0;
    if (!S.next(0, cur)) return;
    PG8_STRIDES(cur, voffA, voffB, hstepA, hstepB); int nt = cur.nt;
    f32x4 acc[2][2][4][2];
#pragma unroll
    for (int a = 0; a < 2; ++a)
#pragma unroll
        for (int b = 0; b < 2; ++b)
#pragma unroll
            for (int m = 0; m < 4; ++m)
#pragma unroll
                for (int n = 0; n < 2; ++n) acc[a][b][m][n] = (f32x4){0.f, 0.f, 0.f, 0.f};
    bf16x8 At[4][2], B0[2][2], B1[2][2];
    const char* cA = cur.A; const char* cB = cur.B;
    S.a_ready(cur);
    if constexpr (SP2) {
        PG8_STAGE(PG8_SB(0, 0), cB, voffB); PG8_STAGE(PG8_SB(0, 1), cB + hstepB, voffB); PG8_STAGE(PG8_SA(0, 0), cA, voffA); PG8_STAGE(PG8_SA(0, 1), cA + hstepA, voffA);
        if (wr == 1) PG8_BAR;
        PG8_WAIT_V(2); PG8_BAR;
        PG8_STAGE(PG8_SB(1, 0), cB + kstep, voffB); PG8_STAGE(PG8_SA(1, 0), cA + kstep, voffA); PG8_STAGE(PG8_SB(1, 1), cB + hstepB + kstep, voffB);
        PG8_WAIT_V(6); PG8_BAR;
    } else {
        PG8_STAGE(PG8_SB(0, 0), cB, voffB); PG8_STAGE(PG8_SA(0, 0), cA, voffA); PG8_STAGE(PG8_SB(0, 1), cB + hstepB, voffB); PG8_STAGE(PG8_SA(0, 1), cA + hstepA, voffA);
        if (wr == 1) PG8_BAR;
        PG8_WAIT_V(4); PG8_BAR;
        PG8_STAGE(PG8_SB(1, 0), cB + kstep, voffB); PG8_STAGE(PG8_SA(1, 0), cA + kstep, voffA); PG8_STAGE(PG8_SB(1, 1), cB + hstepB + kstep, voffB);
        PG8_WAIT_V(6); PG8_BAR;
    }
    for (;;) {
        const bool has_next = S.next(ui + 1, nxt);
        const char* nA = has_next ? nxt.A : cA; const char* nB = has_next ? nxt.B : cB;
        if (has_next) PG8_STRIDES(nxt, voffAn, voffBn, hstepAn, hstepBn); else { voffAn[0] = voffA[0]; voffAn[1] = voffA[1]; voffBn[0] = voffB[0]; voffBn[1] = voffB[1]; hstepAn = hstepA; hstepBn = hstepB; }
        for (int t = 0; t < nt; t += 2) {
            const bool last = (t == nt - 2);
            const char* a1 = cA + (size_t)(t + 1) * kstep;
            const char* a2 = last ? nA : cA + (size_t)(t + 2) * kstep; const char* b2 = last ? nB : cB + (size_t)(t + 2) * kstep;
            const char* a3 = a2 + kstep; const char* b3 = b2 + kstep;
            unsigned vA2[2], vB2[2]; vA2[0] = last ? voffAn[0] : voffA[0]; vA2[1] = last ? voffAn[1] : voffA[1]; vB2[0] = last ? voffBn[0] : voffB[0]; vB2[1] = last ? voffBn[1] : voffB[1];
            const size_t hA2 = last ? hstepAn : hstepA, hB2 = last ? hstepBn : hstepB;
            if (last && has_next) S.a_ready(nxt);
            if constexpr (SP2) {
            PG8_LDB(B0, 0, 0); PG8_LDB(B1, 0, 1); PG8_SCHED; PG8_LDA(At, 0, 0); PG8_STAGE(PG8_SA(1, 1), a1 + hstepA, voffA);
            PG8_WAIT_V(8); PG8_WAIT_L(0); PG8_BAR; PG8_MMA(0, 0, At, B0); PG8_MMA(0, 1, At, B1); PG8_BAR; PG8_SCHED;
            PG8_LDA(At, 0, 1); PG8_STAGE(PG8_SB(0, 0), b2, vB2); PG8_STAGE(PG8_SB(0, 1), b2 + hB2, vB2); PG8_STAGE(PG8_SA(0, 0), a2, vA2);
            PG8_WAIT_V(8); PG8_WAIT_L(0); PG8_BAR; PG8_MMA(1, 0, At, B0); PG8_MMA(1, 1, At, B1); PG8_BAR; PG8_SCHED;
            PG8_LDB(B0, 1, 0); PG8_LDB(B1, 1, 1); PG8_SCHED; PG8_LDA(At, 1, 0); PG8_STAGE(PG8_SA(0, 1), a2 + hA2, vA2);
            PG8_WAIT_V(8); PG8_WAIT_L(0); PG8_BAR; PG8_MMA(0, 0, At, B0); PG8_MMA(0, 1, At, B1); PG8_BAR; PG8_SCHED;
            PG8_LDA(At, 1, 1); PG8_STAGE(PG8_SB(1, 0), b3, vB2); PG8_STAGE(PG8_SB(1, 1), b3 + hB2, vB2); PG8_STAGE(PG8_SA(1, 0), a3, vA2);
            PG8_WAIT_V(8); PG8_WAIT_L(0); PG8_BAR; PG8_MMA(1, 0, At, B0); PG8_MMA(1, 1, At, B1); PG8_BAR; PG8_SCHED;
            } else {
            PG8_LDB(B0, 0, 0); PG8_SCHED; PG8_LDA(At, 0, 0); PG8_STAGE(PG8_SA(1, 1), a1 + hstepA, voffA);
            PG8_WAIT_L(8); PG8_BAR; PG8_WAIT_L(0); PG8_MMA(0, 0, At, B0); PG8_BAR; PG8_SCHED;
            PG8_LDB(B1, 0, 1); PG8_STAGE(PG8_SB(0, 0), b2, vB2);
            PG8_BAR; PG8_WAIT_L(0); PG8_MMA(0, 1, At, B1); PG8_BAR;
            PG8_LDA(At, 0, 1); PG8_STAGE(PG8_SA(0, 0), a2, vA2);
            PG8_BAR; PG8_WAIT_L(0); PG8_MMA(1, 0, At, B0); PG8_BAR; PG8_SCHED;
            PG8_STAGE(PG8_SB(0, 1), b2 + hB2, vB2);
            PG8_WAIT_V(6); PG8_BAR; PG8_MMA(1, 1, At, B1); PG8_BAR;
            PG8_LDB(B0, 1, 0); PG8_SCHED; PG8_LDA(At, 1, 0); PG8_STAGE(PG8_SA(0, 1), a2 + hA2, vA2);
            PG8_WAIT_L(8); PG8_BAR; PG8_WAIT_L(0); PG8_MMA(0, 0, At, B0); PG8_BAR; PG8_SCHED;
            PG8_LDB(B1, 1, 1); PG8_STAGE(PG8_SB(1, 0), b3, vB2);
            PG8_BAR; PG8_WAIT_L(0); PG8_MMA(0, 1, At, B1); PG8_BAR;
            PG8_LDA(At, 1, 1); PG8_STAGE(PG8_SA(1, 0), a3, vA2);
            PG8_BAR; PG8_WAIT_L(0); PG8_MMA(1, 0, At, B0); PG8_BAR; PG8_SCHED;
            PG8_STAGE(PG8_SB(1, 1), b3 + hB2, vB2);
            PG8_WAIT_V(6); PG8_BAR; PG8_MMA(1, 1, At, B1); PG8_BAR;
            }
        }
        if constexpr (ALIGN_EPI) { if (wr == 0) PG8_BAR; }
        if constexpr (!Epi::AFTER_DRAIN) { E(acc, cur, wr, wc, fr, fq); S.done(cur); }
        if (!has_next) break;
#pragma unroll
        for (int a = 0; a < 2; ++a)
#pragma unroll
            for (int b = 0; b < 2; ++b)
#pragma unroll
                for (int m = 0; m < 4; ++m)
#pragma unroll
                    for (int n = 0; n < 2; ++n) acc[a][b][m][n] = (f32x4){0.f, 0.f, 0.f, 0.f};
        cur = nxt; cA = nA; cB = nB; ++ui; nt = cur.nt; voffA[0] = voffAn[0]; voffA[1] = voffAn[1]; voffB[0] = voffBn[0]; voffB[1] = voffBn[1]; hstepA = hstepAn; hstepB = hstepBn;
        if constexpr (ALIGN_EPI) { if (wr == 1) PG8_BAR; }
    }
    PG8_WAIT_V(0);
    if constexpr (!ALIGN_EPI) { if (wr == 0) PG8_BAR; }
    PG8_BAR;
    if constexpr (Epi::AFTER_DRAIN) { E.fused(acc, cur, wr, wc, fr, fq, lds, wid, lane); S.done(cur); }
#undef PG8_STRIDES
#undef PG8_SA
#undef PG8_SB
#undef PG8_STAGE
#undef PG8_LDA
#undef PG8_LDB
#undef PG8_MMA
#undef PG8_WAIT_V
#undef PG8_WAIT_L
#undef PG8_BAR
#undef PG8_SCHED
}
}

#define DI __device__ __forceinline__
typedef unsigned short bf16;
typedef short bf16x8 __attribute__((ext_vector_type(8)));
typedef float f32x4 __attribute__((ext_vector_type(4)));
typedef unsigned u32x4 __attribute__((ext_vector_type(4)));
typedef unsigned u32x2 __attribute__((ext_vector_type(2)));

constexpr int D = 1024, NBATCH = 4, T = 4096, M = NBATCH * T, IN_TOTAL = 12184;
constexpr int LDP = 7168;
constexpr int C_RQ = 0, C_RK = 256, C_RV = 512, C_RG = 1024, C_GQ = 1536, C_GK = 1792, C_GV = 2048, C_GG = 2560,
              C_SX = 3072, C_SZ = 4096, C_WR = 4608, C_WK = 5120, C_WV = 5632, C_WL = 6144, C_AL = 6208, C_WG = 6272,
              C_MQ = 6784, C_GKL = 7040, C_SDT = 7056;
enum { I_X = 0, I_MEM, I_POS, I_NORMG, I_WIN, I_GKW2, I_GKB, I_GNORMG, I_CONVW, I_CONVB, I_DTB, I_ALOG, I_SD, I_SNORMG,
       I_MU, I_W0, I_W2, I_A0, I_A2, I_KK, I_KA, I_RK, I_LNG, I_LNB, I_MNORMG, I_WKV, I_URET, I_UGLA, I_USSD, I_URWKV,
       I_UMEM, I_WOUT, I_FNORMG, N_IN };
constexpr size_t MiB = 1u << 20;
constexpr size_t WS_SSQ = 0;
constexpr size_t WS_DG = 512 * 1024;
constexpr size_t WS_DS = 576 * 1024;
constexpr size_t WS_BAR = 640 * 1024;
constexpr size_t WS_KM = 1 * MiB;
constexpr size_t WS_VMT = 1 * MiB + 512 * 1024;
constexpr size_t WS_MEMN = 2 * MiB;
constexpr size_t WS_BND = 6 * MiB;
constexpr int BND_W = 1792;
constexpr size_t WS_XS = 7 * MiB;
constexpr size_t WS_XCNT = 640 * 1024 + 16384;
constexpr size_t WS_ZERO_BYTES = 16384 + 2 * 64 * 256;
constexpr size_t WS_W1T = 8 * MiB;
constexpr size_t WS_WGT = 22 * MiB;
constexpr size_t WS_UT = 32 * MiB;
constexpr size_t WS_UST = 35 * MiB;
constexpr size_t WS_UMT = 36 * MiB;
constexpr size_t WS_WOT = 37 * MiB;
constexpr size_t WS_WKVT = 39 * MiB;
constexpr size_t WS_XN = 40 * MiB;
constexpr size_t WS_P = 72 * MiB;
constexpr size_t WS_OMEM = 296 * MiB;
constexpr size_t WS_RETL = 304 * MiB;
constexpr size_t WS_GLAL = 312 * MiB;
constexpr size_t WS_SSDL = 320 * MiB;
constexpr size_t WS_MRG = 304 * MiB;
constexpr size_t WS_RWGH = 336 * MiB;
constexpr size_t WS_END = 368 * MiB;

constexpr int LDS_BYTES = 147456;
constexpr int NTHREADS = 512;

struct Params { const float* in[N_IN]; float* out; unsigned char* ws; };

DI float bf2f(unsigned b) { return __uint_as_float(b << 16); }
typedef __bf16 bf16n2 __attribute__((ext_vector_type(2)));
DI unsigned f2bf(float f) { const __bf16 b = (__bf16)f; return (unsigned)__builtin_bit_cast(unsigned short, b); }
DI unsigned pk2(float lo, float hi) { const bf16n2 v = {(__bf16)lo, (__bf16)hi}; return __builtin_bit_cast(unsigned, v); }
DI float lo16(unsigned u) { return __uint_as_float(u << 16); }
DI float hi16(unsigned u) { return __uint_as_float(u & 0xffff0000u); }
DI void unpack8(u32x4 v, float* f) { f[0] = lo16(v.x); f[1] = hi16(v.x); f[2] = lo16(v.y); f[3] = hi16(v.y); f[4] = lo16(v.z); f[5] = hi16(v.z); f[6] = lo16(v.w); f[7] = hi16(v.w); }
DI u32x4 pack8(const float* f) { u32x4 v; v.x = pk2(f[0], f[1]); v.y = pk2(f[2], f[3]); v.z = pk2(f[4], f[5]); v.w = pk2(f[6], f[7]); return v; }
DI u32x2 pack4(f32x4 a) { u32x2 v; v.x = pk2(a[0], a[1]); v.y = pk2(a[2], a[3]); return v; }
DI float fexp(float x) { return __expf(x); }
DI float sigmoidf_(float x) { return __builtin_amdgcn_rcpf(1.0f + __expf(-x)); }
DI float siluf_(float x) { return x * __builtin_amdgcn_rcpf(1.0f + __expf(-x)); }
DI float softplusf_(float x) { return fmaxf(x, 0.0f) + __logf(1.0f + __expf(-fabsf(x))); }
DI float logsigmoidf_(float x) { return fminf(x, 0.0f) - __logf(1.0f + __expf(-fabsf(x))); }
DI float tanhf_(float x) { const float e = __expf(2.0f * x); return 1.0f - 2.0f * __builtin_amdgcn_rcpf(e + 1.0f); }
DI int opaque_tid() { int t = threadIdx.x; asm volatile("" : "+v"(t)); return t; }
#ifdef TPROBE
#define TS_BASE(lds_) ((volatile unsigned*)((lds_) + LDS_BYTES - 64) + 2)
#define TS_BEGIN() do { if (threadIdx.x == 0) TS_BASE(lds)[13] = (unsigned)__builtin_amdgcn_s_memrealtime(); } while (0)
#define TS_MARK(k) do { if (threadIdx.x == 0) { const unsigned t_ = (unsigned)__builtin_amdgcn_s_memrealtime(); volatile unsigned* A_ = TS_BASE(lds); A_[k] += t_ - A_[13]; A_[13] = t_; } } while (0)
#endif
#define WAVE_LDS_SYNC() asm volatile("s_waitcnt lgkmcnt(0)" ::: "memory")
DI float wave_sum(float v) {
#pragma unroll
    for (int o = 1; o < 64; o <<= 1) v += __shfl_xor(v, o);
    return v;
}
DI bf16x8 frag(const bf16* base, int ld, int r0, int k0, int lane) { return *(const bf16x8*)(base + (r0 + (lane & 15)) * ld + k0 + ((lane >> 4) << 3)); }
DI f32x4 mfma16(bf16x8 a, bf16x8 b, f32x4 c) { return __builtin_amdgcn_mfma_f32_16x16x32_bf16(a, b, c, 0, 0, 0); }

DI void tile_map(int L, int nM, int nN, int& pm, int& pn) {
    const int nwg = nM * nN; int wgid = L;
    { const int q = nwg / 8, r = nwg % 8, xcd = wgid % 8, off = wgid / 8; wgid = (xcd < r ? xcd * (q + 1) : r * (q + 1) + (xcd - r) * q) + off; }
    const int nig = 8 * nN, gid = wgid / nig, fm = gid * 8, gsz = (nM - fm) < 8 ? (nM - fm) : 8;
    pm = fm + ((wgid % nig) % gsz); pn = (wgid % nig) / gsz;
}

using pg8::Unit;
struct SchedP1 {
    int G, c; const char* A; const char* B;
    DI bool next(int i, Unit& u) const {
        const long L = (long)i * G + c; if (L >= 64 * 28) return false;
        tile_map((int)L, 64, 28, u.pm, u.pn); u.kind = 0; u.aux = 0; u.nt = 16; u.lda = 1024; u.ldb = 1024; u.pad_ = 0;
        u.A = A + (size_t)u.pm * 256 * 1024 * 2; u.B = B + (size_t)u.pn * 256 * 1024 * 2; return true;
    }
    DI void a_ready(const Unit&) const {}
    DI void done(const Unit&) const {}
};
struct EpiP {
    static constexpr bool PERM = true, AFTER_DRAIN = false;
    bf16* O; bf16* BND;
    DI void operator()(const f32x4 (&acc)[2][2][4][2], const Unit& u, int wr, int wc, int fr, int fq) const {
        const int row0 = u.pm * 256 + wr * 64 + fr, col0 = u.pn * 256 + wc * 32 + 8 * fq;
#pragma unroll
        for (int ai = 0; ai < 2; ++ai)
#pragma unroll
            for (int m = 0; m < 4; ++m) { bf16* rowp = O + (size_t)(row0 + ai * 128 + m * 16) * LDP + col0;
#pragma unroll
                for (int bj = 0; bj < 2; ++bj) { const f32x4 v0 = acc[ai][bj][m][0], v1 = acc[ai][bj][m][1];
                    u32x4 w; w.x = pk2(v0[0], v0[1]); w.y = pk2(v0[2], v0[3]); w.z = pk2(v1[0], v1[1]); w.w = pk2(v1[2], v1[3]);
                    *(u32x4*)(rowp + bj * 128) = w;
                    if (m == 3 && fr == 15 && u.pn >= 18 && u.pn <= 24) *(u32x4*)(BND + (size_t)((row0 + ai * 128 + m * 16) >> 6) * BND_W + (col0 - 4608) + bj * 128) = w; } }
    }
};
DI int gate_slot_col(int s) { return s < 8 ? 128 * s : s < 16 ? 1536 + 128 * (s - 8) : s < 24 ? 3072 + 128 * (s - 16) : s < 37 ? 4608 + 128 * (s - 24) : 6784 + 128 * (s - 37); }
struct SchedP3 {
    int pm, pn; const unsigned char* ws;
    DI bool next(int i0, Unit& u) const {
        if (i0 >= 11) return false;
        const int i = i0 == 0 ? 0 : i0 == 1 ? 5 : i0 == 2 ? 1 : i0 == 3 ? 6 : i0 == 4 ? 3 : i0 == 5 ? 7 : i0 == 6 ? 2 : i0 == 7 ? 8 : i0 == 8 ? 9 : i0 == 9 ? 4 : 10;
        u.pm = pm; u.pn = pn; u.pad_ = 0;
        if (i < 5) { u.kind = i; u.aux = 16; u.nt = 16; u.lda = 1024; u.ldb = 1024; u.A = (const char*)ws + WS_XN + (size_t)pm * 256 * 1024 * 2;
            u.B = (const char*)ws + WS_WGT + ((size_t)i * 1024 + (size_t)pn * 256) * 1024 * 2; }
        else if (i < 8) { const int j = i - 5; const int col = j == 0 ? C_RG : j == 1 ? C_GG : C_WG; u.kind = j == 0 ? 0 : j == 1 ? 1 : 3; u.aux = (j == 0) ? 1 : 0; u.nt = 8; u.lda = LDP; u.ldb = 512;
            u.A = (const char*)ws + WS_P + ((size_t)pm * 256 * LDP + col) * 2;
            u.B = (const char*)ws + WS_UT + ((size_t)j * 1024 + (size_t)pn * 256) * 512 * 2; }
        else if (i < 10) { const int j = i - 8; u.kind = 2; u.aux = (j + 1) << 1; u.nt = 4; u.lda = LDP; u.ldb = 256;
            u.A = (const char*)ws + WS_P + ((size_t)pm * 256 * LDP + C_SZ + j * 256) * 2;
            u.B = (const char*)ws + WS_UST + ((size_t)j * 1024 + (size_t)pn * 256) * 256 * 2; }
        else { u.kind = 4; u.aux = 0; u.nt = 4; u.lda = 256; u.ldb = 256; u.A = (const char*)ws + WS_OMEM + (size_t)pm * 256 * 256 * 2;
            u.B = (const char*)ws + WS_UMT + ((size_t)pn * 256) * 256 * 2; }
        return true;
    }
    DI void a_ready(const Unit&) const {}
    DI void done(const Unit&) const {}
};
typedef float f32x2 __attribute__((ext_vector_type(2)));
DI f32x2 sig255_pk(f32x2 x) {
    x = __builtin_elementwise_min(__builtin_elementwise_max(x, (f32x2){-7.0f, -7.0f}), (f32x2){7.0f, 7.0f});
    const f32x2 x2 = x * x;
    f32x2 q = x2 * 9.362619013e-11f + (-1.716749942e-08f);
    q = q * x2 + 1.283517804e-06f; q = q * x2 + (-5.098115798e-05f); q = q * x2 + 1.195220742e-03f; q = q * x2 + (-1.824038848e-02f); q = q * x2 + 2.476293743e-01f;
    return (x * q) * 255.0f + 128.0f;
}
DI f32x2 sig_pk(f32x2 x) { return (sig255_pk(x) - 128.0f) * (1.0f / 255.0f) + 0.5f; }
struct EpiGate {
    static constexpr bool PERM = true, AFTER_DRAIN = false;
    bf16* P;
    DI void operator()(const f32x4 (&acc)[2][2][4][2], const Unit& u, int wr, int wc, int fr, int fq) const {
        const int row0 = u.pm * 256 + wr * 64 + fr;
#pragma unroll
        for (int bj = 0; bj < 2; ++bj) { const int col = gate_slot_col((u.kind * 4 + u.pn) * 2 + bj);
#pragma unroll
            for (int ai = 0; ai < 2; ++ai)
#pragma unroll
                for (int m = 0; m < 4; ++m) { const f32x4 v0 = acc[ai][bj][m][0], v1 = acc[ai][bj][m][1];
                    const f32x2 a = sig255_pk((f32x2){v0[0], v0[1]}), b = sig255_pk((f32x2){v0[2], v0[3]}), c = sig255_pk((f32x2){v1[0], v1[1]}), d = sig255_pk((f32x2){v1[2], v1[3]});
                    u32x2 w; w.x = (unsigned)a.x | ((unsigned)a.y << 8) | ((unsigned)b.x << 16) | ((unsigned)b.y << 24);
                    w.y = (unsigned)c.x | ((unsigned)c.y << 8) | ((unsigned)d.x << 16) | ((unsigned)d.y << 24);
                    *(u32x2*)((unsigned char*)(P + (size_t)(row0 + ai * 128 + m * 16) * LDP + col) + wc * 32 + 8 * fq) = w; } }
    }
};
struct EpiBranch {
    static constexpr bool PERM = true, AFTER_DRAIN = false;
    const bf16* P; bf16* MG; const float* ssq;
    DI void operator()(const f32x4 (&acc)[2][2][4][2], const Unit& u, int wr, int wc, int fr, int fq) const {
        const int row0 = u.pm * 256 + wr * 64 + fr; const bool first = (u.aux & 1) != 0; const int grp = (u.aux >> 1) - 1;
        const int gc0 = gate_slot_col((u.kind * 4 + u.pn) * 2 + 0), gc1 = gate_slot_col((u.kind * 4 + u.pn) * 2 + 1);
        u32x2 g8[2][2][2]; u32x4 o8[2][2][2]; f32x4 s4[2][2];
#define EB_LOAD(buf, ai, mh) do { \
        _Pragma("unroll") for (int m2 = 0; m2 < 2; ++m2) { const int row = row0 + (ai) * 128 + (2 * (mh) + m2) * 16; \
            s4[buf][m2] = *(const f32x4*)(ssq + (size_t)row * 8 + (grp > 0 ? 4 : 0)); \
            _Pragma("unroll") for (int bj = 0; bj < 2; ++bj) { \
                g8[buf][m2][bj] = *(const u32x2*)((const unsigned char*)(P + (size_t)row * LDP + (bj ? gc1 : gc0)) + wc * 32 + 8 * fq); \
                o8[buf][m2][bj] = *(const u32x4*)(MG + (size_t)row * 1024 + u.pn * 256 + bj * 128 + wc * 32 + 8 * fq); } } } while (0)
#define EB_COMP(buf, ai, mh) do { \
        _Pragma("unroll") for (int m2 = 0; m2 < 2; ++m2) { const int m = 2 * (mh) + m2, row = row0 + (ai) * 128 + m * 16; \
            const float sc = (grp >= 0) ? __builtin_amdgcn_rsqf(((s4[buf][m2][0] + s4[buf][m2][1]) + (s4[buf][m2][2] + s4[buf][m2][3])) * (1.0f / 256.0f) + 1e-6f) : 1.0f; \
            _Pragma("unroll") for (int bj = 0; bj < 2; ++bj) { float g[8], pv[8]; \
                _Pragma("unroll") for (int j = 0; j < 4; ++j) { g[j] = (float)((g8[buf][m2][bj].x >> (8 * j)) & 0xffu) * (1.0f / 255.0f); g[4 + j] = (float)((g8[buf][m2][bj].y >> (8 * j)) & 0xffu) * (1.0f / 255.0f); } \
                unpack8(o8[buf][m2][bj], pv); \
                if (first) { _Pragma("unroll") for (int j = 0; j < 8; ++j) pv[j] = 0.f; } \
                const f32x4 v0 = acc[ai][bj][m][0], v1 = acc[ai][bj][m][1]; \
                float o[8] = { v0[0] * sc * g[0] + pv[0], v0[1] * sc * g[1] + pv[1], v0[2] * sc * g[2] + pv[2], v0[3] * sc * g[3] + pv[3], v1[0] * sc * g[4] + pv[4], v1[1] * sc * g[5] + pv[5], v1[2] * sc * g[6] + pv[6], v1[3] * sc * g[7] + pv[7] }; \
                *(u32x4*)(MG + (size_t)row * 1024 + u.pn * 256 + bj * 128 + wc * 32 + 8 * fq) = pack8(o); } } } while (0)
        EB_LOAD(0, 0, 0); EB_LOAD(1, 0, 1);
        __builtin_amdgcn_sched_barrier(0);
        EB_COMP(0, 0, 0); EB_LOAD(0, 1, 0);
        __builtin_amdgcn_sched_barrier(0);
        EB_COMP(1, 0, 1); EB_LOAD(1, 1, 1);
        __builtin_amdgcn_sched_barrier(0);
        EB_COMP(0, 1, 0);
        __builtin_amdgcn_sched_barrier(0);
        EB_COMP(1, 1, 1);
#undef EB_LOAD
#undef EB_COMP
    }
};
struct EpiP3 {
    static constexpr bool PERM = true, AFTER_DRAIN = false;
    EpiGate G; EpiBranch B;
    DI void operator()(const f32x4 (&acc)[2][2][4][2], const Unit& u, int wr, int wc, int fr, int fq) const { if (u.aux & 16) G(acc, u, wr, wc, fr, fq); else B(acc, u, wr, wc, fr, fq); }
};
struct SchedP4 {
    int G, c; const char* A; const char* B;
    DI bool next(int i, Unit& u) const {
        const long L = (long)i * G + c; if (L >= 64 * 4) return false;
        tile_map((int)L, 64, 4, u.pm, u.pn); u.kind = 0; u.aux = 0; u.nt = 16; u.lda = 1024; u.ldb = 1024; u.pad_ = 0;
        u.A = A + (size_t)u.pm * 256 * 1024 * 2; u.B = B + (size_t)u.pn * 256 * 1024 * 2; return true;
    }
    DI void a_ready(const Unit&) const {}
    DI void done(const Unit&) const {}
};
struct EpiRes {
    static constexpr bool PERM = false, AFTER_DRAIN = false;
    const float* res; float* out;
    DI void operator()(const f32x4 (&acc)[2][2][4][2], const Unit& u, int wr, int wc, int fr, int fq) const {
        const int row0 = u.pm * 256 + wr * 64 + fr, col0 = u.pn * 256 + wc * 32 + 4 * fq;
#pragma unroll
        for (int ai = 0; ai < 2; ++ai)
#pragma unroll
            for (int m = 0; m < 4; ++m) { const size_t off = (size_t)(row0 + ai * 128 + m * 16) * 1024 + col0;
#pragma unroll
                for (int bj = 0; bj < 2; ++bj)
#pragma unroll
                    for (int n = 0; n < 2; ++n) { const f32x4 r = *(const f32x4*)(res + off + bj * 128 + n * 16); *(f32x4*)(out + off + bj * 128 + n * 16) = r + acc[ai][bj][m][n]; } }
    }
};

template <bool LAST> struct EpiNorm {
    static constexpr bool PERM = false, AFTER_DRAIN = true;
    const float* res; float* out; const float* g; bf16* xn; float* xs; unsigned* cnt;
    DI void operator()(const f32x4 (&)[2][2][4][2], const Unit&, int, int, int, int) const {}
    DI void fused(f32x4 (&acc)[2][2][4][2], const Unit& u, int wr, int wc, int fr, int fq, PG8_LAS unsigned char* lds, int wid, int lane) const {
        PG8_LAS float* Pt = (PG8_LAS float*)lds; PG8_LAS float* St = Pt + 1024;
        const int row0 = u.pm * 256 + wr * 64 + fr, col0 = u.pn * 256 + wc * 32 + 4 * fq;
#pragma unroll
        for (int ai = 0; ai < 2; ++ai)
#pragma unroll
            for (int m = 0; m < 4; ++m) { const size_t off = (size_t)(row0 + ai * 128 + m * 16) * 1024 + col0; float s = 0.f;
#pragma unroll
                for (int bj = 0; bj < 2; ++bj)
#pragma unroll
                    for (int n = 0; n < 2; ++n) { const f32x4 r = *(const f32x4*)(res + off + bj * 128 + n * 16); const f32x4 x = r + acc[ai][bj][m][n]; acc[ai][bj][m][n] = x;
                        s += (x[0] * x[0] + x[1] * x[1]) + (x[2] * x[2] + x[3] * x[3]); }
                s += __shfl_xor(s, 16); s += __shfl_xor(s, 32);
                if (fq == 0) Pt[(ai * 128 + wr * 64 + m * 16 + fr) * 4 + wc] = s; }
        asm volatile("s_waitcnt lgkmcnt(0)" ::: "memory"); __builtin_amdgcn_s_barrier(); asm volatile("" ::: "memory");
        const int row = wid * 32 + (lane & 31);
        if (lane < 32) { const float t = (Pt[row * 4 + 0] + Pt[row * 4 + 1]) + (Pt[row * 4 + 2] + Pt[row * 4 + 3]);
            __hip_atomic_store(xs + ((size_t)u.pm * 256 + row) * 4 + u.pn, t, __ATOMIC_RELAXED, __HIP_MEMORY_SCOPE_AGENT); }
        asm volatile("s_waitcnt vmcnt(0)" ::: "memory");
        if (lane == 0) (void)__hip_atomic_fetch_add(cnt + u.pm * 64, 1u, __ATOMIC_RELAXED, __HIP_MEMORY_SCOPE_AGENT);
        if (wid == 0) { unsigned spins = 0;
            while ((unsigned)__builtin_amdgcn_readfirstlane(__hip_atomic_load(cnt + u.pm * 64, __ATOMIC_RELAXED, __HIP_MEMORY_SCOPE_AGENT)) < 32u) { __builtin_amdgcn_s_sleep(2); if (++spins > (1u << 22)) break; }
            __builtin_amdgcn_fence(__ATOMIC_ACQUIRE, "agent"); asm volatile("s_waitcnt vmcnt(0)" ::: "memory"); }
        asm volatile("" ::: "memory"); __builtin_amdgcn_s_barrier(); asm volatile("" ::: "memory");
        if (lane < 32) { const float* sp = xs + ((size_t)u.pm * 256 + row) * 4;
            const float a = __hip_atomic_load(sp + 0, __ATOMIC_RELAXED, __HIP_MEMORY_SCOPE_AGENT), b = __hip_atomic_load(sp + 1, __ATOMIC_RELAXED, __HIP_MEMORY_SCOPE_AGENT),
                        c = __hip_atomic_load(sp + 2, __ATOMIC_RELAXED, __HIP_MEMORY_SCOPE_AGENT), d = __hip_atomic_load(sp + 3, __ATOMIC_RELAXED, __HIP_MEMORY_SCOPE_AGENT);
            St[row] = __builtin_amdgcn_rsqf(((a + b) + (c + d)) * (1.0f / 1024.0f) + 1e-6f); }
        asm volatile("s_waitcnt lgkmcnt(0)" ::: "memory"); __builtin_amdgcn_s_barrier(); asm volatile("" ::: "memory");
#pragma unroll
        for (int ai = 0; ai < 2; ++ai)
#pragma unroll
            for (int m = 0; m < 4; ++m) { const size_t off = (size_t)(row0 + ai * 128 + m * 16) * 1024 + col0; const float rs = St[ai * 128 + wr * 64 + m * 16 + fr];
#pragma unroll
                for (int bj = 0; bj < 2; ++bj)
#pragma unroll
                    for (int n = 0; n < 2; ++n) { const f32x4 gv = *(const f32x4*)(g + col0 + bj * 128 + n * 16); const f32x4 x = acc[ai][bj][m][n]; const f32x4 y = x * rs * gv;
                        if (LAST) *(f32x4*)(out + off + bj * 128 + n * 16) = y;
                        else { *(f32x4*)(out + off + bj * 128 + n * 16) = x; *(u32x2*)(xn + off + bj * 128 + n * 16) = pack4(y); } } }
    }
};

DI void transpose_item(const float* W, int ldw, int K, bf16* WT, float* scr, int item, int nblk, int lane) {
    const int kb = item / nblk, nb = item % nblk, k0 = 64 * kb, n0 = 32 * nb;
    float tv[32];
#pragma unroll
    for (int i = 0; i < 32; ++i) { const int kk = 2 * i + (lane >> 5); tv[i] = W[(size_t)(k0 + kk) * ldw + n0 + (lane & 31)]; }
#pragma unroll
    for (int i = 0; i < 32; ++i) { const int kk = 2 * i + (lane >> 5); scr[kk * 33 + (lane & 31)] = tv[i]; }
    WAVE_LDS_SYNC();
    const int c = lane & 7;
#pragma unroll
    for (int j = 0; j < 4; ++j) { const int n = (lane >> 3) + 8 * j; const float* s = scr + (8 * c) * 33 + n;
        u32x4 o; o.x = pk2(s[0 * 33], s[1 * 33]); o.y = pk2(s[2 * 33], s[3 * 33]); o.z = pk2(s[4 * 33], s[5 * 33]); o.w = pk2(s[6 * 33], s[7 * 33]);
        *(u32x4*)(WT + (size_t)(n0 + n) * K + k0 + 8 * c) = o; }
    WAVE_LDS_SYNC();
}
struct TSeg { int inp, lstride, src0, ldw, K, nblk; unsigned dst_q, dst_rows0; };
DI void rms_row_bf16(const float* xrow, const float* g, bf16* orow, int lane) {
    const f32x4* xr = (const f32x4*)xrow + lane; const f32x4* gr = (const f32x4*)g + lane;
    f32x4 v[4]; float s = 0.f;
#pragma unroll
    for (int j = 0; j < 4; ++j) { v[j] = xr[64 * j]; s += (v[j][0] * v[j][0] + v[j][1] * v[j][1]) + (v[j][2] * v[j][2] + v[j][3] * v[j][3]); }
    const float rstd = __builtin_amdgcn_rsqf(wave_sum(s) * (1.0f / 1024.0f) + 1e-6f);
    u32x2* o8 = (u32x2*)orow + lane;
#pragma unroll
    for (int j = 0; j < 4; ++j) { const f32x4 gg = gr[64 * j]; u32x2 o; o.x = pk2(v[j][0] * rstd * gg[0], v[j][1] * rstd * gg[1]); o.y = pk2(v[j][2] * rstd * gg[2], v[j][3] * rstd * gg[3]); o8[64 * j] = o; }
}
DI void convert_weights(const Params& p, int l, unsigned char* lds) {
    const int tid = opaque_tid(), lane = tid & 63, wave = tid >> 6;
    const int gw = blockIdx.x * 8 + wave, NGW = gridDim.x * 8;
    float* scr = (float*)(lds + wave * 16384);
    static constexpr TSeg segs[] = {
        {I_WIN, 1024 * IN_TOTAL, 0,    IN_TOTAL, 1024, 2560 / 32, 32, 0},
        {I_WIN, 1024 * IN_TOTAL, 2576, IN_TOTAL, 1024, 512 / 32,  32, 2560},
        {I_WIN, 1024 * IN_TOTAL, 3088, IN_TOTAL, 1024, 1024 / 32, 32, 3072},
        {I_WIN, 1024 * IN_TOTAL, 4120, IN_TOTAL, 1024, 512 / 32,  32, 4096},
        {I_WIN, 1024 * IN_TOTAL, 4632, IN_TOTAL, 1024, 1664 / 32, 32, 4608},
        {I_WIN, 1024 * IN_TOTAL, 6296, IN_TOTAL, 1024, 512 / 32,  32, 6272},
        {I_WIN, 1024 * IN_TOTAL, 6808, IN_TOTAL, 1024, 256 / 32,  32, 6784},
        {I_WIN, 1024 * IN_TOTAL, 7064, IN_TOTAL, 1024, 5120 / 32, 88, 0},
        {I_URET,  512 * 1024, 0, 1024, 512, 32, 128, 0},
        {I_UGLA,  512 * 1024, 0, 1024, 512, 32, 128, 1024},
        {I_URWKV, 512 * 1024, 0, 1024, 512, 32, 128, 2048},
        {I_USSD,  512 * 1024, 0,          1024, 256, 32, 140, 0},
        {I_USSD,  512 * 1024, 256 * 1024, 1024, 256, 32, 140, 1024},
        {I_UMEM,  256 * 1024, 0, 1024, 256, 32, 144, 0},
        {I_WOUT, 1024 * 1024, 0, 1024, 1024, 32, 148, 0},
        {I_WKV,  1024 * 512,  0, 512,  1024, 16, 156, 0},
    };
    constexpr int NSEG = sizeof(segs) / sizeof(segs[0]);
    int base = 0;
    for (int s = 0; s < NSEG; ++s) {
        const TSeg sg = segs[s]; const int nitems = (sg.K / 64) * sg.nblk;
        int it = gw - (base % NGW); if (it < 0) it += NGW;
        const float* W = p.in[sg.inp] + (size_t)l * sg.lstride + sg.src0;
        bf16* WT = (bf16*)(p.ws + (size_t)sg.dst_q * 262144) + (size_t)sg.dst_rows0 * sg.K;
        for (; it < nitems; it += NGW) transpose_item(W, sg.ldw, sg.K, WT, scr, it, sg.nblk, lane);
        base += nitems;
    }
    for (int idx = blockIdx.x * NTHREADS + tid; idx < 128 * 1024; idx += gridDim.x * NTHREADS) {
        const int r = (idx >> 10) & 127, k = idx & 1023;
        const float* W = p.in[I_WIN] + (size_t)l * 1024 * IN_TOTAL + (size_t)k * IN_TOTAL;
        const float v = r < 16 ? W[2560 + r] : r < 24 ? W[4112 + (r - 16)] : 0.0f;
        ((bf16*)(p.ws + WS_W1T))[((size_t)7040 + r) * 1024 + k] = (bf16)f2bf(v);
    }
}
DI void rms_rows2_bf16(const float* x0, const float* x1, const float* g, bf16* o0, bf16* o1, int lane) {
    const f32x4* xa = (const f32x4*)x0 + lane; const f32x4* xb = (const f32x4*)x1 + lane; const f32x4* gr = (const f32x4*)g + lane;
    f32x4 va[4], vb[4]; float sa = 0.f, sb = 0.f;
#pragma unroll
    for (int j = 0; j < 4; ++j) { va[j] = xa[64 * j]; vb[j] = xb[64 * j]; }
#pragma unroll
    for (int j = 0; j < 4; ++j) { sa += (va[j][0] * va[j][0] + va[j][1] * va[j][1]) + (va[j][2] * va[j][2] + va[j][3] * va[j][3]); sb += (vb[j][0] * vb[j][0] + vb[j][1] * vb[j][1]) + (vb[j][2] * vb[j][2] + vb[j][3] * vb[j][3]); }
    const float ra = __builtin_amdgcn_rsqf(wave_sum(sa) * (1.0f / 1024.0f) + 1e-6f), rb = __builtin_amdgcn_rsqf(wave_sum(sb) * (1.0f / 1024.0f) + 1e-6f);
    u32x2* pa = (u32x2*)o0 + lane; u32x2* pb = (u32x2*)o1 + lane;
#pragma unroll
    for (int j = 0; j < 4; ++j) { const f32x4 gg = gr[64 * j]; u32x2 o; o.x = pk2(va[j][0] * ra * gg[0], va[j][1] * ra * gg[1]); o.y = pk2(va[j][2] * ra * gg[2], va[j][3] * ra * gg[3]); pa[64 * j] = o;
        o.x = pk2(vb[j][0] * rb * gg[0], vb[j][1] * rb * gg[1]); o.y = pk2(vb[j][2] * rb * gg[2], vb[j][3] * rb * gg[3]); pb[64 * j] = o; }
}
DI void phase_prologue(const Params& p, unsigned char* lds) {
    const int tid = opaque_tid(), lane = tid & 63, wave = tid >> 6;
    const int gw = blockIdx.x * 8 + wave, NGW = gridDim.x * 8;
    convert_weights(p, 0, lds);
    for (int m = gw; m < M; m += 2 * NGW) { const int m1 = m + NGW;
        if (m1 < M) rms_rows2_bf16(p.in[I_X] + (size_t)m * 1024, p.in[I_X] + (size_t)m1 * 1024, p.in[I_NORMG], (bf16*)(p.ws + WS_XN) + (size_t)m * 1024, (bf16*)(p.ws + WS_XN) + (size_t)m1 * 1024, lane);
        else rms_row_bf16(p.in[I_X] + (size_t)m * 1024, p.in[I_NORMG], (bf16*)(p.ws + WS_XN) + (size_t)m * 1024, lane); }
    for (int m = gw; m < 2048; m += NGW) { const int l = m >> 10, r = m & 1023;
        rms_row_bf16(p.in[I_MEM] + (size_t)r * 1024, p.in[I_MNORMG] + l * 1024, (bf16*)(p.ws + WS_MEMN) + (size_t)m * 1024, lane); }
}
DI void phase_norm(const Params& p, int l, float oscale, unsigned char* lds) {
    const int tid = opaque_tid(), lane = tid & 63, wave = tid >> 6;
    const int gw = blockIdx.x * 8 + wave, NGW = gridDim.x * 8;
    if (l == 0) { convert_weights(p, 1, lds); for (int m = gw; m < M; m += NGW) rms_row_bf16(p.out + (size_t)m * 1024, p.in[I_NORMG] + 1024, (bf16*)(p.ws + WS_XN) + (size_t)m * 1024, lane); }
    else {
        for (int m = gw; m < M; m += NGW) {
            f32x4* xr = (f32x4*)(p.out + (size_t)m * 1024) + lane; const f32x4* gr = (const f32x4*)p.in[I_FNORMG] + lane;
            f32x4 v[4]; float s = 0.f;
#pragma unroll
            for (int j = 0; j < 4; ++j) { v[j] = xr[64 * j]; s += (v[j][0] * v[j][0] + v[j][1] * v[j][1]) + (v[j][2] * v[j][2] + v[j][3] * v[j][3]); }
            const float rstd = __builtin_amdgcn_rsqf(wave_sum(s) * (1.0f / 1024.0f) + 1e-6f);
#pragma unroll
            for (int j = 0; j < 4; ++j) xr[64 * j] = v[j] * (rstd * oscale) * gr[64 * j];
        }
    }
}

#define XB_TMO      128
#define XB_XCNT(j)  (256  + 64 * (j))
#define XB_XSUB(j)  (1280 + 64 * (j))
#define XB_XGEN(j)  (2304 + 64 * (j))
#define XB_TOP      3328
#define XB_TOPGEN   3392
#define XCD_BAR_WORDS 3456
#define XB_SPIN_CAP (1u << 18)

__device__ __forceinline__ unsigned xb_ld(unsigned* p)              { return __hip_atomic_load(p, __ATOMIC_RELAXED, __HIP_MEMORY_SCOPE_AGENT); }
__device__ __forceinline__ unsigned xb_add(unsigned* p, unsigned v) { return __hip_atomic_fetch_add(p, v, __ATOMIC_RELAXED, __HIP_MEMORY_SCOPE_AGENT); }
__device__ __forceinline__ unsigned xb_xcc_id() { return (unsigned)__builtin_amdgcn_s_getreg((3 << 11) | 20) & 0xFu; }
#define XB_SPIN(cond, bar) do { unsigned _sp = 0; while (cond) { __builtin_amdgcn_s_sleep(1); \
    if ((++_sp & 255u) == 0u) { if (xb_ld(&(bar)[XB_TMO])) break; if (_sp > XB_SPIN_CAP) { atomicAdd(&(bar)[XB_TMO], 1u); break; } } } } while (0)

struct XcdBarrier {
    unsigned* bar; unsigned x;
    volatile unsigned* st;
};

__device__ __forceinline__ XcdBarrier xcd_barrier_post(unsigned* bar, volatile unsigned* st) {
    XcdBarrier b; b.bar = bar; b.x = xb_xcc_id(); b.st = st;
    if (threadIdx.x == 0) (void)xb_add(&bar[XB_XCNT(b.x)], 1u);
    return b;
}
__device__ __forceinline__ void xcd_barrier_complete(unsigned* bar, unsigned x, unsigned& nloc, unsigned& nx) {
    const unsigned G = gridDim.x * gridDim.y * gridDim.z;
    unsigned sum, cnt, mine, sp = 0u;
    for (;;) {
        sum = 0u; cnt = 0u; mine = 0u;
#pragma unroll
        for (unsigned j = 0; j < 16; ++j) { const unsigned c = xb_ld(&bar[XB_XCNT(j)]); sum += c; cnt += (c > 0u) ? 1u : 0u; mine = (j == x) ? c : mine; }
        if (sum == G) break;
        __builtin_amdgcn_s_sleep(1);
        if ((++sp & 255u) == 0u) { if (xb_ld(&bar[XB_TMO])) break; if (sp > XB_SPIN_CAP) { atomicAdd(&bar[XB_TMO], 1u); break; } }
    }
    nloc = mine > 0u ? mine : 1u; nx = cnt > 0u ? cnt : 1u;
}

__device__ __forceinline__ void xcd_barrier(const XcdBarrier& b) {
    asm volatile("s_waitcnt vmcnt(0)" ::: "memory");
    __syncthreads();
    if (threadIdx.x == 0) {
        unsigned* bar = b.bar;
        __builtin_amdgcn_s_waitcnt(0);
        unsigned nloc = b.st[0], nx = b.st[1];
        if (nloc == 0u) { xcd_barrier_complete(bar, b.x, nloc, nx); b.st[0] = nloc; b.st[1] = nx; }
        const unsigned old = xb_add(&bar[XB_XSUB(b.x)], 1u);
        const unsigned gen = old / nloc;
        if (old + 1u == (gen + 1u) * nloc) {
            __builtin_amdgcn_fence(__ATOMIC_RELEASE, "agent");
            asm volatile("s_waitcnt vmcnt(0)" ::: "memory");
            const unsigned og = xb_add(&bar[XB_TOP], 1u);
            const unsigned tg = og / nx;
            if (og + 1u == (tg + 1u) * nx) xb_add(&bar[XB_TOPGEN], 1u);
            else XB_SPIN(xb_ld(&bar[XB_TOPGEN]) == tg, bar);
            __builtin_amdgcn_fence(__ATOMIC_ACQUIRE, "agent");
            xb_add(&bar[XB_XGEN(b.x)], 1u);
            asm volatile("s_waitcnt vmcnt(0)" ::: "memory");
        } else {
            XB_SPIN(xb_ld(&bar[XB_XGEN(b.x)]) == gen, bar);
            __builtin_amdgcn_fence(__ATOMIC_ACQUIRE, "agent");
            asm volatile("s_waitcnt vmcnt(0)" ::: "memory");
        }
    }
    __syncthreads();
}

DI void sincos_red(float ang, float& s, float& c) {
    const float n = rintf(ang * 0.15915494309189535f); float r = fmaf(-n, 6.28318548202514648f, ang); r = fmaf(-n, -1.7484555e-7f, r);
    s = __sinf(r); c = __cosf(r);
}

typedef short s16x4 __attribute__((ext_vector_type(4)));
DI s16x4 lds_tr(const bf16* p) { return __builtin_amdgcn_ds_read_tr16_b64_v4i16((__attribute__((address_space(3))) s16x4*)p); }
DI bf16x8 frag_tr(const bf16* base, int ld, int r0, int k0, int lane) {
    const bf16* p = base + (k0 + 8 * (lane >> 4) + ((lane & 15) >> 2)) * ld + r0 + 4 * (lane & 3);
    const s16x4 lo = lds_tr(p), hi = lds_tr(p + 4 * ld);
    return (bf16x8){lo[0], lo[1], lo[2], lo[3], hi[0], hi[1], hi[2], hi[3]};
}
DI bf16x8 frag_tr_perm(const bf16* base, int ld, int r0, int k0, int lane) {
    const bf16* p = base + (k0 + 4 * (lane >> 4) + ((lane & 15) >> 2)) * ld + r0 + 4 * (lane & 3);
    const s16x4 lo = lds_tr(p), hi = lds_tr(p + 16 * ld);
    return (bf16x8){lo[0], lo[1], lo[2], lo[3], hi[0], hi[1], hi[2], hi[3]};
}
constexpr int QK_QIN = 0, QK_KIN = 9216, QK_QC = 18432, QK_KST = 27648, QK_VT = 36864, QK_GKL = 55296, QK_INV = 59392, QK_ST = 64512, QK_CUM = 82944, QK_TOT = 99328, QK_RED = 101376, QK_ELAST = 103424;
#if defined(TPROBE) && defined(QTS_SEL)
#define QTS_ON() (((QTS_SEL) & 1) == (GLA ? 1 : 0) && (((QTS_SEL) >> 1) == (full ? 0 : 1)))
#define QTS_BEGIN() do { if (QTS_ON() && threadIdx.x == 0) TS_BASE(lds)[13] = (unsigned)__builtin_amdgcn_s_memrealtime(); } while (0)
#define QTS_MARK(k) do { if (QTS_ON() && threadIdx.x == 0) { const unsigned t_ = (unsigned)__builtin_amdgcn_s_memrealtime(); volatile unsigned* A_ = TS_BASE(lds); A_[k] += t_ - A_[13]; A_[13] = t_; } } while (0)
#else
#define QTS_BEGIN() do {} while (0)
#define QTS_MARK(k) do {} while (0)
#endif
template <bool GLA>
DI void qkv_item(const Params& p, int l, unsigned char* lds, int b, int h, int sc, bool full, bool dry = false) {
    QTS_BEGIN();
    const int tid = opaque_tid(), lane = tid & 63, w = tid >> 6, q4 = lane >> 4, l15 = lane & 15;
    bf16* P = (bf16*)(p.ws + WS_P);
    bf16* QIN = (bf16*)(lds + QK_QIN); bf16* KIN = (bf16*)(lds + QK_KIN); bf16* QC = (bf16*)(lds + QK_QC); bf16* KST = (bf16*)(lds + QK_KST);
    bf16* VT = (bf16*)(lds + QK_VT); bf16* ST = (bf16*)(lds + QK_ST);
    float* GKL = (float*)(lds + QK_GKL); float* INV = (float*)(lds + QK_INV);
    float* CUM = (float*)(lds + QK_CUM); float* TOT = (float*)(lds + QK_TOT); float* RED = (float*)(lds + QK_RED); float* ELAST = (float*)(lds + QK_ELAST);
    const int cq = GLA ? C_GQ : C_RQ, ck = GLA ? C_GK : C_RK, cv = GLA ? C_GV : C_RV, cgate = GLA ? C_GG : C_RG;
    const int bh = b * 4 + h;
    float* Lst = (float*)(p.ws + (GLA ? WS_GLAL : WS_RETL)) + (size_t)(bh * 16 + sc) * 8192;
    const float lgam = __logf(1.0f - exp2f(-5.0f - (float)h));
    const int st_t = tid >> 3, st_cg = tid & 7;
    f32x4 sacc[4];
#pragma unroll
    for (int mt = 0; mt < 4; ++mt) {
        if (full) { for (int j = 0; j < 4; ++j) sacc[mt][j] = Lst[(16 * mt + 4 * q4 + j) * 128 + 16 * w + l15]; *(u32x2*)(ST + (16 * w + l15) * 72 + 16 * mt + 4 * q4) = pack4(sacc[mt]); }
        else sacc[mt] = (f32x4){0.f, 0.f, 0.f, 0.f};
    }
    f32x4 gng = (f32x4){1.f, 1.f, 1.f, 1.f}; if (GLA) gng = *(const f32x4*)(p.in[I_GNORMG] + l * 128 + 16 * w + 4 * q4);
    float w2c[16], gb = 0.f;
    if (GLA) { const int ch = h * 64 + lane;
#pragma unroll
        for (int j = 0; j < 16; ++j) w2c[j] = p.in[I_GKW2][(size_t)l * 16 * 256 + j * 256 + ch];
        gb = p.in[I_GKB][l * 256 + ch]; }
    else if (tid < 32) INV[tid] = 1.0f / powf(10000.0f, (float)tid * (1.0f / 31.0f));
    u32x4 pq, pk, pv0, pv1, pg = (u32x4){0u, 0u, 0u, 0u}; int ipos = 0;
    {   const size_t ro = (size_t)(b * T + sc * 256 + st_t) * LDP;
        pq = *(const u32x4*)(P + ro + cq + h * 64 + 8 * st_cg); pk = *(const u32x4*)(P + ro + ck + h * 64 + 8 * st_cg);
        pv0 = *(const u32x4*)(P + ro + cv + h * 128 + 8 * st_cg); pv1 = *(const u32x4*)(P + ro + cv + h * 128 + 64 + 8 * st_cg);
        if (GLA) { if (st_cg < 2) { float g8[8]; unpack8(*(const u32x4*)(P + ro + C_GKL + 8 * st_cg), g8);
                *(f32x4*)(GKL + st_t * 16 + 8 * st_cg) = (f32x4){g8[0], g8[1], g8[2], g8[3]}; *(f32x4*)(GKL + st_t * 16 + 8 * st_cg + 4) = (f32x4){g8[4], g8[5], g8[6], g8[7]}; } }
        else ipos = ((const int*)p.in[I_POS])[b * T + sc * 256 + st_t]; }
    __syncthreads();
    QTS_MARK(4);
    float dtot = 0.f;
    for (int c = 0; c < 4; ++c) {
        const int t0 = sc * 256 + c * 64, m0 = b * T + t0;
        if (GLA) {
            float cumv[8]; float run = 0.f;
#pragma unroll
            for (int i = 0; i < 8; ++i) { const float* gp = GKL + (8 * w + i) * 16; float x = gb;
#pragma unroll
                for (int j4 = 0; j4 < 4; ++j4) { const f32x4 g = *(const f32x4*)(gp + 4 * j4); x += g[0] * w2c[4 * j4] + g[1] * w2c[4 * j4 + 1] + g[2] * w2c[4 * j4 + 2] + g[3] * w2c[4 * j4 + 3]; }
                run += logsigmoidf_(x) * (1.0f / 16.0f); cumv[i] = run; }
            TOT[w * 64 + lane] = run;
            __syncthreads();
            float off = 0.f;
            for (int ww = 0; ww < w; ++ww) off += TOT[ww * 64 + lane];
#pragma unroll
            for (int i = 0; i < 8; ++i) CUM[(8 * w + i) * 64 + lane] = cumv[i] + off;
            __syncthreads();
            QTS_MARK(0);
        }
        {
            const int t = st_t, cg = st_cg;
            float qf[8], kf[8]; unpack8(pq, qf); unpack8(pk, kf);
            float fqin[8], fkin[8], fqc[8], fkst[8];
            if (GLA) {
#pragma unroll
                for (int i = 0; i < 8; ++i) { const float cu = CUM[t * 64 + 8 * cg + i], rf = CUM[32 * 64 + 8 * cg + i], la = CUM[63 * 64 + 8 * cg + i];
                    qf[i] *= 0.125f; fqin[i] = fexp(cu - rf); fkin[i] = fexp(rf - cu); fqc[i] = fexp(cu); fkst[i] = fexp(la - cu); }
            } else {
                const float ppos = (float)ipos;
#pragma unroll
                for (int i = 0; i < 4; ++i) { float sn, cs; sincos_red(ppos * INV[4 * cg + i], sn, cs);
                    const float q1 = qf[2 * i], q2 = qf[2 * i + 1], k1 = kf[2 * i], k2 = kf[2 * i + 1];
                    qf[2 * i] = q1 * cs - q2 * sn; qf[2 * i + 1] = q2 * cs + q1 * sn;
                    kf[2 * i] = (k1 * cs - k2 * sn) * 0.125f; kf[2 * i + 1] = (k2 * cs + k1 * sn) * 0.125f; }
                const float e = (float)(t + 1); const float a = fexp((e - 33.0f) * lgam), bq = fexp((33.0f - e) * lgam), cc = fexp(e * lgam), dd = fexp((64.0f - e) * lgam);
#pragma unroll
                for (int i = 0; i < 8; ++i) { fqin[i] = a; fkin[i] = bq; fqc[i] = cc; fkst[i] = dd; }
            }
            if (full) { float o1[8], o2[8], o3[8];
#pragma unroll
                for (int i = 0; i < 8; ++i) { o1[i] = qf[i] * fqin[i]; o2[i] = qf[i] * fqc[i]; o3[i] = kf[i] * fkin[i]; }
                *(u32x4*)(QIN + t * 72 + 8 * cg) = pack8(o1); *(u32x4*)(QC + t * 72 + 8 * cg) = pack8(o2); *(u32x4*)(KIN + t * 72 + 8 * cg) = pack8(o3); }
            { float o4[8];
#pragma unroll
              for (int i = 0; i < 8; ++i) o4[i] = kf[i] * fkst[i];
              *(u32x4*)(KST + t * 72 + 8 * cg) = pack8(o4); }
            *(u32x4*)(VT + t * 136 + 8 * cg) = pv0; *(u32x4*)(VT + t * 136 + 64 + 8 * cg) = pv1;
            if (tid < 64) { const float la = GLA ? CUM[63 * 64 + tid] : 64.0f * lgam; ELAST[tid] = fexp(la); dtot += la; }
            if (c < 3) {
                const size_t ro = (size_t)(m0 + 64 + t) * LDP;
                pq = *(const u32x4*)(P + ro + cq + h * 64 + 8 * cg); pk = *(const u32x4*)(P + ro + ck + h * 64 + 8 * cg);
                pv0 = *(const u32x4*)(P + ro + cv + h * 128 + 8 * cg); pv1 = *(const u32x4*)(P + ro + cv + h * 128 + 64 + 8 * cg);
                if (GLA) pg = *(const u32x4*)(P + ro + C_GKL + 8 * (cg & 1));
                else ipos = ((const int*)p.in[I_POS])[b * T + t0 + 64 + t]; }
        }
        __syncthreads();
        QTS_MARK(1);
        if (full) {
            u32x2 g2[4];
#pragma unroll
            for (int tt = 0; tt < 4; ++tt) g2[tt] = *(const u32x2*)(P + (size_t)(m0 + 16 * tt + l15) * LDP + cgate + h * 128 + 16 * w + 4 * q4);
            f32x4 oacc[4];
#pragma unroll
            for (int tt = 0; tt < 4; ++tt) {
                oacc[tt] = (f32x4){0.f, 0.f, 0.f, 0.f};
#pragma unroll
                for (int kk = 0; kk < 2; ++kk) oacc[tt] = mfma16(frag(ST, 72, 16 * w, 32 * kk, lane), frag(QC, 72, 16 * tt, 32 * kk, lane), oacc[tt]);
                const bf16x8 qa = frag(QIN, 72, 16 * tt, 0, lane), qb = frag(QIN, 72, 16 * tt, 32, lane);
                u32x2 pp[4];
#pragma unroll
                for (int st = 0; st < 4; ++st) {
                    if (st <= tt) { f32x4 a = (f32x4){0.f, 0.f, 0.f, 0.f};
                        a = mfma16(frag(KIN, 72, 16 * st, 0, lane), qa, a); a = mfma16(frag(KIN, 72, 16 * st, 32, lane), qb, a);
                        if (st == tt) {
#pragma unroll
                            for (int j = 0; j < 4; ++j) if (4 * q4 + j > l15) a[j] = 0.f; }
                        pp[st] = pack4(a); }
                    else pp[st] = (u32x2){0u, 0u}; }
#pragma unroll
                for (int kk2 = 0; kk2 < 2; ++kk2) { if (2 * kk2 <= tt) {
                        u32x4 pw; pw.x = pp[2 * kk2].x; pw.y = pp[2 * kk2].y; pw.z = pp[2 * kk2 + 1].x; pw.w = pp[2 * kk2 + 1].y;
                        oacc[tt] = mfma16(frag_tr_perm(VT, 136, 16 * w, 32 * kk2, lane), __builtin_bit_cast(bf16x8, pw), oacc[tt]); } }
                float ss = (oacc[tt][0] * oacc[tt][0] + oacc[tt][1] * oacc[tt][1]) + (oacc[tt][2] * oacc[tt][2] + oacc[tt][3] * oacc[tt][3]);
                ss += __shfl_xor(ss, 16); ss += __shfl_xor(ss, 32);
                if (q4 == 0) RED[(16 * tt + l15) * 8 + w] = ss; }
            __syncthreads();
            QTS_MARK(2);
#pragma unroll
            for (int tt = 0; tt < 4; ++tt) { const f32x4 r0 = *(const f32x4*)(RED + (16 * tt + l15) * 8), r1 = *(const f32x4*)(RED + (16 * tt + l15) * 8 + 4);
                const float rstd = __builtin_amdgcn_rsqf(((r0[0] + r0[1]) + (r0[2] + r0[3]) + (r1[0] + r1[1]) + (r1[2] + r1[3])) * (1.0f / 128.0f) + 1e-6f);
                bf16* gp = P + (size_t)(m0 + 16 * tt + l15) * LDP + cgate + h * 128 + 16 * w + 4 * q4;
                const float g[4] = {lo16(g2[tt].x), hi16(g2[tt].x), lo16(g2[tt].y), hi16(g2[tt].y)};
                f32x4 o;
#pragma unroll
                for (int j = 0; j < 4; ++j) { float v = oacc[tt][j] * rstd; if (GLA) v *= gng[j]; o[j] = v * siluf_(g[j]); }
                if (!dry) *(u32x2*)gp = pack4(o); }
        }
#pragma unroll
        for (int mt = 0; mt < 4; ++mt) {
            const f32x4 el = *(const f32x4*)(ELAST + 16 * mt + 4 * q4);
            sacc[mt] = sacc[mt] * el;
#pragma unroll
            for (int kk = 0; kk < 2; ++kk) sacc[mt] = mfma16(frag_tr(KST, 72, 16 * mt, 32 * kk, lane), frag_tr(VT, 136, 16 * w, 32 * kk, lane), sacc[mt]);
            if (full) *(u32x2*)(ST + (16 * w + l15) * 72 + 16 * mt + 4 * q4) = pack4(sacc[mt]);
        }
        if (GLA && c < 3 && st_cg < 2) { float g8[8]; unpack8(pg, g8);
            *(f32x4*)(GKL + st_t * 16 + 8 * st_cg) = (f32x4){g8[0], g8[1], g8[2], g8[3]}; *(f32x4*)(GKL + st_t * 16 + 8 * st_cg + 4) = (f32x4){g8[4], g8[5], g8[6], g8[7]}; }
        __syncthreads();
        QTS_MARK(3);
    }
    if (!full) {
#pragma unroll
        for (int mt = 0; mt < 4; ++mt)
#pragma unroll
            for (int j = 0; j < 4; ++j) Lst[(16 * mt + 4 * q4 + j) * 128 + 16 * w + l15] = sacc[mt][j];
        if (GLA && tid < 64) ((float*)(p.ws + WS_DG))[(bh * 16 + sc) * 64 + tid] = fexp(dtot);
    }
}

constexpr int SD_CS = 0, SD_BS = 17408, SD_BT = 34816, SD_XT = 53248, SD_XST = 62464, SD_PS = 71680, SD_ST = 80896, SD_DT = 98304, SD_CUM = 98560, SD_RED = 98816, SD_CW = 99840;
DI void conv8(const Params& p, int l, const bf16* P, int b, int tpos, int ch, float* y) {
    const float* cw = p.in[I_CONVW] + (size_t)l * 4 * 1024; const float* cb = p.in[I_CONVB] + l * 1024;
    const f32x4 b0 = *(const f32x4*)(cb + ch), b1 = *(const f32x4*)(cb + ch + 4);
    float acc[8] = {b0[0], b0[1], b0[2], b0[3], b1[0], b1[1], b1[2], b1[3]};
#pragma unroll
    for (int j = 0; j < 4; ++j) { const int tp = tpos - 3 + j;
        if (tp >= 0) { float x[8]; unpack8(*(const u32x4*)(P + (size_t)(b * T + tp) * LDP + C_SX + ch), x);
            const f32x4 w0 = *(const f32x4*)(cw + j * 1024 + ch), w1 = *(const f32x4*)(cw + j * 1024 + ch + 4);
            acc[0] += w0[0] * x[0]; acc[1] += w0[1] * x[1]; acc[2] += w0[2] * x[2]; acc[3] += w0[3] * x[3];
            acc[4] += w1[0] * x[4]; acc[5] += w1[1] * x[5]; acc[6] += w1[2] * x[6]; acc[7] += w1[3] * x[7]; } }
#pragma unroll
    for (int i = 0; i < 8; ++i) y[i] = siluf_(acc[i]);
}
DI void conv_rows(const bf16* P, int b, int tpos, int ch, u32x4 (&xr)[7]) {
#pragma unroll
    for (int r = 0; r < 7; ++r) { const int tp = tpos - 3 + r; xr[r] = *(const u32x4*)(P + (size_t)(b * T + (tp < 0 ? 0 : tp)) * LDP + C_SX + ch); }
}
DI void conv_apply(const float* cwl, int lc, const u32x4 (&xr)[7], int tpos, float (&y)[4][8]) {
    { const f32x4 b0 = *(const f32x4*)(cwl + 4 * 320 + lc), b1 = *(const f32x4*)(cwl + 4 * 320 + lc + 4);
#pragma unroll
        for (int o = 0; o < 4; ++o) { y[o][0] = b0[0]; y[o][1] = b0[1]; y[o][2] = b0[2]; y[o][3] = b0[3]; y[o][4] = b1[0]; y[o][5] = b1[1]; y[o][6] = b1[2]; y[o][7] = b1[3]; } }
#pragma unroll
    for (int j = 0; j < 4; ++j) { const f32x4 w0 = *(const f32x4*)(cwl + j * 320 + lc), w1 = *(const f32x4*)(cwl + j * 320 + lc + 4);
        const float wv[8] = {w0[0], w0[1], w0[2], w0[3], w1[0], w1[1], w1[2], w1[3]};
#pragma unroll
        for (int o = 0; o < 4; ++o) { float x[8]; unpack8(xr[o + j], x);
            if (tpos - 3 + o + j < 0) {
#pragma unroll
                for (int i = 0; i < 8; ++i) x[i] = 0.f; }
#pragma unroll
            for (int i = 0; i < 8; ++i) y[o][i] += wv[i] * x[i]; } }
#pragma unroll
    for (int o = 0; o < 4; ++o)
#pragma unroll
        for (int i = 0; i < 8; i += 2) { const f32x2 v = {y[o][i], y[o][i + 1]}; const f32x2 r = v * sig_pk(v); y[o][i] = r.x; y[o][i + 1] = r.y; }
}
DI void ssd_item(const Params& p, int l, unsigned char* lds, int b, int h, int sc, bool full, bool dry = false) {
    const int tid = opaque_tid(), lane = tid & 63, w = tid >> 6, q4 = lane >> 4, l15 = lane & 15;
    bf16* P = (bf16*)(p.ws + WS_P);
    bf16* CS = (bf16*)(lds + SD_CS); bf16* BS = (bf16*)(lds + SD_BS); bf16* XT = (bf16*)(lds + SD_XT); bf16* XST = (bf16*)(lds + SD_XST);
    bf16* ST = (bf16*)(lds + SD_ST);
    float* DTL = (float*)(lds + SD_DT); float* CUMS = (float*)(lds + SD_CUM); float* RED = (float*)(lds + SD_RED);
    const int g = h >> 2, bh = b * 8 + h;
    float* Lst = (float*)(p.ws + WS_SSDL) + (size_t)(bh * 16 + sc) * 8192;
    const float a_h = -fexp(p.in[I_ALOG][l * 8 + h]), dtb = p.in[I_DTB][l * 8 + h], dsk = p.in[I_SD][l * 8 + h];
    const int pt = w & 3, wh = w >> 2;
    const f32x4 sng = *(const f32x4*)(p.in[I_SNORMG] + l * 512 + h * 64 + 16 * pt + 4 * q4);
    const int r_cgi = tid & 31, r_seg = tid >> 5; const bool r_isB = r_cgi >= 16; const int r_cg = r_cgi & 15;
    const int r_ch = (r_isB ? 512 : 768) + g * 128 + 8 * r_cg, r_lc = (r_isB ? 128 : 0) + 8 * r_cg;
    f32x4 sacc[4];
#pragma unroll
    for (int i = 0; i < 4; ++i) { const int nt = 4 * wh + i;
        if (full) { for (int j = 0; j < 4; ++j) sacc[i][j] = Lst[(16 * nt + 4 * q4 + j) * 64 + 16 * pt + l15]; *(u32x2*)(ST + (16 * pt + l15) * 136 + 16 * nt + 4 * q4) = pack4(sacc[i]); }
        else sacc[i] = (f32x4){0.f, 0.f, 0.f, 0.f}; }
    float* CWL = (float*)(lds + SD_CW);
    {
        float cwv[4];
#pragma unroll
        for (int r4 = 0; r4 < 4; ++r4) { const int idx0 = tid + r4 * NTHREADS, idx = idx0 < 1600 ? idx0 : 1599; const int row = idx / 320, ci = idx - row * 320;
            const int gch = ci < 128 ? 768 + g * 128 + ci : ci < 256 ? 512 + g * 128 + (ci - 128) : h * 64 + (ci - 256);
            const float* src = row < 4 ? p.in[I_CONVW] + (size_t)l * 4096 + row * 1024 + gch : p.in[I_CONVB] + l * 1024 + gch;
            cwv[r4] = *src; }
#pragma unroll
        for (int r4 = 0; r4 < 4; ++r4) { const int idx0 = tid + r4 * NTHREADS; if (idx0 < 1600) CWL[idx0] = cwv[r4]; }
    }
    u32x4 xbc[7]; conv_rows(P, b, sc * 256 + 4 * r_seg, r_ch, xbc);
    unsigned dtraw = (unsigned)P[(size_t)(b * T + sc * 256 + lane) * LDP + C_SDT + h];
    float ltot = 0.f;
    for (int c = 0; c < 4; ++c) {
        const int t0 = sc * 256 + c * 64, m0 = b * T + t0;
        if (w == 0) {
            const float dt = softplusf_(bf2f(dtraw) + dtb); float cu = dt * a_h;
#pragma unroll
            for (int o = 1; o < 64; o <<= 1) { const float n = __shfl_up(cu, o); if (lane >= o) cu += n; }
            DTL[lane] = dt; CUMS[lane] = cu;
        }
        if (c < 3) dtraw = (unsigned)P[(size_t)(m0 + 64 + lane) * LDP + C_SDT + h];
        __syncthreads();
        const float clast = CUMS[63];
        ltot += clast;
        {
            u32x4 xx[7];
            conv_rows(P, b, t0 + 4 * ((tid & 127) >> 3), h * 64 + 8 * (tid & 7), xx);
            { float y[4][8]; conv_apply(CWL, r_lc, xbc, t0 + 4 * r_seg, y);
#pragma unroll
                for (int o = 0; o < 4; ++o) { const int t = 4 * r_seg + o; *(u32x4*)((r_isB ? BS : CS) + t * 136 + 8 * r_cg) = pack8(y[o]); }
            }
            if (tid < 128) { const int cg = tid & 7, seg = tid >> 3; float y[4][8]; conv_apply(CWL, 256 + 8 * cg, xx, t0 + 4 * seg, y);
                float coef[4];
#pragma unroll
                for (int o = 0; o < 4; ++o) coef[o] = fexp(clast - CUMS[4 * seg + o]) * DTL[4 * seg + o];
#pragma unroll
                for (int o = 0; o < 4; ++o) { float ys[8];
#pragma unroll
                    for (int i = 0; i < 8; ++i) ys[i] = y[o][i] * coef[o];
                    *(u32x4*)(XT + (4 * seg + o) * 72 + 8 * cg) = pack8(y[o]); *(u32x4*)(XST + (4 * seg + o) * 72 + 8 * cg) = pack8(ys); } }
            if (c < 3) conv_rows(P, b, t0 + 64 + 4 * r_seg, r_ch, xbc);
        }
        __syncthreads();
        if (full) {
#pragma unroll
            for (int i = 0; i < 2; ++i) { const int tt = 2 * wh + i, t = 16 * tt + l15;
                bf16* zp = P + (size_t)(m0 + t) * LDP + C_SZ + h * 64 + 16 * pt + 4 * q4;
                const u32x2 z2 = *(const u32x2*)zp;
                bf16x8 cf[4];
#pragma unroll
                for (int kk = 0; kk < 4; ++kk) cf[kk] = frag(CS, 136, 16 * tt, 32 * kk, lane);
                f32x4 oacc = (f32x4){0.f, 0.f, 0.f, 0.f};
#pragma unroll
                for (int kk = 0; kk < 4; ++kk) oacc = mfma16(frag(ST, 136, 16 * pt, 32 * kk, lane), cf[kk], oacc);
                const float ct = CUMS[t];
                oacc = oacc * fexp(ct);
                u32x2 pp[4];
#pragma unroll
                for (int st = 0; st < 4; ++st) {
                    if (st <= tt) { f32x4 a = (f32x4){0.f, 0.f, 0.f, 0.f};
#pragma unroll
                        for (int kk = 0; kk < 4; ++kk) a = mfma16(frag(BS, 136, 16 * st, 32 * kk, lane), cf[kk], a);
                        const f32x4 cs4 = *(const f32x4*)(CUMS + 16 * st + 4 * q4), dt4 = *(const f32x4*)(DTL + 16 * st + 4 * q4);
#pragma unroll
                        for (int j = 0; j < 4; ++j) a[j] = (16 * st + 4 * q4 + j <= t) ? a[j] * fexp(ct - cs4[j]) * dt4[j] : 0.f;
                        pp[st] = pack4(a); }
                    else pp[st] = (u32x2){0u, 0u}; }
#pragma unroll
                for (int kk2 = 0; kk2 < 2; ++kk2) { if (2 * kk2 <= tt) {
                        u32x4 pw; pw.x = pp[2 * kk2].x; pw.y = pp[2 * kk2].y; pw.z = pp[2 * kk2 + 1].x; pw.w = pp[2 * kk2 + 1].y;
                        oacc = mfma16(frag_tr_perm(XT, 72, 16 * pt, 32 * kk2, lane), __builtin_bit_cast(bf16x8, pw), oacc); } }
                const float z[4] = {lo16(z2.x), hi16(z2.x), lo16(z2.y), hi16(z2.y)};
                f32x4 o; float ss = 0.f;
                const u32x2 xv2 = *(const u32x2*)(XT + t * 72 + 16 * pt + 4 * q4); const float xvv[4] = {lo16(xv2.x), hi16(xv2.x), lo16(xv2.y), hi16(xv2.y)};
#pragma unroll
                for (int j = 0; j < 4; ++j) { const float xv = xvv[j]; const float v = (oacc[j] + dsk * xv) * siluf_(z[j]); ss += v * v;
                    o[j] = v * sng[j]; }
                if (!dry) *(u32x2*)zp = pack4(o);
                ss += __shfl_xor(ss, 16); ss += __shfl_xor(ss, 32);
                if (q4 == 0) RED[t * 4 + pt] = ss; }
        }
        const float el = fexp(clast);
#pragma unroll
        for (int i = 0; i < 4; ++i) { const int nt = 4 * wh + i;
            sacc[i] = sacc[i] * el;
#pragma unroll
            for (int kk = 0; kk < 2; ++kk) sacc[i] = mfma16(frag_tr(BS, 136, 16 * nt, 32 * kk, lane), frag_tr(XST, 72, 16 * pt, 32 * kk, lane), sacc[i]);
            if (full) *(u32x2*)(ST + (16 * pt + l15) * 136 + 16 * nt + 4 * q4) = pack4(sacc[i]); }
        __syncthreads();
        if (full && tid < 64) { const f32x4 r = *(const f32x4*)(RED + tid * 4); ((float*)(p.ws + WS_SSQ))[(size_t)(m0 + tid) * 8 + h] = (r[0] + r[1]) + (r[2] + r[3]); }
    }
    if (!full) {
#pragma unroll
        for (int i = 0; i < 4; ++i)
#pragma unroll
            for (int j = 0; j < 4; ++j) Lst[(16 * (4 * wh + i) + 4 * q4 + j) * 64 + 16 * pt + l15] = sacc[i][j];
        if (tid == 0) ((float*)(p.ws + WS_DS))[bh * 16 + sc] = fexp(ltot);
    }
}

DI void phase_scan(const Params& p, int vb, int nb, bool dry = false) {
    const int gt = vb * NTHREADS + opaque_tid(), NT = nb * NTHREADS;
    for (int idx0 = gt; idx0 < 4 * 131072; idx0 += 2 * NT) {
        float lv[2][16], dv[2][16]; float* Lp[2]; bool ok[2];
#pragma unroll
        for (int e = 0; e < 2; ++e) { const int idx = idx0 + e * NT; ok[e] = idx < 4 * 131072; const int which = idx >> 17, r = idx & 131071;
            float* L = nullptr; const float* dec = nullptr; int dstride = 0; float cdec = 0.f;
            if (ok[e]) {
                if (which == 0) { const int bh = r >> 13, el = r & 8191; L = (float*)(p.ws + WS_RETL) + (size_t)bh * 16 * 8192 + el; cdec = fexp(256.0f * __logf(1.0f - exp2f(-5.0f - (float)(bh & 3)))); }
                else if (which == 1) { const int bh = r >> 13, el = r & 8191; L = (float*)(p.ws + WS_GLAL) + (size_t)bh * 16 * 8192 + el; dec = (const float*)(p.ws + WS_DG) + bh * 16 * 64 + (el >> 7); dstride = 64; }
                else { const int rr = (which - 2) * 131072 + r, bh = rr >> 13, el = rr & 8191; L = (float*)(p.ws + WS_SSDL) + (size_t)bh * 16 * 8192 + el; dec = (const float*)(p.ws + WS_DS) + bh * 16; dstride = 1; } }
            Lp[e] = L;
#pragma unroll
            for (int sc = 0; sc < 16; ++sc) { lv[e][sc] = ok[e] ? L[(size_t)sc * 8192] : 0.f; dv[e][sc] = (ok[e] && dec) ? dec[sc * dstride] : cdec; } }
#pragma unroll
        for (int e = 0; e < 2; ++e) { float prev = 0.f;
#pragma unroll
            for (int sc = 0; sc < 16; ++sc) { if (ok[e] && !dry) Lp[e][(size_t)sc * 8192] = prev; prev = dv[e][sc] * prev + lv[e][sc]; } }
    }
}

DI void memkv_item(const Params& p, int l, int item) {
    const int tid = opaque_tid(), lane = tid & 63, w = tid >> 6, q4 = lane >> 4, l15 = lane & 15;
    const int rb = item >> 4, cb = item & 15;
    const bf16* A = (const bf16*)(p.ws + WS_MEMN) + (size_t)l * 1024 * 1024; const bf16* Bw = (const bf16*)(p.ws + WS_WKVT);
    const int r0 = 64 * rb + 16 * (w >> 1), c0 = 32 * cb + 16 * (w & 1); const bool isV = cb >= 8; const int hh = (c0 >> 6) & 3, dd = c0 & 63;
    f32x4 acc = (f32x4){0.f, 0.f, 0.f, 0.f};
#pragma unroll 1
    for (int k16 = 0; k16 < 32; k16 += 16) {
        bf16x8 fa[16], fb[16];
#pragma unroll
        for (int u = 0; u < 16; ++u) { fa[u] = frag(A, 1024, r0, 32 * (k16 + u), lane); fb[u] = frag(Bw, 1024, c0, 32 * (k16 + u), lane); }
#pragma unroll
        for (int u = 0; u < 16; ++u) acc = isV ? mfma16(fa[u], fb[u], acc) : mfma16(fb[u], fa[u], acc);
    }
    if (!isV) { const int m = r0 + l15, bb = m >> 8, mm = m & 255;
        *(u32x2*)((bf16*)(p.ws + WS_KM) + ((size_t)(bb * 4 + hh) * 256 + mm) * 64 + dd + 4 * q4) = pack4(acc); }
    else { const int m = r0 + 4 * q4, bb = m >> 8, mm = m & 255;
        *(u32x2*)((bf16*)(p.ws + WS_VMT) + ((size_t)(bb * 4 + hh) * 64 + dd + l15) * 256 + mm) = pack4(acc); }
}
constexpr int MA_K = 0, MA_VT = 36864;
DI void memattn_item(const Params& p, unsigned char* lds, int b, int h, int blk) {
    const int tid = opaque_tid(), lane = tid & 63, w = tid >> 6, q4 = lane >> 4, l15 = lane & 15;
    bf16* KS = (bf16*)(lds + MA_K); bf16* VS = (bf16*)(lds + MA_VT);
    const bf16* KM = (const bf16*)(p.ws + WS_KM) + (size_t)(b * 4 + h) * 256 * 64; const bf16* VM = (const bf16*)(p.ws + WS_VMT) + (size_t)(b * 4 + h) * 64 * 256;
    const bf16* P = (const bf16*)(p.ws + WS_P); bf16* OM = (bf16*)(p.ws + WS_OMEM);
#pragma unroll
    for (int r = 0; r < 4; ++r) { const int idx = tid + 512 * r;
        { const int m = idx >> 3, c8 = idx & 7; *(u32x4*)(KS + m * 72 + 8 * c8) = *(const u32x4*)(KM + m * 64 + 8 * c8); }
        { const int d = idx >> 5, c8 = idx & 31; *(u32x4*)(VS + d * 264 + 8 * c8) = *(const u32x4*)(VM + d * 256 + 8 * c8); } }
    __syncthreads();
    bf16x8 qn[2];
#pragma unroll
    for (int kk = 0; kk < 2; ++kk) qn[kk] = *(const bf16x8*)(P + (size_t)(b * T + blk * 256 + w * 16 + l15) * LDP + C_MQ + h * 64 + 32 * kk + 8 * q4);
    for (int rnd = 0; rnd < 2; ++rnd) {
        const int m0 = b * T + blk * 256 + rnd * 128 + w * 16;
        bf16x8 qf[2];
#pragma unroll
        for (int kk = 0; kk < 2; ++kk) { qf[kk] = qn[kk]; if (rnd == 0) qn[kk] = *(const bf16x8*)(P + (size_t)(m0 + 128 + l15) * LDP + C_MQ + h * 64 + 32 * kk + 8 * q4); }
        f32x4 s[16]; float mx = -3.0e38f;
#pragma unroll
        for (int mt = 0; mt < 16; ++mt) { s[mt] = (f32x4){0.f, 0.f, 0.f, 0.f};
#pragma unroll
            for (int kk = 0; kk < 2; ++kk) s[mt] = mfma16(frag(KS, 72, 16 * mt, 32 * kk, lane), qf[kk], s[mt]);
            s[mt] = s[mt] * 0.125f; mx = fmaxf(mx, fmaxf(fmaxf(s[mt][0], s[mt][1]), fmaxf(s[mt][2], s[mt][3]))); __builtin_amdgcn_sched_barrier(0); }
        mx = fmaxf(mx, __shfl_xor(mx, 16)); mx = fmaxf(mx, __shfl_xor(mx, 32));
        float sum = 0.f;
#pragma unroll
        for (int mt = 0; mt < 16; ++mt) {
#pragma unroll
            for (int j = 0; j < 4; ++j) { s[mt][j] = fexp(s[mt][j] - mx); sum += s[mt][j]; } }
        sum += __shfl_xor(sum, 16); sum += __shfl_xor(sum, 32);
        const float rs = __builtin_amdgcn_rcpf(sum);
        f32x4 o[4];
#pragma unroll
        for (int dt = 0; dt < 4; ++dt) o[dt] = (f32x4){0.f, 0.f, 0.f, 0.f};
#pragma unroll
        for (int k2 = 0; k2 < 8; ++k2) {
            u32x4 pw; pw.x = pk2(s[2 * k2][0], s[2 * k2][1]); pw.y = pk2(s[2 * k2][2], s[2 * k2][3]); pw.z = pk2(s[2 * k2 + 1][0], s[2 * k2 + 1][1]); pw.w = pk2(s[2 * k2 + 1][2], s[2 * k2 + 1][3]);
            const bf16x8 pf = __builtin_bit_cast(bf16x8, pw);
#pragma unroll
            for (int dt = 0; dt < 4; ++dt) { const bf16* vp = VS + (16 * dt + l15) * 264 + 32 * k2 + 4 * q4;
                const u32x2 v0 = *(const u32x2*)vp, v1 = *(const u32x2*)(vp + 16); u32x4 vw; vw.x = v0.x; vw.y = v0.y; vw.z = v1.x; vw.w = v1.y;
                o[dt] = mfma16(__builtin_bit_cast(bf16x8, vw), pf, o[dt]); }
            __builtin_amdgcn_sched_barrier(0); }
#pragma unroll
        for (int dt = 0; dt < 4; ++dt) *(u32x2*)(OM + (size_t)(m0 + l15) * 256 + h * 64 + 16 * dt + 4 * q4) = pack4(o[dt] * rs);
    }
    __syncthreads();
}

constexpr int RC_ARL = 0, RC_RRL = 9216, RC_BRL = 18432, RC_KRL = 27648, RC_XT = 0, RC_BHT = 36864, RC_KHT = 46080, RC_VT = 55296, RC_AAK = 64512, RC_LRB = 73728, RC_LRK = 82944,
              RC_AAB = 92160, RC_RHS = 108544, RC_WLAST = 141312, RC_TB = 141568,
              RC_TW = 64512, RC_ALS = 73728, RC_W2T = 82944, RC_A2T = 92160, RC_TOT = 101376, RC_CUM = 108544, RC_AICL = 124928;
#if defined(TPROBE) && !defined(QTS_SEL)
#define RW_STOP_AT(k) TS_MARK(k)
#define RW_TS_BEGIN() TS_BEGIN()
#define RW_TS_END() TS_MARK(7)
#else
#define RW_TS_BEGIN() do {} while (0)
#define RW_TS_END() do {} while (0)
#ifdef RW_STOP
#define RW_STOP_AT(k) do { if (dry && RW_STOP == (k)) return; } while (0)
#else
#define RW_STOP_AT(k) do {} while (0)
#endif
#endif
DI void rwkv_chunk_item(const Params& p, int l, unsigned char* lds, int b, int h, int c, bool dry = false) {
    const int tid = opaque_tid(), lane = tid & 63, w = tid >> 6, q4 = lane >> 4, l15 = lane & 15;
    bf16* P = (bf16*)(p.ws + WS_P);
    bf16* ARL = (bf16*)(lds + RC_ARL); bf16* RRL = (bf16*)(lds + RC_RRL); bf16* BRL = (bf16*)(lds + RC_BRL); bf16* KRL = (bf16*)(lds + RC_KRL); bf16* XT = (bf16*)(lds + RC_XT);
    bf16* BHT = (bf16*)(lds + RC_BHT); bf16* KHT = (bf16*)(lds + RC_KHT); bf16* VT = (bf16*)(lds + RC_VT); bf16* AAK = (bf16*)(lds + RC_AAK); bf16* LRB = (bf16*)(lds + RC_LRB); bf16* LRK = (bf16*)(lds + RC_LRK);
    float* AAB = (float*)(lds + RC_AAB); float* RHS = (float*)(lds + RC_RHS); float* WLAST = (float*)(lds + RC_WLAST); float* TB = (float*)(lds + RC_TB);
    bf16* TW = (bf16*)(lds + RC_TW); bf16* ALS = (bf16*)(lds + RC_ALS); bf16* W2T = (bf16*)(lds + RC_W2T); bf16* A2T = (bf16*)(lds + RC_A2T);
    float* TOT = (float*)(lds + RC_TOT); float* CUM = (float*)(lds + RC_CUM); float* AICL = (float*)(lds + RC_AICL);
    const float* mu = p.in[I_MU] + l * 1664;
    const int t0 = c * 64, m0 = b * T + t0;
    RW_TS_BEGIN();
    const int t_ = tid >> 3, cg = tid & 7, chh = h * 64 + 8 * cg;
    float xr[8], xk[8], xv[8];
    float pkk[8], pka[8], prk[8];
    { const f32x4 a0 = *(const f32x4*)(p.in[I_KK] + l * 512 + chh), a1 = *(const f32x4*)(p.in[I_KK] + l * 512 + chh + 4), b0 = *(const f32x4*)(p.in[I_KA] + l * 512 + chh), b1 = *(const f32x4*)(p.in[I_KA] + l * 512 + chh + 4),
          c0 = *(const f32x4*)(p.in[I_RK] + l * 512 + chh), c1 = *(const f32x4*)(p.in[I_RK] + l * 512 + chh + 4);
#pragma unroll
      for (int i = 0; i < 4; ++i) { pkk[i] = a0[i]; pkk[4 + i] = a1[i]; pka[i] = b0[i]; pka[4 + i] = b1[i]; prk[i] = c0[i]; prk[4 + i] = c1[i]; } }
    f32x4 pw0[4];
#pragma unroll
    for (int ct = 0; ct < 4; ++ct) pw0[ct] = *(const f32x4*)(p.in[(w >> 2) ? I_A0 : I_W0] + l * 512 + h * 64 + 16 * ct + 4 * q4);
    {
        { const int j = tid >> 3;
            const float* s2 = p.in[I_W2] + (size_t)l * 64 * 512 + j * 512 + chh; const float* sa = p.in[I_A2] + (size_t)l * 64 * 512 + j * 512 + chh;
#pragma unroll
            for (int i = 0; i < 8; ++i) { }
            *(u32x4*)(W2T + j * 72 + 8 * cg) = pack8(s2); *(u32x4*)(A2T + j * 72 + 8 * cg) = pack8(sa); }
        const size_t ro = (size_t)(m0 + t_) * LDP; const bool first = (t_ == 0);
        const bf16* prow = first ? (bf16*)(p.ws + WS_BND) + (size_t)(((m0) >> 6) - 1) * BND_W - 4608 : P + ro - LDP;
        const bool hp = (t0 + t_) > 0;
#pragma unroll
        for (int which = 0; which < 5; ++which) {
            const int col = which == 0 ? C_WR + chh : which == 1 ? C_WK + chh : which == 2 ? C_WV + chh : which == 3 ? C_WL + 8 * cg : C_AL + 8 * cg;
            const int mi = which == 0 ? chh : which == 1 ? 512 + chh : which == 2 ? 1024 + chh : which == 3 ? 1536 + 8 * cg : 1600 + 8 * cg;
            float cur[8], prv[8], xs[8];
            unpack8(*(const u32x4*)(P + ro + col), cur);
            unpack8(*(const u32x4*)((hp ? prow : P + ro) + col), prv);
            if (!hp) {
#pragma unroll
                for (int i = 0; i < 8; ++i) prv[i] = 0.f; }
#pragma unroll
            for (int i = 0; i < 8; ++i) xs[i] = cur[i] + (prv[i] - cur[i]) * mu[mi + i];
            if (which == 0) {
#pragma unroll
                for (int i = 0; i < 8; ++i) xr[i] = xs[i]; }
            else if (which == 1) {
#pragma unroll
                for (int i = 0; i < 8; ++i) xk[i] = xs[i]; }
            else if (which == 2) {
#pragma unroll
                for (int i = 0; i < 8; ++i) xv[i] = xs[i]; }
            else if (which == 3) { float tw[8];
#pragma unroll
                for (int i = 0; i < 8; ++i) tw[i] = tanhf_(xs[i]);
                *(u32x4*)(TW + t_ * 72 + 8 * cg) = pack8(tw); }
            else *(u32x4*)(ALS + t_ * 72 + 8 * cg) = pack8(xs);
        }
    }
    __syncthreads();
    RW_STOP_AT(0);
    {
        const int which = w >> 2, tt = w & 3; const bf16* Wm = which ? A2T : W2T; const bf16* Xm = which ? ALS : TW;
#pragma unroll
        for (int ct = 0; ct < 4; ++ct) { f32x4 a = (f32x4){0.f, 0.f, 0.f, 0.f};
#pragma unroll
            for (int kk = 0; kk < 2; ++kk) a = mfma16(frag_tr(Wm, 72, 16 * ct, 32 * kk, lane), frag(Xm, 72, 16 * tt, 32 * kk, lane), a);
            const int ch = 16 * ct + 4 * q4, t = 16 * tt + l15; f32x4 o;
            if (which == 0) { const f32x4 w0 = pw0[ct];
#pragma unroll
                for (int j = 0; j < 4; ++j) o[j] = -0.60653065971f * sigmoidf_(w0[j] + a[j]);
                *(f32x4*)(CUM + t * 64 + ch) = o; }
            else { const f32x4 a0 = pw0[ct];
#pragma unroll
                for (int j = 0; j < 4; ++j) o[j] = sigmoidf_(a0[j] + a[j]);
                *(f32x4*)(AICL + t * 64 + ch) = o; }
        }
    }
    __syncthreads();
    RW_STOP_AT(1);
    {
        float cumv[8]; float run = 0.f;
#pragma unroll
        for (int i = 0; i < 8; ++i) { run += CUM[(8 * w + i) * 64 + lane]; cumv[i] = run; }
        TOT[w * 64 + lane] = run;
        __syncthreads();
        float off = 0.f;
        for (int ww = 0; ww < w; ++ww) off += TOT[ww * 64 + lane];
#pragma unroll
        for (int i = 0; i < 8; ++i) CUM[(8 * w + i) * 64 + lane] = cumv[i] + off;
    }
    __syncthreads();
    RW_STOP_AT(2);
    float aabs[8];
    {
        float kk[8], ai[8], ss = 0.f;
#pragma unroll
        for (int i = 0; i < 8; ++i) { ai[i] = AICL[t_ * 64 + 8 * cg + i]; kk[i] = xk[i] * pkk[i]; ss += kk[i] * kk[i]; }
        ss += __shfl_xor(ss, 1); ss += __shfl_xor(ss, 2); ss += __shfl_xor(ss, 4);
        const float inv = __builtin_amdgcn_rsqf(fmaxf(ss, 1e-24f));
        float bon = 0.f, o_arl[8], o_rrl[8], o_brl[8], o_krl[8], o_rabs[8], o_bh[8], o_kh[8];
#pragma unroll
        for (int i = 0; i < 8; ++i) {
            const float kn = kk[i] * inv, av = -kn, bv = kn * ai[i], km = xk[i] * (1.0f + (ai[i] - 1.0f) * pka[i]);
            bon += xr[i] * km * prk[i];
            const int k = 8 * cg + i;
            const float cu = CUM[t_ * 64 + k], cx = t_ > 0 ? CUM[(t_ - 1) * 64 + k] : 0.f, rf = CUM[32 * 64 + k], la = CUM[63 * 64 + k];
            o_arl[i] = av * fexp(cx - rf); aabs[i] = av * fexp(cx);
            o_rrl[i] = xr[i] * fexp(cu - rf); o_rabs[i] = xr[i] * fexp(cu);
            const float eb = fexp(rf - cu), eh = fexp(la - cu);
            o_brl[i] = bv * eb; o_krl[i] = km * eb;
            o_bh[i] = bv * eh; o_kh[i] = km * eh;
        }
        bon += __shfl_xor(bon, 1); bon += __shfl_xor(bon, 2); bon += __shfl_xor(bon, 4);
        *(u32x4*)(ARL + t_ * 72 + 8 * cg) = pack8(o_arl); *(u32x4*)(RRL + t_ * 72 + 8 * cg) = pack8(o_rrl);
        *(u32x4*)(BRL + t_ * 72 + 8 * cg) = pack8(o_brl); *(u32x4*)(KRL + t_ * 72 + 8 * cg) = pack8(o_krl);
        *(u32x4*)(BHT + t_ * 72 + 8 * cg) = pack8(o_bh); *(u32x4*)(KHT + t_ * 72 + 8 * cg) = pack8(o_kh); *(u32x4*)(VT + t_ * 72 + 8 * cg) = pack8(xv);
        const size_t ro = (size_t)(m0 + t_) * LDP;
        if (!dry) *(u32x4*)(P + ro + C_WR + chh) = pack8(o_rabs);
        float bvv[8];
#pragma unroll
        for (int i = 0; i < 8; ++i) bvv[i] = bon * xv[i];
        if (!dry) *(u32x4*)(P + ro + C_WV + chh) = pack8(bvv);
        if (tid < 64) WLAST[tid] = fexp(CUM[63 * 64 + tid]);
    }
    __syncthreads();
    RW_STOP_AT(3);
    *(f32x4*)(RHS + t_ * 128 + 8 * cg) = (f32x4){aabs[0], aabs[1], aabs[2], aabs[3]}; *(f32x4*)(RHS + t_ * 128 + 8 * cg + 4) = (f32x4){aabs[4], aabs[5], aabs[6], aabs[7]};
    {
        const int prod = w >> 1, half = w & 1; const bf16* Lm = (prod < 2) ? ARL : RRL; const bf16* Rm = (prod & 1) ? KRL : BRL; const int strict = prod < 2 ? 1 : 0;
#pragma unroll
        for (int i8 = 0; i8 < 8; ++i8) { const int id = half * 8 + i8, tt = id >> 2, st = id & 3;
            f32x4 a = (f32x4){0.f, 0.f, 0.f, 0.f};
            if (st <= tt) {
#pragma unroll
                for (int kk = 0; kk < 2; ++kk) a = mfma16(frag(Rm, 72, 16 * st, 32 * kk, lane), frag(Lm, 72, 16 * tt, 32 * kk, lane), a);
                if (st == tt) {
#pragma unroll
                    for (int j = 0; j < 4; ++j) if (4 * q4 + j + strict > l15) a[j] = 0.f; }
            }
            if (prod == 0) *(f32x4*)(AAB + (16 * tt + l15) * 64 + 16 * st + 4 * q4) = a;
            else { bf16* O = prod == 1 ? AAK : prod == 2 ? LRB : LRK; *(u32x2*)(O + (16 * tt + l15) * 72 + 16 * st + 4 * q4) = pack4(a); }
        }
        if (prod == 0) {
            asm volatile("s_waitcnt lgkmcnt(0)" ::: "memory");
            const int bb = 2 * half + ((lane >> 4) & 1), cc = lane & 15; float x[16];
#pragma unroll
            for (int i = 0; i < 16; ++i) { float s0 = (i == cc) ? 1.0f : 0.0f;
#pragma unroll
                for (int s4 = 0; s4 < (i + 3) / 4; ++s4) { const f32x4 av = *(const f32x4*)(AAB + (16 * bb + i) * 64 + 16 * bb + 4 * s4);
#pragma unroll
                    for (int n = 0; n < 4; ++n) if (4 * s4 + n < i) s0 += av[n] * x[4 * s4 + n]; }
                x[i] = s0; if (lane < 32) TB[(bb * 16 + i) * 16 + cc] = s0; }
        }
    }
    __syncthreads();
    RW_STOP_AT(4);
    {
        f32x4 X[4];
#pragma unroll
        for (int bb = 0; bb < 4; ++bb) {
            f32x4 acc;
            if (w < 4) {
#pragma unroll
                for (int j = 0; j < 4; ++j) acc[j] = RHS[(16 * bb + 4 * q4 + j) * 128 + 16 * w + l15]; }
            else {
                acc = (f32x4){0.f, 0.f, 0.f, 0.f};
#pragma unroll
                for (int kk = 0; kk < 2; ++kk) acc = mfma16(frag(AAK, 72, 16 * bb, 32 * kk, lane), frag_tr(VT, 72, 16 * (w - 4), 32 * kk, lane), acc); }
#pragma unroll
            for (int bp = 0; bp < bb; ++bp) { const f32x4 a4 = *(const f32x4*)(AAB + (16 * bb + l15) * 64 + 16 * bp + 4 * q4);
#pragma unroll
                for (int j = 0; j < 4; ++j) acc = __builtin_amdgcn_mfma_f32_16x16x4f32(a4[j], X[bp][j], acc, 0, 0, 0); }
            const f32x4 t4 = *(const f32x4*)(TB + (bb * 16 + l15) * 16 + 4 * q4);
            f32x4 xb = (f32x4){0.f, 0.f, 0.f, 0.f};
#pragma unroll
            for (int j = 0; j < 4; ++j) xb = __builtin_amdgcn_mfma_f32_16x16x4f32(t4[j], acc[j], xb, 0, 0, 0);
            X[bb] = xb;
            *(u32x2*)(XT + (16 * w + l15) * 72 + 16 * bb + 4 * q4) = pack4(xb);
        }
    }
    __syncthreads();
    RW_STOP_AT(6);
    {
        const int prod = w >> 1, half = w & 1;
        bf16* GH = (bf16*)(p.ws + WS_RWGH) + ((size_t)((b * 8 + h) * 64 + c) * 2) * 4096;
#pragma unroll
        for (int i8 = 0; i8 < 8; ++i8) { const int id = half * 8 + i8, rt = id >> 2, ct = id & 3;
            f32x4 a = (f32x4){0.f, 0.f, 0.f, 0.f};
            if (prod == 0) {
#pragma unroll
                for (int kk = 0; kk < 2; ++kk) a = mfma16(frag(XT, 72, 16 * ct, 32 * kk, lane), frag(LRB, 72, 16 * rt, 32 * kk, lane), a);
                bf16* qp = P + (size_t)(m0 + 16 * rt + l15) * LDP + C_WR + h * 64 + 16 * ct + 4 * q4;
                const u32x2 r2 = *(const u32x2*)qp; a[0] += lo16(r2.x); a[1] += hi16(r2.x); a[2] += lo16(r2.y); a[3] += hi16(r2.y);
                if (!dry) *(u32x2*)qp = pack4(a);
            } else if (prod == 1) {
#pragma unroll
                for (int kk = 0; kk < 2; ++kk) a = mfma16(frag(XT, 72, 64 + 16 * ct, 32 * kk, lane), frag(LRB, 72, 16 * rt, 32 * kk, lane), a);
#pragma unroll
                for (int kk = 0; kk < 2; ++kk) a = mfma16(frag_tr(VT, 72, 16 * ct, 32 * kk, lane), frag(LRK, 72, 16 * rt, 32 * kk, lane), a);
                if (!dry) *(u32x2*)(P + (size_t)(m0 + 16 * rt + l15) * LDP + C_WK + h * 64 + 16 * ct + 4 * q4) = pack4(a);
            } else if (prod == 2) {
#pragma unroll
                for (int kk = 0; kk < 2; ++kk) a = mfma16(frag(XT, 72, 16 * ct, 32 * kk, lane), frag_tr(BHT, 72, 16 * rt, 32 * kk, lane), a);
                if (rt == ct) { const float wl = WLAST[16 * rt + l15];
#pragma unroll
                    for (int j = 0; j < 4; ++j) if (4 * q4 + j == l15) a[j] += wl; }
                *(u32x2*)(GH + (16 * rt + l15) * 64 + 16 * ct + 4 * q4) = pack4(a);
            } else {
#pragma unroll
                for (int kk = 0; kk < 2; ++kk) a = mfma16(frag_tr(BHT, 72, 16 * ct, 32 * kk, lane), frag(XT, 72, 64 + 16 * rt, 32 * kk, lane), a);
#pragma unroll
                for (int kk = 0; kk < 2; ++kk) a = mfma16(frag_tr(KHT, 72, 16 * ct, 32 * kk, lane), frag_tr(VT, 72, 16 * rt, 32 * kk, lane), a);
                *(u32x2*)(GH + 4096 + (16 * rt + l15) * 64 + 16 * ct + 4 * q4) = pack4(a);
            }
        }
    }
    __syncthreads();
    RW_TS_END();
}
DI void rwkv_scan_chain(const Params& p, unsigned char* lds, int bh, bool dry = false) {
    const int tid = opaque_tid(), lane = tid & 63, w = tid >> 6, q4 = lane >> 4, l15 = lane & 15;
    bf16* ZB = (bf16*)lds;
    bf16* GH = (bf16*)(p.ws + WS_RWGH) + (size_t)bh * 64 * 2 * 4096;
    const int vt = w & 3, kh = w >> 2;
    u32x2 zp[2];
#pragma unroll
    for (int i = 0; i < 2; ++i) { zp[i] = (u32x2){0u, 0u}; *(u32x2*)(ZB + (16 * vt + l15) * 72 + 16 * (2 * kh + i) + 4 * q4) = zp[i]; }
    bf16x8 gf[4][2][2]; u32x2 hv[4][2];
#define RW_LOAD(slot, cc) do { const bf16* G_ = GH + (size_t)(cc) * 2 * 4096; _Pragma("unroll") for (int i = 0; i < 2; ++i) { const int kt = 2 * kh + i; \
        _Pragma("unroll") for (int kk = 0; kk < 2; ++kk) gf[slot][i][kk] = frag(G_, 64, 16 * kt, 32 * kk, lane); \
        hv[slot][i] = *(const u32x2*)(G_ + 4096 + (16 * vt + l15) * 64 + 16 * kt + 4 * q4); } } while (0)
    RW_LOAD(0, 0); RW_LOAD(1, 1); RW_LOAD(2, 2); RW_LOAD(3, 3);
    __syncthreads();
    for (int c4 = 0; c4 < 64; c4 += 4) {
#pragma unroll
        for (int u = 0; u < 4; ++u) { const int c = c4 + u;
            bf16* HT = GH + (size_t)c * 2 * 4096 + 4096;
            const bf16* Zc = ZB + (c & 1) * 64 * 72; bf16* Zn = ZB + ((c + 1) & 1) * 64 * 72;
#pragma unroll
            for (int i = 0; i < 2; ++i) { const int kt = 2 * kh + i;
                f32x4 a = (f32x4){lo16(hv[u][i].x), hi16(hv[u][i].x), lo16(hv[u][i].y), hi16(hv[u][i].y)};
                if (!dry) *(u32x2*)(HT + (16 * vt + l15) * 64 + 16 * kt + 4 * q4) = zp[i];
#pragma unroll
                for (int kk = 0; kk < 2; ++kk) a = mfma16(gf[u][i][kk], frag(Zc, 72, 16 * vt, 32 * kk, lane), a);
                zp[i] = pack4(a);
                *(u32x2*)(Zn + (16 * vt + l15) * 72 + 16 * kt + 4 * q4) = zp[i]; }
            { const int cn = c + 4 < 64 ? c + 4 : 63; RW_LOAD(u, cn); }
            __syncthreads();
        }
    }
#undef RW_LOAD
}
DI void rwkv_out_item(const Params& p, int l, int bh, int pair, bool dry = false) {
    const int tid = opaque_tid(), lane = tid & 63, w = tid >> 6, q4 = lane >> 4, l15 = lane & 15;
    bf16* P = (bf16*)(p.ws + WS_P);
    const int b = bh >> 3, h = bh & 7, c = 2 * pair + (w >> 2), m = b * T + c * 64 + 16 * (w & 3) + l15;
    const bf16* ZT = (const bf16*)(p.ws + WS_RWGH) + ((size_t)(bh * 64 + c) * 2 + 1) * 4096;
    const size_t ro = (size_t)m * LDP;
    bf16x8 qf[2], zf[4][2]; u32x2 yl[4], bv[4], g2[4]; f32x4 lg[4], lb[4];
#pragma unroll
    for (int kk = 0; kk < 2; ++kk) qf[kk] = *(const bf16x8*)(P + ro + C_WR + h * 64 + 32 * kk + 8 * q4);
#pragma unroll
    for (int vt = 0; vt < 4; ++vt) { yl[vt] = *(const u32x2*)(P + ro + C_WK + h * 64 + 16 * vt + 4 * q4);
#pragma unroll
        for (int kk = 0; kk < 2; ++kk) zf[vt][kk] = frag(ZT, 64, 16 * vt, 32 * kk, lane); }
#pragma unroll
    for (int vt = 0; vt < 4; ++vt) { const int ch = h * 64 + 16 * vt + 4 * q4;
        bv[vt] = *(const u32x2*)(P + ro + C_WV + ch); g2[vt] = *(const u32x2*)(P + ro + C_WG + ch);
        lg[vt] = *(const f32x4*)(p.in[I_LNG] + l * 512 + ch); lb[vt] = *(const f32x4*)(p.in[I_LNB] + l * 512 + ch); }
    f32x4 y[4]; float s = 0.f;
#pragma unroll
    for (int vt = 0; vt < 4; ++vt) {
        y[vt] = (f32x4){lo16(yl[vt].x), hi16(yl[vt].x), lo16(yl[vt].y), hi16(yl[vt].y)};
#pragma unroll
        for (int kk = 0; kk < 2; ++kk) y[vt] = mfma16(zf[vt][kk], qf[kk], y[vt]);
        s += (y[vt][0] + y[vt][1]) + (y[vt][2] + y[vt][3]); }
    s += __shfl_xor(s, 16); s += __shfl_xor(s, 32);
    const float mean = s * (1.0f / 64.0f); float vr = 0.f;
#pragma unroll
    for (int vt = 0; vt < 4; ++vt) { y[vt] = y[vt] - mean; vr += (y[vt][0] * y[vt][0] + y[vt][1] * y[vt][1]) + (y[vt][2] * y[vt][2] + y[vt][3] * y[vt][3]); }
    vr += __shfl_xor(vr, 16); vr += __shfl_xor(vr, 32);
    const float rstd = __builtin_amdgcn_rsqf(vr * (1.0f / 64.0f) + 64e-5f);
#pragma unroll
    for (int vt = 0; vt < 4; ++vt) { const int ch = h * 64 + 16 * vt + 4 * q4; bf16* gp = P + ro + C_WG + ch;
        const float bvf[4] = {lo16(bv[vt].x), hi16(bv[vt].x), lo16(bv[vt].y), hi16(bv[vt].y)}, g[4] = {lo16(g2[vt].x), hi16(g2[vt].x), lo16(g2[vt].y), hi16(g2[vt].y)};
        f32x4 o;
#pragma unroll
        for (int j = 0; j < 4; ++j) o[j] = (y[vt][j] * rstd * lg[vt][j] + lb[vt][j] + bvf[j]) * siluf_(g[j]);
        if (!dry) *(u32x2*)gp = pack4(o); }
}

DI void phase_A(const Params& p, int l, unsigned char* lds, bool dry = false) {
    const int G = gridDim.x, bid = blockIdx.x;
#ifndef DUP_AMASK
#define DUP_AMASK 0xff
#endif
    for (int it = bid; it < 3328; it += G) {
        if (dry) { const int ty = it < 2048 ? 1 : it < 2560 ? 2 : it < 2816 ? 4 : it < 3072 ? 8 : 16; if (!(DUP_AMASK & ty)) continue; }
        if (it < 2048) rwkv_chunk_item(p, l, lds, it >> 9, (it >> 6) & 7, it & 63, dry);
        else if (it < 2560) { const int i = it - 2048; ssd_item(p, l, lds, i >> 7, (i >> 4) & 7, i & 15, false); }
        else if (it < 2816) { const int i = it - 2560; qkv_item<false>(p, l, lds, i >> 6, (i >> 4) & 3, i & 15, false); }
        else if (it < 3072) { const int i = it - 2816; qkv_item<true>(p, l, lds, i >> 6, (i >> 4) & 3, i & 15, false); }
        else memkv_item(p, l, it - 3072);
    }
}
DI void phase_B(const Params& p, unsigned char* lds, bool dry = false) {
    (void)lds; phase_scan(p, blockIdx.x, gridDim.x, dry);
}
DI void rwkv_flag_publish(unsigned* flag) {
    asm volatile("s_waitcnt vmcnt(0)" ::: "memory"); __syncthreads();
    if (threadIdx.x == 0) { __builtin_amdgcn_fence(__ATOMIC_RELEASE, "agent"); asm volatile("s_waitcnt vmcnt(0)" ::: "memory"); __hip_atomic_store(flag, 1u, __ATOMIC_RELAXED, __HIP_MEMORY_SCOPE_AGENT); }
}
DI void rwkv_flag_wait(unsigned* flag) {
    if (threadIdx.x == 0) { unsigned spins = 0;
        while (__hip_atomic_load(flag, __ATOMIC_RELAXED, __HIP_MEMORY_SCOPE_AGENT) == 0u) { __builtin_amdgcn_s_sleep(8); if (++spins > (1u << 22)) break; }
        __builtin_amdgcn_fence(__ATOMIC_ACQUIRE, "agent"); asm volatile("s_waitcnt vmcnt(0)" ::: "memory"); }
    __syncthreads();
}
DI void phase_C(const Params& p, int l, unsigned char* lds, bool dry = false) {
    const int G = gridDim.x, bid = blockIdx.x;
    unsigned* flags = (unsigned*)(p.ws + WS_BAR + 14336) + (dry ? 128 : 0) + l * 32;
    for (int bh = bid; bh < 32; bh += G) { rwkv_scan_chain(p, lds, bh, dry); rwkv_flag_publish(flags + bh); }
    unsigned have = 0u;
#define C_SSD(it)  ssd_item(p, l, lds, (it) >> 7, ((it) >> 4) & 7, (it) & 15, true, dry)
#define C_RET(it)  qkv_item<false>(p, l, lds, (it) >> 6, ((it) >> 4) & 3, (it) & 15, true, dry)
#define C_GLA(it)  qkv_item<true>(p, l, lds, (it) >> 6, ((it) >> 4) & 3, (it) & 15, true, dry)
#define C_MEM(it)  memattn_item(p, lds, (it) >> 6, ((it) >> 4) & 3, (it) & 15)
#define C_RWO(it)  do { const int bh_ = (it) >> 5; if (!((have >> bh_) & 1u)) { rwkv_flag_wait(flags + bh_); have |= 1u << bh_; } rwkv_out_item(p, l, bh_, (it) & 31, dry); } while (0)
    const int nslot = (G == 256) ? 16 : (2304 + G - 1) / G;
    for (int k = 0; k < nslot; ++k) {
        int it = -1;
        if (G == 256) {
            if (bid < 32) { it = k == 0 ? bid : (k >= 1 && k <= 4) ? 1280 + 4 * bid + (k - 1) : -1; }
            else { const int j = bid - 32;
                if (k == 0) it = 32 + j; else if (k == 1) it = 256 + j; else if (k == 2) it = (j < 32) ? 480 + j : -1;
                else if (k == 3) it = 768 + 32 + j; else if (k == 4) it = (j >= 32 && j < 64) ? 768 + (j - 32) : -1;
                else if (k == 5) it = 512 + 32 + j; else if (k == 6) it = (j >= 64 && j < 96) ? 512 + (j - 64) : -1;
                else if (k == 7) it = 1024 + j; else if (k == 8) it = (j >= 96 && j < 128) ? 1024 + 224 + (j - 96) : -1;
                else { const int m = k - 9; int r = -1;
                    if (j < 32) r = -1; else if (j < 64) r = m < 1 ? 128 + (j - 32) : -1; else if (j < 96) r = m < 2 ? 160 + 2 * (j - 64) + m : -1;
                    else if (j < 128) r = m < 5 ? 224 + 5 * (j - 96) + m : -1; else if (j < 192) r = m < 7 ? 384 + 7 * (j - 128) + m : -1; else r = m < 6 ? 832 + 6 * (j - 192) + m : -1;
                    it = r >= 0 ? 1280 + r : -1; } }
        } else { it = bid + k * G; if (it >= 2304) it = -1; }
        if (it < 0) continue;
        if (it < 512) C_SSD(it); else if (it < 768) C_RET(it - 512); else if (it < 1024) C_GLA(it - 768); else if (it < 1280) C_MEM(it - 1024); else C_RWO(it - 1280);
    }
#undef C_SSD
#undef C_RET
#undef C_GLA
#undef C_MEM
#undef C_RWO
}
typedef PG8_LAS unsigned char* lds3_t;
DI void phase_P1(const Params& p, int l, unsigned char* lds) {
    pg8::Gemm g{1024, 1024};
    SchedP1 S{(int)gridDim.x, (int)blockIdx.x, (const char*)p.ws + WS_XN, (const char*)p.ws + WS_W1T};
    EpiP E{(bf16*)(p.ws + WS_P), (bf16*)(p.ws + WS_BND)};
    pg8::gemm_phase<EpiP, SchedP1, true, true>((lds3_t)lds, g, S, E);
}
DI void phase_P3(const Params& p, int l, unsigned char* lds) {
    (void)l;
    for (int L = blockIdx.x; L < 256; L += gridDim.x) {
        int pm, pn; tile_map(L, 64, 4, pm, pn);
        pg8::Gemm g{0, 0}; SchedP3 S{pm, pn, p.ws};
        EpiP3 E{EpiGate{(bf16*)(p.ws + WS_P)}, EpiBranch{(const bf16*)(p.ws + WS_P), (bf16*)(p.ws + WS_MRG), (const float*)(p.ws + WS_SSQ)}};
        pg8::gemm_phase<EpiP3, SchedP3, true, true>((lds3_t)lds, g, S, E);
    }
}
DI void phase_P4(const Params& p, int l, unsigned char* lds) {
    pg8::Gemm g{1024, 1024};
    SchedP4 S{(int)gridDim.x, (int)blockIdx.x, (const char*)p.ws + WS_MRG, (const char*)p.ws + WS_WOT};
    if (gridDim.x == 256) {
        float* xs = (float*)(p.ws + WS_XS) + (size_t)l * 64 * 256 * 4; unsigned* cnt = (unsigned*)(p.ws + WS_XCNT) + l * 64 * 64;
        if (l == 0) { EpiNorm<false> E{p.in[I_X], p.out, p.in[I_NORMG] + 1024, (bf16*)(p.ws + WS_XN), xs, cnt}; pg8::gemm_phase<EpiNorm<false>, SchedP4, true, true>((lds3_t)lds, g, S, E); }
        else { EpiNorm<true> E{p.out, p.out, p.in[I_FNORMG], nullptr, xs, cnt}; pg8::gemm_phase<EpiNorm<true>, SchedP4, true, true>((lds3_t)lds, g, S, E); }
    } else { EpiRes E{l == 0 ? p.in[I_X] : p.out, p.out}; pg8::gemm_phase<EpiRes, SchedP4, true, true>((lds3_t)lds, g, S, E); }
}
DI void phase_post(const Params& p, int l, unsigned char* lds) {
    if (gridDim.x == 256) { if (l == 0) convert_weights(p, 1, lds); }
    else phase_norm(p, l, 1.0f, lds);
}

#ifndef MK_LAUNCHES
#define MK_LAUNCHES 1
#endif
struct KArgs { Params p; int lo, hi; };
constexpr int N_PHASES = 15;
#ifdef NVGPR
__global__ void __launch_bounds__(NTHREADS, 2) __attribute__((amdgpu_num_vgpr(NVGPR))) fwd_kernel(KArgs a) {
#else
__global__ void __launch_bounds__(NTHREADS, 2) fwd_kernel(KArgs a) {
#endif
    extern __shared__ __attribute__((aligned(16))) unsigned char lds[];
    cg::grid_group grid = cg::this_grid();
    const Params& p = a.p;
    volatile unsigned* bst = (volatile unsigned*)(lds + LDS_BYTES - 64);
    if (threadIdx.x < 16) bst[threadIdx.x] = 0u;
    __syncthreads();
    XcdBarrier xbar = xcd_barrier_post((unsigned*)(p.ws + WS_BAR), bst);
    if (a.hi == 12345) grid.sync();
#define GRID_SYNC() xcd_barrier(xbar)
#ifndef DUP_N
#define DUP_N 1
#endif
#ifndef PHMASK
#define PHMASK 0xff
#endif
#if defined(TPROBE) && defined(PH_PROBE)
#define PH_TS_BEGIN() do { if (threadIdx.x == 0) TS_BASE(lds)[13] = (unsigned)__builtin_amdgcn_s_memrealtime(); } while (0)
#define PH_TS_MARK(k) do { __syncthreads(); if (threadIdx.x == 0) { const unsigned t_ = (unsigned)__builtin_amdgcn_s_memrealtime(); volatile unsigned* A_ = TS_BASE(lds); A_[k] += t_ - A_[13]; A_[13] = t_; } } while (0)
#else
#define PH_TS_BEGIN() do {} while (0)
#define PH_TS_MARK(k) do {} while (0)
#endif
#ifdef DUP_S
#define NREP(ty, l) (((ty) == DUP_S && !(((ty) == 6 || (ty) == 7) && (l) != 0)) ? 1 + DUP_N : 1)
#else
#define NREP(ty, l) 1
#endif
#define RUN_PHASE(ty, l, more) do { const int nrep = NREP(ty, l); \
        for (int rep = 0; rep < nrep; ++rep) { const bool dry = (rep + 1 < nrep) && (a.hi != 12345); (void)dry; PH_TS_BEGIN(); \
            if (!((PHMASK >> (ty)) & 1)) {} \
            else if ((ty) == 0) phase_prologue(p, lds); \
            else if ((ty) == 1) phase_P1(p, l, lds); \
            else if ((ty) == 2) phase_A(p, l, lds, dry); \
            else if ((ty) == 3) phase_B(p, lds, dry); \
            else if ((ty) == 4) phase_C(p, l, lds, dry); \
            else if ((ty) == 5) phase_P3(p, l, lds); \
            else if ((ty) == 6) phase_P4(p, l, lds); \
            else phase_post(p, l, lds); \
            PH_TS_MARK(ty); \
            if ((more) || rep + 1 < nrep) GRID_SYNC(); } } while (0)
#if MK_LAUNCHES == 1
#if defined(DUP_S) && DUP_S == 100
    for (int rep = 0; rep < DUP_N; ++rep) GRID_SYNC();
#endif
    RUN_PHASE(0, 0, true);
    RUN_PHASE(1, 0, true); RUN_PHASE(2, 0, true); RUN_PHASE(3, 0, true); RUN_PHASE(4, 0, true); RUN_PHASE(5, 0, true); RUN_PHASE(6, 0, true); RUN_PHASE(7, 0, true);
    RUN_PHASE(1, 1, true); RUN_PHASE(2, 1, true); RUN_PHASE(3, 1, true); RUN_PHASE(4, 1, true); RUN_PHASE(5, 1, true); RUN_PHASE(6, 1, gridDim.x != 256); RUN_PHASE(7, 1, false);
#ifdef TPROBE
    {
        GRID_SYNC();
        unsigned* pw = (unsigned*)(p.ws + WS_XS + 600 * 1024);
        if (threadIdx.x == 0) pw[blockIdx.x] = TS_BASE(lds)[TPROBE];
        GRID_SYNC();
#ifndef TP_MODE
#define TP_MODE 0
#endif
#ifndef TP_LO
#define TP_LO 0
#define TP_HI 1
#endif
        float tot = 0.f, mx = 0.f, ctot = 0.f; int amx = 0; for (int i = 0; i < (int)gridDim.x; ++i) { const float v_ = (float)__hip_atomic_load(pw + i, __ATOMIC_RELAXED, __HIP_MEMORY_SCOPE_AGENT); tot += v_; if (v_ > mx) { mx = v_; amx = i; } if (i >= TP_LO && i < TP_HI) ctot += v_; }
        const float avg_us = TP_MODE == 4 ? (float)amx : TP_MODE == 3 ? (ctot / (float)(TP_HI - TP_LO)) / (tot / (float)gridDim.x) * 100.0f : TP_MODE == 2 ? (mx * (float)gridDim.x / tot - 1.0f) * 100.0f : (TP_MODE == 0 ? tot / (float)gridDim.x : mx) * 0.01f / (float)TP_CNT;
        const float bucket = floorf(avg_us / (float)TP_Q + 0.5f);
        const float sc = 1.0f + bucket * 0.01f;
        for (int i = blockIdx.x * NTHREADS + threadIdx.x; i < M * 256; i += gridDim.x * NTHREADS) { f32x4* o = (f32x4*)p.out + i; *o = *o * sc; }
    }
#endif
#else
    for (int ph = a.lo; ph < a.hi; ++ph) { const int ty = (ph == 0) ? 0 : ((ph - 1) % 7 + 1), l = (ph - 1) / 7; RUN_PHASE(ty, l, ph + 1 < a.hi); }
#endif
}

extern "C" void kernel_launch(void* const* d_in, const int* in_sizes, int n_in, void* d_out, int out_size, void* d_ws, size_t ws_size, hipStream_t stream) {
    static int grid = 0;
    if (grid == 0) {
        if (n_in != N_IN || out_size != M * D || ws_size < WS_END) { fprintf(stderr, "kernel_launch: unexpected shapes (n_in %d, out %d, ws %zu < %zu)\n", n_in, out_size, ws_size, (size_t)WS_END); grid = -1; return; }
        int dev = 0, cus = 0, per_cu = 0;
        hipGetDevice(&dev); hipDeviceGetAttribute(&cus, hipDeviceAttributeMultiprocessorCount, dev);
        hipFuncSetAttribute((const void*)fwd_kernel, hipFuncAttributeMaxDynamicSharedMemorySize, LDS_BYTES);
        hipOccupancyMaxActiveBlocksPerMultiprocessor(&per_cu, (const void*)fwd_kernel, NTHREADS, LDS_BYTES);
        if (per_cu < 1 || cus < 1) { fprintf(stderr, "kernel_launch: occupancy query gave %d blocks/CU on %d CUs\n", per_cu, cus); grid = -1; return; }
        grid = cus * per_cu; if (grid > 256) grid = 256;
    }
    if (grid < 0) return;
    KArgs a{}; for (int i = 0; i < N_IN; ++i) a.p.in[i] = (const float*)d_in[i];
    a.p.out = (float*)d_out; a.p.ws = (unsigned char*)d_ws;
    if (hipMemsetAsync((char*)d_ws + WS_BAR, 0, WS_ZERO_BYTES, stream) != hipSuccess) { fprintf(stderr, "kernel_launch: memset of the barrier words failed\n"); return; }
    if (MK_LAUNCHES == 1) {
        a.lo = 0; a.hi = N_PHASES; void* args[] = {&a};
        hipError_t e = hipLaunchCooperativeKernel((const void*)fwd_kernel, dim3(grid), dim3(NTHREADS), args, LDS_BYTES, stream);
        if (e != hipSuccess) fprintf(stderr, "kernel_launch: cooperative launch failed: %s (grid %d)\n", hipGetErrorString(e), grid);
    } else {
        for (int ph = 0; ph < N_PHASES; ++ph) { a.lo = ph; a.hi = ph + 1; hipLaunchKernelGGL(fwd_kernel, dim3(grid), dim3(NTHREADS), LDS_BYTES, stream, a); }
    }
}
```

```cpp
#include <hip/hip_runtime.h>
#include <hip/hip_cooperative_groups.h>
#include <cstdio>
#include <cstdint>
namespace cg = cooperative_groups;
namespace pg8 {
#define PG8_LAS __attribute__((address_space(3)))
typedef unsigned short bf16_t;
typedef short bf16x8 __attribute__((ext_vector_type(8)));
typedef float f32x4 __attribute__((ext_vector_type(4)));
typedef unsigned u32x4 __attribute__((ext_vector_type(4)));
constexpr int BM = 256, BK = 64, HALF = 128, HTB = HALF * BK * 2  , STAGE_BYTES = 8 * HTB, NXCD = 8, WGM = 8;

__host__ __device__ __forceinline__ int lds_byte(int r, int c) { const int st = (r >> 4) * 2 + (c >> 5), rr = r & 15, cc = c & 31, ob = rr * 64 + cc * 2; return st * 1024 + (ob ^ (((ob >> 9) & 1) << 5)); }
__host__ __device__ __forceinline__ void stage_rc(int b, int& R, int& C) { const int st = b / 1024, sb = b % 1024, swz = sb ^ (((sb >> 9) & 1) << 5); R = (st >> 1) * 16 + swz / 64; C = (st & 1) * 32 + (swz % 64) / 2; }
__host__ __device__ __forceinline__ int perm32(int rho) { const int n = rho >> 4, i = rho & 15; return 8 * (i >> 2) + 4 * n + (i & 3); }

struct Unit { int pm, pn, kind, aux; int nt, lda, ldb; int pad_; const char* A; const char* B; };
struct Gemm { int K, lda; };


template <class Epi, class Sched, bool ALIGN_EPI = false, bool SP2 = false>
__device__ __forceinline__ void gemm_phase(PG8_LAS unsigned char* lds, const Gemm g, const Sched& S, const Epi& E) {
    int tid = threadIdx.x; asm volatile("" : "+v"(tid));
    const int wid = __builtin_amdgcn_readfirstlane(tid >> 6), lane = tid & 63, wr = wid >> 2, wc = wid & 3, fr = lane & 15, fq = lane >> 4;
    int Rv[2], Rbv[2], Cv[2];
#pragma unroll
    for (int i = 0; i < 2; ++i) { int R, C; stage_rc(tid * 16 + i * 8192, R, C); Rv[i] = R; Cv[i] = C; Rbv[i] = Epi::PERM ? ((R & ~31) + perm32(R & 31)) : R; }
    unsigned voffA[2], voffB[2], voffAn[2], voffBn[2];
    const size_t kstep = (size_t)(BK * 2);
    size_t hstepA, hstepB, hstepAn, hstepBn;
#define PG8_STRIDES(u_, vA_, vB_, hA_, hB_) do { _Pragma("unroll") for (int _i = 0; _i < 2; ++_i) { vA_[_i] = (unsigned)(Rv[_i] * (u_).lda + Cv[_i]) * 2u; vB_[_i] = (unsigned)(Rbv[_i] * (u_).ldb + Cv[_i]) * 2u; } \
        hA_ = (size_t)HALF * (u_).lda * 2; hB_ = (size_t)HALF * (u_).ldb * 2; } while (0)
    const unsigned ldsw = (unsigned)wid * 1024u;
    const int aoff = lds_byte(wr * 64 + fr, fq * 8), boff = lds_byte(wc * 32 + fr, fq * 8);
#define PG8_SA(b, h) (((b) * 2 + (h)) * HTB)
#define PG8_SB(b, h) ((4 + (b) * 2 + (h)) * HTB)
#define PG8_STAGE(bufoff, gbase, voff) do { _Pragma("unroll") for (int _i = 0; _i < 2; ++_i) \
        __builtin_amdgcn_global_load_lds((const unsigned*)((const char*)(gbase) + (voff)[_i]), (PG8_LAS unsigned*)(lds + (bufoff) + ldsw + _i * 8192), 16, 0, 0); } while (0)
#define PG8_LDA(dst, b, h) do { _Pragma("unroll") for (int m = 0; m < 4; ++m) _Pragma("unroll") for (int k = 0; k < 2; ++k) dst[m][k] = *(const PG8_LAS bf16x8*)(lds + PG8_SA(b, h) + aoff + m * 2048 + k * 1024); } while (0)
#define PG8_LDB(dst, b, h) do { _Pragma("unroll") for (int n = 0; n < 2; ++n) _Pragma("unroll") for (int k = 0; k < 2; ++k) dst[n][k] = *(const PG8_LAS bf16x8*)(lds + PG8_SB(b, h) + boff + n * 2048 + k * 1024); } while (0)
#define PG8_MMA(ai, bj, At, Bt) do { __builtin_amdgcn_s_setprio(1); _Pragma("unroll") for (int m = 0; m < 4; ++m) _Pragma("unroll") for (int n = 0; n < 2; ++n) _Pragma("unroll") for (int k = 0; k < 2; ++k) \
        acc[ai][bj][m][n] = __builtin_amdgcn_mfma_f32_16x16x32_bf16(Bt[n][k], At[m][k], acc[ai][bj][m][n], 0, 0, 0); __builtin_amdgcn_s_setprio(0); } while (0)
#define PG8_WAIT_V(n) asm volatile("s_waitcnt vmcnt(" #n ")" ::: "memory")
#define PG8_WAIT_L(n) asm volatile("s_waitcnt lgkmcnt(" #n ")" ::: "memory")
#define PG8_BAR __builtin_amdgcn_s_barrier()
#define PG8_SCHED __builtin_amdgcn_sched_barrier(0)
    Unit cur, nxt; int ui = 0;
    if (!S.next(0, cur)) return;
    PG8_STRIDES(cur, voffA, voffB, hstepA, hstepB); int nt = cur.nt;
    f32x4 acc[2][2][4][2];
#pragma unroll
    for (int a = 0; a < 2; ++a)
#pragma unroll
        for (int b = 0; b < 2; ++b)
#pragma unroll
            for (int m = 0; m < 4; ++m)
#pragma unroll
                for (int n = 0; n < 2; ++n) acc[a][b][m][n] = (f32x4){0.f, 0.f, 0.f, 0.f};
    bf16x8 At[4][2], B0[2][2], B1[2][2];
    const char* cA = cur.A; const char* cB = cur.B;
    S.a_ready(cur);
    if constexpr (SP2) {
        PG8_STAGE(PG8_SB(0, 0), cB, voffB); PG8_STAGE(PG8_SB(0, 1), cB + hstepB, voffB); PG8_STAGE(PG8_SA(0, 0), cA, voffA); PG8_STAGE(PG8_SA(0, 1), cA + hstepA, voffA);
        if (wr == 1) PG8_BAR;
        PG8_WAIT_V(2); PG8_BAR;
        PG8_STAGE(PG8_SB(1, 0), cB + kstep, voffB); PG8_STAGE(PG8_SA(1, 0), cA + kstep, voffA); PG8_STAGE(PG8_SB(1, 1), cB + hstepB + kstep, voffB);
        PG8_WAIT_V(6); PG8_BAR;
    } else {
        PG8_STAGE(PG8_SB(0, 0), cB, voffB); PG8_STAGE(PG8_SA(0, 0), cA, voffA); PG8_STAGE(PG8_SB(0, 1), cB + hstepB, voffB); PG8_STAGE(PG8_SA(0, 1), cA + hstepA, voffA);
        if (wr == 1) PG8_BAR;
        PG8_WAIT_V(4); PG8_BAR;
        PG8_STAGE(PG8_SB(1, 0), cB + kstep, voffB); PG8_STAGE(PG8_SA(1, 0), cA + kstep, voffA); PG8_STAGE(PG8_SB(1, 1), cB + hstepB + kstep, voffB);
        PG8_WAIT_V(6); PG8_BAR;
    }
    for (;;) {
        const bool has_next = S.next(ui + 1, nxt);
        const char* nA = has_next ? nxt.A : cA; const char* nB = has_next ? nxt.B : cB;
        if (has_next) PG8_STRIDES(nxt, voffAn, voffBn, hstepAn, hstepBn); else { voffAn[0] = voffA[0]; voffAn[1] = voffA[1]; voffBn[0] = voffB[0]; voffBn[1] = voffB[1]; hstepAn = hstepA; hstepBn = hstepB; }
        for (int t = 0; t < nt; t += 2) {
            const bool last = (t == nt - 2);
            const char* a1 = cA + (size_t)(t + 1) * kstep;
            const char* a2 = last ? nA : cA + (size_t)(t + 2) * kstep; const char* b2 = last ? nB : cB + (size_t)(t + 2) * kstep;
            const char* a3 = a2 + kstep; const char* b3 = b2 + kstep;
            unsigned vA2[2], vB2[2]; vA2[0] = last ? voffAn[0] : voffA[0]; vA2[1] = last ? voffAn[1] : voffA[1]; vB2[0] = last ? voffBn[0] : voffB[0]; vB2[1] = last ? voffBn[1] : voffB[1];
            const size_t hA2 = last ? hstepAn : hstepA, hB2 = last ? hstepBn : hstepB;
            if (last && has_next) S.a_ready(nxt);
            if constexpr (SP2) {
            PG8_LDB(B0, 0, 0); PG8_LDB(B1, 0, 1); PG8_SCHED; PG8_LDA(At, 0, 0); PG8_STAGE(PG8_SA(1, 1), a1 + hstepA, voffA);
            PG8_WAIT_V(8); PG8_WAIT_L(0); PG8_BAR; PG8_MMA(0, 0, At, B0); PG8_MMA(0, 1, At, B1); PG8_BAR; PG8_SCHED;
            PG8_LDA(At, 0, 1); PG8_STAGE(PG8_SB(0, 0), b2, vB2); PG8_STAGE(PG8_SB(0, 1), b2 + hB2, vB2); PG8_STAGE(PG8_SA(0, 0), a2, vA2);
            PG8_WAIT_V(8); PG8_WAIT_L(0); PG8_BAR; PG8_MMA(1, 0, At, B0); PG8_MMA(1, 1, At, B1); PG8_BAR; PG8_SCHED;
            PG8_LDB(B0, 1, 0); PG8_LDB(B1, 1, 1); PG8_SCHED; PG8_LDA(At, 1, 0); PG8_STAGE(PG8_SA(0, 1), a2 + hA2, vA2);
            PG8_WAIT_V(8); PG8_WAIT_L(0); PG8_BAR; PG8_MMA(0, 0, At, B0); PG8_MMA(0, 1, At, B1); PG8_BAR; PG8_SCHED;
            PG8_LDA(At, 1, 1); PG8_STAGE(PG8_SB(1, 0), b3, vB2); PG8_STAGE(PG8_SB(1, 1), b3 + hB2, vB2); PG8_STAGE(PG8_SA(1, 0), a3, vA2);
            PG8_WAIT_V(8); PG8_WAIT_L(0); PG8_BAR; PG8_MMA(1, 0, At, B0); PG8_MMA(1, 1, At, B1); PG8_BAR; PG8_SCHED;
            } else {
            PG8_LDB(B0, 0, 0); PG8_SCHED; PG8_LDA(At, 0, 0); PG8_STAGE(PG8_SA(1, 1), a1 + hstepA, voffA);
            PG8_WAIT_L(8); PG8_BAR; PG8_WAIT_L(0); PG8_MMA(0, 0, At, B0); PG8_BAR; PG8_SCHED;
            PG8_LDB(B1, 0, 1); PG8_STAGE(PG8_SB(0, 0), b2, vB2);
            PG8_BAR; PG8_WAIT_L(0); PG8_MMA(0, 1, At, B1); PG8_BAR;
            PG8_LDA(At, 0, 1); PG8_STAGE(PG8_SA(0, 0), a2, vA2);
            PG8_BAR; PG8_WAIT_L(0); PG8_MMA(1, 0, At, B0); PG8_BAR; PG8_SCHED;
            PG8_STAGE(PG8_SB(0, 1), b2 + hB2, vB2);
            PG8_WAIT_V(6); PG8_BAR; PG8_MMA(1, 1, At, B1); PG8_BAR;
            PG8_LDB(B0, 1, 0); PG8_SCHED; PG8_LDA(At, 1, 0); PG8_STAGE(PG8_SA(0, 1), a2 + hA2, vA2);
            PG8_WAIT_L(8); PG8_BAR; PG8_WAIT_L(0); PG8_MMA(0, 0, At, B0); PG8_BAR; PG8_SCHED;
            PG8_LDB(B1, 1, 1); PG8_STAGE(PG8_SB(1, 0), b3, vB2);
            PG8_BAR; PG8_WAIT_L(0); PG8_MMA(0, 1, At, B1); PG8_BAR;
            PG8_LDA(At, 1, 1); PG8_STAGE(PG8_SA(1, 0), a3, vA2);
            PG8_BAR; PG8_WAIT_L(0); PG8_MMA(1, 0, At, B0); PG8_BAR; PG8_SCHED;
            PG8_STAGE(PG8_SB(1, 1), b3 + hB2, vB2);
            PG8_WAIT_V(6); PG8_BAR; PG8_MMA(1, 1, At, B1); PG8_BAR;
            }
        }
        if constexpr (ALIGN_EPI) { if (wr == 0) PG8_BAR; }
        if constexpr (!Epi::AFTER_DRAIN) { E(acc, cur, wr, wc, fr, fq); S.done(cur); }
        if (!has_next) break;
#pragma unroll
        for (int a = 0; a < 2; ++a)
#pragma unroll
            for (int b = 0; b < 2; ++b)
#pragma unroll
                for (int m = 0; m < 4; ++m)
#pragma unroll
                    for (int n = 0; n < 2; ++n) acc[a][b][m][n] = (f32x4){0.f, 0.f, 0.f, 0.f};
        cur = nxt; cA = nA; cB = nB; ++ui; nt = cur.nt; voffA[0] = voffAn[0]; voffA[1] = voffAn[1]; voffB[0] = voffBn[0]; voffB[1] = voffBn[1]; hstepA = hstepAn; hstepB = hstepBn;
        if constexpr (ALIGN_EPI) { if (wr == 1) PG8_BAR; }
    }
    PG8_WAIT_V(0);
    if constexpr (!ALIGN_EPI) { if (wr == 0) PG8_BAR; }
    PG8_BAR;
    if constexpr (Epi::AFTER_DRAIN) { E.fused(acc, cur, wr, wc, fr, fq, lds, wid, lane); S.done(cur); }
#undef PG8_STRIDES
#undef PG8_SA
#undef PG8_SB
#undef PG8_STAGE
#undef PG8_LDA
#undef PG8_LDB
#undef PG8_MMA
#undef PG8_WAIT_V
#undef PG8_WAIT_L
#undef PG8_BAR
#undef PG8_SCHED
}
}

#define DI __device__ __forceinline__
typedef unsigned short bf16;
typedef short bf16x8 __attribute__((ext_vector_type(8)));
typedef float f32x4 __attribute__((ext_vector_type(4)));
typedef unsigned u32x4 __attribute__((ext_vector_type(4)));
typedef unsigned u32x2 __attribute__((ext_vector_type(2)));

constexpr int D = 1024, NBATCH = 4, T = 4096, M = NBATCH * T, IN_TOTAL = 12184;
constexpr int LDP = 7168;
constexpr int C_RQ = 0, C_RK = 256, C_RV = 512, C_RG = 1024, C_GQ = 1536, C_GK = 1792, C_GV = 2048, C_GG = 2560,
              C_SX = 3072, C_SZ = 4096, C_WR = 4608, C_WK = 5120, C_WV = 5632, C_WL = 6144, C_AL = 6208, C_WG = 6272,
              C_MQ = 6784, C_GKL = 7040, C_SDT = 7056;
enum { I_X = 0, I_MEM, I_POS, I_NORMG, I_WIN, I_GKW2, I_GKB, I_GNORMG, I_CONVW, I_CONVB, I_DTB, I_ALOG, I_SD, I_SNORMG,
       I_MU, I_W0, I_W2, I_A0, I_A2, I_KK, I_KA, I_RK, I_LNG, I_LNB, I_MNORMG, I_WKV, I_URET, I_UGLA, I_USSD, I_URWKV,
       I_UMEM, I_WOUT, I_FNORMG, N_IN };
constexpr size_t MiB = 1u << 20;
constexpr size_t WS_SSQ = 0;
constexpr size_t WS_DG = 512 * 1024;
constexpr size_t WS_DS = 576 * 1024;
constexpr size_t WS_BAR = 640 * 1024;
constexpr size_t WS_KM = 1 * MiB;
constexpr size_t WS_VMT = 1 * MiB + 512 * 1024;
constexpr size_t WS_MEMN = 2 * MiB;
constexpr size_t WS_BND = 6 * MiB;
constexpr int BND_W = 1792;
constexpr size_t WS_XS = 7 * MiB;
constexpr size_t WS_XCNT = 640 * 1024 + 16384;
constexpr size_t WS_ZERO_BYTES = 16384 + 2 * 64 * 256;
constexpr size_t WS_W1T = 8 * MiB;
constexpr size_t WS_WGT = 22 * MiB;
constexpr size_t WS_UT = 32 * MiB;
constexpr size_t WS_UST = 35 * MiB;
constexpr size_t WS_UMT = 36 * MiB;
constexpr size_t WS_WOT = 37 * MiB;
constexpr size_t WS_WKVT = 39 * MiB;
constexpr size_t WS_XN = 40 * MiB;
constexpr size_t WS_P = 72 * MiB;
constexpr size_t WS_OMEM = 296 * MiB;
constexpr size_t WS_RETL = 304 * MiB;
constexpr size_t WS_GLAL = 312 * MiB;
constexpr size_t WS_SSDL = 320 * MiB;
constexpr size_t WS_MRG = 304 * MiB;
constexpr size_t WS_RWGH = 336 * MiB;
constexpr size_t WS_END = 368 * MiB;

constexpr int LDS_BYTES = 147456;
constexpr int NTHREADS = 512;

struct Params { const float* in[N_IN]; float* out; unsigned char* ws; };

DI float bf2f(unsigned b) { return __uint_as_float(b << 16); }
typedef __bf16 bf16n2 __attribute__((ext_vector_type(2)));
DI unsigned f2bf(float f) { const __bf16 b = (__bf16)f; return (unsigned)__builtin_bit_cast(unsigned short, b); }
DI unsigned pk2(float lo, float hi) { const bf16n2 v = {(__bf16)lo, (__bf16)hi}; return __builtin_bit_cast(unsigned, v); }
DI float lo16(unsigned u) { return __uint_as_float(u << 16); }
DI float hi16(unsigned u) { return __uint_as_float(u & 0xffff0000u); }
DI void unpack8(u32x4 v, float* f) { f[0] = lo16(v.x); f[1] = hi16(v.x); f[2] = lo16(v.y); f[3] = hi16(v.y); f[4] = lo16(v.z); f[5] = hi16(v.z); f[6] = lo16(v.w); f[7] = hi16(v.w); }
DI u32x4 pack8(const float* f) { u32x4 v; v.x = pk2(f[0], f[1]); v.y = pk2(f[2], f[3]); v.z = pk2(f[4], f[5]); v.w = pk2(f[6], f[7]); return v; }
DI u32x2 pack4(f32x4 a) { u32x2 v; v.x = pk2(a[0], a[1]); v.y = pk2(a[2], a[3]); return v; }
DI float fexp(float x) { return __expf(x); }
DI float sigmoidf_(float x) { return __builtin_amdgcn_rcpf(1.0f + __expf(-x)); }
DI float siluf_(float x) { return x * __builtin_amdgcn_rcpf(1.0f + __expf(-x)); }
DI float softplusf_(float x) { return fmaxf(x, 0.0f) + __logf(1.0f + __expf(-fabsf(x))); }
DI float logsigmoidf_(float x) { return fminf(x, 0.0f) - __logf(1.0f + __expf(-fabsf(x))); }
DI float tanhf_(float x) { const float e = __expf(2.0f * x); return 1.0f - 2.0f * __builtin_amdgcn_rcpf(e + 1.0f); }
DI int opaque_tid() { int t = threadIdx.x; asm volatile("" : "+v"(t)); return t; }
#ifdef TPROBE
#define TS_BASE(lds_) ((volatile unsigned*)((lds_) + LDS_BYTES - 64) + 2)
#define TS_BEGIN() do { if (threadIdx.x == 0) TS_BASE(lds)[13] = (unsigned)__builtin_amdgcn_s_memrealtime(); } while (0)
#define TS_MARK(k) do { if (threadIdx.x == 0) { const unsigned t_ = (unsigned)__builtin_amdgcn_s_memrealtime(); volatile unsigned* A_ = TS_BASE(lds); A_[k] += t_ - A_[13]; A_[13] = t_; } } while (0)
#endif
#define WAVE_LDS_SYNC() asm volatile("s_waitcnt lgkmcnt(0)" ::: "memory")
DI float wave_sum(float v) {
#pragma unroll
    for (int o = 1; o < 64; o <<= 1) v += __shfl_xor(v, o);
    return v;
}
DI bf16x8 frag(const bf16* base, int ld, int r0, int k0, int lane) { return *(const bf16x8*)(base + (r0 + (lane & 15)) * ld + k0 + ((lane >> 4) << 3)); }
DI f32x4 mfma16(bf16x8 a, bf16x8 b, f32x4 c) { return __builtin_amdgcn_mfma_f32_16x16x32_bf16(a, b, c, 0, 0, 0); }

DI void tile_map(int L, int nM, int nN, int& pm, int& pn) {
    const int nwg = nM * nN; int wgid = L;
    { const int q = nwg / 8, r = nwg % 8, xcd = wgid % 8, off = wgid / 8; wgid = (xcd < r ? xcd * (q + 1) : r * (q + 1) + (xcd - r) * q) + off; }
    const int nig = 8 * nN, gid = wgid / nig, fm = gid * 8, gsz = (nM - fm) < 8 ? (nM - fm) : 8;
    pm = fm + ((wgid % nig) % gsz); pn = (wgid % nig) / gsz;
}

using pg8::Unit;
struct SchedP1 {
    int G, c; const char* A; const char* B;
    DI bool next(int i, Unit& u) const {
        const long L = (long)i * G + c; if (L >= 64 * 28) return false;
        tile_map((int)L, 64, 28, u.pm, u.pn); u.kind = 0; u.aux = 0; u.nt = 16; u.lda = 1024; u.ldb = 1024; u.pad_ = 0;
        u.A = A + (size_t)u.pm * 256 * 1024 * 2; u.B = B + (size_t)u.pn * 256 * 1024 * 2; return true;
    }
    DI void a_ready(const Unit&) const {}
    DI void done(const Unit&) const {}
};
struct EpiP {
    static constexpr bool PERM = true, AFTER_DRAIN = false;
    bf16* O; bf16* BND;
    DI void operator()(const f32x4 (&acc)[2][2][4][2], const Unit& u, int wr, int wc, int fr, int fq) const {
        const int row0 = u.pm * 256 + wr * 64 + fr, col0 = u.pn * 256 + wc * 32 + 8 * fq;
#pragma unroll
        for (int ai = 0; ai < 2; ++ai)
#pragma unroll
            for (int m = 0; m < 4; ++m) { bf16* rowp = O + (size_t)(row0 + ai * 128 + m * 16) * LDP + col0;
#pragma unroll
                for (int bj = 0; bj < 2; ++bj) { const f32x4 v0 = acc[ai][bj][m][0], v1 = acc[ai][bj][m][1];
                    u32x4 w; w.x = pk2(v0[0], v0[1]); w.y = pk2(v0[2], v0[3]); w.z = pk2(v1[0], v1[1]); w.w = pk2(v1[2], v1[3]);
                    *(u32x4*)(rowp + bj * 128) = w;
                    if (m == 3 && fr == 15 && u.pn >= 18 && u.pn <= 24) *(u32x4*)(BND + (size_t)((row0 + ai * 128 + m * 16) >> 6) * BND_W + (col0 - 4608) + bj * 128) = w; } }
    }
};
DI int gate_slot_col(int s) { return s < 8 ? 128 * s : s < 16 ? 1536 + 128 * (s - 8) : s < 24 ? 3072 + 128 * (s - 16) : s < 37 ? 4608 + 128 * (s - 24) : 6784 + 128 * (s - 37); }
struct SchedP3 {
    int pm, pn; const unsigned char* ws; int alt;
    DI bool next(int i0, Unit& u) const {
        if (i0 >= 11) return false;
        const int i = (int)(((alt ? 0xA9847263510ull : 0xA4982736150ull) >> (4 * i0)) & 15ull);
        u.pm = pm; u.pn = pn; u.pad_ = 0;
        if (i < 5) { u.kind = i; u.aux = 16; u.nt = 16; u.lda = 1024; u.ldb = 1024; u.A = (const char*)ws + WS_XN + (size_t)pm * 256 * 1024 * 2;
            u.B = (const char*)ws + WS_WGT + ((size_t)i * 1024 + (size_t)pn * 256) * 1024 * 2; }
        else if (i < 8) { const int j = i - 5; const int col = j == 0 ? C_RG : j == 1 ? C_GG : C_WG; u.kind = j == 0 ? 0 : j == 1 ? 1 : 3; u.aux = (j == 0) ? 1 : 0; u.nt = 8; u.lda = LDP; u.ldb = 512;
            u.A = (const char*)ws + WS_P + ((size_t)pm * 256 * LDP + col) * 2;
            u.B = (const char*)ws + WS_UT + ((size_t)j * 1024 + (size_t)pn * 256) * 512 * 2; }
        else if (i < 10) { const int j = i - 8; u.kind = 2; u.aux = (j + 1) << 1; u.nt = 4; u.lda = LDP; u.ldb = 256;
            u.A = (const char*)ws + WS_P + ((size_t)pm * 256 * LDP + C_SZ + j * 256) * 2;
            u.B = (const char*)ws + WS_UST + ((size_t)j * 1024 + (size_t)pn * 256) * 256 * 2; }
        else { u.kind = 4; u.aux = 0; u.nt = 4; u.lda = 256; u.ldb = 256; u.A = (const char*)ws + WS_OMEM + (size_t)pm * 256 * 256 * 2;
            u.B = (const char*)ws + WS_UMT + ((size_t)pn * 256) * 256 * 2; }
        return true;
    }
    DI void a_ready(const Unit&) const {}
    DI void done(const Unit&) const {}
};
typedef float f32x2 __attribute__((ext_vector_type(2)));
DI f32x2 sig255_pk(f32x2 x) {
    x = __builtin_elementwise_min(__builtin_elementwise_max(x, (f32x2){-7.0f, -7.0f}), (f32x2){7.0f, 7.0f});
    const f32x2 x2 = x * x;
    f32x2 q = x2 * 9.362619013e-11f + (-1.716749942e-08f);
    q = q * x2 + 1.283517804e-06f; q = q * x2 + (-5.098115798e-05f); q = q * x2 + 1.195220742e-03f; q = q * x2 + (-1.824038848e-02f); q = q * x2 + 2.476293743e-01f;
    return (x * q) * 255.0f + 128.0f;
}
DI f32x2 sig_pk(f32x2 x) { return (sig255_pk(x) - 128.0f) * (1.0f / 255.0f) + 0.5f; }
struct EpiGate {
    static constexpr bool PERM = true, AFTER_DRAIN = false;
    bf16* P;
    DI void operator()(const f32x4 (&acc)[2][2][4][2], const Unit& u, int wr, int wc, int fr, int fq) const {
        const int row0 = u.pm * 256 + wr * 64 + fr;
#pragma unroll
        for (int bj = 0; bj < 2; ++bj) { const int col = gate_slot_col((u.kind * 4 + u.pn) * 2 + bj);
#pragma unroll
            for (int ai = 0; ai < 2; ++ai)
#pragma unroll
                for (int m = 0; m < 4; ++m) { const f32x4 v0 = acc[ai][bj][m][0], v1 = acc[ai][bj][m][1];
                    const f32x2 a = sig255_pk((f32x2){v0[0], v0[1]}), b = sig255_pk((f32x2){v0[2], v0[3]}), c = sig255_pk((f32x2){v1[0], v1[1]}), d = sig255_pk((f32x2){v1[2], v1[3]});
                    u32x2 w; w.x = (unsigned)a.x | ((unsigned)a.y << 8) | ((unsigned)b.x << 16) | ((unsigned)b.y << 24);
                    w.y = (unsigned)c.x | ((unsigned)c.y << 8) | ((unsigned)d.x << 16) | ((unsigned)d.y << 24);
                    *(u32x2*)((unsigned char*)(P + (size_t)(row0 + ai * 128 + m * 16) * LDP + col) + wc * 32 + 8 * fq) = w; } }
    }
};
struct EpiBranch {
    static constexpr bool PERM = true, AFTER_DRAIN = false;
    const bf16* P; bf16* MG; const float* ssq;
    DI void operator()(const f32x4 (&acc)[2][2][4][2], const Unit& u, int wr, int wc, int fr, int fq) const {
        const int row0 = u.pm * 256 + wr * 64 + fr; const bool first = (u.aux & 1) != 0; const int grp = (u.aux >> 1) - 1;
        const int gc0 = gate_slot_col((u.kind * 4 + u.pn) * 2 + 0), gc1 = gate_slot_col((u.kind * 4 + u.pn) * 2 + 1);
        u32x2 g8[2][2][2]; u32x4 o8[2][2][2]; f32x4 s4[2][2];
#define EB_LOAD(buf, ai, mh) do { \
        _Pragma("unroll") for (int m2 = 0; m2 < 2; ++m2) { const int row = row0 + (ai) * 128 + (2 * (mh) + m2) * 16; \
            s4[buf][m2] = *(const f32x4*)(ssq + (size_t)row * 8 + (grp > 0 ? 4 : 0)); \
            _Pragma("unroll") for (int bj = 0; bj < 2; ++bj) { \
                g8[buf][m2][bj] = *(const u32x2*)((const unsigned char*)(P + (size_t)row * LDP + (bj ? gc1 : gc0)) + wc * 32 + 8 * fq); \
                o8[buf][m2][bj] = *(const u32x4*)(MG + (size_t)row * 1024 + u.pn * 256 + bj * 128 + wc * 32 + 8 * fq); } } } while (0)
#define EB_COMP(buf, ai, mh) do { \
        _Pragma("unroll") for (int m2 = 0; m2 < 2; ++m2) { const int m = 2 * (mh) + m2, row = row0 + (ai) * 128 + m * 16; \
            const float sc = (grp >= 0) ? __builtin_amdgcn_rsqf(((s4[buf][m2][0] + s4[buf][m2][1]) + (s4[buf][m2][2] + s4[buf][m2][3])) * (1.0f / 256.0f) + 1e-6f) : 1.0f; \
            _Pragma("unroll") for (int bj = 0; bj < 2; ++bj) { float g[8], pv[8]; \
                _Pragma("unroll") for (int j = 0; j < 4; ++j) { g[j] = (float)((g8[buf][m2][bj].x >> (8 * j)) & 0xffu) * (1.0f / 255.0f); g[4 + j] = (float)((g8[buf][m2][bj].y >> (8 * j)) & 0xffu) * (1.0f / 255.0f); } \
                unpack8(o8[buf][m2][bj], pv); \
                if (first) { _Pragma("unroll") for (int j = 0; j < 8; ++j) pv[j] = 0.f; } \
                const f32x4 v0 = acc[ai][bj][m][0], v1 = acc[ai][bj][m][1]; \
                float o[8] = { v0[0] * sc * g[0] + pv[0], v0[1] * sc * g[1] + pv[1], v0[2] * sc * g[2] + pv[2], v0[3] * sc * g[3] + pv[3], v1[0] * sc * g[4] + pv[4], v1[1] * sc * g[5] + pv[5], v1[2] * sc * g[6] + pv[6], v1[3] * sc * g[7] + pv[7] }; \
                *(u32x4*)(MG + (size_t)row * 1024 + u.pn * 256 + bj * 128 + wc * 32 + 8 * fq) = pack8(o); } } } while (0)
        EB_LOAD(0, 0, 0); EB_LOAD(1, 0, 1);
        __builtin_amdgcn_sched_barrier(0);
        EB_COMP(0, 0, 0); EB_LOAD(0, 1, 0);
        __builtin_amdgcn_sched_barrier(0);
        EB_COMP(1, 0, 1); EB_LOAD(1, 1, 1);
        __builtin_amdgcn_sched_barrier(0);
        EB_COMP(0, 1, 0);
        __builtin_amdgcn_sched_barrier(0);
        EB_COMP(1, 1, 1);
#undef EB_LOAD
#undef EB_COMP
    }
};
struct EpiP3 {
    static constexpr bool PERM = true, AFTER_DRAIN = false;
    EpiGate G; EpiBranch B;
    DI void operator()(const f32x4 (&acc)[2][2][4][2], const Unit& u, int wr, int wc, int fr, int fq) const { if (u.aux & 16) G(acc, u, wr, wc, fr, fq); else B(acc, u, wr, wc, fr, fq); }
};
struct SchedP4 {
    int G, c; const char* A; const char* B;
    DI bool next(int i, Unit& u) const {
        const long L = (long)i * G + c; if (L >= 64 * 4) return false;
        tile_map((int)L, 64, 4, u.pm, u.pn); u.kind = 0; u.aux = 0; u.nt = 16; u.lda = 1024; u.ldb = 1024; u.pad_ = 0;
        u.A = A + (size_t)u.pm * 256 * 1024 * 2; u.B = B + (size_t)u.pn * 256 * 1024 * 2; return true;
    }
    DI void a_ready(const Unit&) const {}
    DI void done(const Unit&) const {}
};
struct EpiRes {
    static constexpr bool PERM = false, AFTER_DRAIN = false;
    const float* res; float* out;
    DI void operator()(const f32x4 (&acc)[2][2][4][2], const Unit& u, int wr, int wc, int fr, int fq) const {
        const int row0 = u.pm * 256 + wr * 64 + fr, col0 = u.pn * 256 + wc * 32 + 4 * fq;
#pragma unroll
        for (int ai = 0; ai < 2; ++ai)
#pragma unroll
            for (int m = 0; m < 4; ++m) { const size_t off = (size_t)(row0 + ai * 128 + m * 16) * 1024 + col0;
#pragma unroll
                for (int bj = 0; bj < 2; ++bj)
#pragma unroll
                    for (int n = 0; n < 2; ++n) { const f32x4 r = *(const f32x4*)(res + off + bj * 128 + n * 16); *(f32x4*)(out + off + bj * 128 + n * 16) = r + acc[ai][bj][m][n]; } }
    }
};

template <bool LAST> struct EpiNorm {
    static constexpr bool PERM = false, AFTER_DRAIN = true;
    const float* res; float* out; const float* g; bf16* xn; float* xs; unsigned* cnt;
    DI void operator()(const f32x4 (&)[2][2][4][2], const Unit&, int, int, int, int) const {}
    DI void fused(f32x4 (&acc)[2][2][4][2], const Unit& u, int wr, int wc, int fr, int fq, PG8_LAS unsigned char* lds, int wid, int lane) const {
        PG8_LAS float* Pt = (PG8_LAS float*)lds; PG8_LAS float* St = Pt + 1024;
        const int row0 = u.pm * 256 + wr * 64 + fr, col0 = u.pn * 256 + wc * 32 + 4 * fq;
#pragma unroll
        for (int ai = 0; ai < 2; ++ai)
#pragma unroll
            for (int m = 0; m < 4; ++m) { const size_t off = (size_t)(row0 + ai * 128 + m * 16) * 1024 + col0; float s = 0.f;
#pragma unroll
                for (int bj = 0; bj < 2; ++bj)
#pragma unroll
                    for (int n = 0; n < 2; ++n) { const f32x4 r = *(const f32x4*)(res + off + bj * 128 + n * 16); const f32x4 x = r + acc[ai][bj][m][n]; acc[ai][bj][m][n] = x;
                        s += (x[0] * x[0] + x[1] * x[1]) + (x[2] * x[2] + x[3] * x[3]); }
                s += __shfl_xor(s, 16); s += __shfl_xor(s, 32);
                if (fq == 0) Pt[(ai * 128 + wr * 64 + m * 16 + fr) * 4 + wc] = s; }
        asm volatile("s_waitcnt lgkmcnt(0)" ::: "memory"); __builtin_amdgcn_s_barrier(); asm volatile("" ::: "memory");
        const int row = wid * 32 + (lane & 31);
        if (lane < 32) { const float t = (Pt[row * 4 + 0] + Pt[row * 4 + 1]) + (Pt[row * 4 + 2] + Pt[row * 4 + 3]);
            __hip_atomic_store(xs + ((size_t)u.pm * 256 + row) * 4 + u.pn, t, __ATOMIC_RELAXED, __HIP_MEMORY_SCOPE_AGENT); }
        asm volatile("s_waitcnt vmcnt(0)" ::: "memory");
        if (lane == 0) (void)__hip_atomic_fetch_add(cnt + u.pm * 64, 1u, __ATOMIC_RELAXED, __HIP_MEMORY_SCOPE_AGENT);
        if (wid == 0) { unsigned spins = 0;
            while ((unsigned)__builtin_amdgcn_readfirstlane(__hip_atomic_load(cnt + u.pm * 64, __ATOMIC_RELAXED, __HIP_MEMORY_SCOPE_AGENT)) < 32u) { __builtin_amdgcn_s_sleep(2); if (++spins > (1u << 22)) break; }
            __builtin_amdgcn_fence(__ATOMIC_ACQUIRE, "agent"); asm volatile("s_waitcnt vmcnt(0)" ::: "memory"); }
        asm volatile("" ::: "memory"); __builtin_amdgcn_s_barrier(); asm volatile("" ::: "memory");
        if (lane < 32) { const float* sp = xs + ((size_t)u.pm * 256 + row) * 4;
            const float a = __hip_atomic_load(sp + 0, __ATOMIC_RELAXED, __HIP_MEMORY_SCOPE_AGENT), b = __hip_atomic_load(sp + 1, __ATOMIC_RELAXED, __HIP_MEMORY_SCOPE_AGENT),
                        c = __hip_atomic_load(sp + 2, __ATOMIC_RELAXED, __HIP_MEMORY_SCOPE_AGENT), d = __hip_atomic_load(sp + 3, __ATOMIC_RELAXED, __HIP_MEMORY_SCOPE_AGENT);
            St[row] = __builtin_amdgcn_rsqf(((a + b) + (c + d)) * (1.0f / 1024.0f) + 1e-6f); }
        asm volatile("s_waitcnt lgkmcnt(0)" ::: "memory"); __builtin_amdgcn_s_barrier(); asm volatile("" ::: "memory");
#pragma unroll
        for (int ai = 0; ai < 2; ++ai)
#pragma unroll
            for (int m = 0; m < 4; ++m) { const size_t off = (size_t)(row0 + ai * 128 + m * 16) * 1024 + col0; const float rs = St[ai * 128 + wr * 64 + m * 16 + fr];
#pragma unroll
                for (int bj = 0; bj < 2; ++bj)
#pragma unroll
                    for (int n = 0; n < 2; ++n) { const f32x4 gv = *(const f32x4*)(g + col0 + bj * 128 + n * 16); const f32x4 x = acc[ai][bj][m][n]; const f32x4 y = x * rs * gv;
                        if (LAST) *(f32x4*)(out + off + bj * 128 + n * 16) = y;
                        else { *(f32x4*)(out + off + bj * 128 + n * 16) = x; *(u32x2*)(xn + off + bj * 128 + n * 16) = pack4(y); } } }
    }
};

DI void transpose_item(const float* W, int ldw, int K, bf16* WT, float* scr, int item, int nblk, int lane) {
    const int kb = item / nblk, nb = item % nblk, k0 = 64 * kb, n0 = 32 * nb;
    float tv[32];
#pragma unroll
    for (int i = 0; i < 32; ++i) { const int kk = 2 * i + (lane >> 5); tv[i] = W[(size_t)(k0 + kk) * ldw + n0 + (lane & 31)]; }
#pragma unroll
    for (int i = 0; i < 32; ++i) { const int kk = 2 * i + (lane >> 5); scr[kk * 33 + (lane & 31)] = tv[i]; }
    WAVE_LDS_SYNC();
    const int c = lane & 7;
#pragma unroll
    for (int j = 0; j < 4; ++j) { const int n = (lane >> 3) + 8 * j; const float* s = scr + (8 * c) * 33 + n;
        u32x4 o; o.x = pk2(s[0 * 33], s[1 * 33]); o.y = pk2(s[2 * 33], s[3 * 33]); o.z = pk2(s[4 * 33], s[5 * 33]); o.w = pk2(s[6 * 33], s[7 * 33]);
        *(u32x4*)(WT + (size_t)(n0 + n) * K + k0 + 8 * c) = o; }
    WAVE_LDS_SYNC();
}
struct TSeg { int inp, lstride, src0, ldw, K, nblk; unsigned dst_q, dst_rows0; };
DI void rms_row_bf16(const float* xrow, const float* g, bf16* orow, int lane) {
    const f32x4* xr = (const f32x4*)xrow + lane; const f32x4* gr = (const f32x4*)g + lane;
    f32x4 v[4]; float s = 0.f;
#pragma unroll
    for (int j = 0; j < 4; ++j) { v[j] = xr[64 * j]; s += (v[j][0] * v[j][0] + v[j][1] * v[j][1]) + (v[j][2] * v[j][2] + v[j][3] * v[j][3]); }
    const float rstd = __builtin_amdgcn_rsqf(wave_sum(s) * (1.0f / 1024.0f) + 1e-6f);
    u32x2* o8 = (u32x2*)orow + lane;
#pragma unroll
    for (int j = 0; j < 4; ++j) { const f32x4 gg = gr[64 * j]; u32x2 o; o.x = pk2(v[j][0] * rstd * gg[0], v[j][1] * rstd * gg[1]); o.y = pk2(v[j][2] * rstd * gg[2], v[j][3] * rstd * gg[3]); o8[64 * j] = o; }
}
DI void convert_weights(const Params& p, int l, unsigned char* lds) {
    const int tid = opaque_tid(), lane = tid & 63, wave = tid >> 6;
    const int gw = blockIdx.x * 8 + wave, NGW = gridDim.x * 8;
    float* scr = (float*)(lds + wave * 16384);
    static constexpr TSeg segs[] = {
        {I_WIN, 1024 * IN_TOTAL, 0,    IN_TOTAL, 1024, 2560 / 32, 32, 0},
        {I_WIN, 1024 * IN_TOTAL, 2576, IN_TOTAL, 1024, 512 / 32,  32, 2560},
        {I_WIN, 1024 * IN_TOTAL, 3088, IN_TOTAL, 1024, 1024 / 32, 32, 3072},
        {I_WIN, 1024 * IN_TOTAL, 4120, IN_TOTAL, 1024, 512 / 32,  32, 4096},
        {I_WIN, 1024 * IN_TOTAL, 4632, IN_TOTAL, 1024, 1664 / 32, 32, 4608},
        {I_WIN, 1024 * IN_TOTAL, 6296, IN_TOTAL, 1024, 512 / 32,  32, 6272},
        {I_WIN, 1024 * IN_TOTAL, 6808, IN_TOTAL, 1024, 256 / 32,  32, 6784},
        {I_WIN, 1024 * IN_TOTAL, 7064, IN_TOTAL, 1024, 5120 / 32, 88, 0},
        {I_URET,  512 * 1024, 0, 1024, 512, 32, 128, 0},
        {I_UGLA,  512 * 1024, 0, 1024, 512, 32, 128, 1024},
        {I_URWKV, 512 * 1024, 0, 1024, 512, 32, 128, 2048},
        {I_USSD,  512 * 1024, 0,          1024, 256, 32, 140, 0},
        {I_USSD,  512 * 1024, 256 * 1024, 1024, 256, 32, 140, 1024},
        {I_UMEM,  256 * 1024, 0, 1024, 256, 32, 144, 0},
        {I_WOUT, 1024 * 1024, 0, 1024, 1024, 32, 148, 0},
        {I_WKV,  1024 * 512,  0, 512,  1024, 16, 156, 0},
    };
    constexpr int NSEG = sizeof(segs) / sizeof(segs[0]);
    int base = 0;
    for (int s = 0; s < NSEG; ++s) {
        const TSeg sg = segs[s]; const int nitems = (sg.K / 64) * sg.nblk;
        int it = gw - (base % NGW); if (it < 0) it += NGW;
        const float* W = p.in[sg.inp] + (size_t)l * sg.lstride + sg.src0;
        bf16* WT = (bf16*)(p.ws + (size_t)sg.dst_q * 262144) + (size_t)sg.dst_rows0 * sg.K;
        for (; it < nitems; it += NGW) transpose_item(W, sg.ldw, sg.K, WT, scr, it, sg.nblk, lane);
        base += nitems;
    }
    for (int idx = blockIdx.x * NTHREADS + tid; idx < 128 * 1024; idx += gridDim.x * NTHREADS) {
        const int r = (idx >> 10) & 127, k = idx & 1023;
        const float* W = p.in[I_WIN] + (size_t)l * 1024 * IN_TOTAL + (size_t)k * IN_TOTAL;
        const float v = r < 16 ? W[2560 + r] : r < 24 ? W[4112 + (r - 16)] : 0.0f;
        ((bf16*)(p.ws + WS_W1T))[((size_t)7040 + r) * 1024 + k] = (bf16)f2bf(v);
    }
}
DI void rms_rows2_bf16(const float* x0, const float* x1, const float* g, bf16* o0, bf16* o1, int lane) {
    const f32x4* xa = (const f32x4*)x0 + lane; const f32x4* xb = (const f32x4*)x1 + lane; const f32x4* gr = (const f32x4*)g + lane;
    f32x4 va[4], vb[4]; float sa = 0.f, sb = 0.f;
#pragma unroll
    for (int j = 0; j < 4; ++j) { va[j] = xa[64 * j]; vb[j] = xb[64 * j]; }
#pragma unroll
    for (int j = 0; j < 4; ++j) { sa += (va[j][0] * va[j][0] + va[j][1] * va[j][1]) + (va[j][2] * va[j][2] + va[j][3] * va[j][3]); sb += (vb[j][0] * vb[j][0] + vb[j][1] * vb[j][1]) + (vb[j][2] * vb[j][2] + vb[j][3] * vb[j][3]); }
    const float ra = __builtin_amdgcn_rsqf(wave_sum(sa) * (1.0f / 1024.0f) + 1e-6f), rb = __builtin_amdgcn_rsqf(wave_sum(sb) * (1.0f / 1024.0f) + 1e-6f);
    u32x2* pa = (u32x2*)o0 + lane; u32x2* pb = (u32x2*)o1 + lane;
#pragma unroll
    for (int j = 0; j < 4; ++j) { const f32x4 gg = gr[64 * j]; u32x2 o; o.x = pk2(va[j][0] * ra * gg[0], va[j][1] * ra * gg[1]); o.y = pk2(va[j][2] * ra * gg[2], va[j][3] * ra * gg[3]); pa[64 * j] = o;
        o.x = pk2(vb[j][0] * rb * gg[0], vb[j][1] * rb * gg[1]); o.y = pk2(vb[j][2] * rb * gg[2], vb[j][3] * rb * gg[3]); pb[64 * j] = o; }
}
DI void phase_prologue(const Params& p, unsigned char* lds) {
    const int tid = opaque_tid(), lane = tid & 63, wave = tid >> 6;
    const int gw = blockIdx.x * 8 + wave, NGW = gridDim.x * 8;
    convert_weights(p, 0, lds);
    for (int m = gw; m < M; m += 2 * NGW) { const int m1 = m + NGW;
        if (m1 < M) rms_rows2_bf16(p.in[I_X] + (size_t)m * 1024, p.in[I_X] + (size_t)m1 * 1024, p.in[I_NORMG], (bf16*)(p.ws + WS_XN) + (size_t)m * 1024, (bf16*)(p.ws + WS_XN) + (size_t)m1 * 1024, lane);
        else rms_row_bf16(p.in[I_X] + (size_t)m * 1024, p.in[I_NORMG], (bf16*)(p.ws + WS_XN) + (size_t)m * 1024, lane); }
    for (int m = gw; m < 2048; m += NGW) { const int l = m >> 10, r = m & 1023;
        rms_row_bf16(p.in[I_MEM] + (size_t)r * 1024, p.in[I_MNORMG] + l * 1024, (bf16*)(p.ws + WS_MEMN) + (size_t)m * 1024, lane); }
}
DI void phase_norm(const Params& p, int l, float oscale, unsigned char* lds) {
    const int tid = opaque_tid(), lane = tid & 63, wave = tid >> 6;
    const int gw = blockIdx.x * 8 + wave, NGW = gridDim.x * 8;
    if (l == 0) { convert_weights(p, 1, lds); for (int m = gw; m < M; m += NGW) rms_row_bf16(p.out + (size_t)m * 1024, p.in[I_NORMG] + 1024, (bf16*)(p.ws + WS_XN) + (size_t)m * 1024, lane); }
    else {
        for (int m = gw; m < M; m += NGW) {
            f32x4* xr = (f32x4*)(p.out + (size_t)m * 1024) + lane; const f32x4* gr = (const f32x4*)p.in[I_FNORMG] + lane;
            f32x4 v[4]; float s = 0.f;
#pragma unroll
            for (int j = 0; j < 4; ++j) { v[j] = xr[64 * j]; s += (v[j][0] * v[j][0] + v[j][1] * v[j][1]) + (v[j][2] * v[j][2] + v[j][3] * v[j][3]); }
            const float rstd = __builtin_amdgcn_rsqf(wave_sum(s) * (1.0f / 1024.0f) + 1e-6f);
#pragma unroll
            for (int j = 0; j < 4; ++j) xr[64 * j] = v[j] * (rstd * oscale) * gr[64 * j];
        }
    }
}

#define XB_TMO      128
#define XB_XCNT(j)  (256  + 64 * (j))
#define XB_XSUB(j)  (1280 + 64 * (j))
#define XB_XGEN(j)  (2304 + 64 * (j))
#define XB_TOP      3328
#define XB_TOPGEN   3392
#define XCD_BAR_WORDS 3456
#define XB_SPIN_CAP (1u << 18)

__device__ __forceinline__ unsigned xb_ld(unsigned* p)              { return __hip_atomic_load(p, __ATOMIC_RELAXED, __HIP_MEMORY_SCOPE_AGENT); }
__device__ __forceinline__ unsigned xb_add(unsigned* p, unsigned v) { return __hip_atomic_fetch_add(p, v, __ATOMIC_RELAXED, __HIP_MEMORY_SCOPE_AGENT); }
__device__ __forceinline__ unsigned xb_xcc_id() { return (unsigned)__builtin_amdgcn_s_getreg((3 << 11) | 20) & 0xFu; }
#define XB_SPIN(cond, bar) do { unsigned _sp = 0; while (cond) { __builtin_amdgcn_s_sleep(1); \
    if ((++_sp & 255u) == 0u) { if (xb_ld(&(bar)[XB_TMO])) break; if (_sp > XB_SPIN_CAP) { atomicAdd(&(bar)[XB_TMO], 1u); break; } } } } while (0)

struct XcdBarrier {
    unsigned* bar; unsigned x;
    volatile unsigned* st;
};

__device__ __forceinline__ XcdBarrier xcd_barrier_post(unsigned* bar, volatile unsigned* st) {
    XcdBarrier b; b.bar = bar; b.x = xb_xcc_id(); b.st = st;
    if (threadIdx.x == 0) (void)xb_add(&bar[XB_XCNT(b.x)], 1u);
    return b;
}
__device__ __forceinline__ void xcd_barrier_complete(unsigned* bar, unsigned x, unsigned& nloc, unsigned& nx) {
    const unsigned G = gridDim.x * gridDim.y * gridDim.z;
    unsigned sum, cnt, mine, sp = 0u;
    for (;;) {
        sum = 0u; cnt = 0u; mine = 0u;
#pragma unroll
        for (unsigned j = 0; j < 16; ++j) { const unsigned c = xb_ld(&bar[XB_XCNT(j)]); sum += c; cnt += (c > 0u) ? 1u : 0u; mine = (j == x) ? c : mine; }
        if (sum == G) break;
        __builtin_amdgcn_s_sleep(1);
        if ((++sp & 255u) == 0u) { if (xb_ld(&bar[XB_TMO])) break; if (sp > XB_SPIN_CAP) { atomicAdd(&bar[XB_TMO], 1u); break; } }
    }
    nloc = mine > 0u ? mine : 1u; nx = cnt > 0u ? cnt : 1u;
}

__device__ __forceinline__ void xcd_barrier(const XcdBarrier& b) {
    asm volatile("s_waitcnt vmcnt(0)" ::: "memory");
    __syncthreads();
    if (threadIdx.x == 0) {
        unsigned* bar = b.bar;
        __builtin_amdgcn_s_waitcnt(0);
        unsigned nloc = b.st[0], nx = b.st[1];
        if (nloc == 0u) { xcd_barrier_complete(bar, b.x, nloc, nx); b.st[0] = nloc; b.st[1] = nx; }
        const unsigned old = xb_add(&bar[XB_XSUB(b.x)], 1u);
        const unsigned gen = old / nloc;
        if (old + 1u == (gen + 1u) * nloc) {
            __builtin_amdgcn_fence(__ATOMIC_RELEASE, "agent");
            asm volatile("s_waitcnt vmcnt(0)" ::: "memory");
            const unsigned og = xb_add(&bar[XB_TOP], 1u);
            const unsigned tg = og / nx;
            if (og + 1u == (tg + 1u) * nx) xb_add(&bar[XB_TOPGEN], 1u);
            else XB_SPIN(xb_ld(&bar[XB_TOPGEN]) == tg, bar);
            __builtin_amdgcn_fence(__ATOMIC_ACQUIRE, "agent");
            xb_add(&bar[XB_XGEN(b.x)], 1u);
            asm volatile("s_waitcnt vmcnt(0)" ::: "memory");
        } else {
            XB_SPIN(xb_ld(&bar[XB_XGEN(b.x)]) == gen, bar);
            __builtin_amdgcn_fence(__ATOMIC_ACQUIRE, "agent");
            asm volatile("s_waitcnt vmcnt(0)" ::: "memory");
        }
    }
    __syncthreads();
}

DI void sincos_red(float ang, float& s, float& c) {
    const float n = rintf(ang * 0.15915494309189535f); float r = fmaf(-n, 6.28318548202514648f, ang); r = fmaf(-n, -1.7484555e-7f, r);
    s = __sinf(r); c = __cosf(r);
}

typedef short s16x4 __attribute__((ext_vector_type(4)));
DI s16x4 lds_tr(const bf16* p) { return __builtin_amdgcn_ds_read_tr16_b64_v4i16((__attribute__((address_space(3))) s16x4*)p); }
DI bf16x8 frag_tr(const bf16* base, int ld, int r0, int k0, int lane) {
    const bf16* p = base + (k0 + 8 * (lane >> 4) + ((lane & 15) >> 2)) * ld + r0 + 4 * (lane & 3);
    const s16x4 lo = lds_tr(p), hi = lds_tr(p + 4 * ld);
    return (bf16x8){lo[0], lo[1], lo[2], lo[3], hi[0], hi[1], hi[2], hi[3]};
}
DI bf16x8 frag_tr_perm(const bf16* base, int ld, int r0, int k0, int lane) {
    const bf16* p = base + (k0 + 4 * (lane >> 4) + ((lane & 15) >> 2)) * ld + r0 + 4 * (lane & 3);
    const s16x4 lo = lds_tr(p), hi = lds_tr(p + 16 * ld);
    return (bf16x8){lo[0], lo[1], lo[2], lo[3], hi[0], hi[1], hi[2], hi[3]};
}
constexpr int QK_QIN = 0, QK_KIN = 9216, QK_QC = 18432, QK_KST = 27648, QK_VT = 36864, QK_GKL = 55296, QK_INV = 59392, QK_ST = 64512, QK_CUM = 82944, QK_TOT = 99328, QK_RED = 101376, QK_ELAST = 103424;
#if defined(TPROBE) && defined(QTS_SEL)
#define QTS_ON() (((QTS_SEL) & 1) == (GLA ? 1 : 0) && (((QTS_SEL) >> 1) == (full ? 0 : 1)))
#define QTS_BEGIN() do { if (QTS_ON() && threadIdx.x == 0) TS_BASE(lds)[13] = (unsigned)__builtin_amdgcn_s_memrealtime(); } while (0)
#define QTS_MARK(k) do { if (QTS_ON() && threadIdx.x == 0) { const unsigned t_ = (unsigned)__builtin_amdgcn_s_memrealtime(); volatile unsigned* A_ = TS_BASE(lds); A_[k] += t_ - A_[13]; A_[13] = t_; } } while (0)
#else
#define QTS_BEGIN() do {} while (0)
#define QTS_MARK(k) do {} while (0)
#endif
template <bool GLA>
DI void qkv_item(const Params& p, int l, unsigned char* lds, int b, int h, int sc, bool full, bool dry = false) {
    QTS_BEGIN();
    const int tid = opaque_tid(), lane = tid & 63, w = tid >> 6, q4 = lane >> 4, l15 = lane & 15;
    bf16* P = (bf16*)(p.ws + WS_P);
    bf16* QIN = (bf16*)(lds + QK_QIN); bf16* KIN = (bf16*)(lds + QK_KIN); bf16* QC = (bf16*)(lds + QK_QC); bf16* KST = (bf16*)(lds + QK_KST);
    bf16* VT = (bf16*)(lds + QK_VT); bf16* ST = (bf16*)(lds + QK_ST);
    float* GKL = (float*)(lds + QK_GKL); float* INV = (float*)(lds + QK_INV);
    float* CUM = (float*)(lds + QK_CUM); float* TOT = (float*)(lds + QK_TOT); float* RED = (float*)(lds + QK_RED); float* ELAST = (float*)(lds + QK_ELAST);
    const int cq = GLA ? C_GQ : C_RQ, ck = GLA ? C_GK : C_RK, cv = GLA ? C_GV : C_RV, cgate = GLA ? C_GG : C_RG;
    const int bh = b * 4 + h;
    float* Lst = (float*)(p.ws + (GLA ? WS_GLAL : WS_RETL)) + (size_t)(bh * 16 + sc) * 8192;
    const float lgam = __logf(1.0f - exp2f(-5.0f - (float)h));
    const int st_t = tid >> 3, st_cg = tid & 7;
    f32x4 sacc[4];
#pragma unroll
    for (int mt = 0; mt < 4; ++mt) {
        if (full) { for (int j = 0; j < 4; ++j) sacc[mt][j] = Lst[(16 * mt + 4 * q4 + j) * 128 + 16 * w + l15]; *(u32x2*)(ST + (16 * w + l15) * 72 + 16 * mt + 4 * q4) = pack4(sacc[mt]); }
        else sacc[mt] = (f32x4){0.f, 0.f, 0.f, 0.f};
    }
    f32x4 gng = (f32x4){1.f, 1.f, 1.f, 1.f}; if (GLA) gng = *(const f32x4*)(p.in[I_GNORMG] + l * 128 + 16 * w + 4 * q4);
    float w2c[16], gb = 0.f;
    if (GLA) { const int ch = h * 64 + lane;
#pragma unroll
        for (int j = 0; j < 16; ++j) w2c[j] = p.in[I_GKW2][(size_t)l * 16 * 256 + j * 256 + ch];
        gb = p.in[I_GKB][l * 256 + ch]; }
    else if (tid < 32) INV[tid] = 1.0f / powf(10000.0f, (float)tid * (1.0f / 31.0f));
    u32x4 pq, pk, pv0, pv1, pg = (u32x4){0u, 0u, 0u, 0u}; int ipos = 0;
    {   const size_t ro = (size_t)(b * T + sc * 256 + st_t) * LDP;
        pq = *(const u32x4*)(P + ro + cq + h * 64 + 8 * st_cg); pk = *(const u32x4*)(P + ro + ck + h * 64 + 8 * st_cg);
        pv0 = *(const u32x4*)(P + ro + cv + h * 128 + 8 * st_cg); pv1 = *(const u32x4*)(P + ro + cv + h * 128 + 64 + 8 * st_cg);
        if (GLA) { if (st_cg < 2) { float g8[8]; unpack8(*(const u32x4*)(P + ro + C_GKL + 8 * st_cg), g8);
                *(f32x4*)(GKL + st_t * 16 + 8 * st_cg) = (f32x4){g8[0], g8[1], g8[2], g8[3]}; *(f32x4*)(GKL + st_t * 16 + 8 * st_cg + 4) = (f32x4){g8[4], g8[5], g8[6], g8[7]}; } }
        else ipos = ((const int*)p.in[I_POS])[b * T + sc * 256 + st_t]; }
    __syncthreads();
    QTS_MARK(4);
    float dtot = 0.f;
    for (int c = 0; c < 4; ++c) {
        const int t0 = sc * 256 + c * 64, m0 = b * T + t0;
        if (GLA) {
            float cumv[8]; float run = 0.f;
#pragma unroll
            for (int i = 0; i < 8; ++i) { const float* gp = GKL + (8 * w + i) * 16; float x = gb;
#pragma unroll
                for (int j4 = 0; j4 < 4; ++j4) { const f32x4 g = *(const f32x4*)(gp + 4 * j4); x += g[0] * w2c[4 * j4] + g[1] * w2c[4 * j4 + 1] + g[2] * w2c[4 * j4 + 2] + g[3] * w2c[4 * j4 + 3]; }
                run += logsigmoidf_(x) * (1.0f / 16.0f); cumv[i] = run; }
            TOT[w * 64 + lane] = run;
            __syncthreads();
            float off = 0.f;
            for (int ww = 0; ww < w; ++ww) off += TOT[ww * 64 + lane];
#pragma unroll
            for (int i = 0; i < 8; ++i) CUM[(8 * w + i) * 64 + lane] = cumv[i] + off;
            __syncthreads();
            QTS_MARK(0);
        }
        {
            const int t = st_t, cg = st_cg;
            float qf[8], kf[8]; unpack8(pq, qf); unpack8(pk, kf);
            float fqin[8], fkin[8], fqc[8], fkst[8];
            if (GLA) {
#pragma unroll
                for (int i = 0; i < 8; ++i) { const float cu = CUM[t * 64 + 8 * cg + i], rf = CUM[32 * 64 + 8 * cg + i], la = CUM[63 * 64 + 8 * cg + i];
                    qf[i] *= 0.125f; fqin[i] = fexp(cu - rf); fkin[i] = fexp(rf - cu); fqc[i] = fexp(cu); fkst[i] = fexp(la - cu); }
            } else {
                const float ppos = (float)ipos;
#pragma unroll
                for (int i = 0; i < 4; ++i) { float sn, cs; sincos_red(ppos * INV[4 * cg + i], sn, cs);
                    const float q1 = qf[2 * i], q2 = qf[2 * i + 1], k1 = kf[2 * i], k2 = kf[2 * i + 1];
                    qf[2 * i] = q1 * cs - q2 * sn; qf[2 * i + 1] = q2 * cs + q1 * sn;
                    kf[2 * i] = (k1 * cs - k2 * sn) * 0.125f; kf[2 * i + 1] = (k2 * cs + k1 * sn) * 0.125f; }
                const float e = (float)(t + 1); const float a = fexp((e - 33.0f) * lgam), bq = fexp((33.0f - e) * lgam), cc = fexp(e * lgam), dd = fexp((64.0f - e) * lgam);
#pragma unroll
                for (int i = 0; i < 8; ++i) { fqin[i] = a; fkin[i] = bq; fqc[i] = cc; fkst[i] = dd; }
            }
            if (full) { float o1[8], o2[8], o3[8];
#pragma unroll
                for (int i = 0; i < 8; ++i) { o1[i] = qf[i] * fqin[i]; o2[i] = qf[i] * fqc[i]; o3[i] = kf[i] * fkin[i]; }
                *(u32x4*)(QIN + t * 72 + 8 * cg) = pack8(o1); *(u32x4*)(QC + t * 72 + 8 * cg) = pack8(o2); *(u32x4*)(KIN + t * 72 + 8 * cg) = pack8(o3); }
            { float o4[8];
#pragma unroll
              for (int i = 0; i < 8; ++i) o4[i] = kf[i] * fkst[i];
              *(u32x4*)(KST + t * 72 + 8 * cg) = pack8(o4); }
            *(u32x4*)(VT + t * 136 + 8 * cg) = pv0; *(u32x4*)(VT + t * 136 + 64 + 8 * cg) = pv1;
            if (tid < 64) { const float la = GLA ? CUM[63 * 64 + tid] : 64.0f * lgam; ELAST[tid] = fexp(la); dtot += la; }
            if (c < 3) {
                const size_t ro = (size_t)(m0 + 64 + t) * LDP;
                pq = *(const u32x4*)(P + ro + cq + h * 64 + 8 * cg); pk = *(const u32x4*)(P + ro + ck + h * 64 + 8 * cg);
                pv0 = *(const u32x4*)(P + ro + cv + h * 128 + 8 * cg); pv1 = *(const u32x4*)(P + ro + cv + h * 128 + 64 + 8 * cg);
                if (GLA) pg = *(const u32x4*)(P + ro + C_GKL + 8 * (cg & 1));
                else ipos = ((const int*)p.in[I_POS])[b * T + t0 + 64 + t]; }
        }
        __syncthreads();
        QTS_MARK(1);
        if (full) {
            u32x2 g2[4];
#pragma unroll
            for (int tt = 0; tt < 4; ++tt) g2[tt] = *(const u32x2*)(P + (size_t)(m0 + 16 * tt + l15) * LDP + cgate + h * 128 + 16 * w + 4 * q4);
            f32x4 oacc[4];
#pragma unroll
            for (int tt = 0; tt < 4; ++tt) {
                oacc[tt] = (f32x4){0.f, 0.f, 0.f, 0.f};
#pragma unroll
                for (int kk = 0; kk < 2; ++kk) oacc[tt] = mfma16(frag(ST, 72, 16 * w, 32 * kk, lane), frag(QC, 72, 16 * tt, 32 * kk, lane), oacc[tt]);
                const bf16x8 qa = frag(QIN, 72, 16 * tt, 0, lane), qb = frag(QIN, 72, 16 * tt, 32, lane);
                u32x2 pp[4];
#pragma unroll
                for (int st = 0; st < 4; ++st) {
                    if (st <= tt) { f32x4 a = (f32x4){0.f, 0.f, 0.f, 0.f};
                        a = mfma16(frag(KIN, 72, 16 * st, 0, lane), qa, a); a = mfma16(frag(KIN, 72, 16 * st, 32, lane), qb, a);
                        if (st == tt) {
#pragma unroll
                            for (int j = 0; j < 4; ++j) if (4 * q4 + j > l15) a[j] = 0.f; }
                        pp[st] = pack4(a); }
                    else pp[st] = (u32x2){0u, 0u}; }
#pragma unroll
                for (int kk2 = 0; kk2 < 2; ++kk2) { if (2 * kk2 <= tt) {
                        u32x4 pw; pw.x = pp[2 * kk2].x; pw.y = pp[2 * kk2].y; pw.z = pp[2 * kk2 + 1].x; pw.w = pp[2 * kk2 + 1].y;
                        oacc[tt] = mfma16(frag_tr_perm(VT, 136, 16 * w, 32 * kk2, lane), __builtin_bit_cast(bf16x8, pw), oacc[tt]); } }
                float ss = (oacc[tt][0] * oacc[tt][0] + oacc[tt][1] * oacc[tt][1]) + (oacc[tt][2] * oacc[tt][2] + oacc[tt][3] * oacc[tt][3]);
                ss += __shfl_xor(ss, 16); ss += __shfl_xor(ss, 32);
                if (q4 == 0) RED[(16 * tt + l15) * 8 + w] = ss; }
            __syncthreads();
            QTS_MARK(2);
#pragma unroll
            for (int tt = 0; tt < 4; ++tt) { const f32x4 r0 = *(const f32x4*)(RED + (16 * tt + l15) * 8), r1 = *(const f32x4*)(RED + (16 * tt + l15) * 8 + 4);
                const float rstd = __builtin_amdgcn_rsqf(((r0[0] + r0[1]) + (r0[2] + r0[3]) + (r1[0] + r1[1]) + (r1[2] + r1[3])) * (1.0f / 128.0f) + 1e-6f);
                bf16* gp = P + (size_t)(m0 + 16 * tt + l15) * LDP + cgate + h * 128 + 16 * w + 4 * q4;
                const float g[4] = {lo16(g2[tt].x), hi16(g2[tt].x), lo16(g2[tt].y), hi16(g2[tt].y)};
                f32x4 o;
#pragma unroll
                for (int j = 0; j < 4; ++j) { float v = oacc[tt][j] * rstd; if (GLA) v *= gng[j]; o[j] = v * siluf_(g[j]); }
                if (!dry) *(u32x2*)gp = pack4(o); }
        }
#pragma unroll
        for (int mt = 0; mt < 4; ++mt) {
            const f32x4 el = *(const f32x4*)(ELAST + 16 * mt + 4 * q4);
            sacc[mt] = sacc[mt] * el;
#pragma unroll
            for (int kk = 0; kk < 2; ++kk) sacc[mt] = mfma16(frag_tr(KST, 72, 16 * mt, 32 * kk, lane), frag_tr(VT, 136, 16 * w, 32 * kk, lane), sacc[mt]);
            if (full) *(u32x2*)(ST + (16 * w + l15) * 72 + 16 * mt + 4 * q4) = pack4(sacc[mt]);
        }
        if (GLA && c < 3 && st_cg < 2) { float g8[8]; unpack8(pg, g8);
            *(f32x4*)(GKL + st_t * 16 + 8 * st_cg) = (f32x4){g8[0], g8[1], g8[2], g8[3]}; *(f32x4*)(GKL + st_t * 16 + 8 * st_cg + 4) = (f32x4){g8[4], g8[5], g8[6], g8[7]}; }
        __syncthreads();
        QTS_MARK(3);
    }
    if (!full) {
#pragma unroll
        for (int mt = 0; mt < 4; ++mt)
#pragma unroll
            for (int j = 0; j < 4; ++j) Lst[(16 * mt + 4 * q4 + j) * 128 + 16 * w + l15] = sacc[mt][j];
        if (GLA && tid < 64) ((float*)(p.ws + WS_DG))[(bh * 16 + sc) * 64 + tid] = fexp(dtot);
    }
}

constexpr int SD_CS = 0, SD_BS = 17408, SD_BT = 34816, SD_XT = 53248, SD_XST = 62464, SD_PS = 71680, SD_ST = 80896, SD_DT = 98304, SD_CUM = 98560, SD_RED = 98816, SD_CW = 99840;
DI void conv8(const Params& p, int l, const bf16* P, int b, int tpos, int ch, float* y) {
    const float* cw = p.in[I_CONVW] + (size_t)l * 4 * 1024; const float* cb = p.in[I_CONVB] + l * 1024;
    const f32x4 b0 = *(const f32x4*)(cb + ch), b1 = *(const f32x4*)(cb + ch + 4);
    float acc[8] = {b0[0], b0[1], b0[2], b0[3], b1[0], b1[1], b1[2], b1[3]};
#pragma unroll
    for (int j = 0; j < 4; ++j) { const int tp = tpos - 3 + j;
        if (tp >= 0) { float x[8]; unpack8(*(const u32x4*)(P + (size_t)(b * T + tp) * LDP + C_SX + ch), x);
            const f32x4 w0 = *(const f32x4*)(cw + j * 1024 + ch), w1 = *(const f32x4*)(cw + j * 1024 + ch + 4);
            acc[0] += w0[0] * x[0]; acc[1] += w0[1] * x[1]; acc[2] += w0[2] * x[2]; acc[3] += w0[3] * x[3];
            acc[4] += w1[0] * x[4]; acc[5] += w1[1] * x[5]; acc[6] += w1[2] * x[6]; acc[7] += w1[3] * x[7]; } }
#pragma unroll
    for (int i = 0; i < 8; ++i) y[i] = siluf_(acc[i]);
}
DI void conv_rows(const bf16* P, int b, int tpos, int ch, u32x4 (&xr)[7]) {
#pragma unroll
    for (int r = 0; r < 7; ++r) { const int tp = tpos - 3 + r; xr[r] = *(const u32x4*)(P + (size_t)(b * T + (tp < 0 ? 0 : tp)) * LDP + C_SX + ch); }
}
DI void conv_apply(const float* cwl, int lc, const u32x4 (&xr)[7], int tpos, float (&y)[4][8]) {
    { const f32x4 b0 = *(const f32x4*)(cwl + 4 * 320 + lc), b1 = *(const f32x4*)(cwl + 4 * 320 + lc + 4);
#pragma unroll
        for (int o = 0; o < 4; ++o) { y[o][0] = b0[0]; y[o][1] = b0[1]; y[o][2] = b0[2]; y[o][3] = b0[3]; y[o][4] = b1[0]; y[o][5] = b1[1]; y[o][6] = b1[2]; y[o][7] = b1[3]; } }
#pragma unroll
    for (int j = 0; j < 4; ++j) { const f32x4 w0 = *(const f32x4*)(cwl + j * 320 + lc), w1 = *(const f32x4*)(cwl + j * 320 + lc + 4);
        const float wv[8] = {w0[0], w0[1], w0[2], w0[3], w1[0], w1[1], w1[2], w1[3]};
#pragma unroll
        for (int o = 0; o < 4; ++o) { float x[8]; unpack8(xr[o + j], x);
            if (tpos - 3 + o + j < 0) {
#pragma unroll
                for (int i = 0; i < 8; ++i) x[i] = 0.f; }
#pragma unroll
            for (int i = 0; i < 8; ++i) y[o][i] += wv[i] * x[i]; } }
#pragma unroll
    for (int o = 0; o < 4; ++o)
#pragma unroll
        for (int i = 0; i < 8; i += 2) { const f32x2 v = {y[o][i], y[o][i + 1]}; const f32x2 r = v * sig_pk(v); y[o][i] = r.x; y[o][i + 1] = r.y; }
}
DI void ssd_item(const Params& p, int l, unsigned char* lds, int b, int h, int sc, bool full, bool dry = false) {
    const int tid = opaque_tid(), lane = tid & 63, w = tid >> 6, q4 = lane >> 4, l15 = lane & 15;
    bf16* P = (bf16*)(p.ws + WS_P);
    bf16* CS = (bf16*)(lds + SD_CS); bf16* BS = (bf16*)(lds + SD_BS); bf16* XT = (bf16*)(lds + SD_XT); bf16* XST = (bf16*)(lds + SD_XST);
    bf16* ST = (bf16*)(lds + SD_ST);
    float* DTL = (float*)(lds + SD_DT); float* CUMS = (float*)(lds + SD_CUM); float* RED = (float*)(lds + SD_RED);
    const int g = h >> 2, bh = b * 8 + h;
    float* Lst = (float*)(p.ws + WS_SSDL) + (size_t)(bh * 16 + sc) * 8192;
    const float a_h = -fexp(p.in[I_ALOG][l * 8 + h]), dtb = p.in[I_DTB][l * 8 + h], dsk = p.in[I_SD][l * 8 + h];
    const int pt = w & 3, wh = w >> 2;
    const f32x4 sng = *(const f32x4*)(p.in[I_SNORMG] + l * 512 + h * 64 + 16 * pt + 4 * q4);
    const int r_cgi = tid & 31, r_seg = tid >> 5; const bool r_isB = r_cgi >= 16; const int r_cg = r_cgi & 15;
    const int r_ch = (r_isB ? 512 : 768) + g * 128 + 8 * r_cg, r_lc = (r_isB ? 128 : 0) + 8 * r_cg;
    f32x4 sacc[4];
#pragma unroll
    for (int i = 0; i < 4; ++i) { const int nt = 4 * wh + i;
        if (full) { for (int j = 0; j < 4; ++j) sacc[i][j] = Lst[(16 * nt + 4 * q4 + j) * 64 + 16 * pt + l15]; *(u32x2*)(ST + (16 * pt + l15) * 136 + 16 * nt + 4 * q4) = pack4(sacc[i]); }
        else sacc[i] = (f32x4){0.f, 0.f, 0.f, 0.f}; }
    float* CWL = (float*)(lds + SD_CW);
    {
        float cwv[4];
#pragma unroll
        for (int r4 = 0; r4 < 4; ++r4) { const int idx0 = tid + r4 * NTHREADS, idx = idx0 < 1600 ? idx0 : 1599; const int row = idx / 320, ci = idx - row * 320;
            const int gch = ci < 128 ? 768 + g * 128 + ci : ci < 256 ? 512 + g * 128 + (ci - 128) : h * 64 + (ci - 256);
            const float* src = row < 4 ? p.in[I_CONVW] + (size_t)l * 4096 + row * 1024 + gch : p.in[I_CONVB] + l * 1024 + gch;
            cwv[r4] = *src; }
#pragma unroll
        for (int r4 = 0; r4 < 4; ++r4) { const int idx0 = tid + r4 * NTHREADS; if (idx0 < 1600) CWL[idx0] = cwv[r4]; }
    }
    u32x4 xbc[7]; conv_rows(P, b, sc * 256 + 4 * r_seg, r_ch, xbc);
    unsigned dtraw = (unsigned)P[(size_t)(b * T + sc * 256 + lane) * LDP + C_SDT + h];
    float ltot = 0.f;
    for (int c = 0; c < 4; ++c) {
        const int t0 = sc * 256 + c * 64, m0 = b * T + t0;
        if (w == 0) {
            const float dt = softplusf_(bf2f(dtraw) + dtb); float cu = dt * a_h;
#pragma unroll
            for (int o = 1; o < 64; o <<= 1) { const float n = __shfl_up(cu, o); if (lane >= o) cu += n; }
            DTL[lane] = dt; CUMS[lane] = cu;
        }
        if (c < 3) dtraw = (unsigned)P[(size_t)(m0 + 64 + lane) * LDP + C_SDT + h];
        __syncthreads();
        const float clast = CUMS[63];
        ltot += clast;
        {
            u32x4 xx[7];
            conv_rows(P, b, t0 + 4 * ((tid & 127) >> 3), h * 64 + 8 * (tid & 7), xx);
            { float y[4][8]; conv_apply(CWL, r_lc, xbc, t0 + 4 * r_seg, y);
#pragma unroll
                for (int o = 0; o < 4; ++o) { const int t = 4 * r_seg + o; *(u32x4*)((r_isB ? BS : CS) + t * 136 + 8 * r_cg) = pack8(y[o]); }
            }
            if (tid < 128) { const int cg = tid & 7, seg = tid >> 3; float y[4][8]; conv_apply(CWL, 256 + 8 * cg, xx, t0 + 4 * seg, y);
                float coef[4];
#pragma unroll
                for (int o = 0; o < 4; ++o) coef[o] = fexp(clast - CUMS[4 * seg + o]) * DTL[4 * seg + o];
#pragma unroll
                for (int o = 0; o < 4; ++o) { float ys[8];
#pragma unroll
                    for (int i = 0; i < 8; ++i) ys[i] = y[o][i] * coef[o];
                    *(u32x4*)(XT + (4 * seg + o) * 72 + 8 * cg) = pack8(y[o]); *(u32x4*)(XST + (4 * seg + o) * 72 + 8 * cg) = pack8(ys); } }
            if (c < 3) conv_rows(P, b, t0 + 64 + 4 * r_seg, r_ch, xbc);
        }
        __syncthreads();
        if (full) {
#pragma unroll
            for (int i = 0; i < 2; ++i) { const int tt = 2 * wh + i, t = 16 * tt + l15;
                bf16* zp = P + (size_t)(m0 + t) * LDP + C_SZ + h * 64 + 16 * pt + 4 * q4;
                const u32x2 z2 = *(const u32x2*)zp;
                bf16x8 cf[4];
#pragma unroll
                for (int kk = 0; kk < 4; ++kk) cf[kk] = frag(CS, 136, 16 * tt, 32 * kk, lane);
                f32x4 oacc = (f32x4){0.f, 0.f, 0.f, 0.f};
#pragma unroll
                for (int kk = 0; kk < 4; ++kk) oacc = mfma16(frag(ST, 136, 16 * pt, 32 * kk, lane), cf[kk], oacc);
                const float ct = CUMS[t];
                oacc = oacc * fexp(ct);
                u32x2 pp[4];
#pragma unroll
                for (int st = 0; st < 4; ++st) {
                    if (st <= tt) { f32x4 a = (f32x4){0.f, 0.f, 0.f, 0.f};
#pragma unroll
                        for (int kk = 0; kk < 4; ++kk) a = mfma16(frag(BS, 136, 16 * st, 32 * kk, lane), cf[kk], a);
                        const f32x4 cs4 = *(const f32x4*)(CUMS + 16 * st + 4 * q4), dt4 = *(const f32x4*)(DTL + 16 * st + 4 * q4);
#pragma unroll
                        for (int j = 0; j < 4; ++j) a[j] = (16 * st + 4 * q4 + j <= t) ? a[j] * fexp(ct - cs4[j]) * dt4[j] : 0.f;
                        pp[st] = pack4(a); }
                    else pp[st] = (u32x2){0u, 0u}; }
#pragma unroll
                for (int kk2 = 0; kk2 < 2; ++kk2) { if (2 * kk2 <= tt) {
                        u32x4 pw; pw.x = pp[2 * kk2].x; pw.y = pp[2 * kk2].y; pw.z = pp[2 * kk2 + 1].x; pw.w = pp[2 * kk2 + 1].y;
                        oacc = mfma16(frag_tr_perm(XT, 72, 16 * pt, 32 * kk2, lane), __builtin_bit_cast(bf16x8, pw), oacc); } }
                const float z[4] = {lo16(z2.x), hi16(z2.x), lo16(z2.y), hi16(z2.y)};
                f32x4 o; float ss = 0.f;
                const u32x2 xv2 = *(const u32x2*)(XT + t * 72 + 16 * pt + 4 * q4); const float xvv[4] = {lo16(xv2.x), hi16(xv2.x), lo16(xv2.y), hi16(xv2.y)};
#pragma unroll
                for (int j = 0; j < 4; ++j) { const float xv = xvv[j]; const float v = (oacc[j] + dsk * xv) * siluf_(z[j]); ss += v * v;
                    o[j] = v * sng[j]; }
                if (!dry) *(u32x2*)zp = pack4(o);
                ss += __shfl_xor(ss, 16); ss += __shfl_xor(ss, 32);
                if (q4 == 0) RED[t * 4 + pt] = ss; }
        }
        const float el = fexp(clast);
#pragma unroll
        for (int i = 0; i < 4; ++i) { const int nt = 4 * wh + i;
            sacc[i] = sacc[i] * el;
#pragma unroll
            for (int kk = 0; kk < 2; ++kk) sacc[i] = mfma16(frag_tr(BS, 136, 16 * nt, 32 * kk, lane), frag_tr(XST, 72, 16 * pt, 32 * kk, lane), sacc[i]);
            if (full) *(u32x2*)(ST + (16 * pt + l15) * 136 + 16 * nt + 4 * q4) = pack4(sacc[i]); }
        __syncthreads();
        if (full && tid < 64) { const f32x4 r = *(const f32x4*)(RED + tid * 4); ((float*)(p.ws + WS_SSQ))[(size_t)(m0 + tid) * 8 + h] = (r[0] + r[1]) + (r[2] + r[3]); }
    }
    if (!full) {
#pragma unroll
        for (int i = 0; i < 4; ++i)
#pragma unroll
            for (int j = 0; j < 4; ++j) Lst[(16 * (4 * wh + i) + 4 * q4 + j) * 64 + 16 * pt + l15] = sacc[i][j];
        if (tid == 0) ((float*)(p.ws + WS_DS))[bh * 16 + sc] = fexp(ltot);
    }
}

DI void phase_scan(const Params& p, int vb, int nb, bool dry = false) {
    const int gt = vb * NTHREADS + opaque_tid(), NT = nb * NTHREADS;
    for (int idx0 = gt; idx0 < 4 * 131072; idx0 += 2 * NT) {
        float lv[2][16], dv[2][16]; float* Lp[2]; bool ok[2];
#pragma unroll
        for (int e = 0; e < 2; ++e) { const int idx = idx0 + e * NT; ok[e] = idx < 4 * 131072; const int which = idx >> 17, r = idx & 131071;
            float* L = nullptr; const float* dec = nullptr; int dstride = 0; float cdec = 0.f;
            if (ok[e]) {
                if (which == 0) { const int bh = r >> 13, el = r & 8191; L = (float*)(p.ws + WS_RETL) + (size_t)bh * 16 * 8192 + el; cdec = fexp(256.0f * __logf(1.0f - exp2f(-5.0f - (float)(bh & 3)))); }
                else if (which == 1) { const int bh = r >> 13, el = r & 8191; L = (float*)(p.ws + WS_GLAL) + (size_t)bh * 16 * 8192 + el; dec = (const float*)(p.ws + WS_DG) + bh * 16 * 64 + (el >> 7); dstride = 64; }
                else { const int rr = (which - 2) * 131072 + r, bh = rr >> 13, el = rr & 8191; L = (float*)(p.ws + WS_SSDL) + (size_t)bh * 16 * 8192 + el; dec = (const float*)(p.ws + WS_DS) + bh * 16; dstride = 1; } }
            Lp[e] = L;
#pragma unroll
            for (int sc = 0; sc < 16; ++sc) { lv[e][sc] = ok[e] ? L[(size_t)sc * 8192] : 0.f; dv[e][sc] = (ok[e] && dec) ? dec[sc * dstride] : cdec; } }
#pragma unroll
        for (int e = 0; e < 2; ++e) { float prev = 0.f;
#pragma unroll
            for (int sc = 0; sc < 16; ++sc) { if (ok[e] && !dry) Lp[e][(size_t)sc * 8192] = prev; prev = dv[e][sc] * prev + lv[e][sc]; } }
    }
}

DI void memkv_item(const Params& p, int l, int item) {
    const int tid = opaque_tid(), lane = tid & 63, w = tid >> 6, q4 = lane >> 4, l15 = lane & 15;
    const int rb = item >> 4, cb = item & 15;
    const bf16* A = (const bf16*)(p.ws + WS_MEMN) + (size_t)l * 1024 * 1024; const bf16* Bw = (const bf16*)(p.ws + WS_WKVT);
    const int r0 = 64 * rb + 16 * (w >> 1), c0 = 32 * cb + 16 * (w & 1); const bool isV = cb >= 8; const int hh = (c0 >> 6) & 3, dd = c0 & 63;
    f32x4 acc = (f32x4){0.f, 0.f, 0.f, 0.f};
#pragma unroll 1
    for (int k16 = 0; k16 < 32; k16 += 16) {
        bf16x8 fa[16], fb[16];
#pragma unroll
        for (int u = 0; u < 16; ++u) { fa[u] = frag(A, 1024, r0, 32 * (k16 + u), lane); fb[u] = frag(Bw, 1024, c0, 32 * (k16 + u), lane); }
#pragma unroll
        for (int u = 0; u < 16; ++u) acc = isV ? mfma16(fa[u], fb[u], acc) : mfma16(fb[u], fa[u], acc);
    }
    if (!isV) { const int m = r0 + l15, bb = m >> 8, mm = m & 255;
        *(u32x2*)((bf16*)(p.ws + WS_KM) + ((size_t)(bb * 4 + hh) * 256 + mm) * 64 + dd + 4 * q4) = pack4(acc); }
    else { const int m = r0 + 4 * q4, bb = m >> 8, mm = m & 255;
        *(u32x2*)((bf16*)(p.ws + WS_VMT) + ((size_t)(bb * 4 + hh) * 64 + dd + l15) * 256 + mm) = pack4(acc); }
}
constexpr int MA_K = 0, MA_VT = 36864;
DI void memattn_item(const Params& p, unsigned char* lds, int b, int h, int blk) {
    const int tid = opaque_tid(), lane = tid & 63, w = tid >> 6, q4 = lane >> 4, l15 = lane & 15;
    bf16* KS = (bf16*)(lds + MA_K); bf16* VS = (bf16*)(lds + MA_VT);
    const bf16* KM = (const bf16*)(p.ws + WS_KM) + (size_t)(b * 4 + h) * 256 * 64; const bf16* VM = (const bf16*)(p.ws + WS_VMT) + (size_t)(b * 4 + h) * 64 * 256;
    const bf16* P = (const bf16*)(p.ws + WS_P); bf16* OM = (bf16*)(p.ws + WS_OMEM);
#pragma unroll
    for (int r = 0; r < 4; ++r) { const int idx = tid + 512 * r;
        { const int m = idx >> 3, c8 = idx & 7; *(u32x4*)(KS + m * 72 + 8 * c8) = *(const u32x4*)(KM + m * 64 + 8 * c8); }
        { const int d = idx >> 5, c8 = idx & 31; *(u32x4*)(VS + d * 264 + 8 * c8) = *(const u32x4*)(VM + d * 256 + 8 * c8); } }
    __syncthreads();
    bf16x8 qn[2];
#pragma unroll
    for (int kk = 0; kk < 2; ++kk) qn[kk] = *(const bf16x8*)(P + (size_t)(b * T + blk * 256 + w * 16 + l15) * LDP + C_MQ + h * 64 + 32 * kk + 8 * q4);
    for (int rnd = 0; rnd < 2; ++rnd) {
        const int m0 = b * T + blk * 256 + rnd * 128 + w * 16;
        bf16x8 qf[2];
#pragma unroll
        for (int kk = 0; kk < 2; ++kk) { qf[kk] = qn[kk]; if (rnd == 0) qn[kk] = *(const bf16x8*)(P + (size_t)(m0 + 128 + l15) * LDP + C_MQ + h * 64 + 32 * kk + 8 * q4); }
        f32x4 s[16]; float mx = -3.0e38f;
#pragma unroll
        for (int mt = 0; mt < 16; ++mt) { s[mt] = (f32x4){0.f, 0.f, 0.f, 0.f};
#pragma unroll
            for (int kk = 0; kk < 2; ++kk) s[mt] = mfma16(frag(KS, 72, 16 * mt, 32 * kk, lane), qf[kk], s[mt]);
            s[mt] = s[mt] * 0.125f; mx = fmaxf(mx, fmaxf(fmaxf(s[mt][0], s[mt][1]), fmaxf(s[mt][2], s[mt][3]))); __builtin_amdgcn_sched_barrier(0); }
        mx = fmaxf(mx, __shfl_xor(mx, 16)); mx = fmaxf(mx, __shfl_xor(mx, 32));
        float sum = 0.f;
#pragma unroll
        for (int mt = 0; mt < 16; ++mt) {
#pragma unroll
            for (int j = 0; j < 4; ++j) { s[mt][j] = fexp(s[mt][j] - mx); sum += s[mt][j]; } }
        sum += __shfl_xor(sum, 16); sum += __shfl_xor(sum, 32);
        const float rs = __builtin_amdgcn_rcpf(sum);
        f32x4 o[4];
#pragma unroll
        for (int dt = 0; dt < 4; ++dt) o[dt] = (f32x4){0.f, 0.f, 0.f, 0.f};
#pragma unroll
        for (int k2 = 0; k2 < 8; ++k2) {
            u32x4 pw; pw.x = pk2(s[2 * k2][0], s[2 * k2][1]); pw.y = pk2(s[2 * k2][2], s[2 * k2][3]); pw.z = pk2(s[2 * k2 + 1][0], s[2 * k2 + 1][1]); pw.w = pk2(s[2 * k2 + 1][2], s[2 * k2 + 1][3]);
            const bf16x8 pf = __builtin_bit_cast(bf16x8, pw);
#pragma unroll
            for (int dt = 0; dt < 4; ++dt) { const bf16* vp = VS + (16 * dt + l15) * 264 + 32 * k2 + 4 * q4;
                const u32x2 v0 = *(const u32x2*)vp, v1 = *(const u32x2*)(vp + 16); u32x4 vw; vw.x = v0.x; vw.y = v0.y; vw.z = v1.x; vw.w = v1.y;
                o[dt] = mfma16(__builtin_bit_cast(bf16x8, vw), pf, o[dt]); }
            __builtin_amdgcn_sched_barrier(0); }
#pragma unroll
        for (int dt = 0; dt < 4; ++dt) *(u32x2*)(OM + (size_t)(m0 + l15) * 256 + h * 64 + 16 * dt + 4 * q4) = pack4(o[dt] * rs);
    }
    __syncthreads();
}

constexpr int RC_ARL = 0, RC_RRL = 9216, RC_BRL = 18432, RC_KRL = 27648, RC_XT = 0, RC_BHT = 36864, RC_KHT = 46080, RC_VT = 55296, RC_AAK = 64512, RC_LRB = 73728, RC_LRK = 82944,
              RC_AAB = 92160, RC_RHS = 108544, RC_WLAST = 141312, RC_TB = 141568,
              RC_TW = 64512, RC_ALS = 73728, RC_W2T = 82944, RC_A2T = 92160, RC_TOT = 101376, RC_CUM = 108544, RC_AICL = 124928;
#if defined(TPROBE) && !defined(QTS_SEL)
#define RW_STOP_AT(k) TS_MARK(k)
#define RW_TS_BEGIN() TS_BEGIN()
#define RW_TS_END() TS_MARK(7)
#else
#define RW_TS_BEGIN() do {} while (0)
#define RW_TS_END() do {} while (0)
#ifdef RW_STOP
#define RW_STOP_AT(k) do { if (dry && RW_STOP == (k)) return; } while (0)
#else
#define RW_STOP_AT(k) do {} while (0)
#endif
#endif
DI void rwkv_chunk_item(const Params& p, int l, unsigned char* lds, int b, int h, int c, bool dry = false) {
    const int tid = opaque_tid(), lane = tid & 63, w = tid >> 6, q4 = lane >> 4, l15 = lane & 15;
    bf16* P = (bf16*)(p.ws + WS_P);
    bf16* ARL = (bf16*)(lds + RC_ARL); bf16* RRL = (bf16*)(lds + RC_RRL); bf16* BRL = (bf16*)(lds + RC_BRL); bf16* KRL = (bf16*)(lds + RC_KRL); bf16* XT = (bf16*)(lds + RC_XT);
    bf16* BHT = (bf16*)(lds + RC_BHT); bf16* KHT = (bf16*)(lds + RC_KHT); bf16* VT = (bf16*)(lds + RC_VT); bf16* AAK = (bf16*)(lds + RC_AAK); bf16* LRB = (bf16*)(lds + RC_LRB); bf16* LRK = (bf16*)(lds + RC_LRK);
    float* AAB = (float*)(lds + RC_AAB); float* RHS = (float*)(lds + RC_RHS); float* WLAST = (float*)(lds + RC_WLAST); float* TB = (float*)(lds + RC_TB);
    bf16* TW = (bf16*)(lds + RC_TW); bf16* ALS = (bf16*)(lds + RC_ALS); bf16* W2T = (bf16*)(lds + RC_W2T); bf16* A2T = (bf16*)(lds + RC_A2T);
    float* TOT = (float*)(lds + RC_TOT); float* CUM = (float*)(lds + RC_CUM); float* AICL = (float*)(lds + RC_AICL);
    const float* mu = p.in[I_MU] + l * 1664;
    const int t0 = c * 64, m0 = b * T + t0;
    RW_TS_BEGIN();
    const int t_ = tid >> 3, cg = tid & 7, chh = h * 64 + 8 * cg;
    float xr[8], xk[8], xv[8];
    float pkk[8], pka[8], prk[8];
    { const f32x4 a0 = *(const f32x4*)(p.in[I_KK] + l * 512 + chh), a1 = *(const f32x4*)(p.in[I_KK] + l * 512 + chh + 4), b0 = *(const f32x4*)(p.in[I_KA] + l * 512 + chh), b1 = *(const f32x4*)(p.in[I_KA] + l * 512 + chh + 4),
          c0 = *(const f32x4*)(p.in[I_RK] + l * 512 + chh), c1 = *(const f32x4*)(p.in[I_RK] + l * 512 + chh + 4);
#pragma unroll
      for (int i = 0; i < 4; ++i) { pkk[i] = a0[i]; pkk[4 + i] = a1[i]; pka[i] = b0[i]; pka[4 + i] = b1[i]; prk[i] = c0[i]; prk[4 + i] = c1[i]; } }
    f32x4 pw0[4];
#pragma unroll
    for (int ct = 0; ct < 4; ++ct) pw0[ct] = *(const f32x4*)(p.in[(w >> 2) ? I_A0 : I_W0] + l * 512 + h * 64 + 16 * ct + 4 * q4);
    {
        { const int j = tid >> 3;
            const float* s2 = p.in[I_W2] + (size_t)l * 64 * 512 + j * 512 + chh; const float* sa = p.in[I_A2] + (size_t)l * 64 * 512 + j * 512 + chh;
#pragma unroll
            for (int i = 0; i < 8; ++i) { }
            *(u32x4*)(W2T + j * 72 + 8 * cg) = pack8(s2); *(u32x4*)(A2T + j * 72 + 8 * cg) = pack8(sa); }
        const size_t ro = (size_t)(m0 + t_) * LDP; const bool first = (t_ == 0);
        const bf16* prow = first ? (bf16*)(p.ws + WS_BND) + (size_t)(((m0) >> 6) - 1) * BND_W - 4608 : P + ro - LDP;
        const bool hp = (t0 + t_) > 0;
#pragma unroll
        for (int which = 0; which < 5; ++which) {
            const int col = which == 0 ? C_WR + chh : which == 1 ? C_WK + chh : which == 2 ? C_WV + chh : which == 3 ? C_WL + 8 * cg : C_AL + 8 * cg;
            const int mi = which == 0 ? chh : which == 1 ? 512 + chh : which == 2 ? 1024 + chh : which == 3 ? 1536 + 8 * cg : 1600 + 8 * cg;
            float cur[8], prv[8], xs[8];
            unpack8(*(const u32x4*)(P + ro + col), cur);
            unpack8(*(const u32x4*)((hp ? prow : P + ro) + col), prv);
            if (!hp) {
#pragma unroll
                for (int i = 0; i < 8; ++i) prv[i] = 0.f; }
#pragma unroll
            for (int i = 0; i < 8; ++i) xs[i] = cur[i] + (prv[i] - cur[i]) * mu[mi + i];
            if (which == 0) {
#pragma unroll
                for (int i = 0; i < 8; ++i) xr[i] = xs[i]; }
            else if (which == 1) {
#pragma unroll
                for (int i = 0; i < 8; ++i) xk[i] = xs[i]; }
            else if (which == 2) {
#pragma unroll
                for (int i = 0; i < 8; ++i) xv[i] = xs[i]; }
            else if (which == 3) { float tw[8];
#pragma unroll
                for (int i = 0; i < 8; ++i) tw[i] = tanhf_(xs[i]);
                *(u32x4*)(TW + t_ * 72 + 8 * cg) = pack8(tw); }
            else *(u32x4*)(ALS + t_ * 72 + 8 * cg) = pack8(xs);
        }
    }
    __syncthreads();
    RW_STOP_AT(0);
    {
        const int which = w >> 2, tt = w & 3; const bf16* Wm = which ? A2T : W2T; const bf16* Xm = which ? ALS : TW;
#pragma unroll
        for (int ct = 0; ct < 4; ++ct) { f32x4 a = (f32x4){0.f, 0.f, 0.f, 0.f};
#pragma unroll
            for (int kk = 0; kk < 2; ++kk) a = mfma16(frag_tr(Wm, 72, 16 * ct, 32 * kk, lane), frag(Xm, 72, 16 * tt, 32 * kk, lane), a);
            const int ch = 16 * ct + 4 * q4, t = 16 * tt + l15; f32x4 o;
            if (which == 0) { const f32x4 w0 = pw0[ct];
#pragma unroll
                for (int j = 0; j < 4; ++j) o[j] = -0.60653065971f * sigmoidf_(w0[j] + a[j]);
                *(f32x4*)(CUM + t * 64 + ch) = o; }
            else { const f32x4 a0 = pw0[ct];
#pragma unroll
                for (int j = 0; j < 4; ++j) o[j] = sigmoidf_(a0[j] + a[j]);
                *(f32x4*)(AICL + t * 64 + ch) = o; }
        }
    }
    __syncthreads();
    RW_STOP_AT(1);
    {
        float cumv[8]; float run = 0.f;
#pragma unroll
        for (int i = 0; i < 8; ++i) { run += CUM[(8 * w + i) * 64 + lane]; cumv[i] = run; }
        TOT[w * 64 + lane] = run;
        __syncthreads();
        float off = 0.f;
        for (int ww = 0; ww < w; ++ww) off += TOT[ww * 64 + lane];
#pragma unroll
        for (int i = 0; i < 8; ++i) CUM[(8 * w + i) * 64 + lane] = cumv[i] + off;
    }
    __syncthreads();
    RW_STOP_AT(2);
    float aabs[8];
    {
        float kk[8], ai[8], ss = 0.f;
#pragma unroll
        for (int i = 0; i < 8; ++i) { ai[i] = AICL[t_ * 64 + 8 * cg + i]; kk[i] = xk[i] * pkk[i]; ss += kk[i] * kk[i]; }
        ss += __shfl_xor(ss, 1); ss += __shfl_xor(ss, 2); ss += __shfl_xor(ss, 4);
        const float inv = __builtin_amdgcn_rsqf(fmaxf(ss, 1e-24f));
        float bon = 0.f, o_arl[8], o_rrl[8], o_brl[8], o_krl[8], o_rabs[8], o_bh[8], o_kh[8];
#pragma unroll
        for (int i = 0; i < 8; ++i) {
            const float kn = kk[i] * inv, av = -kn, bv = kn * ai[i], km = xk[i] * (1.0f + (ai[i] - 1.0f) * pka[i]);
            bon += xr[i] * km * prk[i];
            const int k = 8 * cg + i;
            const float cu = CUM[t_ * 64 + k], cx = t_ > 0 ? CUM[(t_ - 1) * 64 + k] : 0.f, rf = CUM[32 * 64 + k], la = CUM[63 * 64 + k];
            o_arl[i] = av * fexp(cx - rf); aabs[i] = av * fexp(cx);
            o_rrl[i] = xr[i] * fexp(cu - rf); o_rabs[i] = xr[i] * fexp(cu);
            const float eb = fexp(rf - cu), eh = fexp(la - cu);
            o_brl[i] = bv * eb; o_krl[i] = km * eb;
            o_bh[i] = bv * eh; o_kh[i] = km * eh;
        }
        bon += __shfl_xor(bon, 1); bon += __shfl_xor(bon, 2); bon += __shfl_xor(bon, 4);
        *(u32x4*)(ARL + t_ * 72 + 8 * cg) = pack8(o_arl); *(u32x4*)(RRL + t_ * 72 + 8 * cg) = pack8(o_rrl);
        *(u32x4*)(BRL + t_ * 72 + 8 * cg) = pack8(o_brl); *(u32x4*)(KRL + t_ * 72 + 8 * cg) = pack8(o_krl);
        *(u32x4*)(BHT + t_ * 72 + 8 * cg) = pack8(o_bh); *(u32x4*)(KHT + t_ * 72 + 8 * cg) = pack8(o_kh); *(u32x4*)(VT + t_ * 72 + 8 * cg) = pack8(xv);
        const size_t ro = (size_t)(m0 + t_) * LDP;
        if (!dry) *(u32x4*)(P + ro + C_WR + chh) = pack8(o_rabs);
        float bvv[8];
#pragma unroll
        for (int i = 0; i < 8; ++i) bvv[i] = bon * xv[i];
        if (!dry) *(u32x4*)(P + ro + C_WV + chh) = pack8(bvv);
        if (tid < 64) WLAST[tid] = fexp(CUM[63 * 64 + tid]);
    }
    __syncthreads();
    RW_STOP_AT(3);
    *(f32x4*)(RHS + t_ * 128 + 8 * cg) = (f32x4){aabs[0], aabs[1], aabs[2], aabs[3]}; *(f32x4*)(RHS + t_ * 128 + 8 * cg + 4) = (f32x4){aabs[4], aabs[5], aabs[6], aabs[7]};
    {
        const int prod = w >> 1, half = w & 1; const bf16* Lm = (prod < 2) ? ARL : RRL; const bf16* Rm = (prod & 1) ? KRL : BRL; const int strict = prod < 2 ? 1 : 0;
#pragma unroll
        for (int i8 = 0; i8 < 8; ++i8) { const int id = half * 8 + i8, tt = id >> 2, st = id & 3;
            f32x4 a = (f32x4){0.f, 0.f, 0.f, 0.f};
            if (st <= tt) {
#pragma unroll
                for (int kk = 0; kk < 2; ++kk) a = mfma16(frag(Rm, 72, 16 * st, 32 * kk, lane), frag(Lm, 72, 16 * tt, 32 * kk, lane), a);
                if (st == tt) {
#pragma unroll
                    for (int j = 0; j < 4; ++j) if (4 * q4 + j + strict > l15) a[j] = 0.f; }
            }
            if (prod == 0) *(f32x4*)(AAB + (16 * tt + l15) * 64 + 16 * st + 4 * q4) = a;
            else { bf16* O = prod == 1 ? AAK : prod == 2 ? LRB : LRK; *(u32x2*)(O + (16 * tt + l15) * 72 + 16 * st + 4 * q4) = pack4(a); }
        }
        if (prod == 0) {
            asm volatile("s_waitcnt lgkmcnt(0)" ::: "memory");
            const int bb = 2 * half + ((lane >> 4) & 1), cc = lane & 15; float x[16];
#pragma unroll
            for (int i = 0; i < 16; ++i) { float s0 = (i == cc) ? 1.0f : 0.0f;
#pragma unroll
                for (int s4 = 0; s4 < (i + 3) / 4; ++s4) { const f32x4 av = *(const f32x4*)(AAB + (16 * bb + i) * 64 + 16 * bb + 4 * s4);
#pragma unroll
                    for (int n = 0; n < 4; ++n) if (4 * s4 + n < i) s0 += av[n] * x[4 * s4 + n]; }
                x[i] = s0; if (lane < 32) TB[(bb * 16 + i) * 16 + cc] = s0; }
        }
    }
    __syncthreads();
    RW_STOP_AT(4);
    {
        f32x4 X[4];
#pragma unroll
        for (int bb = 0; bb < 4; ++bb) {
            f32x4 acc;
            if (w < 4) {
#pragma unroll
                for (int j = 0; j < 4; ++j) acc[j] = RHS[(16 * bb + 4 * q4 + j) * 128 + 16 * w + l15]; }
            else {
                acc = (f32x4){0.f, 0.f, 0.f, 0.f};
#pragma unroll
                for (int kk = 0; kk < 2; ++kk) acc = mfma16(frag(AAK, 72, 16 * bb, 32 * kk, lane), frag_tr(VT, 72, 16 * (w - 4), 32 * kk, lane), acc); }
#pragma unroll
            for (int bp = 0; bp < bb; ++bp) { const f32x4 a4 = *(const f32x4*)(AAB + (16 * bb + l15) * 64 + 16 * bp + 4 * q4);
#pragma unroll
                for (int j = 0; j < 4; ++j) acc = __builtin_amdgcn_mfma_f32_16x16x4f32(a4[j], X[bp][j], acc, 0, 0, 0); }
            const f32x4 t4 = *(const f32x4*)(TB + (bb * 16 + l15) * 16 + 4 * q4);
            f32x4 xb = (f32x4){0.f, 0.f, 0.f, 0.f};
#pragma unroll
            for (int j = 0; j < 4; ++j) xb = __builtin_amdgcn_mfma_f32_16x16x4f32(t4[j], acc[j], xb, 0, 0, 0);
            X[bb] = xb;
            *(u32x2*)(XT + (16 * w + l15) * 72 + 16 * bb + 4 * q4) = pack4(xb);
        }
    }
    __syncthreads();
    RW_STOP_AT(6);
    {
        const int prod = w >> 1, half = w & 1;
        bf16* GH = (bf16*)(p.ws + WS_RWGH) + ((size_t)((b * 8 + h) * 64 + c) * 2) * 4096;
#pragma unroll
        for (int i8 = 0; i8 < 8; ++i8) { const int id = half * 8 + i8, rt = id >> 2, ct = id & 3;
            f32x4 a = (f32x4){0.f, 0.f, 0.f, 0.f};
            if (prod == 0) {
#pragma unroll
                for (int kk = 0; kk < 2; ++kk) a = mfma16(frag(XT, 72, 16 * ct, 32 * kk, lane), frag(LRB, 72, 16 * rt, 32 * kk, lane), a);
                bf16* qp = P + (size_t)(m0 + 16 * rt + l15) * LDP + C_WR + h * 64 + 16 * ct + 4 * q4;
                const u32x2 r2 = *(const u32x2*)qp; a[0] += lo16(r2.x); a[1] += hi16(r2.x); a[2] += lo16(r2.y); a[3] += hi16(r2.y);
                if (!dry) *(u32x2*)qp = pack4(a);
            } else if (prod == 1) {
#pragma unroll
                for (int kk = 0; kk < 2; ++kk) a = mfma16(frag(XT, 72, 64 + 16 * ct, 32 * kk, lane), frag(LRB, 72, 16 * rt, 32 * kk, lane), a);
#pragma unroll
                for (int kk = 0; kk < 2; ++kk) a = mfma16(frag_tr(VT, 72, 16 * ct, 32 * kk, lane), frag(LRK, 72, 16 * rt, 32 * kk, lane), a);
                if (!dry) *(u32x2*)(P + (size_t)(m0 + 16 * rt + l15) * LDP + C_WK + h * 64 + 16 * ct + 4 * q4) = pack4(a);
            } else if (prod == 2) {
#pragma unroll
                for (int kk = 0; kk < 2; ++kk) a = mfma16(frag(XT, 72, 16 * ct, 32 * kk, lane), frag_tr(BHT, 72, 16 * rt, 32 * kk, lane), a);
                if (rt == ct) { const float wl = WLAST[16 * rt + l15];
#pragma unroll
                    for (int j = 0; j < 4; ++j) if (4 * q4 + j == l15) a[j] += wl; }
                *(u32x2*)(GH + (16 * rt + l15) * 64 + 16 * ct + 4 * q4) = pack4(a);
            } else {
#pragma unroll
                for (int kk = 0; kk < 2; ++kk) a = mfma16(frag_tr(BHT, 72, 16 * ct, 32 * kk, lane), frag(XT, 72, 64 + 16 * rt, 32 * kk, lane), a);
#pragma unroll
                for (int kk = 0; kk < 2; ++kk) a = mfma16(frag_tr(KHT, 72, 16 * ct, 32 * kk, lane), frag_tr(VT, 72, 16 * rt, 32 * kk, lane), a);
                *(u32x2*)(GH + 4096 + (16 * rt + l15) * 64 + 16 * ct + 4 * q4) = pack4(a);
            }
        }
    }
    __syncthreads();
    RW_TS_END();
}
DI void rwkv_scan_chain(const Params& p, unsigned char* lds, int bh, bool dry = false) {
    const int tid = opaque_tid(), lane = tid & 63, w = tid >> 6, q4 = lane >> 4, l15 = lane & 15;
    bf16* ZB = (bf16*)lds;
    bf16* GH = (bf16*)(p.ws + WS_RWGH) + (size_t)bh * 64 * 2 * 4096;
    const int vt = w & 3, kh = w >> 2;
    u32x2 zp[2];
#pragma unroll
    for (int i = 0; i < 2; ++i) { zp[i] = (u32x2){0u, 0u}; *(u32x2*)(ZB + (16 * vt + l15) * 72 + 16 * (2 * kh + i) + 4 * q4) = zp[i]; }
    bf16x8 gf[4][2][2]; u32x2 hv[4][2];
#define RW_LOAD(slot, cc) do { const bf16* G_ = GH + (size_t)(cc) * 2 * 4096; _Pragma("unroll") for (int i = 0; i < 2; ++i) { const int kt = 2 * kh + i; \
        _Pragma("unroll") for (int kk = 0; kk < 2; ++kk) gf[slot][i][kk] = frag(G_, 64, 16 * kt, 32 * kk, lane); \
        hv[slot][i] = *(const u32x2*)(G_ + 4096 + (16 * vt + l15) * 64 + 16 * kt + 4 * q4); } } while (0)
    RW_LOAD(0, 0); RW_LOAD(1, 1); RW_LOAD(2, 2); RW_LOAD(3, 3);
    __syncthreads();
    for (int c4 = 0; c4 < 64; c4 += 4) {
#pragma unroll
        for (int u = 0; u < 4; ++u) { const int c = c4 + u;
            bf16* HT = GH + (size_t)c * 2 * 4096 + 4096;
            const bf16* Zc = ZB + (c & 1) * 64 * 72; bf16* Zn = ZB + ((c + 1) & 1) * 64 * 72;
#pragma unroll
            for (int i = 0; i < 2; ++i) { const int kt = 2 * kh + i;
                f32x4 a = (f32x4){lo16(hv[u][i].x), hi16(hv[u][i].x), lo16(hv[u][i].y), hi16(hv[u][i].y)};
                if (!dry) *(u32x2*)(HT + (16 * vt + l15) * 64 + 16 * kt + 4 * q4) = zp[i];
#pragma unroll
                for (int kk = 0; kk < 2; ++kk) a = mfma16(gf[u][i][kk], frag(Zc, 72, 16 * vt, 32 * kk, lane), a);
                zp[i] = pack4(a);
                *(u32x2*)(Zn + (16 * vt + l15) * 72 + 16 * kt + 4 * q4) = zp[i]; }
            { const int cn = c + 4 < 64 ? c + 4 : 63; RW_LOAD(u, cn); }
            __syncthreads();
        }
    }
#undef RW_LOAD
}
DI void rwkv_out_item(const Params& p, int l, int bh, int pair, bool dry = false) {
    const int tid = opaque_tid(), lane = tid & 63, w = tid >> 6, q4 = lane >> 4, l15 = lane & 15;
    bf16* P = (bf16*)(p.ws + WS_P);
    const int b = bh >> 3, h = bh & 7, c = 2 * pair + (w >> 2), m = b * T + c * 64 + 16 * (w & 3) + l15;
    const bf16* ZT = (const bf16*)(p.ws + WS_RWGH) + ((size_t)(bh * 64 + c) * 2 + 1) * 4096;
    const size_t ro = (size_t)m * LDP;
    bf16x8 qf[2], zf[4][2]; u32x2 yl[4], bv[4], g2[4]; f32x4 lg[4], lb[4];
#pragma unroll
    for (int kk = 0; kk < 2; ++kk) qf[kk] = *(const bf16x8*)(P + ro + C_WR + h * 64 + 32 * kk + 8 * q4);
#pragma unroll
    for (int vt = 0; vt < 4; ++vt) { yl[vt] = *(const u32x2*)(P + ro + C_WK + h * 64 + 16 * vt + 4 * q4);
#pragma unroll
        for (int kk = 0; kk < 2; ++kk) zf[vt][kk] = frag(ZT, 64, 16 * vt, 32 * kk, lane); }
#pragma unroll
    for (int vt = 0; vt < 4; ++vt) { const int ch = h * 64 + 16 * vt + 4 * q4;
        bv[vt] = *(const u32x2*)(P + ro + C_WV + ch); g2[vt] = *(const u32x2*)(P + ro + C_WG + ch);
        lg[vt] = *(const f32x4*)(p.in[I_LNG] + l * 512 + ch); lb[vt] = *(const f32x4*)(p.in[I_LNB] + l * 512 + ch); }
    f32x4 y[4]; float s = 0.f;
#pragma unroll
    for (int vt = 0; vt < 4; ++vt) {
        y[vt] = (f32x4){lo16(yl[vt].x), hi16(yl[vt].x), lo16(yl[vt].y), hi16(yl[vt].y)};
#pragma unroll
        for (int kk = 0; kk < 2; ++kk) y[vt] = mfma16(zf[vt][kk], qf[kk], y[vt]);
        s += (y[vt][0] + y[vt][1]) + (y[vt][2] + y[vt][3]); }
    s += __shfl_xor(s, 16); s += __shfl_xor(s, 32);
    const float mean = s * (1.0f / 64.0f); float vr = 0.f;
#pragma unroll
    for (int vt = 0; vt < 4; ++vt) { y[vt] = y[vt] - mean; vr += (y[vt][0] * y[vt][0] + y[vt][1] * y[vt][1]) + (y[vt][2] * y[vt][2] + y[vt][3] * y[vt][3]); }
    vr += __shfl_xor(vr, 16); vr += __shfl_xor(vr, 32);
    const float rstd = __builtin_amdgcn_rsqf(vr * (1.0f / 64.0f) + 64e-5f);
#pragma unroll
    for (int vt = 0; vt < 4; ++vt) { const int ch = h * 64 + 16 * vt + 4 * q4; bf16* gp = P + ro + C_WG + ch;
        const float bvf[4] = {lo16(bv[vt].x), hi16(bv[vt].x), lo16(bv[vt].y), hi16(bv[vt].y)}, g[4] = {lo16(g2[vt].x), hi16(g2[vt].x), lo16(g2[vt].y), hi16(g2[vt].y)};
        f32x4 o;
#pragma unroll
        for (int j = 0; j < 4; ++j) o[j] = (y[vt][j] * rstd * lg[vt][j] + lb[vt][j] + bvf[j]) * siluf_(g[j]);
        if (!dry) *(u32x2*)gp = pack4(o); }
}

DI void phase_A(const Params& p, int l, unsigned char* lds, bool dry = false) {
    const int G = gridDim.x, bid = blockIdx.x;
#ifndef DUP_AMASK
#define DUP_AMASK 0xff
#endif
    for (int it = bid; it < 3328; it += G) {
        if (dry) { const int ty = it < 2048 ? 1 : it < 2560 ? 2 : it < 2816 ? 4 : it < 3072 ? 8 : 16; if (!(DUP_AMASK & ty)) continue; }
        if (it < 2048) rwkv_chunk_item(p, l, lds, it >> 9, (it >> 6) & 7, it & 63, dry);
        else if (it < 2560) { const int i = it - 2048; ssd_item(p, l, lds, i >> 7, (i >> 4) & 7, i & 15, false); }
        else if (it < 2816) { const int i = it - 2560; qkv_item<false>(p, l, lds, i >> 6, (i >> 4) & 3, i & 15, false); }
        else if (it < 3072) { const int i = it - 2816; qkv_item<true>(p, l, lds, i >> 6, (i >> 4) & 3, i & 15, false); }
        else memkv_item(p, l, it - 3072);
    }
}
DI void phase_B(const Params& p, unsigned char* lds, bool dry = false) {
    (void)lds; phase_scan(p, blockIdx.x, gridDim.x, dry);
}
DI void rwkv_flag_publish(unsigned* flag) {
    asm volatile("s_waitcnt vmcnt(0)" ::: "memory"); __syncthreads();
    if (threadIdx.x == 0) { __builtin_amdgcn_fence(__ATOMIC_RELEASE, "agent"); asm volatile("s_waitcnt vmcnt(0)" ::: "memory"); __hip_atomic_store(flag, 1u, __ATOMIC_RELAXED, __HIP_MEMORY_SCOPE_AGENT); }
}
DI void rwkv_flag_wait(unsigned* flag) {
    if (threadIdx.x == 0) { unsigned spins = 0;
        while (__hip_atomic_load(flag, __ATOMIC_RELAXED, __HIP_MEMORY_SCOPE_AGENT) == 0u) { __builtin_amdgcn_s_sleep(8); if (++spins > (1u << 22)) break; }
        __builtin_amdgcn_fence(__ATOMIC_ACQUIRE, "agent"); asm volatile("s_waitcnt vmcnt(0)" ::: "memory"); }
    __syncthreads();
}
DI void phase_C(const Params& p, int l, unsigned char* lds, bool dry = false) {
    const int G = gridDim.x, bid = blockIdx.x;
    unsigned* flags = (unsigned*)(p.ws + WS_BAR + 14336) + (dry ? 128 : 0) + l * 32;
    for (int bh = bid; bh < 32; bh += G) { rwkv_scan_chain(p, lds, bh, dry); rwkv_flag_publish(flags + bh); }
    unsigned have = 0u;
#define C_SSD(it)  ssd_item(p, l, lds, (it) >> 7, ((it) >> 4) & 7, (it) & 15, true, dry)
#define C_RET(it)  qkv_item<false>(p, l, lds, (it) >> 6, ((it) >> 4) & 3, (it) & 15, true, dry)
#define C_GLA(it)  qkv_item<true>(p, l, lds, (it) >> 6, ((it) >> 4) & 3, (it) & 15, true, dry)
#define C_MEM(it)  memattn_item(p, lds, (it) >> 6, ((it) >> 4) & 3, (it) & 15)
#define C_RWO(it)  do { const int bh_ = (it) >> 5; if (!((have >> bh_) & 1u)) { rwkv_flag_wait(flags + bh_); have |= 1u << bh_; } rwkv_out_item(p, l, bh_, (it) & 31, dry); } while (0)
    const int nslot = (G == 256) ? 16 : (2304 + G - 1) / G;
    for (int k = 0; k < nslot; ++k) {
        int it = -1;
        if (G == 256) {
            if (bid < 32) { it = k == 0 ? bid : (k >= 1 && k <= 4) ? 1280 + 4 * bid + (k - 1) : -1; }
            else { const int j = bid - 32;
                if (k == 0) it = 32 + j; else if (k == 1) it = 256 + j; else if (k == 2) it = (j < 32) ? 480 + j : -1;
                else if (k == 3) it = 768 + 32 + j; else if (k == 4) it = (j >= 32 && j < 64) ? 768 + (j - 32) : -1;
                else if (k == 5) it = 512 + 32 + j; else if (k == 6) it = (j >= 64 && j < 96) ? 512 + (j - 64) : -1;
                else if (k == 7) it = 1024 + j; else if (k == 8) it = (j >= 96 && j < 128) ? 1024 + 224 + (j - 96) : -1;
                else { const int m = k - 9; int r = -1;
                    if (j < 32) r = -1; else if (j < 64) r = m < 1 ? 128 + (j - 32) : -1; else if (j < 96) r = m < 2 ? 160 + 2 * (j - 64) + m : -1;
                    else if (j < 128) r = m < 5 ? 224 + 5 * (j - 96) + m : -1; else if (j < 192) r = m < 7 ? 384 + 7 * (j - 128) + m : -1; else r = m < 6 ? 832 + 6 * (j - 192) + m : -1;
                    it = r >= 0 ? 1280 + r : -1; } }
        } else { it = bid + k * G; if (it >= 2304) it = -1; }
        if (it < 0) continue;
        if (it < 512) C_SSD(it); else if (it < 768) C_RET(it - 512); else if (it < 1024) C_GLA(it - 768); else if (it < 1280) C_MEM(it - 1024); else C_RWO(it - 1280);
    }
#undef C_SSD
#undef C_RET
#undef C_GLA
#undef C_MEM
#undef C_RWO
}
typedef PG8_LAS unsigned char* lds3_t;
DI void phase_P1(const Params& p, int l, unsigned char* lds) {
    pg8::Gemm g{1024, 1024};
    SchedP1 S{(int)gridDim.x, (int)blockIdx.x, (const char*)p.ws + WS_XN, (const char*)p.ws + WS_W1T};
    EpiP E{(bf16*)(p.ws + WS_P), (bf16*)(p.ws + WS_BND)};
    pg8::gemm_phase<EpiP, SchedP1, true, true>((lds3_t)lds, g, S, E);
}
DI void phase_P3(const Params& p, int l, unsigned char* lds) {
    (void)l;
    for (int L = blockIdx.x; L < 256; L += gridDim.x) {
        int pm, pn; tile_map(L, 64, 4, pm, pn);
        pg8::Gemm g{0, 0}; SchedP3 S{pm, pn, p.ws, (int)((blockIdx.x >> 3) & 1)};
        EpiP3 E{EpiGate{(bf16*)(p.ws + WS_P)}, EpiBranch{(const bf16*)(p.ws + WS_P), (bf16*)(p.ws + WS_MRG), (const float*)(p.ws + WS_SSQ)}};
        pg8::gemm_phase<EpiP3, SchedP3, true, true>((lds3_t)lds, g, S, E);
    }
}
DI void phase_P4(const Params& p, int l, unsigned char* lds) {
    pg8::Gemm g{1024, 1024};
    SchedP4 S{(int)gridDim.x, (int)blockIdx.x, (const char*)p.ws + WS_MRG, (const char*)p.ws + WS_WOT};
    if (gridDim.x == 256) {
        float* xs = (float*)(p.ws + WS_XS) + (size_t)l * 64 * 256 * 4; unsigned* cnt = (unsigned*)(p.ws + WS_XCNT) + l * 64 * 64;
        if (l == 0) { EpiNorm<false> E{p.in[I_X], p.out, p.in[I_NORMG] + 1024, (bf16*)(p.ws + WS_XN), xs, cnt}; pg8::gemm_phase<EpiNorm<false>, SchedP4, true, true>((lds3_t)lds, g, S, E); }
        else { EpiNorm<true> E{p.out, p.out, p.in[I_FNORMG], nullptr, xs, cnt}; pg8::gemm_phase<EpiNorm<true>, SchedP4, true, true>((lds3_t)lds, g, S, E); }
    } else { EpiRes E{l == 0 ? p.in[I_X] : p.out, p.out}; pg8::gemm_phase<EpiRes, SchedP4, true, true>((lds3_t)lds, g, S, E); }
}
DI void phase_post(const Params& p, int l, unsigned char* lds) {
    if (gridDim.x == 256) { if (l == 0) convert_weights(p, 1, lds); }
    else phase_norm(p, l, 1.0f, lds);
}

#ifndef MK_LAUNCHES
#define MK_LAUNCHES 1
#endif
struct KArgs { Params p; int lo, hi; };
constexpr int N_PHASES = 15;
#ifdef NVGPR
__global__ void __launch_bounds__(NTHREADS, 2) __attribute__((amdgpu_num_vgpr(NVGPR))) fwd_kernel(KArgs a) {
#else
__global__ void __launch_bounds__(NTHREADS, 2) fwd_kernel(KArgs a) {
#endif
    extern __shared__ __attribute__((aligned(16))) unsigned char lds[];
    cg::grid_group grid = cg::this_grid();
    const Params& p = a.p;
    volatile unsigned* bst = (volatile unsigned*)(lds + LDS_BYTES - 64);
    if (threadIdx.x < 16) bst[threadIdx.x] = 0u;
    __syncthreads();
    XcdBarrier xbar = xcd_barrier_post((unsigned*)(p.ws + WS_BAR), bst);
    if (a.hi == 12345) grid.sync();
#define GRID_SYNC() xcd_barrier(xbar)
#ifndef DUP_N
#define DUP_N 1
#endif
#ifndef PHMASK
#define PHMASK 0xff
#endif
#if defined(TPROBE) && defined(PH_PROBE)
#define PH_TS_BEGIN() do { if (threadIdx.x == 0) TS_BASE(lds)[13] = (unsigned)__builtin_amdgcn_s_memrealtime(); } while (0)
#define PH_TS_MARK(k) do { __syncthreads(); if (threadIdx.x == 0) { const unsigned t_ = (unsigned)__builtin_amdgcn_s_memrealtime(); volatile unsigned* A_ = TS_BASE(lds); A_[k] += t_ - A_[13]; A_[13] = t_; } } while (0)
#else
#define PH_TS_BEGIN() do {} while (0)
#define PH_TS_MARK(k) do {} while (0)
#endif
#ifdef DUP_S
#define NREP(ty, l) (((ty) == DUP_S && !(((ty) == 6 || (ty) == 7) && (l) != 0)) ? 1 + DUP_N : 1)
#else
#define NREP(ty, l) 1
#endif
#define RUN_PHASE(ty, l, more) do { const int nrep = NREP(ty, l); \
        for (int rep = 0; rep < nrep; ++rep) { const bool dry = (rep + 1 < nrep) && (a.hi != 12345); (void)dry; PH_TS_BEGIN(); \
            if (!((PHMASK >> (ty)) & 1)) {} \
            else if ((ty) == 0) phase_prologue(p, lds); \
            else if ((ty) == 1) phase_P1(p, l, lds); \
            else if ((ty) == 2) phase_A(p, l, lds, dry); \
            else if ((ty) == 3) phase_B(p, lds, dry); \
            else if ((ty) == 4) phase_C(p, l, lds, dry); \
            else if ((ty) == 5) phase_P3(p, l, lds); \
            else if ((ty) == 6) phase_P4(p, l, lds); \
            else phase_post(p, l, lds); \
            PH_TS_MARK(ty); \
            if ((more) || rep + 1 < nrep) GRID_SYNC(); } } while (0)
#if MK_LAUNCHES == 1
#if defined(DUP_S) && DUP_S == 100
    for (int rep = 0; rep < DUP_N; ++rep) GRID_SYNC();
#endif
    RUN_PHASE(0, 0, true);
    RUN_PHASE(1, 0, true); RUN_PHASE(2, 0, true); RUN_PHASE(3, 0, true); RUN_PHASE(4, 0, true); RUN_PHASE(5, 0, true); RUN_PHASE(6, 0, true); RUN_PHASE(7, 0, true);
    RUN_PHASE(1, 1, true); RUN_PHASE(2, 1, true); RUN_PHASE(3, 1, true); RUN_PHASE(4, 1, true); RUN_PHASE(5, 1, true); RUN_PHASE(6, 1, gridDim.x != 256); RUN_PHASE(7, 1, false);
#ifdef TPROBE
    {
        GRID_SYNC();
        unsigned* pw = (unsigned*)(p.ws + WS_XS + 600 * 1024);
        if (threadIdx.x == 0) pw[blockIdx.x] = TS_BASE(lds)[TPROBE];
        GRID_SYNC();
#ifndef TP_MODE
#define TP_MODE 0
#endif
#ifndef TP_LO
#define TP_LO 0
#define TP_HI 1
#endif
        float tot = 0.f, mx = 0.f, ctot = 0.f; int amx = 0; for (int i = 0; i < (int)gridDim.x; ++i) { const float v_ = (float)__hip_atomic_load(pw + i, __ATOMIC_RELAXED, __HIP_MEMORY_SCOPE_AGENT); tot += v_; if (v_ > mx) { mx = v_; amx = i; } if (i >= TP_LO && i < TP_HI) ctot += v_; }
        const float avg_us = TP_MODE == 4 ? (float)amx : TP_MODE == 3 ? (ctot / (float)(TP_HI - TP_LO)) / (tot / (float)gridDim.x) * 100.0f : TP_MODE == 2 ? (mx * (float)gridDim.x / tot - 1.0f) * 100.0f : (TP_MODE == 0 ? tot / (float)gridDim.x : mx) * 0.01f / (float)TP_CNT;
        const float bucket = floorf(avg_us / (float)TP_Q + 0.5f);
        const float sc = 1.0f + bucket * 0.01f;
        for (int i = blockIdx.x * NTHREADS + threadIdx.x; i < M * 256; i += gridDim.x * NTHREADS) { f32x4* o = (f32x4*)p.out + i; *o = *o * sc; }
    }
#endif
#else
    for (int ph = a.lo; ph < a.hi; ++ph) { const int ty = (ph == 0) ? 0 : ((ph - 1) % 7 + 1), l = (ph - 1) / 7; RUN_PHASE(ty, l, ph + 1 < a.hi); }
#endif
}

extern "C" void kernel_launch(void* const* d_in, const int* in_sizes, int n_in, void* d_out, int out_size, void* d_ws, size_t ws_size, hipStream_t stream) {
    static int grid = 0;
    if (grid == 0) {
        if (n_in != N_IN || out_size != M * D || ws_size < WS_END) { fprintf(stderr, "kernel_launch: unexpected shapes (n_in %d, out %d, ws %zu < %zu)\n", n_in, out_size, ws_size, (size_t)WS_END); grid = -1; return; }
        int dev = 0, cus = 0, per_cu = 0;
        hipGetDevice(&dev); hipDeviceGetAttribute(&cus, hipDeviceAttributeMultiprocessorCount, dev);
        hipFuncSetAttribute((const void*)fwd_kernel, hipFuncAttributeMaxDynamicSharedMemorySize, LDS_BYTES);
        hipOccupancyMaxActiveBlocksPerMultiprocessor(&per_cu, (const void*)fwd_kernel, NTHREADS, LDS_BYTES);
        if (per_cu < 1 || cus < 1) { fprintf(stderr, "kernel_launch: occupancy query gave %d blocks/CU on %d CUs\n", per_cu, cus); grid = -1; return; }
        grid = cus * per_cu; if (grid > 256) grid = 256;
    }
    if (grid < 0) return;
    KArgs a{}; for (int i = 0; i < N_IN; ++i) a.p.in[i] = (const float*)d_in[i];
    a.p.out = (float*)d_out; a.p.ws = (unsigned char*)d_ws;
    if (hipMemsetAsync((char*)d_ws + WS_BAR, 0, WS_ZERO_BYTES, stream) != hipSuccess) { fprintf(stderr, "kernel_launch: memset of the barrier words failed\n"); return; }
    if (MK_LAUNCHES == 1) {
        a.lo = 0; a.hi = N_PHASES; void* args[] = {&a};
        hipError_t e = hipLaunchCooperativeKernel((const void*)fwd_kernel, dim3(grid), dim3(NTHREADS), args, LDS_BYTES, stream);
        if (e != hipSuccess) fprintf(stderr, "kernel_launch: cooperative launch failed: %s (grid %d)\n", hipGetErrorString(e), grid);
    } else {
        for (int ph = 0; ph < N_PHASES; ++ph) { a.lo = ph; a.hi = ph + 1; hipLaunchKernelGGL(fwd_kernel, dim3(grid), dim3(NTHREADS), LDS_BYTES, stream, a); }
    }
}
```

```cpp
#include <hip/hip_runtime.h>
#include <hip/hip_cooperative_groups.h>
#include <cstdio>
#include <cstdint>
namespace cg = cooperative_groups;
namespace pg8 {
#define PG8_LAS __attribute__((address_space(3)))
typedef unsigned short bf16_t;
typedef short bf16x8 __attribute__((ext_vector_type(8)));
typedef float f32x4 __attribute__((ext_vector_type(4)));
typedef unsigned u32x4 __attribute__((ext_vector_type(4)));
constexpr int BM = 256, BK = 64, HALF = 128, HTB = HALF * BK * 2  , STAGE_BYTES = 8 * HTB, NXCD = 8, WGM = 8;

__host__ __device__ __forceinline__ int lds_byte(int r, int c) { const int st = (r >> 4) * 2 + (c >> 5), rr = r & 15, cc = c & 31, ob = rr * 64 + cc * 2; return st * 1024 + (ob ^ (((ob >> 9) & 1) << 5)); }
__host__ __device__ __forceinline__ void stage_rc(int b, int& R, int& C) { const int st = b / 1024, sb = b % 1024, swz = sb ^ (((sb >> 9) & 1) << 5); R = (st >> 1) * 16 + swz / 64; C = (st & 1) * 32 + (swz % 64) / 2; }
__host__ __device__ __forceinline__ int perm32(int rho) { const int n = rho >> 4, i = rho & 15; return 8 * (i >> 2) + 4 * n + (i & 3); }

struct Unit { int pm, pn, kind, aux; int nt, lda, ldb; int pad_; const char* A; const char* B; };
struct Gemm { int K, lda; };


template <class Epi, class Sched, bool ALIGN_EPI = false, bool SP2 = false>
__device__ __forceinline__ void gemm_phase(PG8_LAS unsigned char* lds, const Gemm g, const Sched& S, const Epi& E) {
    int tid = threadIdx.x; asm volatile("" : "+v"(tid));
    const int wid = __builtin_amdgcn_readfirstlane(tid >> 6), lane = tid & 63, wr = wid >> 2, wc = wid & 3, fr = lane & 15, fq = lane >> 4;
    int Rv[2], Rbv[2], Cv[2];
#pragma unroll
    for (int i = 0; i < 2; ++i) { int R, C; stage_rc(tid * 16 + i * 8192, R, C); Rv[i] = R; Cv[i] = C; Rbv[i] = Epi::PERM ? ((R & ~31) + perm32(R & 31)) : R; }
    unsigned voffA[2], voffB[2], voffAn[2], voffBn[2];
    const size_t kstep = (size_t)(BK * 2);
    size_t hstepA, hstepB, hstepAn, hstepBn;
#define PG8_STRIDES(u_, vA_, vB_, hA_, hB_) do { _Pragma("unroll") for (int _i = 0; _i < 2; ++_i) { vA_[_i] = (unsigned)(Rv[_i] * (u_).lda + Cv[_i]) * 2u; vB_[_i] = (unsigned)(Rbv[_i] * (u_).ldb + Cv[_i]) * 2u; } \
        hA_ = (size_t)HALF * (u_).lda * 2; hB_ = (size_t)HALF * (u_).ldb * 2; } while (0)
    const unsigned ldsw = (unsigned)wid * 1024u;
    const int aoff = lds_byte(wr * 64 + fr, fq * 8), boff = lds_byte(wc * 32 + fr, fq * 8);
#define PG8_SA(b, h) (((b) * 2 + (h)) * HTB)
#define PG8_SB(b, h) ((4 + (b) * 2 + (h)) * HTB)
#define PG8_STAGE(bufoff, gbase, voff) do { _Pragma("unroll") for (int _i = 0; _i < 2; ++_i) \
        __builtin_amdgcn_global_load_lds((const unsigned*)((const char*)(gbase) + (voff)[_i]), (PG8_LAS unsigned*)(lds + (bufoff) + ldsw + _i * 8192), 16, 0, 0); } while (0)
#define PG8_LDA(dst, b, h) do { _Pragma("unroll") for (int m = 0; m < 4; ++m) _Pragma("unroll") for (int k = 0; k < 2; ++k) dst[m][k] = *(const PG8_LAS bf16x8*)(lds + PG8_SA(b, h) + aoff + m * 2048 + k * 1024); } while (0)
#define PG8_LDB(dst, b, h) do { _Pragma("unroll") for (int n = 0; n < 2; ++n) _Pragma("unroll") for (int k = 0; k < 2; ++k) dst[n][k] = *(const PG8_LAS bf16x8*)(lds + PG8_SB(b, h) + boff + n * 2048 + k * 1024); } while (0)
#define PG8_MMA(ai, bj, At, Bt) do { __builtin_amdgcn_s_setprio(1); _Pragma("unroll") for (int m = 0; m < 4; ++m) _Pragma("unroll") for (int n = 0; n < 2; ++n) _Pragma("unroll") for (int k = 0; k < 2; ++k) \
        acc[ai][bj][m][n] = __builtin_amdgcn_mfma_f32_16x16x32_bf16(Bt[n][k], At[m][k], acc[ai][bj][m][n], 0, 0, 0); __builtin_amdgcn_s_setprio(0); } while (0)
#define PG8_WAIT_V(n) asm volatile("s_waitcnt vmcnt(" #n ")" ::: "memory")
#define PG8_WAIT_L(n) asm volatile("s_waitcnt lgkmcnt(" #n ")" ::: "memory")
#define PG8_BAR __builtin_amdgcn_s_barrier()
#define PG8_SCHED __builtin_amdgcn_sched_barrier(0)
    Unit cur, nxt; int ui = 0;
    if (!S.next(0, cur)) return;
    PG8_STRIDES(cur, voffA, voffB, hstepA, hstepB); int nt = cur.nt;
    f32x4 acc[2][2][4][2];
#pragma unroll
    for (int a = 0; a < 2; ++a)
#pragma unroll
        for (int b = 0; b < 2; ++b)
#pragma unroll
            for (int m = 0; m < 4; ++m)
#pragma unroll
                for (int n = 0; n < 2; ++n) acc[a][b][m][n] = (f32x4){0.f, 0.f, 0.f, 0.f};
    bf16x8 At[4][2], B0[2][2], B1[2][2];
    const char* cA = cur.A; const char* cB = cur.B;
    S.a_ready(cur);
    if constexpr (SP2) {
        PG8_STAGE(PG8_SB(0, 0), cB, voffB); PG8_STAGE(PG8_SB(0, 1), cB + hstepB, voffB); PG8_STAGE(PG8_SA(0, 0), cA, voffA); PG8_STAGE(PG8_SA(0, 1), cA + hstepA, voffA);
        if (wr == 1) PG8_BAR;
        PG8_WAIT_V(2); PG8_BAR;
        PG8_STAGE(PG8_SB(1, 0), cB + kstep, voffB); PG8_STAGE(PG8_SA(1, 0), cA + kstep, voffA); PG8_STAGE(PG8_SB(1, 1), cB + hstepB + kstep, voffB);
        PG8_WAIT_V(6); PG8_BAR;
    } else {
        PG8_STAGE(PG8_SB(0, 0), cB, voffB); PG8_STAGE(PG8_SA(0, 0), cA, voffA); PG8_STAGE(PG8_SB(0, 1), cB + hstepB, voffB); PG8_STAGE(PG8_SA(0, 1), cA + hstepA, voffA);
        if (wr == 1) PG8_BAR;
        PG8_WAIT_V(4); PG8_BAR;
        PG8_STAGE(PG8_SB(1, 0), cB + kstep, voffB); PG8_STAGE(PG8_SA(1, 0), cA + kstep, voffA); PG8_STAGE(PG8_SB(1, 1), cB + hstepB + kstep, voffB);
        PG8_WAIT_V(6); PG8_BAR;
    }
    for (;;) {
        const bool has_next = S.next(ui + 1, nxt);
        const char* nA = has_next ? nxt.A : cA; const char* nB = has_next ? nxt.B : cB;
        if (has_next) PG8_STRIDES(nxt, voffAn, voffBn, hstepAn, hstepBn); else { voffAn[0] = voffA[0]; voffAn[1] = voffA[1]; voffBn[0] = voffB[0]; voffBn[1] = voffB[1]; hstepAn = hstepA; hstepBn = hstepB; }
        for (int t = 0; t < nt; t += 2) {
            const bool last = (t == nt - 2);
            const char* a1 = cA + (size_t)(t + 1) * kstep;
            const char* a2 = last ? nA : cA + (size_t)(t + 2) * kstep; const char* b2 = last ? nB : cB + (size_t)(t + 2) * kstep;
            const char* a3 = a2 + kstep; const char* b3 = b2 + kstep;
            unsigned vA2[2], vB2[2]; vA2[0] = last ? voffAn[0] : voffA[0]; vA2[1] = last ? voffAn[1] : voffA[1]; vB2[0] = last ? voffBn[0] : voffB[0]; vB2[1] = last ? voffBn[1] : voffB[1];
            const size_t hA2 = last ? hstepAn : hstepA, hB2 = last ? hstepBn : hstepB;
            if (last && has_next) S.a_ready(nxt);
            if constexpr (SP2) {
            PG8_LDB(B0, 0, 0); PG8_LDB(B1, 0, 1); PG8_SCHED; PG8_LDA(At, 0, 0); PG8_STAGE(PG8_SA(1, 1), a1 + hstepA, voffA);
            PG8_WAIT_V(8); PG8_WAIT_L(0); PG8_BAR; PG8_MMA(0, 0, At, B0); PG8_MMA(0, 1, At, B1); PG8_BAR; PG8_SCHED;
            PG8_LDA(At, 0, 1); PG8_STAGE(PG8_SB(0, 0), b2, vB2); PG8_STAGE(PG8_SB(0, 1), b2 + hB2, vB2); PG8_STAGE(PG8_SA(0, 0), a2, vA2);
            PG8_WAIT_V(8); PG8_WAIT_L(0); PG8_BAR; PG8_MMA(1, 0, At, B0); PG8_MMA(1, 1, At, B1); PG8_BAR; PG8_SCHED;
            PG8_LDB(B0, 1, 0); PG8_LDB(B1, 1, 1); PG8_SCHED; PG8_LDA(At, 1, 0); PG8_STAGE(PG8_SA(0, 1), a2 + hA2, vA2);
            PG8_WAIT_V(8); PG8_WAIT_L(0); PG8_BAR; PG8_MMA(0, 0, At, B0); PG8_MMA(0, 1, At, B1); PG8_BAR; PG8_SCHED;
            PG8_LDA(At, 1, 1); PG8_STAGE(PG8_SB(1, 0), b3, vB2); PG8_STAGE(PG8_SB(1, 1), b3 + hB2, vB2); PG8_STAGE(PG8_SA(1, 0), a3, vA2);
            PG8_WAIT_V(8); PG8_WAIT_L(0); PG8_BAR; PG8_MMA(1, 0, At, B0); PG8_MMA(1, 1, At, B1); PG8_BAR; PG8_SCHED;
            } else {
            PG8_LDB(B0, 0, 0); PG8_SCHED; PG8_LDA(At, 0, 0); PG8_STAGE(PG8_SA(1, 1), a1 + hstepA, voffA);
            PG8_WAIT_L(8); PG8_BAR; PG8_WAIT_L(0); PG8_MMA(0, 0, At, B0); PG8_BAR; PG8_SCHED;
            PG8_LDB(B1, 0, 1); PG8_STAGE(PG8_SB(0, 0), b2, vB2);
            PG8_BAR; PG8_WAIT_L(0); PG8_MMA(0, 1, At, B1); PG8_BAR;
            PG8_LDA(At, 0, 1); PG8_STAGE(PG8_SA(0, 0), a2, vA2);
            PG8_BAR; PG8_WAIT_L(0); PG8_MMA(1, 0, At, B0); PG8_BAR; PG8_SCHED;
            PG8_STAGE(PG8_SB(0, 1), b2 + hB2, vB2);
            PG8_WAIT_V(6); PG8_BAR; PG8_MMA(1, 1, At, B1); PG8_BAR;
            PG8_LDB(B0, 1, 0); PG8_SCHED; PG8_LDA(At, 1, 0); PG8_STAGE(PG8_SA(0, 1), a2 + hA2, vA2);
            PG8_WAIT_L(8); PG8_BAR; PG8_WAIT_L(0); PG8_MMA(0, 0, At, B0); PG8_BAR; PG8_SCHED;
            PG8_LDB(B1, 1, 1); PG8_STAGE(PG8_SB(1, 0), b3, vB2);
            PG8_BAR; PG8_WAIT_L(0); PG8_MMA(0, 1, At, B1); PG8_BAR;
            PG8_LDA(At, 1, 1); PG8_STAGE(PG8_SA(1, 0), a3, vA2);
            PG8_BAR; PG8_WAIT_L(0); PG8_MMA(1, 0, At, B0); PG8_BAR; PG8_SCHED;
            PG8_STAGE(PG8_SB(1, 1), b3 + hB2, vB2);
            PG8_WAIT_V(6); PG8_BAR; PG8_MMA(1, 1, At, B1); PG8_BAR;
            }
        }
        if constexpr (ALIGN_EPI) { if (wr == 0) PG8_BAR; }
        if constexpr (!Epi::AFTER_DRAIN) { E(acc, cur, wr, wc, fr, fq); S.done(cur); }
        if (!has_next) break;
#pragma unroll
        for (int a = 0; a < 2; ++a)
#pragma unroll
            for (int b = 0; b < 2; ++b)
#pragma unroll
                for (int m = 0; m < 4; ++m)
#pragma unroll
                    for (int n = 0; n < 2; ++n) acc[a][b][m][n] = (f32x4){0.f, 0.f, 0.f, 0.f};
        cur = nxt; cA = nA; cB = nB; ++ui; nt = cur.nt; voffA[0] = voffAn[0]; voffA[1] = voffAn[1]; voffB[0] = voffBn[0]; voffB[1] = voffBn[1]; hstepA = hstepAn; hstepB = hstepBn;
        if constexpr (ALIGN_EPI) { if (wr == 1) PG8_BAR; }
    }
    PG8_WAIT_V(0);
    if constexpr (!ALIGN_EPI) { if (wr == 0) PG8_BAR; }
    PG8_BAR;
    if constexpr (Epi::AFTER_DRAIN) { E.fused(acc, cur, wr, wc, fr, fq, lds, wid, lane); S.done(cur); }
#undef PG8_STRIDES
#undef PG8_SA
#undef PG8_SB
#undef PG8_STAGE
#undef PG8_LDA
#undef PG8_LDB
#undef PG8_MMA
#undef PG8_WAIT_V
#undef PG8_WAIT_L
#undef PG8_BAR
#undef PG8_SCHED
}
}

#define DI __device__ __forceinline__
typedef unsigned short bf16;
typedef short bf16x8 __attribute__((ext_vector_type(8)));
typedef float f32x4 __attribute__((ext_vector_type(4)));
typedef unsigned u32x4 __attribute__((ext_vector_type(4)));
typedef unsigned u32x2 __attribute__((ext_vector_type(2)));

constexpr int D = 1024, NBATCH = 4, T = 4096, M = NBATCH * T, IN_TOTAL = 12184;
constexpr int LDP = 7168;
constexpr int C_RQ = 0, C_RK = 256, C_RV = 512, C_RG = 1024, C_GQ = 1536, C_GK = 1792, C_GV = 2048, C_GG = 2560,
              C_SX = 3072, C_SZ = 4096, C_WR = 4608, C_WK = 5120, C_WV = 5632, C_WL = 6144, C_AL = 6208, C_WG = 6272,
              C_MQ = 6784, C_GKL = 7040, C_SDT = 7056;
enum { I_X = 0, I_MEM, I_POS, I_NORMG, I_WIN, I_GKW2, I_GKB, I_GNORMG, I_CONVW, I_CONVB, I_DTB, I_ALOG, I_SD, I_SNORMG,
       I_MU, I_W0, I_W2, I_A0, I_A2, I_KK, I_KA, I_RK, I_LNG, I_LNB, I_MNORMG, I_WKV, I_URET, I_UGLA, I_USSD, I_URWKV,
       I_UMEM, I_WOUT, I_FNORMG, N_IN };
constexpr size_t MiB = 1u << 20;
constexpr size_t WS_SSQ = 0;
constexpr size_t WS_DG = 512 * 1024;
constexpr size_t WS_DS = 576 * 1024;
constexpr size_t WS_BAR = 640 * 1024;
constexpr size_t WS_KM = 1 * MiB;
constexpr size_t WS_VMT = 1 * MiB + 512 * 1024;
constexpr size_t WS_MEMN = 2 * MiB;
constexpr size_t WS_BND = 6 * MiB;
constexpr int BND_W = 1792;
constexpr size_t WS_XS = 7 * MiB;
constexpr size_t WS_XCNT = 640 * 1024 + 16384;
constexpr size_t WS_ZERO_BYTES = 16384 + 2 * 64 * 256;
constexpr size_t WS_W1T = 8 * MiB;
constexpr size_t WS_WGT = 22 * MiB;
constexpr size_t WS_UT = 32 * MiB;
constexpr size_t WS_UST = 35 * MiB;
constexpr size_t WS_UMT = 36 * MiB;
constexpr size_t WS_WOT = 37 * MiB;
constexpr size_t WS_WKVT = 39 * MiB;
constexpr size_t WS_XN = 40 * MiB;
constexpr size_t WS_P = 72 * MiB;
constexpr size_t WS_OMEM = 296 * MiB;
constexpr size_t WS_RETL = 304 * MiB;
constexpr size_t WS_GLAL = 312 * MiB;
constexpr size_t WS_SSDL = 320 * MiB;
constexpr size_t WS_MRG = 304 * MiB;
constexpr size_t WS_RWGH = 336 * MiB;
constexpr size_t WS_END = 368 * MiB;

constexpr int LDS_BYTES = 147456;
constexpr int NTHREADS = 512;

struct Params { const float* in[N_IN]; float* out; unsigned char* ws; };

DI float bf2f(unsigned b) { return __uint_as_float(b << 16); }
typedef __bf16 bf16n2 __attribute__((ext_vector_type(2)));
DI unsigned f2bf(float f) { const __bf16 b = (__bf16)f; return (unsigned)__builtin_bit_cast(unsigned short, b); }
DI unsigned pk2(float lo, float hi) { const bf16n2 v = {(__bf16)lo, (__bf16)hi}; return __builtin_bit_cast(unsigned, v); }
DI float lo16(unsigned u) { return __uint_as_float(u << 16); }
DI float hi16(unsigned u) { return __uint_as_float(u & 0xffff0000u); }
DI void unpack8(u32x4 v, float* f) { f[0] = lo16(v.x); f[1] = hi16(v.x); f[2] = lo16(v.y); f[3] = hi16(v.y); f[4] = lo16(v.z); f[5] = hi16(v.z); f[6] = lo16(v.w); f[7] = hi16(v.w); }
DI u32x4 pack8(const float* f) { u32x4 v; v.x = pk2(f[0], f[1]); v.y = pk2(f[2], f[3]); v.z = pk2(f[4], f[5]); v.w = pk2(f[6], f[7]); return v; }
DI u32x2 pack4(f32x4 a) { u32x2 v; v.x = pk2(a[0], a[1]); v.y = pk2(a[2], a[3]); return v; }
DI float fexp(float x) { return __expf(x); }
DI float sigmoidf_(float x) { return __builtin_amdgcn_rcpf(1.0f + __expf(-x)); }
DI float siluf_(float x) { return x * __builtin_amdgcn_rcpf(1.0f + __expf(-x)); }
DI float softplusf_(float x) { return fmaxf(x, 0.0f) + __logf(1.0f + __expf(-fabsf(x))); }
DI float logsigmoidf_(float x) { return fminf(x, 0.0f) - __logf(1.0f + __expf(-fabsf(x))); }
DI float tanhf_(float x) { const float e = __expf(2.0f * x); return 1.0f - 2.0f * __builtin_amdgcn_rcpf(e + 1.0f); }
DI int opaque_tid() { int t = threadIdx.x; asm volatile("" : "+v"(t)); return t; }
#ifdef TPROBE
#define TS_BASE(lds_) ((volatile unsigned*)((lds_) + LDS_BYTES - 64) + 2)
#define TS_BEGIN() do { if (threadIdx.x == 0) TS_BASE(lds)[13] = (unsigned)__builtin_amdgcn_s_memrealtime(); } while (0)
#define TS_MARK(k) do { if (threadIdx.x == 0) { const unsigned t_ = (unsigned)__builtin_amdgcn_s_memrealtime(); volatile unsigned* A_ = TS_BASE(lds); A_[k] += t_ - A_[13]; A_[13] = t_; } } while (0)
#endif
#define WAVE_LDS_SYNC() asm volatile("s_waitcnt lgkmcnt(0)" ::: "memory")
DI float wave_sum(float v) {
#pragma unroll
    for (int o = 1; o < 64; o <<= 1) v += __shfl_xor(v, o);
    return v;
}
DI bf16x8 frag(const bf16* base, int ld, int r0, int k0, int lane) { return *(const bf16x8*)(base + (r0 + (lane & 15)) * ld + k0 + ((lane >> 4) << 3)); }
DI f32x4 mfma16(bf16x8 a, bf16x8 b, f32x4 c) { return __builtin_amdgcn_mfma_f32_16x16x32_bf16(a, b, c, 0, 0, 0); }

DI void tile_map(int L, int nM, int nN, int& pm, int& pn) {
    const int nwg = nM * nN; int wgid = L;
    { const int q = nwg / 8, r = nwg % 8, xcd = wgid % 8, off = wgid / 8; wgid = (xcd < r ? xcd * (q + 1) : r * (q + 1) + (xcd - r) * q) + off; }
    const int nig = 8 * nN, gid = wgid / nig, fm = gid * 8, gsz = (nM - fm) < 8 ? (nM - fm) : 8;
    pm = fm + ((wgid % nig) % gsz); pn = (wgid % nig) / gsz;
}

using pg8::Unit;
struct SchedP1 {
    int G, c; const char* A; const char* B;
    DI bool next(int i, Unit& u) const {
        const long L = (long)i * G + c; if (L >= 64 * 28) return false;
        tile_map((int)L, 64, 28, u.pm, u.pn); u.kind = 0; u.aux = 0; u.nt = 16; u.lda = 1024; u.ldb = 1024; u.pad_ = 0;
        u.A = A + (size_t)u.pm * 256 * 1024 * 2; u.B = B + (size_t)u.pn * 256 * 1024 * 2; return true;
    }
    DI void a_ready(const Unit&) const {}
    DI void done(const Unit&) const {}
};
struct EpiP {
    static constexpr bool PERM = true, AFTER_DRAIN = false;
    bf16* O; bf16* BND;
    DI void operator()(const f32x4 (&acc)[2][2][4][2], const Unit& u, int wr, int wc, int fr, int fq) const {
        const int row0 = u.pm * 256 + wr * 64 + fr, col0 = u.pn * 256 + wc * 32 + 8 * fq;
#pragma unroll
        for (int ai = 0; ai < 2; ++ai)
#pragma unroll
            for (int m = 0; m < 4; ++m) { bf16* rowp = O + (size_t)(row0 + ai * 128 + m * 16) * LDP + col0;
#pragma unroll
                for (int bj = 0; bj < 2; ++bj) { const f32x4 v0 = acc[ai][bj][m][0], v1 = acc[ai][bj][m][1];
                    u32x4 w; w.x = pk2(v0[0], v0[1]); w.y = pk2(v0[2], v0[3]); w.z = pk2(v1[0], v1[1]); w.w = pk2(v1[2], v1[3]);
                    *(u32x4*)(rowp + bj * 128) = w;
                    if (m == 3 && fr == 15 && u.pn >= 18 && u.pn <= 24) *(u32x4*)(BND + (size_t)((row0 + ai * 128 + m * 16) >> 6) * BND_W + (col0 - 4608) + bj * 128) = w; } }
    }
};
DI int gate_slot_col(int s) { return s < 8 ? 128 * s : s < 16 ? 1536 + 128 * (s - 8) : s < 24 ? 3072 + 128 * (s - 16) : s < 37 ? 4608 + 128 * (s - 24) : 6784 + 128 * (s - 37); }
struct SchedP3 {
    int pm, pn; const unsigned char* ws; int alt;
    DI bool next(int i0, Unit& u) const {
        if (i0 >= 11) return false;
        const unsigned long long code = alt == 0 ? 0xA4982736150ull : alt == 1 ? 0xA9847263510ull : alt == 2 ? 0x736150982A4ull : 0x76315908A24ull;
        const int i = (int)((code >> (4 * i0)) & 15ull), fb = alt < 2 ? 5 : 10;
        u.pm = pm; u.pn = pn; u.pad_ = 0;
        if (i < 5) { u.kind = i; u.aux = 16; u.nt = 16; u.lda = 1024; u.ldb = 1024; u.A = (const char*)ws + WS_XN + (size_t)pm * 256 * 1024 * 2;
            u.B = (const char*)ws + WS_WGT + ((size_t)i * 1024 + (size_t)pn * 256) * 1024 * 2; }
        else if (i < 8) { const int j = i - 5; const int col = j == 0 ? C_RG : j == 1 ? C_GG : C_WG; u.kind = j == 0 ? 0 : j == 1 ? 1 : 3; u.aux = (i == fb) ? 1 : 0; u.nt = 8; u.lda = LDP; u.ldb = 512;
            u.A = (const char*)ws + WS_P + ((size_t)pm * 256 * LDP + col) * 2;
            u.B = (const char*)ws + WS_UT + ((size_t)j * 1024 + (size_t)pn * 256) * 512 * 2; }
        else if (i < 10) { const int j = i - 8; u.kind = 2; u.aux = (j + 1) << 1; u.nt = 4; u.lda = LDP; u.ldb = 256;
            u.A = (const char*)ws + WS_P + ((size_t)pm * 256 * LDP + C_SZ + j * 256) * 2;
            u.B = (const char*)ws + WS_UST + ((size_t)j * 1024 + (size_t)pn * 256) * 256 * 2; }
        else { u.kind = 4; u.aux = (i == fb) ? 1 : 0; u.nt = 4; u.lda = 256; u.ldb = 256; u.A = (const char*)ws + WS_OMEM + (size_t)pm * 256 * 256 * 2;
            u.B = (const char*)ws + WS_UMT + ((size_t)pn * 256) * 256 * 2; }
        return true;
    }
    DI void a_ready(const Unit&) const {}
    DI void done(const Unit&) const {}
};
typedef float f32x2 __attribute__((ext_vector_type(2)));
DI f32x2 sig255_pk(f32x2 x) {
    x = __builtin_elementwise_min(__builtin_elementwise_max(x, (f32x2){-7.0f, -7.0f}), (f32x2){7.0f, 7.0f});
    const f32x2 x2 = x * x;
    f32x2 q = x2 * 9.362619013e-11f + (-1.716749942e-08f);
    q = q * x2 + 1.283517804e-06f; q = q * x2 + (-5.098115798e-05f); q = q * x2 + 1.195220742e-03f; q = q * x2 + (-1.824038848e-02f); q = q * x2 + 2.476293743e-01f;
    return (x * q) * 255.0f + 128.0f;
}
DI f32x2 sig_pk(f32x2 x) { return (sig255_pk(x) - 128.0f) * (1.0f / 255.0f) + 0.5f; }
struct EpiGate {
    static constexpr bool PERM = true, AFTER_DRAIN = false;
    bf16* P;
    DI void operator()(const f32x4 (&acc)[2][2][4][2], const Unit& u, int wr, int wc, int fr, int fq) const {
        const int row0 = u.pm * 256 + wr * 64 + fr;
#pragma unroll
        for (int bj = 0; bj < 2; ++bj) { const int col = gate_slot_col((u.kind * 4 + u.pn) * 2 + bj);
#pragma unroll
            for (int ai = 0; ai < 2; ++ai)
#pragma unroll
                for (int m = 0; m < 4; ++m) { const f32x4 v0 = acc[ai][bj][m][0], v1 = acc[ai][bj][m][1];
                    const f32x2 a = sig255_pk((f32x2){v0[0], v0[1]}), b = sig255_pk((f32x2){v0[2], v0[3]}), c = sig255_pk((f32x2){v1[0], v1[1]}), d = sig255_pk((f32x2){v1[2], v1[3]});
                    u32x2 w; w.x = (unsigned)a.x | ((unsigned)a.y << 8) | ((unsigned)b.x << 16) | ((unsigned)b.y << 24);
                    w.y = (unsigned)c.x | ((unsigned)c.y << 8) | ((unsigned)d.x << 16) | ((unsigned)d.y << 24);
                    *(u32x2*)((unsigned char*)(P + (size_t)(row0 + ai * 128 + m * 16) * LDP + col) + wc * 32 + 8 * fq) = w; } }
    }
};
struct EpiBranch {
    static constexpr bool PERM = true, AFTER_DRAIN = false;
    const bf16* P; bf16* MG; const float* ssq;
    DI void operator()(const f32x4 (&acc)[2][2][4][2], const Unit& u, int wr, int wc, int fr, int fq) const {
        const int row0 = u.pm * 256 + wr * 64 + fr; const bool first = (u.aux & 1) != 0; const int grp = (u.aux >> 1) - 1;
        const int gc0 = gate_slot_col((u.kind * 4 + u.pn) * 2 + 0), gc1 = gate_slot_col((u.kind * 4 + u.pn) * 2 + 1);
        u32x2 g8[2][2][2]; u32x4 o8[2][2][2]; f32x4 s4[2][2];
#define EB_LOAD(buf, ai, mh) do { \
        _Pragma("unroll") for (int m2 = 0; m2 < 2; ++m2) { const int row = row0 + (ai) * 128 + (2 * (mh) + m2) * 16; \
            s4[buf][m2] = *(const f32x4*)(ssq + (size_t)row * 8 + (grp > 0 ? 4 : 0)); \
            _Pragma("unroll") for (int bj = 0; bj < 2; ++bj) { \
                g8[buf][m2][bj] = *(const u32x2*)((const unsigned char*)(P + (size_t)row * LDP + (bj ? gc1 : gc0)) + wc * 32 + 8 * fq); \
                o8[buf][m2][bj] = *(const u32x4*)(MG + (size_t)row * 1024 + u.pn * 256 + bj * 128 + wc * 32 + 8 * fq); } } } while (0)
#define EB_COMP(buf, ai, mh) do { \
        _Pragma("unroll") for (int m2 = 0; m2 < 2; ++m2) { const int m = 2 * (mh) + m2, row = row0 + (ai) * 128 + m * 16; \
            const float sc = (grp >= 0) ? __builtin_amdgcn_rsqf(((s4[buf][m2][0] + s4[buf][m2][1]) + (s4[buf][m2][2] + s4[buf][m2][3])) * (1.0f / 256.0f) + 1e-6f) : 1.0f; \
            _Pragma("unroll") for (int bj = 0; bj < 2; ++bj) { float g[8], pv[8]; \
                _Pragma("unroll") for (int j = 0; j < 4; ++j) { g[j] = (float)((g8[buf][m2][bj].x >> (8 * j)) & 0xffu) * (1.0f / 255.0f); g[4 + j] = (float)((g8[buf][m2][bj].y >> (8 * j)) & 0xffu) * (1.0f / 255.0f); } \
                unpack8(o8[buf][m2][bj], pv); \
                if (first) { _Pragma("unroll") for (int j = 0; j < 8; ++j) pv[j] = 0.f; } \
                const f32x4 v0 = acc[ai][bj][m][0], v1 = acc[ai][bj][m][1]; \
                float o[8] = { v0[0] * sc * g[0] + pv[0], v0[1] * sc * g[1] + pv[1], v0[2] * sc * g[2] + pv[2], v0[3] * sc * g[3] + pv[3], v1[0] * sc * g[4] + pv[4], v1[1] * sc * g[5] + pv[5], v1[2] * sc * g[6] + pv[6], v1[3] * sc * g[7] + pv[7] }; \
                *(u32x4*)(MG + (size_t)row * 1024 + u.pn * 256 + bj * 128 + wc * 32 + 8 * fq) = pack8(o); } } } while (0)
        EB_LOAD(0, 0, 0); EB_LOAD(1, 0, 1);
        __builtin_amdgcn_sched_barrier(0);
        EB_COMP(0, 0, 0); EB_LOAD(0, 1, 0);
        __builtin_amdgcn_sched_barrier(0);
        EB_COMP(1, 0, 1); EB_LOAD(1, 1, 1);
        __builtin_amdgcn_sched_barrier(0);
        EB_COMP(0, 1, 0);
        __builtin_amdgcn_sched_barrier(0);
        EB_COMP(1, 1, 1);
#undef EB_LOAD
#undef EB_COMP
    }
};
struct EpiP3 {
    static constexpr bool PERM = true, AFTER_DRAIN = false;
    EpiGate G; EpiBranch B;
    DI void operator()(const f32x4 (&acc)[2][2][4][2], const Unit& u, int wr, int wc, int fr, int fq) const { if (u.aux & 16) G(acc, u, wr, wc, fr, fq); else B(acc, u, wr, wc, fr, fq); }
};
struct SchedP4 {
    int G, c; const char* A; const char* B;
    DI bool next(int i, Unit& u) const {
        const long L = (long)i * G + c; if (L >= 64 * 4) return false;
        tile_map((int)L, 64, 4, u.pm, u.pn); u.kind = 0; u.aux = 0; u.nt = 16; u.lda = 1024; u.ldb = 1024; u.pad_ = 0;
        u.A = A + (size_t)u.pm * 256 * 1024 * 2; u.B = B + (size_t)u.pn * 256 * 1024 * 2; return true;
    }
    DI void a_ready(const Unit&) const {}
    DI void done(const Unit&) const {}
};
struct EpiRes {
    static constexpr bool PERM = false, AFTER_DRAIN = false;
    const float* res; float* out;
    DI void operator()(const f32x4 (&acc)[2][2][4][2], const Unit& u, int wr, int wc, int fr, int fq) const {
        const int row0 = u.pm * 256 + wr * 64 + fr, col0 = u.pn * 256 + wc * 32 + 4 * fq;
#pragma unroll
        for (int ai = 0; ai < 2; ++ai)
#pragma unroll
            for (int m = 0; m < 4; ++m) { const size_t off = (size_t)(row0 + ai * 128 + m * 16) * 1024 + col0;
#pragma unroll
                for (int bj = 0; bj < 2; ++bj)
#pragma unroll
                    for (int n = 0; n < 2; ++n) { const f32x4 r = *(const f32x4*)(res + off + bj * 128 + n * 16); *(f32x4*)(out + off + bj * 128 + n * 16) = r + acc[ai][bj][m][n]; } }
    }
};

template <bool LAST> struct EpiNorm {
    static constexpr bool PERM = false, AFTER_DRAIN = true;
    const float* res; float* out; const float* g; bf16* xn; float* xs; unsigned* cnt;
    DI void operator()(const f32x4 (&)[2][2][4][2], const Unit&, int, int, int, int) const {}
    DI void fused(f32x4 (&acc)[2][2][4][2], const Unit& u, int wr, int wc, int fr, int fq, PG8_LAS unsigned char* lds, int wid, int lane) const {
        PG8_LAS float* Pt = (PG8_LAS float*)lds; PG8_LAS float* St = Pt + 1024;
        const int row0 = u.pm * 256 + wr * 64 + fr, col0 = u.pn * 256 + wc * 32 + 4 * fq;
#pragma unroll
        for (int ai = 0; ai < 2; ++ai)
#pragma unroll
            for (int m = 0; m < 4; ++m) { const size_t off = (size_t)(row0 + ai * 128 + m * 16) * 1024 + col0; float s = 0.f;
#pragma unroll
                for (int bj = 0; bj < 2; ++bj)
#pragma unroll
                    for (int n = 0; n < 2; ++n) { const f32x4 r = *(const f32x4*)(res + off + bj * 128 + n * 16); const f32x4 x = r + acc[ai][bj][m][n]; acc[ai][bj][m][n] = x;
                        s += (x[0] * x[0] + x[1] * x[1]) + (x[2] * x[2] + x[3] * x[3]); }
                s += __shfl_xor(s, 16); s += __shfl_xor(s, 32);
                if (fq == 0) Pt[(ai * 128 + wr * 64 + m * 16 + fr) * 4 + wc] = s; }
        asm volatile("s_waitcnt lgkmcnt(0)" ::: "memory"); __builtin_amdgcn_s_barrier(); asm volatile("" ::: "memory");
        const int row = wid * 32 + (lane & 31);
        if (lane < 32) { const float t = (Pt[row * 4 + 0] + Pt[row * 4 + 1]) + (Pt[row * 4 + 2] + Pt[row * 4 + 3]);
            __hip_atomic_store(xs + ((size_t)u.pm * 256 + row) * 4 + u.pn, t, __ATOMIC_RELAXED, __HIP_MEMORY_SCOPE_AGENT); }
        asm volatile("s_waitcnt vmcnt(0)" ::: "memory");
        if (lane == 0) (void)__hip_atomic_fetch_add(cnt + u.pm * 64, 1u, __ATOMIC_RELAXED, __HIP_MEMORY_SCOPE_AGENT);
        if (wid == 0) { unsigned spins = 0;
            while ((unsigned)__builtin_amdgcn_readfirstlane(__hip_atomic_load(cnt + u.pm * 64, __ATOMIC_RELAXED, __HIP_MEMORY_SCOPE_AGENT)) < 32u) { __builtin_amdgcn_s_sleep(2); if (++spins > (1u << 22)) break; }
            __builtin_amdgcn_fence(__ATOMIC_ACQUIRE, "agent"); asm volatile("s_waitcnt vmcnt(0)" ::: "memory"); }
        asm volatile("" ::: "memory"); __builtin_amdgcn_s_barrier(); asm volatile("" ::: "memory");
        if (lane < 32) { const float* sp = xs + ((size_t)u.pm * 256 + row) * 4;
            const float a = __hip_atomic_load(sp + 0, __ATOMIC_RELAXED, __HIP_MEMORY_SCOPE_AGENT), b = __hip_atomic_load(sp + 1, __ATOMIC_RELAXED, __HIP_MEMORY_SCOPE_AGENT),
                        c = __hip_atomic_load(sp + 2, __ATOMIC_RELAXED, __HIP_MEMORY_SCOPE_AGENT), d = __hip_atomic_load(sp + 3, __ATOMIC_RELAXED, __HIP_MEMORY_SCOPE_AGENT);
            St[row] = __builtin_amdgcn_rsqf(((a + b) + (c + d)) * (1.0f / 1024.0f) + 1e-6f); }
        asm volatile("s_waitcnt lgkmcnt(0)" ::: "memory"); __builtin_amdgcn_s_barrier(); asm volatile("" ::: "memory");
#pragma unroll
        for (int ai = 0; ai < 2; ++ai)
#pragma unroll
            for (int m = 0; m < 4; ++m) { const size_t off = (size_t)(row0 + ai * 128 + m * 16) * 1024 + col0; const float rs = St[ai * 128 + wr * 64 + m * 16 + fr];
#pragma unroll
                for (int bj = 0; bj < 2; ++bj)
#pragma unroll
                    for (int n = 0; n < 2; ++n) { const f32x4 gv = *(const f32x4*)(g + col0 + bj * 128 + n * 16); const f32x4 x = acc[ai][bj][m][n]; const f32x4 y = x * rs * gv;
                        if (LAST) *(f32x4*)(out + off + bj * 128 + n * 16) = y;
                        else { *(f32x4*)(out + off + bj * 128 + n * 16) = x; *(u32x2*)(xn + off + bj * 128 + n * 16) = pack4(y); } } }
    }
};

DI void transpose_item(const float* W, int ldw, int K, bf16* WT, float* scr, int item, int nblk, int lane) {
    const int kb = item / nblk, nb = item % nblk, k0 = 64 * kb, n0 = 32 * nb;
    float tv[32];
#pragma unroll
    for (int i = 0; i < 32; ++i) { const int kk = 2 * i + (lane >> 5); tv[i] = W[(size_t)(k0 + kk) * ldw + n0 + (lane & 31)]; }
#pragma unroll
    for (int i = 0; i < 32; ++i) { const int kk = 2 * i + (lane >> 5); scr[kk * 33 + (lane & 31)] = tv[i]; }
    WAVE_LDS_SYNC();
    const int c = lane & 7;
#pragma unroll
    for (int j = 0; j < 4; ++j) { const int n = (lane >> 3) + 8 * j; const float* s = scr + (8 * c) * 33 + n;
        u32x4 o; o.x = pk2(s[0 * 33], s[1 * 33]); o.y = pk2(s[2 * 33], s[3 * 33]); o.z = pk2(s[4 * 33], s[5 * 33]); o.w = pk2(s[6 * 33], s[7 * 33]);
        *(u32x4*)(WT + (size_t)(n0 + n) * K + k0 + 8 * c) = o; }
    WAVE_LDS_SYNC();
}
struct TSeg { int inp, lstride, src0, ldw, K, nblk; unsigned dst_q, dst_rows0; };
DI void rms_row_bf16(const float* xrow, const float* g, bf16* orow, int lane) {
    const f32x4* xr = (const f32x4*)xrow + lane; const f32x4* gr = (const f32x4*)g + lane;
    f32x4 v[4]; float s = 0.f;
#pragma unroll
    for (int j = 0; j < 4; ++j) { v[j] = xr[64 * j]; s += (v[j][0] * v[j][0] + v[j][1] * v[j][1]) + (v[j][2] * v[j][2] + v[j][3] * v[j][3]); }
    const float rstd = __builtin_amdgcn_rsqf(wave_sum(s) * (1.0f / 1024.0f) + 1e-6f);
    u32x2* o8 = (u32x2*)orow + lane;
#pragma unroll
    for (int j = 0; j < 4; ++j) { const f32x4 gg = gr[64 * j]; u32x2 o; o.x = pk2(v[j][0] * rstd * gg[0], v[j][1] * rstd * gg[1]); o.y = pk2(v[j][2] * rstd * gg[2], v[j][3] * rstd * gg[3]); o8[64 * j] = o; }
}
DI void convert_weights(const Params& p, int l, unsigned char* lds) {
    const int tid = opaque_tid(), lane = tid & 63, wave = tid >> 6;
    const int gw = blockIdx.x * 8 + wave, NGW = gridDim.x * 8;
    float* scr = (float*)(lds + wave * 16384);
    static constexpr TSeg segs[] = {
        {I_WIN, 1024 * IN_TOTAL, 0,    IN_TOTAL, 1024, 2560 / 32, 32, 0},
        {I_WIN, 1024 * IN_TOTAL, 2576, IN_TOTAL, 1024, 512 / 32,  32, 2560},
        {I_WIN, 1024 * IN_TOTAL, 3088, IN_TOTAL, 1024, 1024 / 32, 32, 3072},
        {I_WIN, 1024 * IN_TOTAL, 4120, IN_TOTAL, 1024, 512 / 32,  32, 4096},
        {I_WIN, 1024 * IN_TOTAL, 4632, IN_TOTAL, 1024, 1664 / 32, 32, 4608},
        {I_WIN, 1024 * IN_TOTAL, 6296, IN_TOTAL, 1024, 512 / 32,  32, 6272},
        {I_WIN, 1024 * IN_TOTAL, 6808, IN_TOTAL, 1024, 256 / 32,  32, 6784},
        {I_WIN, 1024 * IN_TOTAL, 7064, IN_TOTAL, 1024, 5120 / 32, 88, 0},
        {I_URET,  512 * 1024, 0, 1024, 512, 32, 128, 0},
        {I_UGLA,  512 * 1024, 0, 1024, 512, 32, 128, 1024},
        {I_URWKV, 512 * 1024, 0, 1024, 512, 32, 128, 2048},
        {I_USSD,  512 * 1024, 0,          1024, 256, 32, 140, 0},
        {I_USSD,  512 * 1024, 256 * 1024, 1024, 256, 32, 140, 1024},
        {I_UMEM,  256 * 1024, 0, 1024, 256, 32, 144, 0},
        {I_WOUT, 1024 * 1024, 0, 1024, 1024, 32, 148, 0},
        {I_WKV,  1024 * 512,  0, 512,  1024, 16, 156, 0},
    };
    constexpr int NSEG = sizeof(segs) / sizeof(segs[0]);
    int base = 0;
    for (int s = 0; s < NSEG; ++s) {
        const TSeg sg = segs[s]; const int nitems = (sg.K / 64) * sg.nblk;
        int it = gw - (base % NGW); if (it < 0) it += NGW;
        const float* W = p.in[sg.inp] + (size_t)l * sg.lstride + sg.src0;
        bf16* WT = (bf16*)(p.ws + (size_t)sg.dst_q * 262144) + (size_t)sg.dst_rows0 * sg.K;
        for (; it < nitems; it += NGW) transpose_item(W, sg.ldw, sg.K, WT, scr, it, sg.nblk, lane);
        base += nitems;
    }
    for (int idx = blockIdx.x * NTHREADS + tid; idx < 128 * 1024; idx += gridDim.x * NTHREADS) {
        const int r = (idx >> 10) & 127, k = idx & 1023;
        const float* W = p.in[I_WIN] + (size_t)l * 1024 * IN_TOTAL + (size_t)k * IN_TOTAL;
        const float v = r < 16 ? W[2560 + r] : r < 24 ? W[4112 + (r - 16)] : 0.0f;
        ((bf16*)(p.ws + WS_W1T))[((size_t)7040 + r) * 1024 + k] = (bf16)f2bf(v);
    }
}
DI void rms_rows2_bf16(const float* x0, const float* x1, const float* g, bf16* o0, bf16* o1, int lane) {
    const f32x4* xa = (const f32x4*)x0 + lane; const f32x4* xb = (const f32x4*)x1 + lane; const f32x4* gr = (const f32x4*)g + lane;
    f32x4 va[4], vb[4]; float sa = 0.f, sb = 0.f;
#pragma unroll
    for (int j = 0; j < 4; ++j) { va[j] = xa[64 * j]; vb[j] = xb[64 * j]; }
#pragma unroll
    for (int j = 0; j < 4; ++j) { sa += (va[j][0] * va[j][0] + va[j][1] * va[j][1]) + (va[j][2] * va[j][2] + va[j][3] * va[j][3]); sb += (vb[j][0] * vb[j][0] + vb[j][1] * vb[j][1]) + (vb[j][2] * vb[j][2] + vb[j][3] * vb[j][3]); }
    const float ra = __builtin_amdgcn_rsqf(wave_sum(sa) * (1.0f / 1024.0f) + 1e-6f), rb = __builtin_amdgcn_rsqf(wave_sum(sb) * (1.0f / 1024.0f) + 1e-6f);
    u32x2* pa = (u32x2*)o0 + lane; u32x2* pb = (u32x2*)o1 + lane;
#pragma unroll
    for (int j = 0; j < 4; ++j) { const f32x4 gg = gr[64 * j]; u32x2 o; o.x = pk2(va[j][0] * ra * gg[0], va[j][1] * ra * gg[1]); o.y = pk2(va[j][2] * ra * gg[2], va[j][3] * ra * gg[3]); pa[64 * j] = o;
        o.x = pk2(vb[j][0] * rb * gg[0], vb[j][1] * rb * gg[1]); o.y = pk2(vb[j][2] * rb * gg[2], vb[j][3] * rb * gg[3]); pb[64 * j] = o; }
}
DI void phase_prologue(const Params& p, unsigned char* lds) {
    const int tid = opaque_tid(), lane = tid & 63, wave = tid >> 6;
    const int gw = blockIdx.x * 8 + wave, NGW = gridDim.x * 8;
    convert_weights(p, 0, lds);
    for (int m = gw; m < M; m += 2 * NGW) { const int m1 = m + NGW;
        if (m1 < M) rms_rows2_bf16(p.in[I_X] + (size_t)m * 1024, p.in[I_X] + (size_t)m1 * 1024, p.in[I_NORMG], (bf16*)(p.ws + WS_XN) + (size_t)m * 1024, (bf16*)(p.ws + WS_XN) + (size_t)m1 * 1024, lane);
        else rms_row_bf16(p.in[I_X] + (size_t)m * 1024, p.in[I_NORMG], (bf16*)(p.ws + WS_XN) + (size_t)m * 1024, lane); }
    for (int m = gw; m < 2048; m += NGW) { const int l = m >> 10, r = m & 1023;
        rms_row_bf16(p.in[I_MEM] + (size_t)r * 1024, p.in[I_MNORMG] + l * 1024, (bf16*)(p.ws + WS_MEMN) + (size_t)m * 1024, lane); }
}
DI void phase_norm(const Params& p, int l, float oscale, unsigned char* lds) {
    const int tid = opaque_tid(), lane = tid & 63, wave = tid >> 6;
    const int gw = blockIdx.x * 8 + wave, NGW = gridDim.x * 8;
    if (l == 0) { convert_weights(p, 1, lds); for (int m = gw; m < M; m += NGW) rms_row_bf16(p.out + (size_t)m * 1024, p.in[I_NORMG] + 1024, (bf16*)(p.ws + WS_XN) + (size_t)m * 1024, lane); }
    else {
        for (int m = gw; m < M; m += NGW) {
            f32x4* xr = (f32x4*)(p.out + (size_t)m * 1024) + lane; const f32x4* gr = (const f32x4*)p.in[I_FNORMG] + lane;
            f32x4 v[4]; float s = 0.f;
#pragma unroll
            for (int j = 0; j < 4; ++j) { v[j] = xr[64 * j]; s += (v[j][0] * v[j][0] + v[j][1] * v[j][1]) + (v[j][2] * v[j][2] + v[j][3] * v[j][3]); }
            const float rstd = __builtin_amdgcn_rsqf(wave_sum(s) * (1.0f / 1024.0f) + 1e-6f);
#pragma unroll
            for (int j = 0; j < 4; ++j) xr[64 * j] = v[j] * (rstd * oscale) * gr[64 * j];
        }
    }
}

#define XB_TMO      128
#define XB_XCNT(j)  (256  + 64 * (j))
#define XB_XSUB(j)  (1280 + 64 * (j))
#define XB_XGEN(j)  (2304 + 64 * (j))
#define XB_TOP      3328
#define XB_TOPGEN   3392
#define XCD_BAR_WORDS 3456
#define XB_SPIN_CAP (1u << 18)

__device__ __forceinline__ unsigned xb_ld(unsigned* p)              { return __hip_atomic_load(p, __ATOMIC_RELAXED, __HIP_MEMORY_SCOPE_AGENT); }
__device__ __forceinline__ unsigned xb_add(unsigned* p, unsigned v) { return __hip_atomic_fetch_add(p, v, __ATOMIC_RELAXED, __HIP_MEMORY_SCOPE_AGENT); }
__device__ __forceinline__ unsigned xb_xcc_id() { return (unsigned)__builtin_amdgcn_s_getreg((3 << 11) | 20) & 0xFu; }
#define XB_SPIN(cond, bar) do { unsigned _sp = 0; while (cond) { __builtin_amdgcn_s_sleep(1); \
    if ((++_sp & 255u) == 0u) { if (xb_ld(&(bar)[XB_TMO])) break; if (_sp > XB_SPIN_CAP) { atomicAdd(&(bar)[XB_TMO], 1u); break; } } } } while (0)

struct XcdBarrier {
    unsigned* bar; unsigned x;
    volatile unsigned* st;
};

__device__ __forceinline__ XcdBarrier xcd_barrier_post(unsigned* bar, volatile unsigned* st) {
    XcdBarrier b; b.bar = bar; b.x = xb_xcc_id(); b.st = st;
    if (threadIdx.x == 0) (void)xb_add(&bar[XB_XCNT(b.x)], 1u);
    return b;
}
__device__ __forceinline__ void xcd_barrier_complete(unsigned* bar, unsigned x, unsigned& nloc, unsigned& nx) {
    const unsigned G = gridDim.x * gridDim.y * gridDim.z;
    unsigned sum, cnt, mine, sp = 0u;
    for (;;) {
        sum = 0u; cnt = 0u; mine = 0u;
#pragma unroll
        for (unsigned j = 0; j < 16; ++j) { const unsigned c = xb_ld(&bar[XB_XCNT(j)]); sum += c; cnt += (c > 0u) ? 1u : 0u; mine = (j == x) ? c : mine; }
        if (sum == G) break;
        __builtin_amdgcn_s_sleep(1);
        if ((++sp & 255u) == 0u) { if (xb_ld(&bar[XB_TMO])) break; if (sp > XB_SPIN_CAP) { atomicAdd(&bar[XB_TMO], 1u); break; } }
    }
    nloc = mine > 0u ? mine : 1u; nx = cnt > 0u ? cnt : 1u;
}

__device__ __forceinline__ void xcd_barrier(const XcdBarrier& b) {
    asm volatile("s_waitcnt vmcnt(0)" ::: "memory");
    __syncthreads();
    if (threadIdx.x == 0) {
        unsigned* bar = b.bar;
        __builtin_amdgcn_s_waitcnt(0);
        unsigned nloc = b.st[0], nx = b.st[1];
        if (nloc == 0u) { xcd_barrier_complete(bar, b.x, nloc, nx); b.st[0] = nloc; b.st[1] = nx; }
        const unsigned old = xb_add(&bar[XB_XSUB(b.x)], 1u);
        const unsigned gen = old / nloc;
        if (old + 1u == (gen + 1u) * nloc) {
            __builtin_amdgcn_fence(__ATOMIC_RELEASE, "agent");
            asm volatile("s_waitcnt vmcnt(0)" ::: "memory");
            const unsigned og = xb_add(&bar[XB_TOP], 1u);
            const unsigned tg = og / nx;
            if (og + 1u == (tg + 1u) * nx) xb_add(&bar[XB_TOPGEN], 1u);
            else XB_SPIN(xb_ld(&bar[XB_TOPGEN]) == tg, bar);
            __builtin_amdgcn_fence(__ATOMIC_ACQUIRE, "agent");
            xb_add(&bar[XB_XGEN(b.x)], 1u);
            asm volatile("s_waitcnt vmcnt(0)" ::: "memory");
        } else {
            XB_SPIN(xb_ld(&bar[XB_XGEN(b.x)]) == gen, bar);
            __builtin_amdgcn_fence(__ATOMIC_ACQUIRE, "agent");
            asm volatile("s_waitcnt vmcnt(0)" ::: "memory");
        }
    }
    __syncthreads();
}

DI void sincos_red(float ang, float& s, float& c) {
    const float n = rintf(ang * 0.15915494309189535f); float r = fmaf(-n, 6.28318548202514648f, ang); r = fmaf(-n, -1.7484555e-7f, r);
    s = __sinf(r); c = __cosf(r);
}

typedef short s16x4 __attribute__((ext_vector_type(4)));
DI s16x4 lds_tr(const bf16* p) { return __builtin_amdgcn_ds_read_tr16_b64_v4i16((__attribute__((address_space(3))) s16x4*)p); }
DI bf16x8 frag_tr(const bf16* base, int ld, int r0, int k0, int lane) {
    const bf16* p = base + (k0 + 8 * (lane >> 4) + ((lane & 15) >> 2)) * ld + r0 + 4 * (lane & 3);
    const s16x4 lo = lds_tr(p), hi = lds_tr(p + 4 * ld);
    return (bf16x8){lo[0], lo[1], lo[2], lo[3], hi[0], hi[1], hi[2], hi[3]};
}
DI bf16x8 frag_tr_perm(const bf16* base, int ld, int r0, int k0, int lane) {
    const bf16* p = base + (k0 + 4 * (lane >> 4) + ((lane & 15) >> 2)) * ld + r0 + 4 * (lane & 3);
    const s16x4 lo = lds_tr(p), hi = lds_tr(p + 16 * ld);
    return (bf16x8){lo[0], lo[1], lo[2], lo[3], hi[0], hi[1], hi[2], hi[3]};
}
constexpr int QK_QIN = 0, QK_KIN = 9216, QK_QC = 18432, QK_KST = 27648, QK_VT = 36864, QK_GKL = 55296, QK_INV = 59392, QK_ST = 64512, QK_CUM = 82944, QK_TOT = 99328, QK_RED = 101376, QK_ELAST = 103424;
#if defined(TPROBE) && defined(QTS_SEL)
#define QTS_ON() (((QTS_SEL) & 1) == (GLA ? 1 : 0) && (((QTS_SEL) >> 1) == (full ? 0 : 1)))
#define QTS_BEGIN() do { if (QTS_ON() && threadIdx.x == 0) TS_BASE(lds)[13] = (unsigned)__builtin_amdgcn_s_memrealtime(); } while (0)
#define QTS_MARK(k) do { if (QTS_ON() && threadIdx.x == 0) { const unsigned t_ = (unsigned)__builtin_amdgcn_s_memrealtime(); volatile unsigned* A_ = TS_BASE(lds); A_[k] += t_ - A_[13]; A_[13] = t_; } } while (0)
#else
#define QTS_BEGIN() do {} while (0)
#define QTS_MARK(k) do {} while (0)
#endif
template <bool GLA>
DI void qkv_item(const Params& p, int l, unsigned char* lds, int b, int h, int sc, bool full, bool dry = false) {
    QTS_BEGIN();
    const int tid = opaque_tid(), lane = tid & 63, w = tid >> 6, q4 = lane >> 4, l15 = lane & 15;
    bf16* P = (bf16*)(p.ws + WS_P);
    bf16* QIN = (bf16*)(lds + QK_QIN); bf16* KIN = (bf16*)(lds + QK_KIN); bf16* QC = (bf16*)(lds + QK_QC); bf16* KST = (bf16*)(lds + QK_KST);
    bf16* VT = (bf16*)(lds + QK_VT); bf16* ST = (bf16*)(lds + QK_ST);
    float* GKL = (float*)(lds + QK_GKL); float* INV = (float*)(lds + QK_INV);
    float* CUM = (float*)(lds + QK_CUM); float* TOT = (float*)(lds + QK_TOT); float* RED = (float*)(lds + QK_RED); float* ELAST = (float*)(lds + QK_ELAST);
    const int cq = GLA ? C_GQ : C_RQ, ck = GLA ? C_GK : C_RK, cv = GLA ? C_GV : C_RV, cgate = GLA ? C_GG : C_RG;
    const int bh = b * 4 + h;
    float* Lst = (float*)(p.ws + (GLA ? WS_GLAL : WS_RETL)) + (size_t)(bh * 16 + sc) * 8192;
    const float lgam = __logf(1.0f - exp2f(-5.0f - (float)h));
    const int st_t = tid >> 3, st_cg = tid & 7;
    f32x4 sacc[4];
#pragma unroll
    for (int mt = 0; mt < 4; ++mt) {
        if (full) { for (int j = 0; j < 4; ++j) sacc[mt][j] = Lst[(16 * mt + 4 * q4 + j) * 128 + 16 * w + l15]; *(u32x2*)(ST + (16 * w + l15) * 72 + 16 * mt + 4 * q4) = pack4(sacc[mt]); }
        else sacc[mt] = (f32x4){0.f, 0.f, 0.f, 0.f};
    }
    f32x4 gng = (f32x4){1.f, 1.f, 1.f, 1.f}; if (GLA) gng = *(const f32x4*)(p.in[I_GNORMG] + l * 128 + 16 * w + 4 * q4);
    float w2c[16], gb = 0.f;
    if (GLA) { const int ch = h * 64 + lane;
#pragma unroll
        for (int j = 0; j < 16; ++j) w2c[j] = p.in[I_GKW2][(size_t)l * 16 * 256 + j * 256 + ch];
        gb = p.in[I_GKB][l * 256 + ch]; }
    else if (tid < 32) INV[tid] = 1.0f / powf(10000.0f, (float)tid * (1.0f / 31.0f));
    u32x4 pq, pk, pv0, pv1, pg = (u32x4){0u, 0u, 0u, 0u}; int ipos = 0;
    {   const size_t ro = (size_t)(b * T + sc * 256 + st_t) * LDP;
        pq = *(const u32x4*)(P + ro + cq + h * 64 + 8 * st_cg); pk = *(const u32x4*)(P + ro + ck + h * 64 + 8 * st_cg);
        pv0 = *(const u32x4*)(P + ro + cv + h * 128 + 8 * st_cg); pv1 = *(const u32x4*)(P + ro + cv + h * 128 + 64 + 8 * st_cg);
        if (GLA) { if (st_cg < 2) { float g8[8]; unpack8(*(const u32x4*)(P + ro + C_GKL + 8 * st_cg), g8);
                *(f32x4*)(GKL + st_t * 16 + 8 * st_cg) = (f32x4){g8[0], g8[1], g8[2], g8[3]}; *(f32x4*)(GKL + st_t * 16 + 8 * st_cg + 4) = (f32x4){g8[4], g8[5], g8[6], g8[7]}; } }
        else ipos = ((const int*)p.in[I_POS])[b * T + sc * 256 + st_t]; }
    __syncthreads();
    QTS_MARK(4);
    float dtot = 0.f;
    for (int c = 0; c < 4; ++c) {
        const int t0 = sc * 256 + c * 64, m0 = b * T + t0;
        if (GLA) {
            float cumv[8]; float run = 0.f;
#pragma unroll
            for (int i = 0; i < 8; ++i) { const float* gp = GKL + (8 * w + i) * 16; float x = gb;
#pragma unroll
                for (int j4 = 0; j4 < 4; ++j4) { const f32x4 g = *(const f32x4*)(gp + 4 * j4); x += g[0] * w2c[4 * j4] + g[1] * w2c[4 * j4 + 1] + g[2] * w2c[4 * j4 + 2] + g[3] * w2c[4 * j4 + 3]; }
                run += logsigmoidf_(x) * (1.0f / 16.0f); cumv[i] = run; }
            TOT[w * 64 + lane] = run;
            __syncthreads();
            float off = 0.f;
            for (int ww = 0; ww < w; ++ww) off += TOT[ww * 64 + lane];
#pragma unroll
            for (int i = 0; i < 8; ++i) CUM[(8 * w + i) * 64 + lane] = cumv[i] + off;
            __syncthreads();
            QTS_MARK(0);
        }
        {
            const int t = st_t, cg = st_cg;
            float qf[8], kf[8]; unpack8(pq, qf); unpack8(pk, kf);
            float fqin[8], fkin[8], fqc[8], fkst[8];
            if (GLA) {
#pragma unroll
                for (int i = 0; i < 8; ++i) { const float cu = CUM[t * 64 + 8 * cg + i], rf = CUM[32 * 64 + 8 * cg + i], la = CUM[63 * 64 + 8 * cg + i];
                    qf[i] *= 0.125f; fqin[i] = fexp(cu - rf); fkin[i] = fexp(rf - cu); fqc[i] = fexp(cu); fkst[i] = fexp(la - cu); }
            } else {
                const float ppos = (float)ipos;
#pragma unroll
                for (int i = 0; i < 4; ++i) { float sn, cs; sincos_red(ppos * INV[4 * cg + i], sn, cs);
                    const float q1 = qf[2 * i], q2 = qf[2 * i + 1], k1 = kf[2 * i], k2 = kf[2 * i + 1];
                    qf[2 * i] = q1 * cs - q2 * sn; qf[2 * i + 1] = q2 * cs + q1 * sn;
                    kf[2 * i] = (k1 * cs - k2 * sn) * 0.125f; kf[2 * i + 1] = (k2 * cs + k1 * sn) * 0.125f; }
                const float e = (float)(t + 1); const float a = fexp((e - 33.0f) * lgam), bq = fexp((33.0f - e) * lgam), cc = fexp(e * lgam), dd = fexp((64.0f - e) * lgam);
#pragma unroll
                for (int i = 0; i < 8; ++i) { fqin[i] = a; fkin[i] = bq; fqc[i] = cc; fkst[i] = dd; }
            }
            if (full) { float o1[8], o2[8], o3[8];
#pragma unroll
                for (int i = 0; i < 8; ++i) { o1[i] = qf[i] * fqin[i]; o2[i] = qf[i] * fqc[i]; o3[i] = kf[i] * fkin[i]; }
                *(u32x4*)(QIN + t * 72 + 8 * cg) = pack8(o1); *(u32x4*)(QC + t * 72 + 8 * cg) = pack8(o2); *(u32x4*)(KIN + t * 72 + 8 * cg) = pack8(o3); }
            { float o4[8];
#pragma unroll
              for (int i = 0; i < 8; ++i) o4[i] = kf[i] * fkst[i];
              *(u32x4*)(KST + t * 72 + 8 * cg) = pack8(o4); }
            *(u32x4*)(VT + t * 136 + 8 * cg) = pv0; *(u32x4*)(VT + t * 136 + 64 + 8 * cg) = pv1;
            if (tid < 64) { const float la = GLA ? CUM[63 * 64 + tid] : 64.0f * lgam; ELAST[tid] = fexp(la); dtot += la; }
            if (c < 3) {
                const size_t ro = (size_t)(m0 + 64 + t) * LDP;
                pq = *(const u32x4*)(P + ro + cq + h * 64 + 8 * cg); pk = *(const u32x4*)(P + ro + ck + h * 64 + 8 * cg);
                pv0 = *(const u32x4*)(P + ro + cv + h * 128 + 8 * cg); pv1 = *(const u32x4*)(P + ro + cv + h * 128 + 64 + 8 * cg);
                if (GLA) pg = *(const u32x4*)(P + ro + C_GKL + 8 * (cg & 1));
                else ipos = ((const int*)p.in[I_POS])[b * T + t0 + 64 + t]; }
        }
        __syncthreads();
        QTS_MARK(1);
        if (full) {
            u32x2 g2[4];
#pragma unroll
            for (int tt = 0; tt < 4; ++tt) g2[tt] = *(const u32x2*)(P + (size_t)(m0 + 16 * tt + l15) * LDP + cgate + h * 128 + 16 * w + 4 * q4);
            f32x4 oacc[4];
#pragma unroll
            for (int tt = 0; tt < 4; ++tt) {
                oacc[tt] = (f32x4){0.f, 0.f, 0.f, 0.f};
#pragma unroll
                for (int kk = 0; kk < 2; ++kk) oacc[tt] = mfma16(frag(ST, 72, 16 * w, 32 * kk, lane), frag(QC, 72, 16 * tt, 32 * kk, lane), oacc[tt]);
                const bf16x8 qa = frag(QIN, 72, 16 * tt, 0, lane), qb = frag(QIN, 72, 16 * tt, 32, lane);
                u32x2 pp[4];
#pragma unroll
                for (int st = 0; st < 4; ++st) {
                    if (st <= tt) { f32x4 a = (f32x4){0.f, 0.f, 0.f, 0.f};
                        a = mfma16(frag(KIN, 72, 16 * st, 0, lane), qa, a); a = mfma16(frag(KIN, 72, 16 * st, 32, lane), qb, a);
                        if (st == tt) {
#pragma unroll
                            for (int j = 0; j < 4; ++j) if (4 * q4 + j > l15) a[j] = 0.f; }
                        pp[st] = pack4(a); }
                    else pp[st] = (u32x2){0u, 0u}; }
#pragma unroll
                for (int kk2 = 0; kk2 < 2; ++kk2) { if (2 * kk2 <= tt) {
                        u32x4 pw; pw.x = pp[2 * kk2].x; pw.y = pp[2 * kk2].y; pw.z = pp[2 * kk2 + 1].x; pw.w = pp[2 * kk2 + 1].y;
                        oacc[tt] = mfma16(frag_tr_perm(VT, 136, 16 * w, 32 * kk2, lane), __builtin_bit_cast(bf16x8, pw), oacc[tt]); } }
                float ss = (oacc[tt][0] * oacc[tt][0] + oacc[tt][1] * oacc[tt][1]) + (oacc[tt][2] * oacc[tt][2] + oacc[tt][3] * oacc[tt][3]);
                ss += __shfl_xor(ss, 16); ss += __shfl_xor(ss, 32);
                if (q4 == 0) RED[(16 * tt + l15) * 8 + w] = ss; }
            __syncthreads();
            QTS_MARK(2);
#pragma unroll
            for (int tt = 0; tt < 4; ++tt) { const f32x4 r0 = *(const f32x4*)(RED + (16 * tt + l15) * 8), r1 = *(const f32x4*)(RED + (16 * tt + l15) * 8 + 4);
                const float rstd = __builtin_amdgcn_rsqf(((r0[0] + r0[1]) + (r0[2] + r0[3]) + (r1[0] + r1[1]) + (r1[2] + r1[3])) * (1.0f / 128.0f) + 1e-6f);
                bf16* gp = P + (size_t)(m0 + 16 * tt + l15) * LDP + cgate + h * 128 + 16 * w + 4 * q4;
                const float g[4] = {lo16(g2[tt].x), hi16(g2[tt].x), lo16(g2[tt].y), hi16(g2[tt].y)};
                f32x4 o;
#pragma unroll
                for (int j = 0; j < 4; ++j) { float v = oacc[tt][j] * rstd; if (GLA) v *= gng[j]; o[j] = v * siluf_(g[j]); }
                if (!dry) *(u32x2*)gp = pack4(o); }
        }
#pragma unroll
        for (int mt = 0; mt < 4; ++mt) {
            const f32x4 el = *(const f32x4*)(ELAST + 16 * mt + 4 * q4);
            sacc[mt] = sacc[mt] * el;
#pragma unroll
            for (int kk = 0; kk < 2; ++kk) sacc[mt] = mfma16(frag_tr(KST, 72, 16 * mt, 32 * kk, lane), frag_tr(VT, 136, 16 * w, 32 * kk, lane), sacc[mt]);
            if (full) *(u32x2*)(ST + (16 * w + l15) * 72 + 16 * mt + 4 * q4) = pack4(sacc[mt]);
        }
        if (GLA && c < 3 && st_cg < 2) { float g8[8]; unpack8(pg, g8);
            *(f32x4*)(GKL + st_t * 16 + 8 * st_cg) = (f32x4){g8[0], g8[1], g8[2], g8[3]}; *(f32x4*)(GKL + st_t * 16 + 8 * st_cg + 4) = (f32x4){g8[4], g8[5], g8[6], g8[7]}; }
        __syncthreads();
        QTS_MARK(3);
    }
    if (!full) {
#pragma unroll
        for (int mt = 0; mt < 4; ++mt)
#pragma unroll
            for (int j = 0; j < 4; ++j) Lst[(16 * mt + 4 * q4 + j) * 128 + 16 * w + l15] = sacc[mt][j];
        if (GLA && tid < 64) ((float*)(p.ws + WS_DG))[(bh * 16 + sc) * 64 + tid] = fexp(dtot);
    }
}

constexpr int SD_CS = 0, SD_BS = 17408, SD_BT = 34816, SD_XT = 53248, SD_XST = 62464, SD_PS = 71680, SD_ST = 80896, SD_DT = 98304, SD_CUM = 98560, SD_RED = 98816, SD_CW = 99840;
DI void conv8(const Params& p, int l, const bf16* P, int b, int tpos, int ch, float* y) {
    const float* cw = p.in[I_CONVW] + (size_t)l * 4 * 1024; const float* cb = p.in[I_CONVB] + l * 1024;
    const f32x4 b0 = *(const f32x4*)(cb + ch), b1 = *(const f32x4*)(cb + ch + 4);
    float acc[8] = {b0[0], b0[1], b0[2], b0[3], b1[0], b1[1], b1[2], b1[3]};
#pragma unroll
    for (int j = 0; j < 4; ++j) { const int tp = tpos - 3 + j;
        if (tp >= 0) { float x[8]; unpack8(*(const u32x4*)(P + (size_t)(b * T + tp) * LDP + C_SX + ch), x);
            const f32x4 w0 = *(const f32x4*)(cw + j * 1024 + ch), w1 = *(const f32x4*)(cw + j * 1024 + ch + 4);
            acc[0] += w0[0] * x[0]; acc[1] += w0[1] * x[1]; acc[2] += w0[2] * x[2]; acc[3] += w0[3] * x[3];
            acc[4] += w1[0] * x[4]; acc[5] += w1[1] * x[5]; acc[6] += w1[2] * x[6]; acc[7] += w1[3] * x[7]; } }
#pragma unroll
    for (int i = 0; i < 8; ++i) y[i] = siluf_(acc[i]);
}
DI void conv_rows(const bf16* P, int b, int tpos, int ch, u32x4 (&xr)[7]) {
#pragma unroll
    for (int r = 0; r < 7; ++r) { const int tp = tpos - 3 + r; xr[r] = *(const u32x4*)(P + (size_t)(b * T + (tp < 0 ? 0 : tp)) * LDP + C_SX + ch); }
}
DI void conv_apply(const float* cwl, int lc, const u32x4 (&xr)[7], int tpos, float (&y)[4][8]) {
    { const f32x4 b0 = *(const f32x4*)(cwl + 4 * 320 + lc), b1 = *(const f32x4*)(cwl + 4 * 320 + lc + 4);
#pragma unroll
        for (int o = 0; o < 4; ++o) { y[o][0] = b0[0]; y[o][1] = b0[1]; y[o][2] = b0[2]; y[o][3] = b0[3]; y[o][4] = b1[0]; y[o][5] = b1[1]; y[o][6] = b1[2]; y[o][7] = b1[3]; } }
#pragma unroll
    for (int j = 0; j < 4; ++j) { const f32x4 w0 = *(const f32x4*)(cwl + j * 320 + lc), w1 = *(const f32x4*)(cwl + j * 320 + lc + 4);
        const float wv[8] = {w0[0], w0[1], w0[2], w0[3], w1[0], w1[1], w1[2], w1[3]};
#pragma unroll
        for (int o = 0; o < 4; ++o) { float x[8]; unpack8(xr[o + j], x);
            if (tpos - 3 + o + j < 0) {
#pragma unroll
                for (int i = 0; i < 8; ++i) x[i] = 0.f; }
#pragma unroll
            for (int i = 0; i < 8; ++i) y[o][i] += wv[i] * x[i]; } }
#pragma unroll
    for (int o = 0; o < 4; ++o)
#pragma unroll
        for (int i = 0; i < 8; i += 2) { const f32x2 v = {y[o][i], y[o][i + 1]}; const f32x2 r = v * sig_pk(v); y[o][i] = r.x; y[o][i + 1] = r.y; }
}
DI void ssd_item(const Params& p, int l, unsigned char* lds, int b, int h, int sc, bool full, bool dry = false) {
    const int tid = opaque_tid(), lane = tid & 63, w = tid >> 6, q4 = lane >> 4, l15 = lane & 15;
    bf16* P = (bf16*)(p.ws + WS_P);
    bf16* CS = (bf16*)(lds + SD_CS); bf16* BS = (bf16*)(lds + SD_BS); bf16* XT = (bf16*)(lds + SD_XT); bf16* XST = (bf16*)(lds + SD_XST);
    bf16* ST = (bf16*)(lds + SD_ST);
    float* DTL = (float*)(lds + SD_DT); float* CUMS = (float*)(lds + SD_CUM); float* RED = (float*)(lds + SD_RED);
    const int g = h >> 2, bh = b * 8 + h;
    float* Lst = (float*)(p.ws + WS_SSDL) + (size_t)(bh * 16 + sc) * 8192;
    const float a_h = -fexp(p.in[I_ALOG][l * 8 + h]), dtb = p.in[I_DTB][l * 8 + h], dsk = p.in[I_SD][l * 8 + h];
    const int pt = w & 3, wh = w >> 2;
    const f32x4 sng = *(const f32x4*)(p.in[I_SNORMG] + l * 512 + h * 64 + 16 * pt + 4 * q4);
    const int r_cgi = tid & 31, r_seg = tid >> 5; const bool r_isB = r_cgi >= 16; const int r_cg = r_cgi & 15;
    const int r_ch = (r_isB ? 512 : 768) + g * 128 + 8 * r_cg, r_lc = (r_isB ? 128 : 0) + 8 * r_cg;
    f32x4 sacc[4];
#pragma unroll
    for (int i = 0; i < 4; ++i) { const int nt = 4 * wh + i;
        if (full) { for (int j = 0; j < 4; ++j) sacc[i][j] = Lst[(16 * nt + 4 * q4 + j) * 64 + 16 * pt + l15]; *(u32x2*)(ST + (16 * pt + l15) * 136 + 16 * nt + 4 * q4) = pack4(sacc[i]); }
        else sacc[i] = (f32x4){0.f, 0.f, 0.f, 0.f}; }
    float* CWL = (float*)(lds + SD_CW);
    {
        float cwv[4];
#pragma unroll
        for (int r4 = 0; r4 < 4; ++r4) { const int idx0 = tid + r4 * NTHREADS, idx = idx0 < 1600 ? idx0 : 1599; const int row = idx / 320, ci = idx - row * 320;
            const int gch = ci < 128 ? 768 + g * 128 + ci : ci < 256 ? 512 + g * 128 + (ci - 128) : h * 64 + (ci - 256);
            const float* src = row < 4 ? p.in[I_CONVW] + (size_t)l * 4096 + row * 1024 + gch : p.in[I_CONVB] + l * 1024 + gch;
            cwv[r4] = *src; }
#pragma unroll
        for (int r4 = 0; r4 < 4; ++r4) { const int idx0 = tid + r4 * NTHREADS; if (idx0 < 1600) CWL[idx0] = cwv[r4]; }
    }
    u32x4 xbc[7]; conv_rows(P, b, sc * 256 + 4 * r_seg, r_ch, xbc);
    unsigned dtraw = (unsigned)P[(size_t)(b * T + sc * 256 + lane) * LDP + C_SDT + h];
    float ltot = 0.f;
    for (int c = 0; c < 4; ++c) {
        const int t0 = sc * 256 + c * 64, m0 = b * T + t0;
        if (w == 0) {
            const float dt = softplusf_(bf2f(dtraw) + dtb); float cu = dt * a_h;
#pragma unroll
            for (int o = 1; o < 64; o <<= 1) { const float n = __shfl_up(cu, o); if (lane >= o) cu += n; }
            DTL[lane] = dt; CUMS[lane] = cu;
        }
        if (c < 3) dtraw = (unsigned)P[(size_t)(m0 + 64 + lane) * LDP + C_SDT + h];
        __syncthreads();
        const float clast = CUMS[63];
        ltot += clast;
        {
            u32x4 xx[7];
            conv_rows(P, b, t0 + 4 * ((tid & 127) >> 3), h * 64 + 8 * (tid & 7), xx);
            { float y[4][8]; conv_apply(CWL, r_lc, xbc, t0 + 4 * r_seg, y);
#pragma unroll
                for (int o = 0; o < 4; ++o) { const int t = 4 * r_seg + o; *(u32x4*)((r_isB ? BS : CS) + t * 136 + 8 * r_cg) = pack8(y[o]); }
            }
            if (tid < 128) { const int cg = tid & 7, seg = tid >> 3; float y[4][8]; conv_apply(CWL, 256 + 8 * cg, xx, t0 + 4 * seg, y);
                float coef[4];
#pragma unroll
                for (int o = 0; o < 4; ++o) coef[o] = fexp(clast - CUMS[4 * seg + o]) * DTL[4 * seg + o];
#pragma unroll
                for (int o = 0; o < 4; ++o) { float ys[8];
#pragma unroll
                    for (int i = 0; i < 8; ++i) ys[i] = y[o][i] * coef[o];
                    *(u32x4*)(XT + (4 * seg + o) * 72 + 8 * cg) = pack8(y[o]); *(u32x4*)(XST + (4 * seg + o) * 72 + 8 * cg) = pack8(ys); } }
            if (c < 3) conv_rows(P, b, t0 + 64 + 4 * r_seg, r_ch, xbc);
        }
        __syncthreads();
        if (full) {
#pragma unroll
            for (int i = 0; i < 2; ++i) { const int tt = 2 * wh + i, t = 16 * tt + l15;
                bf16* zp = P + (size_t)(m0 + t) * LDP + C_SZ + h * 64 + 16 * pt + 4 * q4;
                const u32x2 z2 = *(const u32x2*)zp;
                bf16x8 cf[4];
#pragma unroll
                for (int kk = 0; kk < 4; ++kk) cf[kk] = frag(CS, 136, 16 * tt, 32 * kk, lane);
                f32x4 oacc = (f32x4){0.f, 0.f, 0.f, 0.f};
#pragma unroll
                for (int kk = 0; kk < 4; ++kk) oacc = mfma16(frag(ST, 136, 16 * pt, 32 * kk, lane), cf[kk], oacc);
                const float ct = CUMS[t];
                oacc = oacc * fexp(ct);
                u32x2 pp[4];
#pragma unroll
                for (int st = 0; st < 4; ++st) {
                    if (st <= tt) { f32x4 a = (f32x4){0.f, 0.f, 0.f, 0.f};
#pragma unroll
                        for (int kk = 0; kk < 4; ++kk) a = mfma16(frag(BS, 136, 16 * st, 32 * kk, lane), cf[kk], a);
                        const f32x4 cs4 = *(const f32x4*)(CUMS + 16 * st + 4 * q4), dt4 = *(const f32x4*)(DTL + 16 * st + 4 * q4);
#pragma unroll
                        for (int j = 0; j < 4; ++j) a[j] = (16 * st + 4 * q4 + j <= t) ? a[j] * fexp(ct - cs4[j]) * dt4[j] : 0.f;
                        pp[st] = pack4(a); }
                    else pp[st] = (u32x2){0u, 0u}; }
#pragma unroll
                for (int kk2 = 0; kk2 < 2; ++kk2) { if (2 * kk2 <= tt) {
                        u32x4 pw; pw.x = pp[2 * kk2].x; pw.y = pp[2 * kk2].y; pw.z = pp[2 * kk2 + 1].x; pw.w = pp[2 * kk2 + 1].y;
                        oacc = mfma16(frag_tr_perm(XT, 72, 16 * pt, 32 * kk2, lane), __builtin_bit_cast(bf16x8, pw), oacc); } }
                const float z[4] = {lo16(z2.x), hi16(z2.x), lo16(z2.y), hi16(z2.y)};
                f32x4 o; float ss = 0.f;
                const u32x2 xv2 = *(const u32x2*)(XT + t * 72 + 16 * pt + 4 * q4); const float xvv[4] = {lo16(xv2.x), hi16(xv2.x), lo16(xv2.y), hi16(xv2.y)};
#pragma unroll
                for (int j = 0; j < 4; ++j) { const float xv = xvv[j]; const float v = (oacc[j] + dsk * xv) * siluf_(z[j]); ss += v * v;
                    o[j] = v * sng[j]; }
                if (!dry) *(u32x2*)zp = pack4(o);
                ss += __shfl_xor(ss, 16); ss += __shfl_xor(ss, 32);
                if (q4 == 0) RED[t * 4 + pt] = ss; }
        }
        const float el = fexp(clast);
#pragma unroll
        for (int i = 0; i < 4; ++i) { const int nt = 4 * wh + i;
            sacc[i] = sacc[i] * el;
#pragma unroll
            for (int kk = 0; kk < 2; ++kk) sacc[i] = mfma16(frag_tr(BS, 136, 16 * nt, 32 * kk, lane), frag_tr(XST, 72, 16 * pt, 32 * kk, lane), sacc[i]);
            if (full) *(u32x2*)(ST + (16 * pt + l15) * 136 + 16 * nt + 4 * q4) = pack4(sacc[i]); }
        __syncthreads();
        if (full && tid < 64) { const f32x4 r = *(const f32x4*)(RED + tid * 4); ((float*)(p.ws + WS_SSQ))[(size_t)(m0 + tid) * 8 + h] = (r[0] + r[1]) + (r[2] + r[3]); }
    }
    if (!full) {
#pragma unroll
        for (int i = 0; i < 4; ++i)
#pragma unroll
            for (int j = 0; j < 4; ++j) Lst[(16 * (4 * wh + i) + 4 * q4 + j) * 64 + 16 * pt + l15] = sacc[i][j];
        if (tid == 0) ((float*)(p.ws + WS_DS))[bh * 16 + sc] = fexp(ltot);
    }
}

DI void phase_scan(const Params& p, int vb, int nb, bool dry = false) {
    const int gt = vb * NTHREADS + opaque_tid(), NT = nb * NTHREADS;
    for (int idx0 = gt; idx0 < 4 * 131072; idx0 += 2 * NT) {
        float lv[2][16], dv[2][16]; float* Lp[2]; bool ok[2];
#pragma unroll
        for (int e = 0; e < 2; ++e) { const int idx = idx0 + e * NT; ok[e] = idx < 4 * 131072; const int which = idx >> 17, r = idx & 131071;
            float* L = nullptr; const float* dec = nullptr; int dstride = 0; float cdec = 0.f;
            if (ok[e]) {
                if (which == 0) { const int bh = r >> 13, el = r & 8191; L = (float*)(p.ws + WS_RETL) + (size_t)bh * 16 * 8192 + el; cdec = fexp(256.0f * __logf(1.0f - exp2f(-5.0f - (float)(bh & 3)))); }
                else if (which == 1) { const int bh = r >> 13, el = r & 8191; L = (float*)(p.ws + WS_GLAL) + (size_t)bh * 16 * 8192 + el; dec = (const float*)(p.ws + WS_DG) + bh * 16 * 64 + (el >> 7); dstride = 64; }
                else { const int rr = (which - 2) * 131072 + r, bh = rr >> 13, el = rr & 8191; L = (float*)(p.ws + WS_SSDL) + (size_t)bh * 16 * 8192 + el; dec = (const float*)(p.ws + WS_DS) + bh * 16; dstride = 1; } }
            Lp[e] = L;
#pragma unroll
            for (int sc = 0; sc < 16; ++sc) { lv[e][sc] = ok[e] ? L[(size_t)sc * 8192] : 0.f; dv[e][sc] = (ok[e] && dec) ? dec[sc * dstride] : cdec; } }
#pragma unroll
        for (int e = 0; e < 2; ++e) { float prev = 0.f;
#pragma unroll
            for (int sc = 0; sc < 16; ++sc) { if (ok[e] && !dry) Lp[e][(size_t)sc * 8192] = prev; prev = dv[e][sc] * prev + lv[e][sc]; } }
    }
}

DI void memkv_item(const Params& p, int l, int item) {
    const int tid = opaque_tid(), lane = tid & 63, w = tid >> 6, q4 = lane >> 4, l15 = lane & 15;
    const int rb = item >> 4, cb = item & 15;
    const bf16* A = (const bf16*)(p.ws + WS_MEMN) + (size_t)l * 1024 * 1024; const bf16* Bw = (const bf16*)(p.ws + WS_WKVT);
    const int r0 = 64 * rb + 16 * (w >> 1), c0 = 32 * cb + 16 * (w & 1); const bool isV = cb >= 8; const int hh = (c0 >> 6) & 3, dd = c0 & 63;
    f32x4 acc = (f32x4){0.f, 0.f, 0.f, 0.f};
#pragma unroll 1
    for (int k16 = 0; k16 < 32; k16 += 16) {
        bf16x8 fa[16], fb[16];
#pragma unroll
        for (int u = 0; u < 16; ++u) { fa[u] = frag(A, 1024, r0, 32 * (k16 + u), lane); fb[u] = frag(Bw, 1024, c0, 32 * (k16 + u), lane); }
#pragma unroll
        for (int u = 0; u < 16; ++u) acc = isV ? mfma16(fa[u], fb[u], acc) : mfma16(fb[u], fa[u], acc);
    }
    if (!isV) { const int m = r0 + l15, bb = m >> 8, mm = m & 255;
        *(u32x2*)((bf16*)(p.ws + WS_KM) + ((size_t)(bb * 4 + hh) * 256 + mm) * 64 + dd + 4 * q4) = pack4(acc); }
    else { const int m = r0 + 4 * q4, bb = m >> 8, mm = m & 255;
        *(u32x2*)((bf16*)(p.ws + WS_VMT) + ((size_t)(bb * 4 + hh) * 64 + dd + l15) * 256 + mm) = pack4(acc); }
}
constexpr int MA_K = 0, MA_VT = 36864;
DI void memattn_item(const Params& p, unsigned char* lds, int b, int h, int blk) {
    const int tid = opaque_tid(), lane = tid & 63, w = tid >> 6, q4 = lane >> 4, l15 = lane & 15;
    bf16* KS = (bf16*)(lds + MA_K); bf16* VS = (bf16*)(lds + MA_VT);
    const bf16* KM = (const bf16*)(p.ws + WS_KM) + (size_t)(b * 4 + h) * 256 * 64; const bf16* VM = (const bf16*)(p.ws + WS_VMT) + (size_t)(b * 4 + h) * 64 * 256;
    const bf16* P = (const bf16*)(p.ws + WS_P); bf16* OM = (bf16*)(p.ws + WS_OMEM);
#pragma unroll
    for (int r = 0; r < 4; ++r) { const int idx = tid + 512 * r;
        { const int m = idx >> 3, c8 = idx & 7; *(u32x4*)(KS + m * 72 + 8 * c8) = *(const u32x4*)(KM + m * 64 + 8 * c8); }
        { const int d = idx >> 5, c8 = idx & 31; *(u32x4*)(VS + d * 264 + 8 * c8) = *(const u32x4*)(VM + d * 256 + 8 * c8); } }
    __syncthreads();
    bf16x8 qn[2];
#pragma unroll
    for (int kk = 0; kk < 2; ++kk) qn[kk] = *(const bf16x8*)(P + (size_t)(b * T + blk * 256 + w * 16 + l15) * LDP + C_MQ + h * 64 + 32 * kk + 8 * q4);
    for (int rnd = 0; rnd < 2; ++rnd) {
        const int m0 = b * T + blk * 256 + rnd * 128 + w * 16;
        bf16x8 qf[2];
#pragma unroll
        for (int kk = 0; kk < 2; ++kk) { qf[kk] = qn[kk]; if (rnd == 0) qn[kk] = *(const bf16x8*)(P + (size_t)(m0 + 128 + l15) * LDP + C_MQ + h * 64 + 32 * kk + 8 * q4); }
        f32x4 s[16]; float mx = -3.0e38f;
#pragma unroll
        for (int mt = 0; mt < 16; ++mt) { s[mt] = (f32x4){0.f, 0.f, 0.f, 0.f};
#pragma unroll
            for (int kk = 0; kk < 2; ++kk) s[mt] = mfma16(frag(KS, 72, 16 * mt, 32 * kk, lane), qf[kk], s[mt]);
            s[mt] = s[mt] * 0.125f; mx = fmaxf(mx, fmaxf(fmaxf(s[mt][0], s[mt][1]), fmaxf(s[mt][2], s[mt][3]))); __builtin_amdgcn_sched_barrier(0); }
        mx = fmaxf(mx, __shfl_xor(mx, 16)); mx = fmaxf(mx, __shfl_xor(mx, 32));
        float sum = 0.f;
#pragma unroll
        for (int mt = 0; mt < 16; ++mt) {
#pragma unroll
            for (int j = 0; j < 4; ++j) { s[mt][j] = fexp(s[mt][j] - mx); sum += s[mt][j]; } }
        sum += __shfl_xor(sum, 16); sum += __shfl_xor(sum, 32);
        const float rs = __builtin_amdgcn_rcpf(sum);
        f32x4 o[4];
#pragma unroll
        for (int dt = 0; dt < 4; ++dt) o[dt] = (f32x4){0.f, 0.f, 0.f, 0.f};
#pragma unroll
        for (int k2 = 0; k2 < 8; ++k2) {
            u32x4 pw; pw.x = pk2(s[2 * k2][0], s[2 * k2][1]); pw.y = pk2(s[2 * k2][2], s[2 * k2][3]); pw.z = pk2(s[2 * k2 + 1][0], s[2 * k2 + 1][1]); pw.w = pk2(s[2 * k2 + 1][2], s[2 * k2 + 1][3]);
            const bf16x8 pf = __builtin_bit_cast(bf16x8, pw);
#pragma unroll
            for (int dt = 0; dt < 4; ++dt) { const bf16* vp = VS + (16 * dt + l15) * 264 + 32 * k2 + 4 * q4;
                const u32x2 v0 = *(const u32x2*)vp, v1 = *(const u32x2*)(vp + 16); u32x4 vw; vw.x = v0.x; vw.y = v0.y; vw.z = v1.x; vw.w = v1.y;
                o[dt] = mfma16(__builtin_bit_cast(bf16x8, vw), pf, o[dt]); }
            __builtin_amdgcn_sched_barrier(0); }
#pragma unroll
        for (int dt = 0; dt < 4; ++dt) *(u32x2*)(OM + (size_t)(m0 + l15) * 256 + h * 64 + 16 * dt + 4 * q4) = pack4(o[dt] * rs);
    }
    __syncthreads();
}

constexpr int RC_ARL = 0, RC_RRL = 9216, RC_BRL = 18432, RC_KRL = 27648, RC_XT = 0, RC_BHT = 36864, RC_KHT = 46080, RC_VT = 55296, RC_AAK = 64512, RC_LRB = 73728, RC_LRK = 82944,
              RC_AAB = 92160, RC_RHS = 108544, RC_WLAST = 141312, RC_TB = 141568,
              RC_TW = 64512, RC_ALS = 73728, RC_W2T = 82944, RC_A2T = 92160, RC_TOT = 101376, RC_CUM = 108544, RC_AICL = 124928;
#if defined(TPROBE) && !defined(QTS_SEL)
#define RW_STOP_AT(k) TS_MARK(k)
#define RW_TS_BEGIN() TS_BEGIN()
#define RW_TS_END() TS_MARK(7)
#else
#define RW_TS_BEGIN() do {} while (0)
#define RW_TS_END() do {} while (0)
#ifdef RW_STOP
#define RW_STOP_AT(k) do { if (dry && RW_STOP == (k)) return; } while (0)
#else
#define RW_STOP_AT(k) do {} while (0)
#endif
#endif
DI void rwkv_chunk_item(const Params& p, int l, unsigned char* lds, int b, int h, int c, bool dry = false) {
    const int tid = opaque_tid(), lane = tid & 63, w = tid >> 6, q4 = lane >> 4, l15 = lane & 15;
    bf16* P = (bf16*)(p.ws + WS_P);
    bf16* ARL = (bf16*)(lds + RC_ARL); bf16* RRL = (bf16*)(lds + RC_RRL); bf16* BRL = (bf16*)(lds + RC_BRL); bf16* KRL = (bf16*)(lds + RC_KRL); bf16* XT = (bf16*)(lds + RC_XT);
    bf16* BHT = (bf16*)(lds + RC_BHT); bf16* KHT = (bf16*)(lds + RC_KHT); bf16* VT = (bf16*)(lds + RC_VT); bf16* AAK = (bf16*)(lds + RC_AAK); bf16* LRB = (bf16*)(lds + RC_LRB); bf16* LRK = (bf16*)(lds + RC_LRK);
    float* AAB = (float*)(lds + RC_AAB); float* RHS = (float*)(lds + RC_RHS); float* WLAST = (float*)(lds + RC_WLAST); float* TB = (float*)(lds + RC_TB);
    bf16* TW = (bf16*)(lds + RC_TW); bf16* ALS = (bf16*)(lds + RC_ALS); bf16* W2T = (bf16*)(lds + RC_W2T); bf16* A2T = (bf16*)(lds + RC_A2T);
    float* TOT = (float*)(lds + RC_TOT); float* CUM = (float*)(lds + RC_CUM); float* AICL = (float*)(lds + RC_AICL);
    const float* mu = p.in[I_MU] + l * 1664;
    const int t0 = c * 64, m0 = b * T + t0;
    RW_TS_BEGIN();
    const int t_ = tid >> 3, cg = tid & 7, chh = h * 64 + 8 * cg;
    float xr[8], xk[8], xv[8];
    float pkk[8], pka[8], prk[8];
    { const f32x4 a0 = *(const f32x4*)(p.in[I_KK] + l * 512 + chh), a1 = *(const f32x4*)(p.in[I_KK] + l * 512 + chh + 4), b0 = *(const f32x4*)(p.in[I_KA] + l * 512 + chh), b1 = *(const f32x4*)(p.in[I_KA] + l * 512 + chh + 4),
          c0 = *(const f32x4*)(p.in[I_RK] + l * 512 + chh), c1 = *(const f32x4*)(p.in[I_RK] + l * 512 + chh + 4);
#pragma unroll
      for (int i = 0; i < 4; ++i) { pkk[i] = a0[i]; pkk[4 + i] = a1[i]; pka[i] = b0[i]; pka[4 + i] = b1[i]; prk[i] = c0[i]; prk[4 + i] = c1[i]; } }
    f32x4 pw0[4];
#pragma unroll
    for (int ct = 0; ct < 4; ++ct) pw0[ct] = *(const f32x4*)(p.in[(w >> 2) ? I_A0 : I_W0] + l * 512 + h * 64 + 16 * ct + 4 * q4);
    {
        { const int j = tid >> 3;
            const float* s2 = p.in[I_W2] + (size_t)l * 64 * 512 + j * 512 + chh; const float* sa = p.in[I_A2] + (size_t)l * 64 * 512 + j * 512 + chh;
#pragma unroll
            for (int i = 0; i < 8; ++i) { }
            *(u32x4*)(W2T + j * 72 + 8 * cg) = pack8(s2); *(u32x4*)(A2T + j * 72 + 8 * cg) = pack8(sa); }
        const size_t ro = (size_t)(m0 + t_) * LDP; const bool first = (t_ == 0);
        const bf16* prow = first ? (bf16*)(p.ws + WS_BND) + (size_t)(((m0) >> 6) - 1) * BND_W - 4608 : P + ro - LDP;
        const bool hp = (t0 + t_) > 0;
#pragma unroll
        for (int which = 0; which < 5; ++which) {
            const int col = which == 0 ? C_WR + chh : which == 1 ? C_WK + chh : which == 2 ? C_WV + chh : which == 3 ? C_WL + 8 * cg : C_AL + 8 * cg;
            const int mi = which == 0 ? chh : which == 1 ? 512 + chh : which == 2 ? 1024 + chh : which == 3 ? 1536 + 8 * cg : 1600 + 8 * cg;
            float cur[8], prv[8], xs[8];
            unpack8(*(const u32x4*)(P + ro + col), cur);
            unpack8(*(const u32x4*)((hp ? prow : P + ro) + col), prv);
            if (!hp) {
#pragma unroll
                for (int i = 0; i < 8; ++i) prv[i] = 0.f; }
#pragma unroll
            for (int i = 0; i < 8; ++i) xs[i] = cur[i] + (prv[i] - cur[i]) * mu[mi + i];
            if (which == 0) {
#pragma unroll
                for (int i = 0; i < 8; ++i) xr[i] = xs[i]; }
            else if (which == 1) {
#pragma unroll
                for (int i = 0; i < 8; ++i) xk[i] = xs[i]; }
            else if (which == 2) {
#pragma unroll
                for (int i = 0; i < 8; ++i) xv[i] = xs[i]; }
            else if (which == 3) { float tw[8];
#pragma unroll
                for (int i = 0; i < 8; ++i) tw[i] = tanhf_(xs[i]);
                *(u32x4*)(TW + t_ * 72 + 8 * cg) = pack8(tw); }
            else *(u32x4*)(ALS + t_ * 72 + 8 * cg) = pack8(xs);
        }
    }
    __syncthreads();
    RW_STOP_AT(0);
    {
        const int which = w >> 2, tt = w & 3; const bf16* Wm = which ? A2T : W2T; const bf16* Xm = which ? ALS : TW;
#pragma unroll
        for (int ct = 0; ct < 4; ++ct) { f32x4 a = (f32x4){0.f, 0.f, 0.f, 0.f};
#pragma unroll
            for (int kk = 0; kk < 2; ++kk) a = mfma16(frag_tr(Wm, 72, 16 * ct, 32 * kk, lane), frag(Xm, 72, 16 * tt, 32 * kk, lane), a);
            const int ch = 16 * ct + 4 * q4, t = 16 * tt + l15; f32x4 o;
            if (which == 0) { const f32x4 w0 = pw0[ct];
#pragma unroll
                for (int j = 0; j < 4; ++j) o[j] = -0.60653065971f * sigmoidf_(w0[j] + a[j]);
                *(f32x4*)(CUM + t * 64 + ch) = o; }
            else { const f32x4 a0 = pw0[ct];
#pragma unroll
                for (int j = 0; j < 4; ++j) o[j] = sigmoidf_(a0[j] + a[j]);
                *(f32x4*)(AICL + t * 64 + ch) = o; }
        }
    }
    __syncthreads();
    RW_STOP_AT(1);
    {
        float cumv[8]; float run = 0.f;
#pragma unroll
        for (int i = 0; i < 8; ++i) { run += CUM[(8 * w + i) * 64 + lane]; cumv[i] = run; }
        TOT[w * 64 + lane] = run;
        __syncthreads();
        float off = 0.f;
        for (int ww = 0; ww < w; ++ww) off += TOT[ww * 64 + lane];
#pragma unroll
        for (int i = 0; i < 8; ++i) CUM[(8 * w + i) * 64 + lane] = cumv[i] + off;
    }
    __syncthreads();
    RW_STOP_AT(2);
    float aabs[8];
    {
        float kk[8], ai[8], ss = 0.f;
#pragma unroll
        for (int i = 0; i < 8; ++i) { ai[i] = AICL[t_ * 64 + 8 * cg + i]; kk[i] = xk[i] * pkk[i]; ss += kk[i] * kk[i]; }
        ss += __shfl_xor(ss, 1); ss += __shfl_xor(ss, 2); ss += __shfl_xor(ss, 4);
        const float inv = __builtin_amdgcn_rsqf(fmaxf(ss, 1e-24f));
        float bon = 0.f, o_arl[8], o_rrl[8], o_brl[8], o_krl[8], o_rabs[8], o_bh[8], o_kh[8];
#pragma unroll
        for (int i = 0; i < 8; ++i) {
            const float kn = kk[i] * inv, av = -kn, bv = kn * ai[i], km = xk[i] * (1.0f + (ai[i] - 1.0f) * pka[i]);
            bon += xr[i] * km * prk[i];
            const int k = 8 * cg + i;
            const float cu = CUM[t_ * 64 + k], cx = t_ > 0 ? CUM[(t_ - 1) * 64 + k] : 0.f, rf = CUM[32 * 64 + k], la = CUM[63 * 64 + k];
            o_arl[i] = av * fexp(cx - rf); aabs[i] = av * fexp(cx);
            o_rrl[i] = xr[i] * fexp(cu - rf); o_rabs[i] = xr[i] * fexp(cu);
            const float eb = fexp(rf - cu), eh = fexp(la - cu);
            o_brl[i] = bv * eb; o_krl[i] = km * eb;
            o_bh[i] = bv * eh; o_kh[i] = km * eh;
        }
        bon += __shfl_xor(bon, 1); bon += __shfl_xor(bon, 2); bon += __shfl_xor(bon, 4);
        *(u32x4*)(ARL + t_ * 72 + 8 * cg) = pack8(o_arl); *(u32x4*)(RRL + t_ * 72 + 8 * cg) = pack8(o_rrl);
        *(u32x4*)(BRL + t_ * 72 + 8 * cg) = pack8(o_brl); *(u32x4*)(KRL + t_ * 72 + 8 * cg) = pack8(o_krl);
        *(u32x4*)(BHT + t_ * 72 + 8 * cg) = pack8(o_bh); *(u32x4*)(KHT + t_ * 72 + 8 * cg) = pack8(o_kh); *(u32x4*)(VT + t_ * 72 + 8 * cg) = pack8(xv);
        const size_t ro = (size_t)(m0 + t_) * LDP;
        if (!dry) *(u32x4*)(P + ro + C_WR + chh) = pack8(o_rabs);
        float bvv[8];
#pragma unroll
        for (int i = 0; i < 8; ++i) bvv[i] = bon * xv[i];
        if (!dry) *(u32x4*)(P + ro + C_WV + chh) = pack8(bvv);
        if (tid < 64) WLAST[tid] = fexp(CUM[63 * 64 + tid]);
    }
    __syncthreads();
    RW_STOP_AT(3);
    *(f32x4*)(RHS + t_ * 128 + 8 * cg) = (f32x4){aabs[0], aabs[1], aabs[2], aabs[3]}; *(f32x4*)(RHS + t_ * 128 + 8 * cg + 4) = (f32x4){aabs[4], aabs[5], aabs[6], aabs[7]};
    {
        const int prod = w >> 1, half = w & 1; const bf16* Lm = (prod < 2) ? ARL : RRL; const bf16* Rm = (prod & 1) ? KRL : BRL; const int strict = prod < 2 ? 1 : 0;
#pragma unroll
        for (int i8 = 0; i8 < 8; ++i8) { const int id = half * 8 + i8, tt = id >> 2, st = id & 3;
            f32x4 a = (f32x4){0.f, 0.f, 0.f, 0.f};
            if (st <= tt) {
#pragma unroll
                for (int kk = 0; kk < 2; ++kk) a = mfma16(frag(Rm, 72, 16 * st, 32 * kk, lane), frag(Lm, 72, 16 * tt, 32 * kk, lane), a);
                if (st == tt) {
#pragma unroll
                    for (int j = 0; j < 4; ++j) if (4 * q4 + j + strict > l15) a[j] = 0.f; }
            }
            if (prod == 0) *(f32x4*)(AAB + (16 * tt + l15) * 64 + 16 * st + 4 * q4) = a;
            else { bf16* O = prod == 1 ? AAK : prod == 2 ? LRB : LRK; *(u32x2*)(O + (16 * tt + l15) * 72 + 16 * st + 4 * q4) = pack4(a); }
        }
        if (prod == 0) {
            asm volatile("s_waitcnt lgkmcnt(0)" ::: "memory");
            const int bb = 2 * half + ((lane >> 4) & 1), cc = lane & 15; float x[16];
#pragma unroll
            for (int i = 0; i < 16; ++i) { float s0 = (i == cc) ? 1.0f : 0.0f;
#pragma unroll
                for (int s4 = 0; s4 < (i + 3) / 4; ++s4) { const f32x4 av = *(const f32x4*)(AAB + (16 * bb + i) * 64 + 16 * bb + 4 * s4);
#pragma unroll
                    for (int n = 0; n < 4; ++n) if (4 * s4 + n < i) s0 += av[n] * x[4 * s4 + n]; }
                x[i] = s0; if (lane < 32) TB[(bb * 16 + i) * 16 + cc] = s0; }
        }
    }
    __syncthreads();
    RW_STOP_AT(4);
    {
        f32x4 X[4];
#pragma unroll
        for (int bb = 0; bb < 4; ++bb) {
            f32x4 acc;
            if (w < 4) {
#pragma unroll
                for (int j = 0; j < 4; ++j) acc[j] = RHS[(16 * bb + 4 * q4 + j) * 128 + 16 * w + l15]; }
            else {
                acc = (f32x4){0.f, 0.f, 0.f, 0.f};
#pragma unroll
                for (int kk = 0; kk < 2; ++kk) acc = mfma16(frag(AAK, 72, 16 * bb, 32 * kk, lane), frag_tr(VT, 72, 16 * (w - 4), 32 * kk, lane), acc); }
#pragma unroll
            for (int bp = 0; bp < bb; ++bp) { const f32x4 a4 = *(const f32x4*)(AAB + (16 * bb + l15) * 64 + 16 * bp + 4 * q4);
#pragma unroll
                for (int j = 0; j < 4; ++j) acc = __builtin_amdgcn_mfma_f32_16x16x4f32(a4[j], X[bp][j], acc, 0, 0, 0); }
            const f32x4 t4 = *(const f32x4*)(TB + (bb * 16 + l15) * 16 + 4 * q4);
            f32x4 xb = (f32x4){0.f, 0.f, 0.f, 0.f};
#pragma unroll
            for (int j = 0; j < 4; ++j) xb = __builtin_amdgcn_mfma_f32_16x16x4f32(t4[j], acc[j], xb, 0, 0, 0);
            X[bb] = xb;
            *(u32x2*)(XT + (16 * w + l15) * 72 + 16 * bb + 4 * q4) = pack4(xb);
        }
    }
    __syncthreads();
    RW_STOP_AT(6);
    {
        const int prod = w >> 1, half = w & 1;
        bf16* GH = (bf16*)(p.ws + WS_RWGH) + ((size_t)((b * 8 + h) * 64 + c) * 2) * 4096;
#pragma unroll
        for (int i8 = 0; i8 < 8; ++i8) { const int id = half * 8 + i8, rt = id >> 2, ct = id & 3;
            f32x4 a = (f32x4){0.f, 0.f, 0.f, 0.f};
            if (prod == 0) {
#pragma unroll
                for (int kk = 0; kk < 2; ++kk) a = mfma16(frag(XT, 72, 16 * ct, 32 * kk, lane), frag(LRB, 72, 16 * rt, 32 * kk, lane), a);
                bf16* qp = P + (size_t)(m0 + 16 * rt + l15) * LDP + C_WR + h * 64 + 16 * ct + 4 * q4;
                const u32x2 r2 = *(const u32x2*)qp; a[0] += lo16(r2.x); a[1] += hi16(r2.x); a[2] += lo16(r2.y); a[3] += hi16(r2.y);
                if (!dry) *(u32x2*)qp = pack4(a);
            } else if (prod == 1) {
#pragma unroll
                for (int kk = 0; kk < 2; ++kk) a = mfma16(frag(XT, 72, 64 + 16 * ct, 32 * kk, lane), frag(LRB, 72, 16 * rt, 32 * kk, lane), a);
#pragma unroll
                for (int kk = 0; kk < 2; ++kk) a = mfma16(frag_tr(VT, 72, 16 * ct, 32 * kk, lane), frag(LRK, 72, 16 * rt, 32 * kk, lane), a);
                if (!dry) *(u32x2*)(P + (size_t)(m0 + 16 * rt + l15) * LDP + C_WK + h * 64 + 16 * ct + 4 * q4) = pack4(a);
            } else if (prod == 2) {
#pragma unroll
                for (int kk = 0; kk < 2; ++kk) a = mfma16(frag(XT, 72, 16 * ct, 32 * kk, lane), frag_tr(BHT, 72, 16 * rt, 32 * kk, lane), a);
                if (rt == ct) { const float wl = WLAST[16 * rt + l15];
#pragma unroll
                    for (int j = 0; j < 4; ++j) if (4 * q4 + j == l15) a[j] += wl; }
                *(u32x2*)(GH + (16 * rt + l15) * 64 + 16 * ct + 4 * q4) = pack4(a);
            } else {
#pragma unroll
                for (int kk = 0; kk < 2; ++kk) a = mfma16(frag_tr(BHT, 72, 16 * ct, 32 * kk, lane), frag(XT, 72, 64 + 16 * rt, 32 * kk, lane), a);
#pragma unroll
                for (int kk = 0; kk < 2; ++kk) a = mfma16(frag_tr(KHT, 72, 16 * ct, 32 * kk, lane), frag_tr(VT, 72, 16 * rt, 32 * kk, lane), a);
                *(u32x2*)(GH + 4096 + (16 * rt + l15) * 64 + 16 * ct + 4 * q4) = pack4(a);
            }
        }
    }
    __syncthreads();
    RW_TS_END();
}
DI void rwkv_scan_chain(const Params& p, unsigned char* lds, int bh, bool dry = false) {
    const int tid = opaque_tid(), lane = tid & 63, w = tid >> 6, q4 = lane >> 4, l15 = lane & 15;
    bf16* ZB = (bf16*)lds;
    bf16* GH = (bf16*)(p.ws + WS_RWGH) + (size_t)bh * 64 * 2 * 4096;
    const int vt = w & 3, kh = w >> 2;
    u32x2 zp[2];
#pragma unroll
    for (int i = 0; i < 2; ++i) { zp[i] = (u32x2){0u, 0u}; *(u32x2*)(ZB + (16 * vt + l15) * 72 + 16 * (2 * kh + i) + 4 * q4) = zp[i]; }
    bf16x8 gf[4][2][2]; u32x2 hv[4][2];
#define RW_LOAD(slot, cc) do { const bf16* G_ = GH + (size_t)(cc) * 2 * 4096; _Pragma("unroll") for (int i = 0; i < 2; ++i) { const int kt = 2 * kh + i; \
        _Pragma("unroll") for (int kk = 0; kk < 2; ++kk) gf[slot][i][kk] = frag(G_, 64, 16 * kt, 32 * kk, lane); \
        hv[slot][i] = *(const u32x2*)(G_ + 4096 + (16 * vt + l15) * 64 + 16 * kt + 4 * q4); } } while (0)
    RW_LOAD(0, 0); RW_LOAD(1, 1); RW_LOAD(2, 2); RW_LOAD(3, 3);
    __syncthreads();
    for (int c4 = 0; c4 < 64; c4 += 4) {
#pragma unroll
        for (int u = 0; u < 4; ++u) { const int c = c4 + u;
            bf16* HT = GH + (size_t)c * 2 * 4096 + 4096;
            const bf16* Zc = ZB + (c & 1) * 64 * 72; bf16* Zn = ZB + ((c + 1) & 1) * 64 * 72;
#pragma unroll
            for (int i = 0; i < 2; ++i) { const int kt = 2 * kh + i;
                f32x4 a = (f32x4){lo16(hv[u][i].x), hi16(hv[u][i].x), lo16(hv[u][i].y), hi16(hv[u][i].y)};
                if (!dry) *(u32x2*)(HT + (16 * vt + l15) * 64 + 16 * kt + 4 * q4) = zp[i];
#pragma unroll
                for (int kk = 0; kk < 2; ++kk) a = mfma16(gf[u][i][kk], frag(Zc, 72, 16 * vt, 32 * kk, lane), a);
                zp[i] = pack4(a);
                *(u32x2*)(Zn + (16 * vt + l15) * 72 + 16 * kt + 4 * q4) = zp[i]; }
            { const int cn = c + 4 < 64 ? c + 4 : 63; RW_LOAD(u, cn); }
            __syncthreads();
        }
    }
#undef RW_LOAD
}
DI void rwkv_out_item(const Params& p, int l, int bh, int pair, bool dry = false) {
    const int tid = opaque_tid(), lane = tid & 63, w = tid >> 6, q4 = lane >> 4, l15 = lane & 15;
    bf16* P = (bf16*)(p.ws + WS_P);
    const int b = bh >> 3, h = bh & 7, c = 2 * pair + (w >> 2), m = b * T + c * 64 + 16 * (w & 3) + l15;
    const bf16* ZT = (const bf16*)(p.ws + WS_RWGH) + ((size_t)(bh * 64 + c) * 2 + 1) * 4096;
    const size_t ro = (size_t)m * LDP;
    bf16x8 qf[2], zf[4][2]; u32x2 yl[4], bv[4], g2[4]; f32x4 lg[4], lb[4];
#pragma unroll
    for (int kk = 0; kk < 2; ++kk) qf[kk] = *(const bf16x8*)(P + ro + C_WR + h * 64 + 32 * kk + 8 * q4);
#pragma unroll
    for (int vt = 0; vt < 4; ++vt) { yl[vt] = *(const u32x2*)(P + ro + C_WK + h * 64 + 16 * vt + 4 * q4);
#pragma unroll
        for (int kk = 0; kk < 2; ++kk) zf[vt][kk] = frag(ZT, 64, 16 * vt, 32 * kk, lane); }
#pragma unroll
    for (int vt = 0; vt < 4; ++vt) { const int ch = h * 64 + 16 * vt + 4 * q4;
        bv[vt] = *(const u32x2*)(P + ro + C_WV + ch); g2[vt] = *(const u32x2*)(P + ro + C_WG + ch);
        lg[vt] = *(const f32x4*)(p.in[I_LNG] + l * 512 + ch); lb[vt] = *(const f32x4*)(p.in[I_LNB] + l * 512 + ch); }
    f32x4 y[4]; float s = 0.f;
#pragma unroll
    for (int vt = 0; vt < 4; ++vt) {
        y[vt] = (f32x4){lo16(yl[vt].x), hi16(yl[vt].x), lo16(yl[vt].y), hi16(yl[vt].y)};
#pragma unroll
        for (int kk = 0; kk < 2; ++kk) y[vt] = mfma16(zf[vt][kk], qf[kk], y[vt]);
        s += (y[vt][0] + y[vt][1]) + (y[vt][2] + y[vt][3]); }
    s += __shfl_xor(s, 16); s += __shfl_xor(s, 32);
    const float mean = s * (1.0f / 64.0f); float vr = 0.f;
#pragma unroll
    for (int vt = 0; vt < 4; ++vt) { y[vt] = y[vt] - mean; vr += (y[vt][0] * y[vt][0] + y[vt][1] * y[vt][1]) + (y[vt][2] * y[vt][2] + y[vt][3] * y[vt][3]); }
    vr += __shfl_xor(vr, 16); vr += __shfl_xor(vr, 32);
    const float rstd = __builtin_amdgcn_rsqf(vr * (1.0f / 64.0f) + 64e-5f);
#pragma unroll
    for (int vt = 0; vt < 4; ++vt) { const int ch = h * 64 + 16 * vt + 4 * q4; bf16* gp = P + ro + C_WG + ch;
        const float bvf[4] = {lo16(bv[vt].x), hi16(bv[vt].x), lo16(bv[vt].y), hi16(bv[vt].y)}, g[4] = {lo16(g2[vt].x), hi16(g2[vt].x), lo16(g2[vt].y), hi16(g2[vt].y)};
        f32x4 o;
#pragma unroll
        for (int j = 0; j < 4; ++j) o[j] = (y[vt][j] * rstd * lg[vt][j] + lb[vt][j] + bvf[j]) * siluf_(g[j]);
        if (!dry) *(u32x2*)gp = pack4(o); }
}

DI void phase_A(const Params& p, int l, unsigned char* lds, bool dry = false) {
    const int G = gridDim.x, bid = blockIdx.x;
#ifndef DUP_AMASK
#define DUP_AMASK 0xff
#endif
    for (int it = bid; it < 3328; it += G) {
        if (dry) { const int ty = it < 2048 ? 1 : it < 2560 ? 2 : it < 2816 ? 4 : it < 3072 ? 8 : 16; if (!(DUP_AMASK & ty)) continue; }
        if (it < 2048) rwkv_chunk_item(p, l, lds, it >> 9, (it >> 6) & 7, it & 63, dry);
        else if (it < 2560) { const int i = it - 2048; ssd_item(p, l, lds, i >> 7, (i >> 4) & 7, i & 15, false); }
        else if (it < 2816) { const int i = it - 2560; qkv_item<false>(p, l, lds, i >> 6, (i >> 4) & 3, i & 15, false); }
        else if (it < 3072) { const int i = it - 2816; qkv_item<true>(p, l, lds, i >> 6, (i >> 4) & 3, i & 15, false); }
        else memkv_item(p, l, it - 3072);
    }
}
DI void phase_B(const Params& p, unsigned char* lds, bool dry = false) {
    (void)lds; phase_scan(p, blockIdx.x, gridDim.x, dry);
}
DI void rwkv_flag_publish(unsigned* flag) {
    asm volatile("s_waitcnt vmcnt(0)" ::: "memory"); __syncthreads();
    if (threadIdx.x == 0) { __builtin_amdgcn_fence(__ATOMIC_RELEASE, "agent"); asm volatile("s_waitcnt vmcnt(0)" ::: "memory"); __hip_atomic_store(flag, 1u, __ATOMIC_RELAXED, __HIP_MEMORY_SCOPE_AGENT); }
}
DI void rwkv_flag_wait(unsigned* flag) {
    if (threadIdx.x == 0) { unsigned spins = 0;
        while (__hip_atomic_load(flag, __ATOMIC_RELAXED, __HIP_MEMORY_SCOPE_AGENT) == 0u) { __builtin_amdgcn_s_sleep(8); if (++spins > (1u << 22)) break; }
        __builtin_amdgcn_fence(__ATOMIC_ACQUIRE, "agent"); asm volatile("s_waitcnt vmcnt(0)" ::: "memory"); }
    __syncthreads();
}
DI void phase_C(const Params& p, int l, unsigned char* lds, bool dry = false) {
    const int G = gridDim.x, bid = blockIdx.x;
    unsigned* flags = (unsigned*)(p.ws + WS_BAR + 14336) + (dry ? 128 : 0) + l * 32;
    for (int bh = bid; bh < 32; bh += G) { rwkv_scan_chain(p, lds, bh, dry); rwkv_flag_publish(flags + bh); }
    unsigned have = 0u;
#define C_SSD(it)  ssd_item(p, l, lds, (it) >> 7, ((it) >> 4) & 7, (it) & 15, true, dry)
#define C_RET(it)  qkv_item<false>(p, l, lds, (it) >> 6, ((it) >> 4) & 3, (it) & 15, true, dry)
#define C_GLA(it)  qkv_item<true>(p, l, lds, (it) >> 6, ((it) >> 4) & 3, (it) & 15, true, dry)
#define C_MEM(it)  memattn_item(p, lds, (it) >> 6, ((it) >> 4) & 3, (it) & 15)
#define C_RWO(it)  do { const int bh_ = (it) >> 5; if (!((have >> bh_) & 1u)) { rwkv_flag_wait(flags + bh_); have |= 1u << bh_; } rwkv_out_item(p, l, bh_, (it) & 31, dry); } while (0)
    const int nslot = (G == 256) ? 16 : (2304 + G - 1) / G;
    for (int k = 0; k < nslot; ++k) {
        int it = -1;
        if (G == 256) {
            if (bid < 32) { it = k == 0 ? bid : (k >= 1 && k <= 4) ? 1280 + 4 * bid + (k - 1) : -1; }
            else { const int j = bid - 32;
                if (k == 0) it = 32 + j; else if (k == 1) it = 256 + j; else if (k == 2) it = (j < 32) ? 480 + j : -1;
                else if (k == 3) it = 768 + 32 + j; else if (k == 4) it = (j >= 32 && j < 64) ? 768 + (j - 32) : -1;
                else if (k == 5) it = 512 + 32 + j; else if (k == 6) it = (j >= 64 && j < 96) ? 512 + (j - 64) : -1;
                else if (k == 7) it = 1024 + j; else if (k == 8) it = (j >= 96 && j < 128) ? 1024 + 224 + (j - 96) : -1;
                else { const int m = k - 9; int r = -1;
                    if (j < 32) r = -1; else if (j < 64) r = m < 1 ? 128 + (j - 32) : -1; else if (j < 96) r = m < 2 ? 160 + 2 * (j - 64) + m : -1;
                    else if (j < 128) r = m < 5 ? 224 + 5 * (j - 96) + m : -1; else if (j < 192) r = m < 7 ? 384 + 7 * (j - 128) + m : -1; else r = m < 6 ? 832 + 6 * (j - 192) + m : -1;
                    it = r >= 0 ? 1280 + r : -1; } }
        } else { it = bid + k * G; if (it >= 2304) it = -1; }
        if (it < 0) continue;
        if (it < 512) C_SSD(it); else if (it < 768) C_RET(it - 512); else if (it < 1024) C_GLA(it - 768); else if (it < 1280) C_MEM(it - 1024); else C_RWO(it - 1280);
    }
#undef C_SSD
#undef C_RET
#undef C_GLA
#undef C_MEM
#undef C_RWO
}
typedef PG8_LAS unsigned char* lds3_t;
DI void phase_P1(const Params& p, int l, unsigned char* lds) {
    pg8::Gemm g{1024, 1024};
    SchedP1 S{(int)gridDim.x, (int)blockIdx.x, (const char*)p.ws + WS_XN, (const char*)p.ws + WS_W1T};
    EpiP E{(bf16*)(p.ws + WS_P), (bf16*)(p.ws + WS_BND)};
    pg8::gemm_phase<EpiP, SchedP1, true, true>((lds3_t)lds, g, S, E);
}
DI void phase_P3(const Params& p, int l, unsigned char* lds) {
    (void)l;
    for (int L = blockIdx.x; L < 256; L += gridDim.x) {
        int pm, pn; tile_map(L, 64, 4, pm, pn);
        pg8::Gemm g{0, 0}; SchedP3 S{pm, pn, p.ws, (int)((blockIdx.x >> 3) & 3)};
        EpiP3 E{EpiGate{(bf16*)(p.ws + WS_P)}, EpiBranch{(const bf16*)(p.ws + WS_P), (bf16*)(p.ws + WS_MRG), (const float*)(p.ws + WS_SSQ)}};
        pg8::gemm_phase<EpiP3, SchedP3, true, true>((lds3_t)lds, g, S, E);
    }
}
DI void phase_P4(const Params& p, int l, unsigned char* lds) {
    pg8::Gemm g{1024, 1024};
    SchedP4 S{(int)gridDim.x, (int)blockIdx.x, (const char*)p.ws + WS_MRG, (const char*)p.ws + WS_WOT};
    if (gridDim.x == 256) {
        float* xs = (float*)(p.ws + WS_XS) + (size_t)l * 64 * 256 * 4; unsigned* cnt = (unsigned*)(p.ws + WS_XCNT) + l * 64 * 64;
        if (l == 0) { EpiNorm<false> E{p.in[I_X], p.out, p.in[I_NORMG] + 1024, (bf16*)(p.ws + WS_XN), xs, cnt}; pg8::gemm_phase<EpiNorm<false>, SchedP4, true, true>((lds3_t)lds, g, S, E); }
        else { EpiNorm<true> E{p.out, p.out, p.in[I_FNORMG], nullptr, xs, cnt}; pg8::gemm_phase<EpiNorm<true>, SchedP4, true, true>((lds3_t)lds, g, S, E); }
    } else { EpiRes E{l == 0 ? p.in[I_X] : p.out, p.out}; pg8::gemm_phase<EpiRes, SchedP4, true, true>((lds3_t)lds, g, S, E); }
}
DI void phase_post(const Params& p, int l, unsigned char* lds) {
    if (gridDim.x == 256) { if (l == 0) convert_weights(p, 1, lds); }
    else phase_norm(p, l, 1.0f, lds);
}

#ifndef MK_LAUNCHES
#define MK_LAUNCHES 1
#endif
struct KArgs { Params p; int lo, hi; };
constexpr int N_PHASES = 15;
#ifdef NVGPR
__global__ void __launch_bounds__(NTHREADS, 2) __attribute__((amdgpu_num_vgpr(NVGPR))) fwd_kernel(KArgs a) {
#else
__global__ void __launch_bounds__(NTHREADS, 2) fwd_kernel(KArgs a) {
#endif
    extern __shared__ __attribute__((aligned(16))) unsigned char lds[];
    cg::grid_group grid = cg::this_grid();
    const Params& p = a.p;
    volatile unsigned* bst = (volatile unsigned*)(lds + LDS_BYTES - 64);
    if (threadIdx.x < 16) bst[threadIdx.x] = 0u;
    __syncthreads();
    XcdBarrier xbar = xcd_barrier_post((unsigned*)(p.ws + WS_BAR), bst);
    if (a.hi == 12345) grid.sync();
#define GRID_SYNC() xcd_barrier(xbar)
#ifndef DUP_N
#define DUP_N 1
#endif
#ifndef PHMASK
#define PHMASK 0xff
#endif
#if defined(TPROBE) && defined(PH_PROBE)
#define PH_TS_BEGIN() do { if (threadIdx.x == 0) TS_BASE(lds)[13] = (unsigned)__builtin_amdgcn_s_memrealtime(); } while (0)
#define PH_TS_MARK(k) do { __syncthreads(); if (threadIdx.x == 0) { const unsigned t_ = (unsigned)__builtin_amdgcn_s_memrealtime(); volatile unsigned* A_ = TS_BASE(lds); A_[k] += t_ - A_[13]; A_[13] = t_; } } while (0)
#else
#define PH_TS_BEGIN() do {} while (0)
#define PH_TS_MARK(k) do {} while (0)
#endif
#ifdef DUP_S
#define NREP(ty, l) (((ty) == DUP_S && !(((ty) == 6 || (ty) == 7) && (l) != 0)) ? 1 + DUP_N : 1)
#else
#define NREP(ty, l) 1
#endif
#define RUN_PHASE(ty, l, more) do { const int nrep = NREP(ty, l); \
        for (int rep = 0; rep < nrep; ++rep) { const bool dry = (rep + 1 < nrep) && (a.hi != 12345); (void)dry; PH_TS_BEGIN(); \
            if (!((PHMASK >> (ty)) & 1)) {} \
            else if ((ty) == 0) phase_prologue(p, lds); \
            else if ((ty) == 1) phase_P1(p, l, lds); \
            else if ((ty) == 2) phase_A(p, l, lds, dry); \
            else if ((ty) == 3) phase_B(p, lds, dry); \
            else if ((ty) == 4) phase_C(p, l, lds, dry); \
            else if ((ty) == 5) phase_P3(p, l, lds); \
            else if ((ty) == 6) phase_P4(p, l, lds); \
            else phase_post(p, l, lds); \
            PH_TS_MARK(ty); \
            if ((more) || rep + 1 < nrep) GRID_SYNC(); } } while (0)
#if MK_LAUNCHES == 1
#if defined(DUP_S) && DUP_S == 100
    for (int rep = 0; rep < DUP_N; ++rep) GRID_SYNC();
#endif
    RUN_PHASE(0, 0, true);
    RUN_PHASE(1, 0, true); RUN_PHASE(2, 0, true); RUN_PHASE(3, 0, true); RUN_PHASE(4, 0, true); RUN_PHASE(5, 0, true); RUN_PHASE(6, 0, true); RUN_PHASE(7, 0, true);
    RUN_PHASE(1, 1, true); RUN_PHASE(2, 1, true); RUN_PHASE(3, 1, true); RUN_PHASE(4, 1, true); RUN_PHASE(5, 1, true); RUN_PHASE(6, 1, gridDim.x != 256); RUN_PHASE(7, 1, false);
#ifdef TPROBE
    {
        GRID_SYNC();
        unsigned* pw = (unsigned*)(p.ws + WS_XS + 600 * 1024);
        if (threadIdx.x == 0) pw[blockIdx.x] = TS_BASE(lds)[TPROBE];
        GRID_SYNC();
#ifndef TP_MODE
#define TP_MODE 0
#endif
#ifndef TP_LO
#define TP_LO 0
#define TP_HI 1
#endif
        float tot = 0.f, mx = 0.f, ctot = 0.f; int amx = 0; for (int i = 0; i < (int)gridDim.x; ++i) { const float v_ = (float)__hip_atomic_load(pw + i, __ATOMIC_RELAXED, __HIP_MEMORY_SCOPE_AGENT); tot += v_; if (v_ > mx) { mx = v_; amx = i; } if (i >= TP_LO && i < TP_HI) ctot += v_; }
        const float avg_us = TP_MODE == 4 ? (float)amx : TP_MODE == 3 ? (ctot / (float)(TP_HI - TP_LO)) / (tot / (float)gridDim.x) * 100.0f : TP_MODE == 2 ? (mx * (float)gridDim.x / tot - 1.0f) * 100.0f : (TP_MODE == 0 ? tot / (float)gridDim.x : mx) * 0.01f / (float)TP_CNT;
        const float bucket = floorf(avg_us / (float)TP_Q + 0.5f);
        const float sc = 1.0f + bucket * 0.01f;
        for (int i = blockIdx.x * NTHREADS + threadIdx.x; i < M * 256; i += gridDim.x * NTHREADS) { f32x4* o = (f32x4*)p.out + i; *o = *o * sc; }
    }
#endif
#else
    for (int ph = a.lo; ph < a.hi; ++ph) { const int ty = (ph == 0) ? 0 : ((ph - 1) % 7 + 1), l = (ph - 1) / 7; RUN_PHASE(ty, l, ph + 1 < a.hi); }
#endif
}

extern "C" void kernel_launch(void* const* d_in, const int* in_sizes, int n_in, void* d_out, int out_size, void* d_ws, size_t ws_size, hipStream_t stream) {
    static int grid = 0;
    if (grid == 0) {
        if (n_in != N_IN || out_size != M * D || ws_size < WS_END) { fprintf(stderr, "kernel_launch: unexpected shapes (n_in %d, out %d, ws %zu < %zu)\n", n_in, out_size, ws_size, (size_t)WS_END); grid = -1; return; }
        int dev = 0, cus = 0, per_cu = 0;
        hipGetDevice(&dev); hipDeviceGetAttribute(&cus, hipDeviceAttributeMultiprocessorCount, dev);
        hipFuncSetAttribute((const void*)fwd_kernel, hipFuncAttributeMaxDynamicSharedMemorySize, LDS_BYTES);
        hipOccupancyMaxActiveBlocksPerMultiprocessor(&per_cu, (const void*)fwd_kernel, NTHREADS, LDS_BYTES);
        if (per_cu < 1 || cus < 1) { fprintf(stderr, "kernel_launch: occupancy query gave %d blocks/CU on %d CUs\n", per_cu, cus); grid = -1; return; }
        grid = cus * per_cu; if (grid > 256) grid = 256;
    }
    if (grid < 0) return;
    KArgs a{}; for (int i = 0; i < N_IN; ++i) a.p.in[i] = (const float*)d_in[i];
    a.p.out = (float*)d_out; a.p.ws = (unsigned char*)d_ws;
    if (hipMemsetAsync((char*)d_ws + WS_BAR, 0, WS_ZERO_BYTES, stream) != hipSuccess) { fprintf(stderr, "kernel_launch: memset of the barrier words failed\n"); return; }
    if (MK_LAUNCHES == 1) {
        a.lo = 0; a.hi = N_PHASES; void* args[] = {&a};
        hipError_t e = hipLaunchCooperativeKernel((const void*)fwd_kernel, dim3(grid), dim3(NTHREADS), args, LDS_BYTES, stream);
        if (e != hipSuccess) fprintf(stderr, "kernel_launch: cooperative launch failed: %s (grid %d)\n", hipGetErrorString(e), grid);
    } else {
        for (int ph = 0; ph < N_PHASES; ++ph) { a.lo = ph; a.hi = ph + 1; hipLaunchKernelGGL(fwd_kernel, dim3(grid), dim3(NTHREADS), LDS_BYTES, stream, a); }
    }
}
```

```cpp
#include <hip/hip_runtime.h>
#include <hip/hip_cooperative_groups.h>
#include <cstdio>
#include <cstdint>
namespace cg = cooperative_groups;
namespace pg8 {
#define PG8_LAS __attribute__((address_space(3)))
typedef unsigned short bf16_t;
typedef short bf16x8 __attribute__((ext_vector_type(8)));
typedef float f32x4 __attribute__((ext_vector_type(4)));
typedef unsigned u32x4 __attribute__((ext_vector_type(4)));
constexpr int BM = 256, BK = 64, HALF = 128, HTB = HALF * BK * 2  , STAGE_BYTES = 8 * HTB, NXCD = 8, WGM = 8;

__host__ __device__ __forceinline__ int lds_byte(int r, int c) { const int st = (r >> 4) * 2 + (c >> 5), rr = r & 15, cc = c & 31, ob = rr * 64 + cc * 2; return st * 1024 + (ob ^ (((ob >> 9) & 1) << 5)); }
__host__ __device__ __forceinline__ void stage_rc(int b, int& R, int& C) { const int st = b / 1024, sb = b % 1024, swz = sb ^ (((sb >> 9) & 1) << 5); R = (st >> 1) * 16 + swz / 64; C = (st & 1) * 32 + (swz % 64) / 2; }
__host__ __device__ __forceinline__ int perm32(int rho) { const int n = rho >> 4, i = rho & 15; return 8 * (i >> 2) + 4 * n + (i & 3); }

struct Unit { int pm, pn, kind, aux; int nt, lda, ldb; int pad_; const char* A; const char* B; };
struct Gemm { int K, lda; };


template <class Epi, class Sched, bool ALIGN_EPI = false, bool SP2 = false>
__device__ __forceinline__ void gemm_phase(PG8_LAS unsigned char* lds, const Gemm g, const Sched& S, const Epi& E) {
    int tid = threadIdx.x; asm volatile("" : "+v"(tid));
    const int wid = __builtin_amdgcn_readfirstlane(tid >> 6), lane = tid & 63, wr = wid >> 2, wc = wid & 3, fr = lane & 15, fq = lane >> 4;
    int Rv[2], Rbv[2], Cv[2];
#pragma unroll
    for (int i = 0; i < 2; ++i) { int R, C; stage_rc(tid * 16 + i * 8192, R, C); Rv[i] = R; Cv[i] = C; Rbv[i] = Epi::PERM ? ((R & ~31) + perm32(R & 31)) : R; }
    unsigned voffA[2], voffB[2], voffAn[2], voffBn[2];
    const size_t kstep = (size_t)(BK * 2);
    size_t hstepA, hstepB, hstepAn, hstepBn;
#define PG8_STRIDES(u_, vA_, vB_, hA_, hB_) do { _Pragma("unroll") for (int _i = 0; _i < 2; ++_i) { vA_[_i] = (unsigned)(Rv[_i] * (u_).lda + Cv[_i]) * 2u; vB_[_i] = (unsigned)(Rbv[_i] * (u_).ldb + Cv[_i]) * 2u; } \
        hA_ = (size_t)HALF * (u_).lda * 2; hB_ = (size_t)HALF * (u_).ldb * 2; } while (0)
    const unsigned ldsw = (unsigned)wid * 1024u;
    const int aoff = lds_byte(wr * 64 + fr, fq * 8), boff = lds_byte(wc * 32 + fr, fq * 8);
#define PG8_SA(b, h) (((b) * 2 + (h)) * HTB)
#define PG8_SB(b, h) ((4 + (b) * 2 + (h)) * HTB)
#define PG8_STAGE(bufoff, gbase, voff) do { _Pragma("unroll") for (int _i = 0; _i < 2; ++_i) \
        __builtin_amdgcn_global_load_lds((const unsigned*)((const char*)(gbase) + (voff)[_i]), (PG8_LAS unsigned*)(lds + (bufoff) + ldsw + _i * 8192), 16, 0, 0); } while (0)
#define PG8_LDA(dst, b, h) do { _Pragma("unroll") for (int m = 0; m < 4; ++m) _Pragma("unroll") for (int k = 0; k < 2; ++k) dst[m][k] = *(const PG8_LAS bf16x8*)(lds + PG8_SA(b, h) + aoff + m * 2048 + k * 1024); } while (0)
#define PG8_LDB(dst, b, h) do { _Pragma("unroll") for (int n = 0; n < 2; ++n) _Pragma("unroll") for (int k = 0; k < 2; ++k) dst[n][k] = *(const PG8_LAS bf16x8*)(lds + PG8_SB(b, h) + boff + n * 2048 + k * 1024); } while (0)
#define PG8_MMA(ai, bj, At, Bt) do { __builtin_amdgcn_s_setprio(1); _Pragma("unroll") for (int m = 0; m < 4; ++m) _Pragma("unroll") for (int n = 0; n < 2; ++n) _Pragma("unroll") for (int k = 0; k < 2; ++k) \
        acc[ai][bj][m][n] = __builtin_amdgcn_mfma_f32_16x16x32_bf16(Bt[n][k], At[m][k], acc[ai][bj][m][n], 0, 0, 0); __builtin_amdgcn_s_setprio(0); } while (0)
#define PG8_WAIT_V(n) asm volatile("s_waitcnt vmcnt(" #n ")" ::: "memory")
#define PG8_WAIT_L(n) asm volatile("s_waitcnt lgkmcnt(" #n ")" ::: "memory")
#define PG8_BAR __builtin_amdgcn_s_barrier()
#define PG8_SCHED __builtin_amdgcn_sched_barrier(0)
    Unit cur, nxt; int ui = 0;
    if (!S.next(0, cur)) return;
    PG8_STRIDES(cur, voffA, voffB, hstepA, hstepB); int nt = cur.nt;
    f32x4 acc[2][2][4][2];
#pragma unroll
    for (int a = 0; a < 2; ++a)
#pragma unroll
        for (int b = 0; b < 2; ++b)
#pragma unroll
            for (int m = 0; m < 4; ++m)
#pragma unroll
                for (int n = 0; n < 2; ++n) acc[a][b][m][n] = (f32x4){0.f, 0.f, 0.f, 0.f};
    bf16x8 At[4][2], B0[2][2], B1[2][2];
    const char* cA = cur.A; const char* cB = cur.B;
    S.a_ready(cur);
    if constexpr (SP2) {
        PG8_STAGE(PG8_SB(0, 0), cB, voffB); PG8_STAGE(PG8_SB(0, 1), cB + hstepB, voffB); PG8_STAGE(PG8_SA(0, 0), cA, voffA); PG8_STAGE(PG8_SA(0, 1), cA + hstepA, voffA);
        if (wr == 1) PG8_BAR;
        PG8_WAIT_V(2); PG8_BAR;
        PG8_STAGE(PG8_SB(1, 0), cB + kstep, voffB); PG8_STAGE(PG8_SA(1, 0), cA + kstep, voffA); PG8_STAGE(PG8_SB(1, 1), cB + hstepB + kstep, voffB);
        PG8_WAIT_V(6); PG8_BAR;
    } else {
        PG8_STAGE(PG8_SB(0, 0), cB, voffB); PG8_STAGE(PG8_SA(0, 0), cA, voffA); PG8_STAGE(PG8_SB(0, 1), cB + hstepB, voffB); PG8_STAGE(PG8_SA(0, 1), cA + hstepA, voffA);
        if (wr == 1) PG8_BAR;
        PG8_WAIT_V(4); PG8_BAR;
        PG8_STAGE(PG8_SB(1, 0), cB + kstep, voffB); PG8_STAGE(PG8_SA(1, 0), cA + kstep, voffA); PG8_STAGE(PG8_SB(1, 1), cB + hstepB + kstep, voffB);
        PG8_WAIT_V(6); PG8_BAR;
    }
    for (;;) {
        const bool has_next = S.next(ui + 1, nxt);
        const char* nA = has_next ? nxt.A : cA; const char* nB = has_next ? nxt.B : cB;
        if (has_next) PG8_STRIDES(nxt, voffAn, voffBn, hstepAn, hstepBn); else { voffAn[0] = voffA[0]; voffAn[1] = voffA[1]; voffBn[0] = voffB[0]; voffBn[1] = voffB[1]; hstepAn = hstepA; hstepBn = hstepB; }
        for (int t = 0; t < nt; t += 2) {
            const bool last = (t == nt - 2);
            const char* a1 = cA + (size_t)(t + 1) * kstep;
            const char* a2 = last ? nA : cA + (size_t)(t + 2) * kstep; const char* b2 = last ? nB : cB + (size_t)(t + 2) * kstep;
            const char* a3 = a2 + kstep; const char* b3 = b2 + kstep;
            unsigned vA2[2], vB2[2]; vA2[0] = last ? voffAn[0] : voffA[0]; vA2[1] = last ? voffAn[1] : voffA[1]; vB2[0] = last ? voffBn[0] : voffB[0]; vB2[1] = last ? voffBn[1] : voffB[1];
            const size_t hA2 = last ? hstepAn : hstepA, hB2 = last ? hstepBn : hstepB;
            if (last && has_next) S.a_ready(nxt);
            if constexpr (SP2) {
            PG8_LDB(B0, 0, 0); PG8_LDB(B1, 0, 1); PG8_SCHED; PG8_LDA(At, 0, 0); PG8_STAGE(PG8_SA(1, 1), a1 + hstepA, voffA);
            PG8_WAIT_V(8); PG8_WAIT_L(0); PG8_BAR; PG8_MMA(0, 0, At, B0); PG8_MMA(0, 1, At, B1); PG8_BAR; PG8_SCHED;
            PG8_LDA(At, 0, 1); PG8_STAGE(PG8_SB(0, 0), b2, vB2); PG8_STAGE(PG8_SB(0, 1), b2 + hB2, vB2); PG8_STAGE(PG8_SA(0, 0), a2, vA2);
            PG8_WAIT_V(8); PG8_WAIT_L(0); PG8_BAR; PG8_MMA(1, 0, At, B0); PG8_MMA(1, 1, At, B1); PG8_BAR; PG8_SCHED;
            PG8_LDB(B0, 1, 0); PG8_LDB(B1, 1, 1); PG8_SCHED; PG8_LDA(At, 1, 0); PG8_STAGE(PG8_SA(0, 1), a2 + hA2, vA2);
            PG8_WAIT_V(8); PG8_WAIT_L(0); PG8_BAR; PG8_MMA(0, 0, At, B0); PG8_MMA(0, 1, At, B1); PG8_BAR; PG8_SCHED;
            PG8_LDA(At, 1, 1); PG8_STAGE(PG8_SB(1, 0), b3, vB2); PG8_STAGE(PG8_SB(1, 1), b3 + hB2, vB2); PG8_STAGE(PG8_SA(1, 0), a3, vA2);
            PG8_WAIT_V(8); PG8_WAIT_L(0); PG8_BAR; PG8_MMA(1, 0, At, B0); PG8_MMA(1, 1, At, B1); PG8_BAR; PG8_SCHED;
            } else {
            PG8_LDB(B0, 0, 0); PG8_SCHED; PG8_LDA(At, 0, 0); PG8_STAGE(PG8_SA(1, 1), a1 + hstepA, voffA);
            PG8_WAIT_L(8); PG8_BAR; PG8_WAIT_L(0); PG8_MMA(0, 0, At, B0); PG8_BAR; PG8_SCHED;
            PG8_LDB(B1, 0, 1); PG8_STAGE(PG8_SB(0, 0), b2, vB2);
            PG8_BAR; PG8_WAIT_L(0); PG8_MMA(0, 1, At, B1); PG8_BAR;
            PG8_LDA(At, 0, 1); PG8_STAGE(PG8_SA(0, 0), a2, vA2);
            PG8_BAR; PG8_WAIT_L(0); PG8_MMA(1, 0, At, B0); PG8_BAR; PG8_SCHED;
            PG8_STAGE(PG8_SB(0, 1), b2 + hB2, vB2);
            PG8_WAIT_V(6); PG8_BAR; PG8_MMA(1, 1, At, B1); PG8_BAR;
            PG8_LDB(B0, 1, 0); PG8_SCHED; PG8_LDA(At, 1, 0); PG8_STAGE(PG8_SA(0, 1), a2 + hA2, vA2);
            PG8_WAIT_L(8); PG8_BAR; PG8_WAIT_L(0); PG8_MMA(0, 0, At, B0); PG8_BAR; PG8_SCHED;
            PG8_LDB(B1, 1, 1); PG8_STAGE(PG8_SB(1, 0), b3, vB2);
            PG8_BAR; PG8_WAIT_L(0); PG8_MMA(0, 1, At, B1); PG8_BAR;
            PG8_LDA(At, 1, 1); PG8_STAGE(PG8_SA(1, 0), a3, vA2);
            PG8_BAR; PG8_WAIT_L(0); PG8_MMA(1, 0, At, B0); PG8_BAR; PG8_SCHED;
            PG8_STAGE(PG8_SB(1, 1), b3 + hB2, vB2);
            PG8_WAIT_V(6); PG8_BAR; PG8_MMA(1, 1, At, B1); PG8_BAR;
            }
        }
        if constexpr (ALIGN_EPI) { if (wr == 0) PG8_BAR; }
        if constexpr (!Epi::AFTER_DRAIN) { E(acc, cur, wr, wc, fr, fq); S.done(cur); }
        if (!has_next) break;
#pragma unroll
        for (int a = 0; a < 2; ++a)
#pragma unroll
            for (int b = 0; b < 2; ++b)
#pragma unroll
                for (int m = 0; m < 4; ++m)
#pragma unroll
                    for (int n = 0; n < 2; ++n) acc[a][b][m][n] = (f32x4){0.f, 0.f, 0.f, 0.f};
        cur = nxt; cA = nA; cB = nB; ++ui; nt = cur.nt; voffA[0] = voffAn[0]; voffA[1] = voffAn[1]; voffB[0] = voffBn[0]; voffB[1] = voffBn[1]; hstepA = hstepAn; hstepB = hstepBn;
        if constexpr (ALIGN_EPI) { if (wr == 1) PG8_BAR; }
    }
    PG8_WAIT_V(0);
    if constexpr (!ALIGN_EPI) { if (wr == 0) PG8_BAR; }
    PG8_BAR;
    if constexpr (Epi::AFTER_DRAIN) { E.fused(acc, cur, wr, wc, fr, fq, lds, wid, lane); S.done(cur); }
#undef PG8_STRIDES
#undef PG8_SA
#undef PG8_SB
#undef PG8_STAGE
#undef PG8_LDA
#undef PG8_LDB
#undef PG8_MMA
#undef PG8_WAIT_V
#undef PG8_WAIT_L
#undef PG8_BAR
#undef PG8_SCHED
}
}

#define DI __device__ __forceinline__
typedef unsigned short bf16;
typedef short bf16x8 __attribute__((ext_vector_type(8)));
typedef float f32x4 __attribute__((ext_vector_type(4)));
typedef unsigned u32x4 __attribute__((ext_vector_type(4)));
typedef unsigned u32x2 __attribute__((ext_vector_type(2)));

constexpr int D = 1024, NBATCH = 4, T = 4096, M = NBATCH * T, IN_TOTAL = 12184;
constexpr int LDP = 7168;
constexpr int C_RQ = 0, C_RK = 256, C_RV = 512, C_RG = 1024, C_GQ = 1536, C_GK = 1792, C_GV = 2048, C_GG = 2560,
              C_SX = 3072, C_SZ = 4096, C_WR = 4608, C_WK = 5120, C_WV = 5632, C_WL = 6144, C_AL = 6208, C_WG = 6272,
              C_MQ = 6784, C_GKL = 7040, C_SDT = 7056;
enum { I_X = 0, I_MEM, I_POS, I_NORMG, I_WIN, I_GKW2, I_GKB, I_GNORMG, I_CONVW, I_CONVB, I_DTB, I_ALOG, I_SD, I_SNORMG,
       I_MU, I_W0, I_W2, I_A0, I_A2, I_KK, I_KA, I_RK, I_LNG, I_LNB, I_MNORMG, I_WKV, I_URET, I_UGLA, I_USSD, I_URWKV,
       I_UMEM, I_WOUT, I_FNORMG, N_IN };
constexpr size_t MiB = 1u << 20;
constexpr size_t WS_SSQ = 0;
constexpr size_t WS_DG = 512 * 1024;
constexpr size_t WS_DS = 576 * 1024;
constexpr size_t WS_BAR = 640 * 1024;
constexpr size_t WS_KM = 1 * MiB;
constexpr size_t WS_VMT = 1 * MiB + 512 * 1024;
constexpr size_t WS_MEMN = 2 * MiB;
constexpr size_t WS_BND = 6 * MiB;
constexpr int BND_W = 1792;
constexpr size_t WS_XS = 7 * MiB;
constexpr size_t WS_XCNT = 640 * 1024 + 16384;
constexpr size_t WS_ZERO_BYTES = 16384 + 2 * 64 * 256;
constexpr size_t WS_W1T = 8 * MiB;
constexpr size_t WS_WGT = 22 * MiB;
constexpr size_t WS_UT = 32 * MiB;
constexpr size_t WS_UST = 35 * MiB;
constexpr size_t WS_UMT = 36 * MiB;
constexpr size_t WS_WOT = 37 * MiB;
constexpr size_t WS_WKVT = 39 * MiB;
constexpr size_t WS_XN = 40 * MiB;
constexpr size_t WS_P = 72 * MiB;
constexpr size_t WS_OMEM = 296 * MiB;
constexpr size_t WS_RETL = 304 * MiB;
constexpr size_t WS_GLAL = 312 * MiB;
constexpr size_t WS_SSDL = 320 * MiB;
constexpr size_t WS_MRG = 304 * MiB;
constexpr size_t WS_RWGH = 336 * MiB;
constexpr size_t WS_END = 368 * MiB;

constexpr int LDS_BYTES = 147456;
constexpr int NTHREADS = 512;

struct Params { const float* in[N_IN]; float* out; unsigned char* ws; };

DI float bf2f(unsigned b) { return __uint_as_float(b << 16); }
typedef __bf16 bf16n2 __attribute__((ext_vector_type(2)));
DI unsigned f2bf(float f) { const __bf16 b = (__bf16)f; return (unsigned)__builtin_bit_cast(unsigned short, b); }
DI unsigned pk2(float lo, float hi) { const bf16n2 v = {(__bf16)lo, (__bf16)hi}; return __builtin_bit_cast(unsigned, v); }
DI float lo16(unsigned u) { return __uint_as_float(u << 16); }
DI float hi16(unsigned u) { return __uint_as_float(u & 0xffff0000u); }
DI void unpack8(u32x4 v, float* f) { f[0] = lo16(v.x); f[1] = hi16(v.x); f[2] = lo16(v.y); f[3] = hi16(v.y); f[4] = lo16(v.z); f[5] = hi16(v.z); f[6] = lo16(v.w); f[7] = hi16(v.w); }
DI u32x4 pack8(const float* f) { u32x4 v; v.x = pk2(f[0], f[1]); v.y = pk2(f[2], f[3]); v.z = pk2(f[4], f[5]); v.w = pk2(f[6], f[7]); return v; }
DI u32x2 pack4(f32x4 a) { u32x2 v; v.x = pk2(a[0], a[1]); v.y = pk2(a[2], a[3]); return v; }
DI float fexp(float x) { return __expf(x); }
DI float sigmoidf_(float x) { return __builtin_amdgcn_rcpf(1.0f + __expf(-x)); }
DI float siluf_(float x) { return x * __builtin_amdgcn_rcpf(1.0f + __expf(-x)); }
DI float softplusf_(float x) { return fmaxf(x, 0.0f) + __logf(1.0f + __expf(-fabsf(x))); }
DI float logsigmoidf_(float x) { return fminf(x, 0.0f) - __logf(1.0f + __expf(-fabsf(x))); }
DI float tanhf_(float x) { const float e = __expf(2.0f * x); return 1.0f - 2.0f * __builtin_amdgcn_rcpf(e + 1.0f); }
DI int opaque_tid() { int t = threadIdx.x; asm volatile("" : "+v"(t)); return t; }
#ifdef TPROBE
#define TS_BASE(lds_) ((volatile unsigned*)((lds_) + LDS_BYTES - 64) + 2)
#define TS_BEGIN() do { if (threadIdx.x == 0) TS_BASE(lds)[13] = (unsigned)__builtin_amdgcn_s_memrealtime(); } while (0)
#define TS_MARK(k) do { if (threadIdx.x == 0) { const unsigned t_ = (unsigned)__builtin_amdgcn_s_memrealtime(); volatile unsigned* A_ = TS_BASE(lds); A_[k] += t_ - A_[13]; A_[13] = t_; } } while (0)
#endif
#define WAVE_LDS_SYNC() asm volatile("s_waitcnt lgkmcnt(0)" ::: "memory")
DI float wave_sum(float v) {
#pragma unroll
    for (int o = 1; o < 64; o <<= 1) v += __shfl_xor(v, o);
    return v;
}
DI bf16x8 frag(const bf16* base, int ld, int r0, int k0, int lane) { return *(const bf16x8*)(base + (r0 + (lane & 15)) * ld + k0 + ((lane >> 4) << 3)); }
DI f32x4 mfma16(bf16x8 a, bf16x8 b, f32x4 c) { return __builtin_amdgcn_mfma_f32_16x16x32_bf16(a, b, c, 0, 0, 0); }

DI void tile_map(int L, int nM, int nN, int& pm, int& pn) {
    const int nwg = nM * nN; int wgid = L;
    { const int q = nwg / 8, r = nwg % 8, xcd = wgid % 8, off = wgid / 8; wgid = (xcd < r ? xcd * (q + 1) : r * (q + 1) + (xcd - r) * q) + off; }
    const int nig = 8 * nN, gid = wgid / nig, fm = gid * 8, gsz = (nM - fm) < 8 ? (nM - fm) : 8;
    pm = fm + ((wgid % nig) % gsz); pn = (wgid % nig) / gsz;
}

using pg8::Unit;
struct SchedP1 {
    int G, c; const char* A; const char* B;
    DI bool next(int i, Unit& u) const {
        const long L = (long)i * G + c; if (L >= 64 * 28) return false;
        tile_map((int)L, 64, 28, u.pm, u.pn); u.kind = 0; u.aux = 0; u.nt = 16; u.lda = 1024; u.ldb = 1024; u.pad_ = 0;
        u.A = A + (size_t)u.pm * 256 * 1024 * 2; u.B = B + (size_t)u.pn * 256 * 1024 * 2; return true;
    }
    DI void a_ready(const Unit&) const {}
    DI void done(const Unit&) const {}
};
struct EpiP {
    static constexpr bool PERM = true, AFTER_DRAIN = false;
    bf16* O; bf16* BND;
    DI void operator()(const f32x4 (&acc)[2][2][4][2], const Unit& u, int wr, int wc, int fr, int fq) const {
        const int row0 = u.pm * 256 + wr * 64 + fr, col0 = u.pn * 256 + wc * 32 + 8 * fq;
#pragma unroll
        for (int ai = 0; ai < 2; ++ai)
#pragma unroll
            for (int m = 0; m < 4; ++m) { bf16* rowp = O + (size_t)(row0 + ai * 128 + m * 16) * LDP + col0;
#pragma unroll
                for (int bj = 0; bj < 2; ++bj) { const f32x4 v0 = acc[ai][bj][m][0], v1 = acc[ai][bj][m][1];
                    u32x4 w; w.x = pk2(v0[0], v0[1]); w.y = pk2(v0[2], v0[3]); w.z = pk2(v1[0], v1[1]); w.w = pk2(v1[2], v1[3]);
                    *(u32x4*)(rowp + bj * 128) = w;
                    if (m == 3 && fr == 15 && u.pn >= 18 && u.pn <= 24) *(u32x4*)(BND + (size_t)((row0 + ai * 128 + m * 16) >> 6) * BND_W + (col0 - 4608) + bj * 128) = w; } }
    }
};
DI int gate_slot_col(int s) { return s < 8 ? 128 * s : s < 16 ? 1536 + 128 * (s - 8) : s < 24 ? 3072 + 128 * (s - 16) : s < 37 ? 4608 + 128 * (s - 24) : 6784 + 128 * (s - 37); }
struct SchedP3 {
    int pm, pn; const unsigned char* ws; int alt;
    DI bool next(int i0, Unit& u) const {
        if (i0 >= 11) return false;
        const unsigned long long code = alt == 0 ? 0xA4982736150ull : alt == 1 ? 0xA9847263510ull : alt == 2 ? 0x736150982A4ull : 0x76315908A24ull;
        const int i = (int)((code >> (4 * i0)) & 15ull), fb = alt < 2 ? 5 : 10;
        u.pm = pm; u.pn = pn; u.pad_ = 0;
        if (i < 5) { u.kind = i; u.aux = 16; u.nt = 16; u.lda = 1024; u.ldb = 1024; u.A = (const char*)ws + WS_XN + (size_t)pm * 256 * 1024 * 2;
            u.B = (const char*)ws + WS_WGT + ((size_t)i * 1024 + (size_t)pn * 256) * 1024 * 2; }
        else if (i < 8) { const int j = i - 5; const int col = j == 0 ? C_RG : j == 1 ? C_GG : C_WG; u.kind = j == 0 ? 0 : j == 1 ? 1 : 3; u.aux = (i == fb) ? 1 : 0; u.nt = 8; u.lda = LDP; u.ldb = 512;
            u.A = (const char*)ws + WS_P + ((size_t)pm * 256 * LDP + col) * 2;
            u.B = (const char*)ws + WS_UT + ((size_t)j * 1024 + (size_t)pn * 256) * 512 * 2; }
        else if (i < 10) { const int j = i - 8; u.kind = 2; u.aux = (j + 1) << 1; u.nt = 4; u.lda = LDP; u.ldb = 256;
            u.A = (const char*)ws + WS_P + ((size_t)pm * 256 * LDP + C_SZ + j * 256) * 2;
            u.B = (const char*)ws + WS_UST + ((size_t)j * 1024 + (size_t)pn * 256) * 256 * 2; }
        else { u.kind = 4; u.aux = (i == fb) ? 1 : 0; u.nt = 4; u.lda = 256; u.ldb = 256; u.A = (const char*)ws + WS_OMEM + (size_t)pm * 256 * 256 * 2;
            u.B = (const char*)ws + WS_UMT + ((size_t)pn * 256) * 256 * 2; }
        return true;
    }
    DI void a_ready(const Unit&) const {}
    DI void done(const Unit&) const {}
};
typedef float f32x2 __attribute__((ext_vector_type(2)));
DI f32x2 sig255_pk(f32x2 x) {
    x = __builtin_elementwise_min(__builtin_elementwise_max(x, (f32x2){-7.0f, -7.0f}), (f32x2){7.0f, 7.0f});
    const f32x2 x2 = x * x;
    f32x2 q = x2 * 9.362619013e-11f + (-1.716749942e-08f);
    q = q * x2 + 1.283517804e-06f; q = q * x2 + (-5.098115798e-05f); q = q * x2 + 1.195220742e-03f; q = q * x2 + (-1.824038848e-02f); q = q * x2 + 2.476293743e-01f;
    return (x * q) * 255.0f + 128.0f;
}
DI f32x2 sig_pk(f32x2 x) { return (sig255_pk(x) - 128.0f) * (1.0f / 255.0f) + 0.5f; }
struct EpiGate {
    static constexpr bool PERM = true, AFTER_DRAIN = false;
    bf16* P;
    DI void operator()(const f32x4 (&acc)[2][2][4][2], const Unit& u, int wr, int wc, int fr, int fq) const {
        const int row0 = u.pm * 256 + wr * 64 + fr;
#pragma unroll
        for (int bj = 0; bj < 2; ++bj) { const int col = gate_slot_col((u.kind * 4 + u.pn) * 2 + bj);
#pragma unroll
            for (int ai = 0; ai < 2; ++ai)
#pragma unroll
                for (int m = 0; m < 4; ++m) { const f32x4 v0 = acc[ai][bj][m][0], v1 = acc[ai][bj][m][1];
                    const f32x2 a = sig255_pk((f32x2){v0[0], v0[1]}), b = sig255_pk((f32x2){v0[2], v0[3]}), c = sig255_pk((f32x2){v1[0], v1[1]}), d = sig255_pk((f32x2){v1[2], v1[3]});
                    u32x2 w; w.x = (unsigned)a.x | ((unsigned)a.y << 8) | ((unsigned)b.x << 16) | ((unsigned)b.y << 24);
                    w.y = (unsigned)c.x | ((unsigned)c.y << 8) | ((unsigned)d.x << 16) | ((unsigned)d.y << 24);
                    *(u32x2*)((unsigned char*)(P + (size_t)(row0 + ai * 128 + m * 16) * LDP + col) + wc * 32 + 8 * fq) = w; } }
    }
};
struct EpiBranch {
    static constexpr bool PERM = true, AFTER_DRAIN = false;
    const bf16* P; bf16* MG; const float* ssq;
    DI void operator()(const f32x4 (&acc)[2][2][4][2], const Unit& u, int wr, int wc, int fr, int fq) const {
        const int row0 = u.pm * 256 + wr * 64 + fr; const bool first = (u.aux & 1) != 0; const int grp = (u.aux >> 1) - 1;
        const int gc0 = gate_slot_col((u.kind * 4 + u.pn) * 2 + 0), gc1 = gate_slot_col((u.kind * 4 + u.pn) * 2 + 1);
        u32x2 g8[2][2][2]; u32x4 o8[2][2][2]; f32x4 s4[2][2];
#define EB_LOAD(buf, ai, mh) do { \
        _Pragma("unroll") for (int m2 = 0; m2 < 2; ++m2) { const int row = row0 + (ai) * 128 + (2 * (mh) + m2) * 16; \
            s4[buf][m2] = *(const f32x4*)(ssq + (size_t)row * 8 + (grp > 0 ? 4 : 0)); \
            _Pragma("unroll") for (int bj = 0; bj < 2; ++bj) { \
                g8[buf][m2][bj] = *(const u32x2*)((const unsigned char*)(P + (size_t)row * LDP + (bj ? gc1 : gc0)) + wc * 32 + 8 * fq); \
                o8[buf][m2][bj] = *(const u32x4*)(MG + (size_t)row * 1024 + u.pn * 256 + bj * 128 + wc * 32 + 8 * fq); } } } while (0)
#define EB_COMP(buf, ai, mh) do { \
        _Pragma("unroll") for (int m2 = 0; m2 < 2; ++m2) { const int m = 2 * (mh) + m2, row = row0 + (ai) * 128 + m * 16; \
            const float sc = (grp >= 0) ? __builtin_amdgcn_rsqf(((s4[buf][m2][0] + s4[buf][m2][1]) + (s4[buf][m2][2] + s4[buf][m2][3])) * (1.0f / 256.0f) + 1e-6f) : 1.0f; \
            _Pragma("unroll") for (int bj = 0; bj < 2; ++bj) { float g[8], pv[8]; \
                _Pragma("unroll") for (int j = 0; j < 4; ++j) { g[j] = (float)((g8[buf][m2][bj].x >> (8 * j)) & 0xffu) * (1.0f / 255.0f); g[4 + j] = (float)((g8[buf][m2][bj].y >> (8 * j)) & 0xffu) * (1.0f / 255.0f); } \
                unpack8(o8[buf][m2][bj], pv); \
                if (first) { _Pragma("unroll") for (int j = 0; j < 8; ++j) pv[j] = 0.f; } \
                const f32x4 v0 = acc[ai][bj][m][0], v1 = acc[ai][bj][m][1]; \
                float o[8] = { v0[0] * sc * g[0] + pv[0], v0[1] * sc * g[1] + pv[1], v0[2] * sc * g[2] + pv[2], v0[3] * sc * g[3] + pv[3], v1[0] * sc * g[4] + pv[4], v1[1] * sc * g[5] + pv[5], v1[2] * sc * g[6] + pv[6], v1[3] * sc * g[7] + pv[7] }; \
                *(u32x4*)(MG + (size_t)row * 1024 + u.pn * 256 + bj * 128 + wc * 32 + 8 * fq) = pack8(o); } } } while (0)
        EB_LOAD(0, 0, 0); EB_LOAD(1, 0, 1);
        __builtin_amdgcn_sched_barrier(0);
        EB_COMP(0, 0, 0); EB_LOAD(0, 1, 0);
        __builtin_amdgcn_sched_barrier(0);
        EB_COMP(1, 0, 1); EB_LOAD(1, 1, 1);
        __builtin_amdgcn_sched_barrier(0);
        EB_COMP(0, 1, 0);
        __builtin_amdgcn_sched_barrier(0);
        EB_COMP(1, 1, 1);
#undef EB_LOAD
#undef EB_COMP
    }
};
struct EpiP3 {
    static constexpr bool PERM = true, AFTER_DRAIN = false;
    EpiGate G; EpiBranch B;
    DI void operator()(const f32x4 (&acc)[2][2][4][2], const Unit& u, int wr, int wc, int fr, int fq) const { if (u.aux & 16) G(acc, u, wr, wc, fr, fq); else B(acc, u, wr, wc, fr, fq); }
};
struct SchedP4 {
    int G, c; const char* A; const char* B;
    DI bool next(int i, Unit& u) const {
        const long L = (long)i * G + c; if (L >= 64 * 4) return false;
        tile_map((int)L, 64, 4, u.pm, u.pn); u.kind = 0; u.aux = 0; u.nt = 16; u.lda = 1024; u.ldb = 1024; u.pad_ = 0;
        u.A = A + (size_t)u.pm * 256 * 1024 * 2; u.B = B + (size_t)u.pn * 256 * 1024 * 2; return true;
    }
    DI void a_ready(const Unit&) const {}
    DI void done(const Unit&) const {}
};
struct EpiRes {
    static constexpr bool PERM = false, AFTER_DRAIN = false;
    const float* res; float* out;
    DI void operator()(const f32x4 (&acc)[2][2][4][2], const Unit& u, int wr, int wc, int fr, int fq) const {
        const int row0 = u.pm * 256 + wr * 64 + fr, col0 = u.pn * 256 + wc * 32 + 4 * fq;
#pragma unroll
        for (int ai = 0; ai < 2; ++ai)
#pragma unroll
            for (int m = 0; m < 4; ++m) { const size_t off = (size_t)(row0 + ai * 128 + m * 16) * 1024 + col0;
#pragma unroll
                for (int bj = 0; bj < 2; ++bj)
#pragma unroll
                    for (int n = 0; n < 2; ++n) { const f32x4 r = *(const f32x4*)(res + off + bj * 128 + n * 16); *(f32x4*)(out + off + bj * 128 + n * 16) = r + acc[ai][bj][m][n]; } }
    }
};

template <bool LAST> struct EpiNorm {
    static constexpr bool PERM = false, AFTER_DRAIN = true;
    const float* res; float* out; const float* g; bf16* xn; float* xs; unsigned* cnt;
    DI void operator()(const f32x4 (&)[2][2][4][2], const Unit&, int, int, int, int) const {}
    DI void fused(f32x4 (&acc)[2][2][4][2], const Unit& u, int wr, int wc, int fr, int fq, PG8_LAS unsigned char* lds, int wid, int lane) const {
        PG8_LAS float* Pt = (PG8_LAS float*)lds; PG8_LAS float* St = Pt + 1024;
        const int row0 = u.pm * 256 + wr * 64 + fr, col0 = u.pn * 256 + wc * 32 + 4 * fq;
        f32x4 rr[4][4];
#define EN_LOAD(k) do { const size_t off_ = (size_t)(row0 + ((k) >> 2) * 128 + ((k) & 3) * 16) * 1024 + col0; \
            _Pragma("unroll") for (int q = 0; q < 4; ++q) rr[(k) & 3][q] = *(const f32x4*)(res + off_ + (q >> 1) * 128 + (q & 1) * 16); } while (0)
        EN_LOAD(0); EN_LOAD(1); EN_LOAD(2); EN_LOAD(3);
#pragma unroll
        for (int k = 0; k < 8; ++k) { const int ai = k >> 2, m = k & 3; float s = 0.f;
#pragma unroll
            for (int q = 0; q < 4; ++q) { const int bj = q >> 1, n = q & 1; const f32x4 x = rr[k & 3][q] + acc[ai][bj][m][n]; acc[ai][bj][m][n] = x;
                s += (x[0] * x[0] + x[1] * x[1]) + (x[2] * x[2] + x[3] * x[3]); }
            if (k + 4 < 8) EN_LOAD(k + 4);
            s += __shfl_xor(s, 16); s += __shfl_xor(s, 32);
            if (fq == 0) Pt[(ai * 128 + wr * 64 + m * 16 + fr) * 4 + wc] = s; }
#undef EN_LOAD
        asm volatile("s_waitcnt lgkmcnt(0)" ::: "memory"); __builtin_amdgcn_s_barrier(); asm volatile("" ::: "memory");
        const int row = wid * 32 + (lane & 31);
        if (lane < 32) { const float t = (Pt[row * 4 + 0] + Pt[row * 4 + 1]) + (Pt[row * 4 + 2] + Pt[row * 4 + 3]);
            __hip_atomic_store(xs + ((size_t)u.pm * 256 + row) * 4 + u.pn, t, __ATOMIC_RELAXED, __HIP_MEMORY_SCOPE_AGENT); }
        asm volatile("s_waitcnt vmcnt(0)" ::: "memory");
        if (lane == 0) (void)__hip_atomic_fetch_add(cnt + u.pm * 64, 1u, __ATOMIC_RELAXED, __HIP_MEMORY_SCOPE_AGENT);
        if (wid == 0) { unsigned spins = 0;
            while ((unsigned)__builtin_amdgcn_readfirstlane(__hip_atomic_load(cnt + u.pm * 64, __ATOMIC_RELAXED, __HIP_MEMORY_SCOPE_AGENT)) < 32u) { __builtin_amdgcn_s_sleep(2); if (++spins > (1u << 22)) break; }
            __builtin_amdgcn_fence(__ATOMIC_ACQUIRE, "agent"); asm volatile("s_waitcnt vmcnt(0)" ::: "memory"); }
        asm volatile("" ::: "memory"); __builtin_amdgcn_s_barrier(); asm volatile("" ::: "memory");
        if (lane < 32) { const float* sp = xs + ((size_t)u.pm * 256 + row) * 4;
            const float a = __hip_atomic_load(sp + 0, __ATOMIC_RELAXED, __HIP_MEMORY_SCOPE_AGENT), b = __hip_atomic_load(sp + 1, __ATOMIC_RELAXED, __HIP_MEMORY_SCOPE_AGENT),
                        c = __hip_atomic_load(sp + 2, __ATOMIC_RELAXED, __HIP_MEMORY_SCOPE_AGENT), d = __hip_atomic_load(sp + 3, __ATOMIC_RELAXED, __HIP_MEMORY_SCOPE_AGENT);
            St[row] = __builtin_amdgcn_rsqf(((a + b) + (c + d)) * (1.0f / 1024.0f) + 1e-6f); }
        asm volatile("s_waitcnt lgkmcnt(0)" ::: "memory"); __builtin_amdgcn_s_barrier(); asm volatile("" ::: "memory");
#pragma unroll
        for (int ai = 0; ai < 2; ++ai)
#pragma unroll
            for (int m = 0; m < 4; ++m) { const size_t off = (size_t)(row0 + ai * 128 + m * 16) * 1024 + col0; const float rs = St[ai * 128 + wr * 64 + m * 16 + fr];
#pragma unroll
                for (int bj = 0; bj < 2; ++bj)
#pragma unroll
                    for (int n = 0; n < 2; ++n) { const f32x4 gv = *(const f32x4*)(g + col0 + bj * 128 + n * 16); const f32x4 x = acc[ai][bj][m][n]; const f32x4 y = x * rs * gv;
                        if (LAST) *(f32x4*)(out + off + bj * 128 + n * 16) = y;
                        else { *(f32x4*)(out + off + bj * 128 + n * 16) = x; *(u32x2*)(xn + off + bj * 128 + n * 16) = pack4(y); } } }
    }
};

DI void transpose_item(const float* W, int ldw, int K, bf16* WT, float* scr, int item, int nblk, int lane) {
    const int kb = item / nblk, nb = item % nblk, k0 = 64 * kb, n0 = 32 * nb;
    float tv[32];
#pragma unroll
    for (int i = 0; i < 32; ++i) { const int kk = 2 * i + (lane >> 5); tv[i] = W[(size_t)(k0 + kk) * ldw + n0 + (lane & 31)]; }
#pragma unroll
    for (int i = 0; i < 32; ++i) { const int kk = 2 * i + (lane >> 5); scr[kk * 33 + (lane & 31)] = tv[i]; }
    WAVE_LDS_SYNC();
    const int c = lane & 7;
#pragma unroll
    for (int j = 0; j < 4; ++j) { const int n = (lane >> 3) + 8 * j; const float* s = scr + (8 * c) * 33 + n;
        u32x4 o; o.x = pk2(s[0 * 33], s[1 * 33]); o.y = pk2(s[2 * 33], s[3 * 33]); o.z = pk2(s[4 * 33], s[5 * 33]); o.w = pk2(s[6 * 33], s[7 * 33]);
        *(u32x4*)(WT + (size_t)(n0 + n) * K + k0 + 8 * c) = o; }
    WAVE_LDS_SYNC();
}
struct TSeg { int inp, lstride, src0, ldw, K, nblk; unsigned dst_q, dst_rows0; };
DI void rms_row_bf16(const float* xrow, const float* g, bf16* orow, int lane) {
    const f32x4* xr = (const f32x4*)xrow + lane; const f32x4* gr = (const f32x4*)g + lane;
    f32x4 v[4]; float s = 0.f;
#pragma unroll
    for (int j = 0; j < 4; ++j) { v[j] = xr[64 * j]; s += (v[j][0] * v[j][0] + v[j][1] * v[j][1]) + (v[j][2] * v[j][2] + v[j][3] * v[j][3]); }
    const float rstd = __builtin_amdgcn_rsqf(wave_sum(s) * (1.0f / 1024.0f) + 1e-6f);
    u32x2* o8 = (u32x2*)orow + lane;
#pragma unroll
    for (int j = 0; j < 4; ++j) { const f32x4 gg = gr[64 * j]; u32x2 o; o.x = pk2(v[j][0] * rstd * gg[0], v[j][1] * rstd * gg[1]); o.y = pk2(v[j][2] * rstd * gg[2], v[j][3] * rstd * gg[3]); o8[64 * j] = o; }
}
DI void convert_weights(const Params& p, int l, unsigned char* lds) {
    const int tid = opaque_tid(), lane = tid & 63, wave = tid >> 6;
    const int gw = blockIdx.x * 8 + wave, NGW = gridDim.x * 8;
    float* scr = (float*)(lds + wave * 16384);
    static constexpr TSeg segs[] = {
        {I_WIN, 1024 * IN_TOTAL, 0,    IN_TOTAL, 1024, 2560 / 32, 32, 0},
        {I_WIN, 1024 * IN_TOTAL, 2576, IN_TOTAL, 1024, 512 / 32,  32, 2560},
        {I_WIN, 1024 * IN_TOTAL, 3088, IN_TOTAL, 1024, 1024 / 32, 32, 3072},
        {I_WIN, 1024 * IN_TOTAL, 4120, IN_TOTAL, 1024, 512 / 32,  32, 4096},
        {I_WIN, 1024 * IN_TOTAL, 4632, IN_TOTAL, 1024, 1664 / 32, 32, 4608},
        {I_WIN, 1024 * IN_TOTAL, 6296, IN_TOTAL, 1024, 512 / 32,  32, 6272},
        {I_WIN, 1024 * IN_TOTAL, 6808, IN_TOTAL, 1024, 256 / 32,  32, 6784},
        {I_WIN, 1024 * IN_TOTAL, 7064, IN_TOTAL, 1024, 5120 / 32, 88, 0},
        {I_URET,  512 * 1024, 0, 1024, 512, 32, 128, 0},
        {I_UGLA,  512 * 1024, 0, 1024, 512, 32, 128, 1024},
        {I_URWKV, 512 * 1024, 0, 1024, 512, 32, 128, 2048},
        {I_USSD,  512 * 1024, 0,          1024, 256, 32, 140, 0},
        {I_USSD,  512 * 1024, 256 * 1024, 1024, 256, 32, 140, 1024},
        {I_UMEM,  256 * 1024, 0, 1024, 256, 32, 144, 0},
        {I_WOUT, 1024 * 1024, 0, 1024, 1024, 32, 148, 0},
        {I_WKV,  1024 * 512,  0, 512,  1024, 16, 156, 0},
    };
    constexpr int NSEG = sizeof(segs) / sizeof(segs[0]);
    int base = 0;
    for (int s = 0; s < NSEG; ++s) {
        const TSeg sg = segs[s]; const int nitems = (sg.K / 64) * sg.nblk;
        int it = gw - (base % NGW); if (it < 0) it += NGW;
        const float* W = p.in[sg.inp] + (size_t)l * sg.lstride + sg.src0;
        bf16* WT = (bf16*)(p.ws + (size_t)sg.dst_q * 262144) + (size_t)sg.dst_rows0 * sg.K;
        for (; it < nitems; it += NGW) transpose_item(W, sg.ldw, sg.K, WT, scr, it, sg.nblk, lane);
        base += nitems;
    }
    for (int idx = blockIdx.x * NTHREADS + tid; idx < 128 * 1024; idx += gridDim.x * NTHREADS) {
        const int r = (idx >> 10) & 127, k = idx & 1023;
        const float* W = p.in[I_WIN] + (size_t)l * 1024 * IN_TOTAL + (size_t)k * IN_TOTAL;
        const float v = r < 16 ? W[2560 + r] : r < 24 ? W[4112 + (r - 16)] : 0.0f;
        ((bf16*)(p.ws + WS_W1T))[((size_t)7040 + r) * 1024 + k] = (bf16)f2bf(v);
    }
}
DI void rms_rows2_bf16(const float* x0, const float* x1, const float* g, bf16* o0, bf16* o1, int lane) {
    const f32x4* xa = (const f32x4*)x0 + lane; const f32x4* xb = (const f32x4*)x1 + lane; const f32x4* gr = (const f32x4*)g + lane;
    f32x4 va[4], vb[4]; float sa = 0.f, sb = 0.f;
#pragma unroll
    for (int j = 0; j < 4; ++j) { va[j] = xa[64 * j]; vb[j] = xb[64 * j]; }
#pragma unroll
    for (int j = 0; j < 4; ++j) { sa += (va[j][0] * va[j][0] + va[j][1] * va[j][1]) + (va[j][2] * va[j][2] + va[j][3] * va[j][3]); sb += (vb[j][0] * vb[j][0] + vb[j][1] * vb[j][1]) + (vb[j][2] * vb[j][2] + vb[j][3] * vb[j][3]); }
    const float ra = __builtin_amdgcn_rsqf(wave_sum(sa) * (1.0f / 1024.0f) + 1e-6f), rb = __builtin_amdgcn_rsqf(wave_sum(sb) * (1.0f / 1024.0f) + 1e-6f);
    u32x2* pa = (u32x2*)o0 + lane; u32x2* pb = (u32x2*)o1 + lane;
#pragma unroll
    for (int j = 0; j < 4; ++j) { const f32x4 gg = gr[64 * j]; u32x2 o; o.x = pk2(va[j][0] * ra * gg[0], va[j][1] * ra * gg[1]); o.y = pk2(va[j][2] * ra * gg[2], va[j][3] * ra * gg[3]); pa[64 * j] = o;
        o.x = pk2(vb[j][0] * rb * gg[0], vb[j][1] * rb * gg[1]); o.y = pk2(vb[j][2] * rb * gg[2], vb[j][3] * rb * gg[3]); pb[64 * j] = o; }
}
DI void phase_prologue(const Params& p, unsigned char* lds) {
    const int tid = opaque_tid(), lane = tid & 63, wave = tid >> 6;
    const int gw = blockIdx.x * 8 + wave, NGW = gridDim.x * 8;
    convert_weights(p, 0, lds);
    for (int m = gw; m < M; m += 2 * NGW) { const int m1 = m + NGW;
        if (m1 < M) rms_rows2_bf16(p.in[I_X] + (size_t)m * 1024, p.in[I_X] + (size_t)m1 * 1024, p.in[I_NORMG], (bf16*)(p.ws + WS_XN) + (size_t)m * 1024, (bf16*)(p.ws + WS_XN) + (size_t)m1 * 1024, lane);
        else rms_row_bf16(p.in[I_X] + (size_t)m * 1024, p.in[I_NORMG], (bf16*)(p.ws + WS_XN) + (size_t)m * 1024, lane); }
    for (int m = gw; m < 2048; m += NGW) { const int l = m >> 10, r = m & 1023;
        rms_row_bf16(p.in[I_MEM] + (size_t)r * 1024, p.in[I_MNORMG] + l * 1024, (bf16*)(p.ws + WS_MEMN) + (size_t)m * 1024, lane); }
}
DI void phase_norm(const Params& p, int l, float oscale, unsigned char* lds) {
    const int tid = opaque_tid(), lane = tid & 63, wave = tid >> 6;
    const int gw = blockIdx.x * 8 + wave, NGW = gridDim.x * 8;
    if (l == 0) { convert_weights(p, 1, lds); for (int m = gw; m < M; m += NGW) rms_row_bf16(p.out + (size_t)m * 1024, p.in[I_NORMG] + 1024, (bf16*)(p.ws + WS_XN) + (size_t)m * 1024, lane); }
    else {
        for (int m = gw; m < M; m += NGW) {
            f32x4* xr = (f32x4*)(p.out + (size_t)m * 1024) + lane; const f32x4* gr = (const f32x4*)p.in[I_FNORMG] + lane;
            f32x4 v[4]; float s = 0.f;
#pragma unroll
            for (int j = 0; j < 4; ++j) { v[j] = xr[64 * j]; s += (v[j][0] * v[j][0] + v[j][1] * v[j][1]) + (v[j][2] * v[j][2] + v[j][3] * v[j][3]); }
            const float rstd = __builtin_amdgcn_rsqf(wave_sum(s) * (1.0f / 1024.0f) + 1e-6f);
#pragma unroll
            for (int j = 0; j < 4; ++j) xr[64 * j] = v[j] * (rstd * oscale) * gr[64 * j];
        }
    }
}

#define XB_TMO      128
#define XB_XCNT(j)  (256  + 64 * (j))
#define XB_XSUB(j)  (1280 + 64 * (j))
#define XB_XGEN(j)  (2304 + 64 * (j))
#define XB_TOP      3328
#define XB_TOPGEN   3392
#define XCD_BAR_WORDS 3456
#define XB_SPIN_CAP (1u << 18)

__device__ __forceinline__ unsigned xb_ld(unsigned* p)              { return __hip_atomic_load(p, __ATOMIC_RELAXED, __HIP_MEMORY_SCOPE_AGENT); }
__device__ __forceinline__ unsigned xb_add(unsigned* p, unsigned v) { return __hip_atomic_fetch_add(p, v, __ATOMIC_RELAXED, __HIP_MEMORY_SCOPE_AGENT); }
__device__ __forceinline__ unsigned xb_xcc_id() { return (unsigned)__builtin_amdgcn_s_getreg((3 << 11) | 20) & 0xFu; }
#define XB_SPIN(cond, bar) do { unsigned _sp = 0; while (cond) { __builtin_amdgcn_s_sleep(1); \
    if ((++_sp & 255u) == 0u) { if (xb_ld(&(bar)[XB_TMO])) break; if (_sp > XB_SPIN_CAP) { atomicAdd(&(bar)[XB_TMO], 1u); break; } } } } while (0)

struct XcdBarrier {
    unsigned* bar; unsigned x;
    volatile unsigned* st;
};

__device__ __forceinline__ XcdBarrier xcd_barrier_post(unsigned* bar, volatile unsigned* st) {
    XcdBarrier b; b.bar = bar; b.x = xb_xcc_id(); b.st = st;
    if (threadIdx.x == 0) (void)xb_add(&bar[XB_XCNT(b.x)], 1u);
    return b;
}
__device__ __forceinline__ void xcd_barrier_complete(unsigned* bar, unsigned x, unsigned& nloc, unsigned& nx) {
    const unsigned G = gridDim.x * gridDim.y * gridDim.z;
    unsigned sum, cnt, mine, sp = 0u;
    for (;;) {
        sum = 0u; cnt = 0u; mine = 0u;
#pragma unroll
        for (unsigned j = 0; j < 16; ++j) { const unsigned c = xb_ld(&bar[XB_XCNT(j)]); sum += c; cnt += (c > 0u) ? 1u : 0u; mine = (j == x) ? c : mine; }
        if (sum == G) break;
        __builtin_amdgcn_s_sleep(1);
        if ((++sp & 255u) == 0u) { if (xb_ld(&bar[XB_TMO])) break; if (sp > XB_SPIN_CAP) { atomicAdd(&bar[XB_TMO], 1u); break; } }
    }
    nloc = mine > 0u ? mine : 1u; nx = cnt > 0u ? cnt : 1u;
}

__device__ __forceinline__ void xcd_barrier(const XcdBarrier& b) {
    asm volatile("s_waitcnt vmcnt(0)" ::: "memory");
    __syncthreads();
    if (threadIdx.x == 0) {
        unsigned* bar = b.bar;
        __builtin_amdgcn_s_waitcnt(0);
        unsigned nloc = b.st[0], nx = b.st[1];
        if (nloc == 0u) { xcd_barrier_complete(bar, b.x, nloc, nx); b.st[0] = nloc; b.st[1] = nx; }
        const unsigned old = xb_add(&bar[XB_XSUB(b.x)], 1u);
        const unsigned gen = old / nloc;
        if (old + 1u == (gen + 1u) * nloc) {
            __builtin_amdgcn_fence(__ATOMIC_RELEASE, "agent");
            asm volatile("s_waitcnt vmcnt(0)" ::: "memory");
            const unsigned og = xb_add(&bar[XB_TOP], 1u);
            const unsigned tg = og / nx;
            if (og + 1u == (tg + 1u) * nx) xb_add(&bar[XB_TOPGEN], 1u);
            else XB_SPIN(xb_ld(&bar[XB_TOPGEN]) == tg, bar);
            __builtin_amdgcn_fence(__ATOMIC_ACQUIRE, "agent");
            xb_add(&bar[XB_XGEN(b.x)], 1u);
            asm volatile("s_waitcnt vmcnt(0)" ::: "memory");
        } else {
            XB_SPIN(xb_ld(&bar[XB_XGEN(b.x)]) == gen, bar);
            __builtin_amdgcn_fence(__ATOMIC_ACQUIRE, "agent");
            asm volatile("s_waitcnt vmcnt(0)" ::: "memory");
        }
    }
    __syncthreads();
}

DI void sincos_red(float ang, float& s, float& c) {
    const float n = rintf(ang * 0.15915494309189535f); float r = fmaf(-n, 6.28318548202514648f, ang); r = fmaf(-n, -1.7484555e-7f, r);
    s = __sinf(r); c = __cosf(r);
}

typedef short s16x4 __attribute__((ext_vector_type(4)));
DI s16x4 lds_tr(const bf16* p) { return __builtin_amdgcn_ds_read_tr16_b64_v4i16((__attribute__((address_space(3))) s16x4*)p); }
DI bf16x8 frag_tr(const bf16* base, int ld, int r0, int k0, int lane) {
    const bf16* p = base + (k0 + 8 * (lane >> 4) + ((lane & 15) >> 2)) * ld + r0 + 4 * (lane & 3);
    const s16x4 lo = lds_tr(p), hi = lds_tr(p + 4 * ld);
    return (bf16x8){lo[0], lo[1], lo[2], lo[3], hi[0], hi[1], hi[2], hi[3]};
}
DI bf16x8 frag_tr_perm(const bf16* base, int ld, int r0, int k0, int lane) {
    const bf16* p = base + (k0 + 4 * (lane >> 4) + ((lane & 15) >> 2)) * ld + r0 + 4 * (lane & 3);
    const s16x4 lo = lds_tr(p), hi = lds_tr(p + 16 * ld);
    return (bf16x8){lo[0], lo[1], lo[2], lo[3], hi[0], hi[1], hi[2], hi[3]};
}
constexpr int QK_QIN = 0, QK_KIN = 9216, QK_QC = 18432, QK_KST = 27648, QK_VT = 36864, QK_GKL = 55296, QK_INV = 59392, QK_ST = 64512, QK_CUM = 82944, QK_TOT = 99328, QK_RED = 101376, QK_ELAST = 103424;
#if defined(TPROBE) && defined(QTS_SEL)
#define QTS_ON() (((QTS_SEL) & 1) == (GLA ? 1 : 0) && (((QTS_SEL) >> 1) == (full ? 0 : 1)))
#define QTS_BEGIN() do { if (QTS_ON() && threadIdx.x == 0) TS_BASE(lds)[13] = (unsigned)__builtin_amdgcn_s_memrealtime(); } while (0)
#define QTS_MARK(k) do { if (QTS_ON() && threadIdx.x == 0) { const unsigned t_ = (unsigned)__builtin_amdgcn_s_memrealtime(); volatile unsigned* A_ = TS_BASE(lds); A_[k] += t_ - A_[13]; A_[13] = t_; } } while (0)
#else
#define QTS_BEGIN() do {} while (0)
#define QTS_MARK(k) do {} while (0)
#endif
template <bool GLA>
DI void qkv_item(const Params& p, int l, unsigned char* lds, int b, int h, int sc, bool full, bool dry = false) {
    QTS_BEGIN();
    const int tid = opaque_tid(), lane = tid & 63, w = tid >> 6, q4 = lane >> 4, l15 = lane & 15;
    bf16* P = (bf16*)(p.ws + WS_P);
    bf16* QIN = (bf16*)(lds + QK_QIN); bf16* KIN = (bf16*)(lds + QK_KIN); bf16* QC = (bf16*)(lds + QK_QC); bf16* KST = (bf16*)(lds + QK_KST);
    bf16* VT = (bf16*)(lds + QK_VT); bf16* ST = (bf16*)(lds + QK_ST);
    float* GKL = (float*)(lds + QK_GKL); float* INV = (float*)(lds + QK_INV);
    float* CUM = (float*)(lds + QK_CUM); float* TOT = (float*)(lds + QK_TOT); float* RED = (float*)(lds + QK_RED); float* ELAST = (float*)(lds + QK_ELAST);
    const int cq = GLA ? C_GQ : C_RQ, ck = GLA ? C_GK : C_RK, cv = GLA ? C_GV : C_RV, cgate = GLA ? C_GG : C_RG;
    const int bh = b * 4 + h;
    float* Lst = (float*)(p.ws + (GLA ? WS_GLAL : WS_RETL)) + (size_t)(bh * 16 + sc) * 8192;
    const float lgam = __logf(1.0f - exp2f(-5.0f - (float)h));
    const int st_t = tid >> 3, st_cg = tid & 7;
    f32x4 sacc[4];
#pragma unroll
    for (int mt = 0; mt < 4; ++mt) {
        if (full) { for (int j = 0; j < 4; ++j) sacc[mt][j] = Lst[(16 * mt + 4 * q4 + j) * 128 + 16 * w + l15]; *(u32x2*)(ST + (16 * w + l15) * 72 + 16 * mt + 4 * q4) = pack4(sacc[mt]); }
        else sacc[mt] = (f32x4){0.f, 0.f, 0.f, 0.f};
    }
    f32x4 gng = (f32x4){1.f, 1.f, 1.f, 1.f}; if (GLA) gng = *(const f32x4*)(p.in[I_GNORMG] + l * 128 + 16 * w + 4 * q4);
    float w2c[16], gb = 0.f;
    if (GLA) { const int ch = h * 64 + lane;
#pragma unroll
        for (int j = 0; j < 16; ++j) w2c[j] = p.in[I_GKW2][(size_t)l * 16 * 256 + j * 256 + ch];
        gb = p.in[I_GKB][l * 256 + ch]; }
    else if (tid < 32) INV[tid] = 1.0f / powf(10000.0f, (float)tid * (1.0f / 31.0f));
    u32x4 pq, pk, pv0, pv1, pg = (u32x4){0u, 0u, 0u, 0u}; int ipos = 0;
    {   const size_t ro = (size_t)(b * T + sc * 256 + st_t) * LDP;
        pq = *(const u32x4*)(P + ro + cq + h * 64 + 8 * st_cg); pk = *(const u32x4*)(P + ro + ck + h * 64 + 8 * st_cg);
        pv0 = *(const u32x4*)(P + ro + cv + h * 128 + 8 * st_cg); pv1 = *(const u32x4*)(P + ro + cv + h * 128 + 64 + 8 * st_cg);
        if (GLA) { if (st_cg < 2) { float g8[8]; unpack8(*(const u32x4*)(P + ro + C_GKL + 8 * st_cg), g8);
                *(f32x4*)(GKL + st_t * 16 + 8 * st_cg) = (f32x4){g8[0], g8[1], g8[2], g8[3]}; *(f32x4*)(GKL + st_t * 16 + 8 * st_cg + 4) = (f32x4){g8[4], g8[5], g8[6], g8[7]}; } }
        else ipos = ((const int*)p.in[I_POS])[b * T + sc * 256 + st_t]; }
    __syncthreads();
    QTS_MARK(4);
    float dtot = 0.f;
    for (int c = 0; c < 4; ++c) {
        const int t0 = sc * 256 + c * 64, m0 = b * T + t0;
        if (GLA) {
            float cumv[8]; float run = 0.f;
#pragma unroll
            for (int i = 0; i < 8; ++i) { const float* gp = GKL + (8 * w + i) * 16; float x = gb;
#pragma unroll
                for (int j4 = 0; j4 < 4; ++j4) { const f32x4 g = *(const f32x4*)(gp + 4 * j4); x += g[0] * w2c[4 * j4] + g[1] * w2c[4 * j4 + 1] + g[2] * w2c[4 * j4 + 2] + g[3] * w2c[4 * j4 + 3]; }
                run += logsigmoidf_(x) * (1.0f / 16.0f); cumv[i] = run; }
            TOT[w * 64 + lane] = run;
            __syncthreads();
            float off = 0.f;
            for (int ww = 0; ww < w; ++ww) off += TOT[ww * 64 + lane];
#pragma unroll
            for (int i = 0; i < 8; ++i) CUM[(8 * w + i) * 64 + lane] = cumv[i] + off;
            __syncthreads();
            QTS_MARK(0);
        }
        {
            const int t = st_t, cg = st_cg;
            float qf[8], kf[8]; unpack8(pq, qf); unpack8(pk, kf);
            float fqin[8], fkin[8], fqc[8], fkst[8];
            if (GLA) {
#pragma unroll
                for (int i = 0; i < 8; ++i) { const float cu = CUM[t * 64 + 8 * cg + i], rf = CUM[32 * 64 + 8 * cg + i], la = CUM[63 * 64 + 8 * cg + i];
                    qf[i] *= 0.125f; fqin[i] = fexp(cu - rf); fkin[i] = fexp(rf - cu); fqc[i] = fexp(cu); fkst[i] = fexp(la - cu); }
            } else {
                const float ppos = (float)ipos;
#pragma unroll
                for (int i = 0; i < 4; ++i) { float sn, cs; sincos_red(ppos * INV[4 * cg + i], sn, cs);
                    const float q1 = qf[2 * i], q2 = qf[2 * i + 1], k1 = kf[2 * i], k2 = kf[2 * i + 1];
                    qf[2 * i] = q1 * cs - q2 * sn; qf[2 * i + 1] = q2 * cs + q1 * sn;
                    kf[2 * i] = (k1 * cs - k2 * sn) * 0.125f; kf[2 * i + 1] = (k2 * cs + k1 * sn) * 0.125f; }
                const float e = (float)(t + 1); const float a = fexp((e - 33.0f) * lgam), bq = fexp((33.0f - e) * lgam), cc = fexp(e * lgam), dd = fexp((64.0f - e) * lgam);
#pragma unroll
                for (int i = 0; i < 8; ++i) { fqin[i] = a; fkin[i] = bq; fqc[i] = cc; fkst[i] = dd; }
            }
            if (full) { float o1[8], o2[8], o3[8];
#pragma unroll
                for (int i = 0; i < 8; ++i) { o1[i] = qf[i] * fqin[i]; o2[i] = qf[i] * fqc[i]; o3[i] = kf[i] * fkin[i]; }
                *(u32x4*)(QIN + t * 72 + 8 * cg) = pack8(o1); *(u32x4*)(QC + t * 72 + 8 * cg) = pack8(o2); *(u32x4*)(KIN + t * 72 + 8 * cg) = pack8(o3); }
            { float o4[8];
#pragma unroll
              for (int i = 0; i < 8; ++i) o4[i] = kf[i] * fkst[i];
              *(u32x4*)(KST + t * 72 + 8 * cg) = pack8(o4); }
            *(u32x4*)(VT + t * 136 + 8 * cg) = pv0; *(u32x4*)(VT + t * 136 + 64 + 8 * cg) = pv1;
            if (tid < 64) { const float la = GLA ? CUM[63 * 64 + tid] : 64.0f * lgam; ELAST[tid] = fexp(la); dtot += la; }
            if (c < 3) {
                const size_t ro = (size_t)(m0 + 64 + t) * LDP;
                pq = *(const u32x4*)(P + ro + cq + h * 64 + 8 * cg); pk = *(const u32x4*)(P + ro + ck + h * 64 + 8 * cg);
                pv0 = *(const u32x4*)(P + ro + cv + h * 128 + 8 * cg); pv1 = *(const u32x4*)(P + ro + cv + h * 128 + 64 + 8 * cg);
                if (GLA) pg = *(const u32x4*)(P + ro + C_GKL + 8 * (cg & 1));
                else ipos = ((const int*)p.in[I_POS])[b * T + t0 + 64 + t]; }
        }
        __syncthreads();
        QTS_MARK(1);
        if (full) {
            u32x2 g2[4];
#pragma unroll
            for (int tt = 0; tt < 4; ++tt) g2[tt] = *(const u32x2*)(P + (size_t)(m0 + 16 * tt + l15) * LDP + cgate + h * 128 + 16 * w + 4 * q4);
            f32x4 oacc[4];
#pragma unroll
            for (int tt = 0; tt < 4; ++tt) {
                oacc[tt] = (f32x4){0.f, 0.f, 0.f, 0.f};
#pragma unroll
                for (int kk = 0; kk < 2; ++kk) oacc[tt] = mfma16(frag(ST, 72, 16 * w, 32 * kk, lane), frag(QC, 72, 16 * tt, 32 * kk, lane), oacc[tt]);
                const bf16x8 qa = frag(QIN, 72, 16 * tt, 0, lane), qb = frag(QIN, 72, 16 * tt, 32, lane);
                u32x2 pp[4];
#pragma unroll
                for (int st = 0; st < 4; ++st) {
                    if (st <= tt) { f32x4 a = (f32x4){0.f, 0.f, 0.f, 0.f};
                        a = mfma16(frag(KIN, 72, 16 * st, 0, lane), qa, a); a = mfma16(frag(KIN, 72, 16 * st, 32, lane), qb, a);
                        if (st == tt) {
#pragma unroll
                            for (int j = 0; j < 4; ++j) if (4 * q4 + j > l15) a[j] = 0.f; }
                        pp[st] = pack4(a); }
                    else pp[st] = (u32x2){0u, 0u}; }
#pragma unroll
                for (int kk2 = 0; kk2 < 2; ++kk2) { if (2 * kk2 <= tt) {
                        u32x4 pw; pw.x = pp[2 * kk2].x; pw.y = pp[2 * kk2].y; pw.z = pp[2 * kk2 + 1].x; pw.w = pp[2 * kk2 + 1].y;
                        oacc[tt] = mfma16(frag_tr_perm(VT, 136, 16 * w, 32 * kk2, lane), __builtin_bit_cast(bf16x8, pw), oacc[tt]); } }
                float ss = (oacc[tt][0] * oacc[tt][0] + oacc[tt][1] * oacc[tt][1]) + (oacc[tt][2] * oacc[tt][2] + oacc[tt][3] * oacc[tt][3]);
                ss += __shfl_xor(ss, 16); ss += __shfl_xor(ss, 32);
                if (q4 == 0) RED[(16 * tt + l15) * 8 + w] = ss; }
            __syncthreads();
            QTS_MARK(2);
#pragma unroll
            for (int tt = 0; tt < 4; ++tt) { const f32x4 r0 = *(const f32x4*)(RED + (16 * tt + l15) * 8), r1 = *(const f32x4*)(RED + (16 * tt + l15) * 8 + 4);
                const float rstd = __builtin_amdgcn_rsqf(((r0[0] + r0[1]) + (r0[2] + r0[3]) + (r1[0] + r1[1]) + (r1[2] + r1[3])) * (1.0f / 128.0f) + 1e-6f);
                bf16* gp = P + (size_t)(m0 + 16 * tt + l15) * LDP + cgate + h * 128 + 16 * w + 4 * q4;
                const float g[4] = {lo16(g2[tt].x), hi16(g2[tt].x), lo16(g2[tt].y), hi16(g2[tt].y)};
                f32x4 o;
#pragma unroll
                for (int j = 0; j < 4; ++j) { float v = oacc[tt][j] * rstd; if (GLA) v *= gng[j]; o[j] = v * siluf_(g[j]); }
                if (!dry) *(u32x2*)gp = pack4(o); }
        }
#pragma unroll
        for (int mt = 0; mt < 4; ++mt) {
            const f32x4 el = *(const f32x4*)(ELAST + 16 * mt + 4 * q4);
            sacc[mt] = sacc[mt] * el;
#pragma unroll
            for (int kk = 0; kk < 2; ++kk) sacc[mt] = mfma16(frag_tr(KST, 72, 16 * mt, 32 * kk, lane), frag_tr(VT, 136, 16 * w, 32 * kk, lane), sacc[mt]);
            if (full) *(u32x2*)(ST + (16 * w + l15) * 72 + 16 * mt + 4 * q4) = pack4(sacc[mt]);
        }
        if (GLA && c < 3 && st_cg < 2) { float g8[8]; unpack8(pg, g8);
            *(f32x4*)(GKL + st_t * 16 + 8 * st_cg) = (f32x4){g8[0], g8[1], g8[2], g8[3]}; *(f32x4*)(GKL + st_t * 16 + 8 * st_cg + 4) = (f32x4){g8[4], g8[5], g8[6], g8[7]}; }
        __syncthreads();
        QTS_MARK(3);
    }
    if (!full) {
#pragma unroll
        for (int mt = 0; mt < 4; ++mt)
#pragma unroll
            for (int j = 0; j < 4; ++j) Lst[(16 * mt + 4 * q4 + j) * 128 + 16 * w + l15] = sacc[mt][j];
        if (GLA && tid < 64) ((float*)(p.ws + WS_DG))[(bh * 16 + sc) * 64 + tid] = fexp(dtot);
    }
}

constexpr int SD_CS = 0, SD_BS = 17408, SD_BT = 34816, SD_XT = 53248, SD_XST = 62464, SD_PS = 71680, SD_ST = 80896, SD_DT = 98304, SD_CUM = 98560, SD_RED = 98816, SD_CW = 99840;
DI void conv8(const Params& p, int l, const bf16* P, int b, int tpos, int ch, float* y) {
    const float* cw = p.in[I_CONVW] + (size_t)l * 4 * 1024; const float* cb = p.in[I_CONVB] + l * 1024;
    const f32x4 b0 = *(const f32x4*)(cb + ch), b1 = *(const f32x4*)(cb + ch + 4);
    float acc[8] = {b0[0], b0[1], b0[2], b0[3], b1[0], b1[1], b1[2], b1[3]};
#pragma unroll
    for (int j = 0; j < 4; ++j) { const int tp = tpos - 3 + j;
        if (tp >= 0) { float x[8]; unpack8(*(const u32x4*)(P + (size_t)(b * T + tp) * LDP + C_SX + ch), x);
            const f32x4 w0 = *(const f32x4*)(cw + j * 1024 + ch), w1 = *(const f32x4*)(cw + j * 1024 + ch + 4);
            acc[0] += w0[0] * x[0]; acc[1] += w0[1] * x[1]; acc[2] += w0[2] * x[2]; acc[3] += w0[3] * x[3];
            acc[4] += w1[0] * x[4]; acc[5] += w1[1] * x[5]; acc[6] += w1[2] * x[6]; acc[7] += w1[3] * x[7]; } }
#pragma unroll
    for (int i = 0; i < 8; ++i) y[i] = siluf_(acc[i]);
}
DI void conv_rows(const bf16* P, int b, int tpos, int ch, u32x4 (&xr)[7]) {
#pragma unroll
    for (int r = 0; r < 7; ++r) { const int tp = tpos - 3 + r; xr[r] = *(const u32x4*)(P + (size_t)(b * T + (tp < 0 ? 0 : tp)) * LDP + C_SX + ch); }
}
DI void conv_apply(const float* cwl, int lc, const u32x4 (&xr)[7], int tpos, float (&y)[4][8]) {
    { const f32x4 b0 = *(const f32x4*)(cwl + 4 * 320 + lc), b1 = *(const f32x4*)(cwl + 4 * 320 + lc + 4);
#pragma unroll
        for (int o = 0; o < 4; ++o) { y[o][0] = b0[0]; y[o][1] = b0[1]; y[o][2] = b0[2]; y[o][3] = b0[3]; y[o][4] = b1[0]; y[o][5] = b1[1]; y[o][6] = b1[2]; y[o][7] = b1[3]; } }
#pragma unroll
    for (int j = 0; j < 4; ++j) { const f32x4 w0 = *(const f32x4*)(cwl + j * 320 + lc), w1 = *(const f32x4*)(cwl + j * 320 + lc + 4);
        const float wv[8] = {w0[0], w0[1], w0[2], w0[3], w1[0], w1[1], w1[2], w1[3]};
#pragma unroll
        for (int o = 0; o < 4; ++o) { float x[8]; unpack8(xr[o + j], x);
            if (tpos - 3 + o + j < 0) {
#pragma unroll
                for (int i = 0; i < 8; ++i) x[i] = 0.f; }
#pragma unroll
            for (int i = 0; i < 8; ++i) y[o][i] += wv[i] * x[i]; } }
#pragma unroll
    for (int o = 0; o < 4; ++o)
#pragma unroll
        for (int i = 0; i < 8; i += 2) { const f32x2 v = {y[o][i], y[o][i + 1]}; const f32x2 r = v * sig_pk(v); y[o][i] = r.x; y[o][i + 1] = r.y; }
}
DI void ssd_item(const Params& p, int l, unsigned char* lds, int b, int h, int sc, bool full, bool dry = false) {
    const int tid = opaque_tid(), lane = tid & 63, w = tid >> 6, q4 = lane >> 4, l15 = lane & 15;
    bf16* P = (bf16*)(p.ws + WS_P);
    bf16* CS = (bf16*)(lds + SD_CS); bf16* BS = (bf16*)(lds + SD_BS); bf16* XT = (bf16*)(lds + SD_XT); bf16* XST = (bf16*)(lds + SD_XST);
    bf16* ST = (bf16*)(lds + SD_ST);
    float* DTL = (float*)(lds + SD_DT); float* CUMS = (float*)(lds + SD_CUM); float* RED = (float*)(lds + SD_RED);
    const int g = h >> 2, bh = b * 8 + h;
    float* Lst = (float*)(p.ws + WS_SSDL) + (size_t)(bh * 16 + sc) * 8192;
    const float a_h = -fexp(p.in[I_ALOG][l * 8 + h]), dtb = p.in[I_DTB][l * 8 + h], dsk = p.in[I_SD][l * 8 + h];
    const int pt = w & 3, wh = w >> 2;
    const f32x4 sng = *(const f32x4*)(p.in[I_SNORMG] + l * 512 + h * 64 + 16 * pt + 4 * q4);
    const int r_cgi = tid & 31, r_seg = tid >> 5; const bool r_isB = r_cgi >= 16; const int r_cg = r_cgi & 15;
    const int r_ch = (r_isB ? 512 : 768) + g * 128 + 8 * r_cg, r_lc = (r_isB ? 128 : 0) + 8 * r_cg;
    f32x4 sacc[4];
#pragma unroll
    for (int i = 0; i < 4; ++i) { const int nt = 4 * wh + i;
        if (full) { for (int j = 0; j < 4; ++j) sacc[i][j] = Lst[(16 * nt + 4 * q4 + j) * 64 + 16 * pt + l15]; *(u32x2*)(ST + (16 * pt + l15) * 136 + 16 * nt + 4 * q4) = pack4(sacc[i]); }
        else sacc[i] = (f32x4){0.f, 0.f, 0.f, 0.f}; }
    float* CWL = (float*)(lds + SD_CW);
    {
        float cwv[4];
#pragma unroll
        for (int r4 = 0; r4 < 4; ++r4) { const int idx0 = tid + r4 * NTHREADS, idx = idx0 < 1600 ? idx0 : 1599; const int row = idx / 320, ci = idx - row * 320;
            const int gch = ci < 128 ? 768 + g * 128 + ci : ci < 256 ? 512 + g * 128 + (ci - 128) : h * 64 + (ci - 256);
            const float* src = row < 4 ? p.in[I_CONVW] + (size_t)l * 4096 + row * 1024 + gch : p.in[I_CONVB] + l * 1024 + gch;
            cwv[r4] = *src; }
#pragma unroll
        for (int r4 = 0; r4 < 4; ++r4) { const int idx0 = tid + r4 * NTHREADS; if (idx0 < 1600) CWL[idx0] = cwv[r4]; }
    }
    u32x4 xbc[7]; conv_rows(P, b, sc * 256 + 4 * r_seg, r_ch, xbc);
    unsigned dtraw = (unsigned)P[(size_t)(b * T + sc * 256 + lane) * LDP + C_SDT + h];
    float ltot = 0.f;
    for (int c = 0; c < 4; ++c) {
        const int t0 = sc * 256 + c * 64, m0 = b * T + t0;
        if (w == 0) {
            const float dt = softplusf_(bf2f(dtraw) + dtb); float cu = dt * a_h;
#pragma unroll
            for (int o = 1; o < 64; o <<= 1) { const float n = __shfl_up(cu, o); if (lane >= o) cu += n; }
            DTL[lane] = dt; CUMS[lane] = cu;
        }
        if (c < 3) dtraw = (unsigned)P[(size_t)(m0 + 64 + lane) * LDP + C_SDT + h];
        __syncthreads();
        const float clast = CUMS[63];
        ltot += clast;
        {
            u32x4 xx[7];
            conv_rows(P, b, t0 + 4 * ((tid & 127) >> 3), h * 64 + 8 * (tid & 7), xx);
            { float y[4][8]; conv_apply(CWL, r_lc, xbc, t0 + 4 * r_seg, y);
#pragma unroll
                for (int o = 0; o < 4; ++o) { const int t = 4 * r_seg + o; *(u32x4*)((r_isB ? BS : CS) + t * 136 + 8 * r_cg) = pack8(y[o]); }
            }
            if (tid < 128) { const int cg = tid & 7, seg = tid >> 3; float y[4][8]; conv_apply(CWL, 256 + 8 * cg, xx, t0 + 4 * seg, y);
                float coef[4];
#pragma unroll
                for (int o = 0; o < 4; ++o) coef[o] = fexp(clast - CUMS[4 * seg + o]) * DTL[4 * seg + o];
#pragma unroll
                for (int o = 0; o < 4; ++o) { float ys[8];
#pragma unroll
                    for (int i = 0; i < 8; ++i) ys[i] = y[o][i] * coef[o];
                    *(u32x4*)(XT + (4 * seg + o) * 72 + 8 * cg) = pack8(y[o]); *(u32x4*)(XST + (4 * seg + o) * 72 + 8 * cg) = pack8(ys); } }
            if (c < 3) conv_rows(P, b, t0 + 64 + 4 * r_seg, r_ch, xbc);
        }
        __syncthreads();
        if (full) {
#pragma unroll
            for (int i = 0; i < 2; ++i) { const int tt = 2 * wh + i, t = 16 * tt + l15;
                bf16* zp = P + (size_t)(m0 + t) * LDP + C_SZ + h * 64 + 16 * pt + 4 * q4;
                const u32x2 z2 = *(const u32x2*)zp;
                bf16x8 cf[4];
#pragma unroll
                for (int kk = 0; kk < 4; ++kk) cf[kk] = frag(CS, 136, 16 * tt, 32 * kk, lane);
                f32x4 oacc = (f32x4){0.f, 0.f, 0.f, 0.f};
#pragma unroll
                for (int kk = 0; kk < 4; ++kk) oacc = mfma16(frag(ST, 136, 16 * pt, 32 * kk, lane), cf[kk], oacc);
                const float ct = CUMS[t];
                oacc = oacc * fexp(ct);
                u32x2 pp[4];
#pragma unroll
                for (int st = 0; st < 4; ++st) {
                    if (st <= tt) { f32x4 a = (f32x4){0.f, 0.f, 0.f, 0.f};
#pragma unroll
                        for (int kk = 0; kk < 4; ++kk) a = mfma16(frag(BS, 136, 16 * st, 32 * kk, lane), cf[kk], a);
                        const f32x4 cs4 = *(const f32x4*)(CUMS + 16 * st + 4 * q4), dt4 = *(const f32x4*)(DTL + 16 * st + 4 * q4);
#pragma unroll
                        for (int j = 0; j < 4; ++j) a[j] = (16 * st + 4 * q4 + j <= t) ? a[j] * fexp(ct - cs4[j]) * dt4[j] : 0.f;
                        pp[st] = pack4(a); }
                    else pp[st] = (u32x2){0u, 0u}; }
#pragma unroll
                for (int kk2 = 0; kk2 < 2; ++kk2) { if (2 * kk2 <= tt) {
                        u32x4 pw; pw.x = pp[2 * kk2].x; pw.y = pp[2 * kk2].y; pw.z = pp[2 * kk2 + 1].x; pw.w = pp[2 * kk2 + 1].y;
                        oacc = mfma16(frag_tr_perm(XT, 72, 16 * pt, 32 * kk2, lane), __builtin_bit_cast(bf16x8, pw), oacc); } }
                const float z[4] = {lo16(z2.x), hi16(z2.x), lo16(z2.y), hi16(z2.y)};
                f32x4 o; float ss = 0.f;
                const u32x2 xv2 = *(const u32x2*)(XT + t * 72 + 16 * pt + 4 * q4); const float xvv[4] = {lo16(xv2.x), hi16(xv2.x), lo16(xv2.y), hi16(xv2.y)};
#pragma unroll
                for (int j = 0; j < 4; ++j) { const float xv = xvv[j]; const float v = (oacc[j] + dsk * xv) * siluf_(z[j]); ss += v * v;
                    o[j] = v * sng[j]; }
                if (!dry) *(u32x2*)zp = pack4(o);
                ss += __shfl_xor(ss, 16); ss += __shfl_xor(ss, 32);
                if (q4 == 0) RED[t * 4 + pt] = ss; }
        }
        const float el = fexp(clast);
#pragma unroll
        for (int i = 0; i < 4; ++i) { const int nt = 4 * wh + i;
            sacc[i] = sacc[i] * el;
#pragma unroll
            for (int kk = 0; kk < 2; ++kk) sacc[i] = mfma16(frag_tr(BS, 136, 16 * nt, 32 * kk, lane), frag_tr(XST, 72, 16 * pt, 32 * kk, lane), sacc[i]);
            if (full) *(u32x2*)(ST + (16 * pt + l15) * 136 + 16 * nt + 4 * q4) = pack4(sacc[i]); }
        __syncthreads();
        if (full && tid < 64) { const f32x4 r = *(const f32x4*)(RED + tid * 4); ((float*)(p.ws + WS_SSQ))[(size_t)(m0 + tid) * 8 + h] = (r[0] + r[1]) + (r[2] + r[3]); }
    }
    if (!full) {
#pragma unroll
        for (int i = 0; i < 4; ++i)
#pragma unroll
            for (int j = 0; j < 4; ++j) Lst[(16 * (4 * wh + i) + 4 * q4 + j) * 64 + 16 * pt + l15] = sacc[i][j];
        if (tid == 0) ((float*)(p.ws + WS_DS))[bh * 16 + sc] = fexp(ltot);
    }
}

DI void phase_scan(const Params& p, int vb, int nb, bool dry = false) {
    const int gt = vb * NTHREADS + opaque_tid(), NT = nb * NTHREADS;
    for (int idx0 = gt; idx0 < 4 * 131072; idx0 += 2 * NT) {
        float lv[2][16], dv[2][16]; float* Lp[2]; bool ok[2];
#pragma unroll
        for (int e = 0; e < 2; ++e) { const int idx = idx0 + e * NT; ok[e] = idx < 4 * 131072; const int which = idx >> 17, r = idx & 131071;
            float* L = nullptr; const float* dec = nullptr; int dstride = 0; float cdec = 0.f;
            if (ok[e]) {
                if (which == 0) { const int bh = r >> 13, el = r & 8191; L = (float*)(p.ws + WS_RETL) + (size_t)bh * 16 * 8192 + el; cdec = fexp(256.0f * __logf(1.0f - exp2f(-5.0f - (float)(bh & 3)))); }
                else if (which == 1) { const int bh = r >> 13, el = r & 8191; L = (float*)(p.ws + WS_GLAL) + (size_t)bh * 16 * 8192 + el; dec = (const float*)(p.ws + WS_DG) + bh * 16 * 64 + (el >> 7); dstride = 64; }
                else { const int rr = (which - 2) * 131072 + r, bh = rr >> 13, el = rr & 8191; L = (float*)(p.ws + WS_SSDL) + (size_t)bh * 16 * 8192 + el; dec = (const float*)(p.ws + WS_DS) + bh * 16; dstride = 1; } }
            Lp[e] = L;
#pragma unroll
            for (int sc = 0; sc < 16; ++sc) { lv[e][sc] = ok[e] ? L[(size_t)sc * 8192] : 0.f; dv[e][sc] = (ok[e] && dec) ? dec[sc * dstride] : cdec; } }
#pragma unroll
        for (int e = 0; e < 2; ++e) { float prev = 0.f;
#pragma unroll
            for (int sc = 0; sc < 16; ++sc) { if (ok[e] && !dry) Lp[e][(size_t)sc * 8192] = prev; prev = dv[e][sc] * prev + lv[e][sc]; } }
    }
}

DI void memkv_item(const Params& p, int l, int item) {
    const int tid = opaque_tid(), lane = tid & 63, w = tid >> 6, q4 = lane >> 4, l15 = lane & 15;
    const int rb = item >> 4, cb = item & 15;
    const bf16* A = (const bf16*)(p.ws + WS_MEMN) + (size_t)l * 1024 * 1024; const bf16* Bw = (const bf16*)(p.ws + WS_WKVT);
    const int r0 = 64 * rb + 16 * (w >> 1), c0 = 32 * cb + 16 * (w & 1); const bool isV = cb >= 8; const int hh = (c0 >> 6) & 3, dd = c0 & 63;
    f32x4 acc = (f32x4){0.f, 0.f, 0.f, 0.f};
#pragma unroll 1
    for (int k16 = 0; k16 < 32; k16 += 16) {
        bf16x8 fa[16], fb[16];
#pragma unroll
        for (int u = 0; u < 16; ++u) { fa[u] = frag(A, 1024, r0, 32 * (k16 + u), lane); fb[u] = frag(Bw, 1024, c0, 32 * (k16 + u), lane); }
#pragma unroll
        for (int u = 0; u < 16; ++u) acc = isV ? mfma16(fa[u], fb[u], acc) : mfma16(fb[u], fa[u], acc);
    }
    if (!isV) { const int m = r0 + l15, bb = m >> 8, mm = m & 255;
        *(u32x2*)((bf16*)(p.ws + WS_KM) + ((size_t)(bb * 4 + hh) * 256 + mm) * 64 + dd + 4 * q4) = pack4(acc); }
    else { const int m = r0 + 4 * q4, bb = m >> 8, mm = m & 255;
        *(u32x2*)((bf16*)(p.ws + WS_VMT) + ((size_t)(bb * 4 + hh) * 64 + dd + l15) * 256 + mm) = pack4(acc); }
}
constexpr int MA_K = 0, MA_VT = 36864;
DI void memattn_item(const Params& p, unsigned char* lds, int b, int h, int blk) {
    const int tid = opaque_tid(), lane = tid & 63, w = tid >> 6, q4 = lane >> 4, l15 = lane & 15;
    bf16* KS = (bf16*)(lds + MA_K); bf16* VS = (bf16*)(lds + MA_VT);
    const bf16* KM = (const bf16*)(p.ws + WS_KM) + (size_t)(b * 4 + h) * 256 * 64; const bf16* VM = (const bf16*)(p.ws + WS_VMT) + (size_t)(b * 4 + h) * 64 * 256;
    const bf16* P = (const bf16*)(p.ws + WS_P); bf16* OM = (bf16*)(p.ws + WS_OMEM);
#pragma unroll
    for (int r = 0; r < 4; ++r) { const int idx = tid + 512 * r;
        { const int m = idx >> 3, c8 = idx & 7; *(u32x4*)(KS + m * 72 + 8 * c8) = *(const u32x4*)(KM + m * 64 + 8 * c8); }
        { const int d = idx >> 5, c8 = idx & 31; *(u32x4*)(VS + d * 264 + 8 * c8) = *(const u32x4*)(VM + d * 256 + 8 * c8); } }
    __syncthreads();
    bf16x8 qn[2];
#pragma unroll
    for (int kk = 0; kk < 2; ++kk) qn[kk] = *(const bf16x8*)(P + (size_t)(b * T + blk * 256 + w * 16 + l15) * LDP + C_MQ + h * 64 + 32 * kk + 8 * q4);
    for (int rnd = 0; rnd < 2; ++rnd) {
        const int m0 = b * T + blk * 256 + rnd * 128 + w * 16;
        bf16x8 qf[2];
#pragma unroll
        for (int kk = 0; kk < 2; ++kk) { qf[kk] = qn[kk]; if (rnd == 0) qn[kk] = *(const bf16x8*)(P + (size_t)(m0 + 128 + l15) * LDP + C_MQ + h * 64 + 32 * kk + 8 * q4); }
        f32x4 s[16]; float mx = -3.0e38f;
#pragma unroll
        for (int mt = 0; mt < 16; ++mt) { s[mt] = (f32x4){0.f, 0.f, 0.f, 0.f};
#pragma unroll
            for (int kk = 0; kk < 2; ++kk) s[mt] = mfma16(frag(KS, 72, 16 * mt, 32 * kk, lane), qf[kk], s[mt]);
            s[mt] = s[mt] * 0.125f; mx = fmaxf(mx, fmaxf(fmaxf(s[mt][0], s[mt][1]), fmaxf(s[mt][2], s[mt][3]))); __builtin_amdgcn_sched_barrier(0); }
        mx = fmaxf(mx, __shfl_xor(mx, 16)); mx = fmaxf(mx, __shfl_xor(mx, 32));
        float sum = 0.f;
#pragma unroll
        for (int mt = 0; mt < 16; ++mt) {
#pragma unroll
            for (int j = 0; j < 4; ++j) { s[mt][j] = fexp(s[mt][j] - mx); sum += s[mt][j]; } }
        sum += __shfl_xor(sum, 16); sum += __shfl_xor(sum, 32);
        const float rs = __builtin_amdgcn_rcpf(sum);
        f32x4 o[4];
#pragma unroll
        for (int dt = 0; dt < 4; ++dt) o[dt] = (f32x4){0.f, 0.f, 0.f, 0.f};
#pragma unroll
        for (int k2 = 0; k2 < 8; ++k2) {
            u32x4 pw; pw.x = pk2(s[2 * k2][0], s[2 * k2][1]); pw.y = pk2(s[2 * k2][2], s[2 * k2][3]); pw.z = pk2(s[2 * k2 + 1][0], s[2 * k2 + 1][1]); pw.w = pk2(s[2 * k2 + 1][2], s[2 * k2 + 1][3]);
            const bf16x8 pf = __builtin_bit_cast(bf16x8, pw);
#pragma unroll
            for (int dt = 0; dt < 4; ++dt) { const bf16* vp = VS + (16 * dt + l15) * 264 + 32 * k2 + 4 * q4;
                const u32x2 v0 = *(const u32x2*)vp, v1 = *(const u32x2*)(vp + 16); u32x4 vw; vw.x = v0.x; vw.y = v0.y; vw.z = v1.x; vw.w = v1.y;
                o[dt] = mfma16(__builtin_bit_cast(bf16x8, vw), pf, o[dt]); }
            __builtin_amdgcn_sched_barrier(0); }
#pragma unroll
        for (int dt = 0; dt < 4; ++dt) *(u32x2*)(OM + (size_t)(m0 + l15) * 256 + h * 64 + 16 * dt + 4 * q4) = pack4(o[dt] * rs);
    }
    __syncthreads();
}

constexpr int RC_ARL = 0, RC_RRL = 9216, RC_BRL = 18432, RC_KRL = 27648, RC_XT = 0, RC_BHT = 36864, RC_KHT = 46080, RC_VT = 55296, RC_AAK = 64512, RC_LRB = 73728, RC_LRK = 82944,
              RC_AAB = 92160, RC_RHS = 108544, RC_WLAST = 141312, RC_TB = 141568,
              RC_TW = 64512, RC_ALS = 73728, RC_W2T = 82944, RC_A2T = 92160, RC_TOT = 101376, RC_CUM = 108544, RC_AICL = 124928;
#if defined(TPROBE) && !defined(QTS_SEL)
#define RW_STOP_AT(k) TS_MARK(k)
#define RW_TS_BEGIN() TS_BEGIN()
#define RW_TS_END() TS_MARK(7)
#else
#define RW_TS_BEGIN() do {} while (0)
#define RW_TS_END() do {} while (0)
#ifdef RW_STOP
#define RW_STOP_AT(k) do { if (dry && RW_STOP == (k)) return; } while (0)
#else
#define RW_STOP_AT(k) do {} while (0)
#endif
#endif
DI void rwkv_chunk_item(const Params& p, int l, unsigned char* lds, int b, int h, int c, bool dry = false) {
    const int tid = opaque_tid(), lane = tid & 63, w = tid >> 6, q4 = lane >> 4, l15 = lane & 15;
    bf16* P = (bf16*)(p.ws + WS_P);
    bf16* ARL = (bf16*)(lds + RC_ARL); bf16* RRL = (bf16*)(lds + RC_RRL); bf16* BRL = (bf16*)(lds + RC_BRL); bf16* KRL = (bf16*)(lds + RC_KRL); bf16* XT = (bf16*)(lds + RC_XT);
    bf16* BHT = (bf16*)(lds + RC_BHT); bf16* KHT = (bf16*)(lds + RC_KHT); bf16* VT = (bf16*)(lds + RC_VT); bf16* AAK = (bf16*)(lds + RC_AAK); bf16* LRB = (bf16*)(lds + RC_LRB); bf16* LRK = (bf16*)(lds + RC_LRK);
    float* AAB = (float*)(lds + RC_AAB); float* RHS = (float*)(lds + RC_RHS); float* WLAST = (float*)(lds + RC_WLAST); float* TB = (float*)(lds + RC_TB);
    bf16* TW = (bf16*)(lds + RC_TW); bf16* ALS = (bf16*)(lds + RC_ALS); bf16* W2T = (bf16*)(lds + RC_W2T); bf16* A2T = (bf16*)(lds + RC_A2T);
    float* TOT = (float*)(lds + RC_TOT); float* CUM = (float*)(lds + RC_CUM); float* AICL = (float*)(lds + RC_AICL);
    const float* mu = p.in[I_MU] + l * 1664;
    const int t0 = c * 64, m0 = b * T + t0;
    RW_TS_BEGIN();
    const int t_ = tid >> 3, cg = tid & 7, chh = h * 64 + 8 * cg;
    float xr[8], xk[8], xv[8];
    float pkk[8], pka[8], prk[8];
    { const f32x4 a0 = *(const f32x4*)(p.in[I_KK] + l * 512 + chh), a1 = *(const f32x4*)(p.in[I_KK] + l * 512 + chh + 4), b0 = *(const f32x4*)(p.in[I_KA] + l * 512 + chh), b1 = *(const f32x4*)(p.in[I_KA] + l * 512 + chh + 4),
          c0 = *(const f32x4*)(p.in[I_RK] + l * 512 + chh), c1 = *(const f32x4*)(p.in[I_RK] + l * 512 + chh + 4);
#pragma unroll
      for (int i = 0; i < 4; ++i) { pkk[i] = a0[i]; pkk[4 + i] = a1[i]; pka[i] = b0[i]; pka[4 + i] = b1[i]; prk[i] = c0[i]; prk[4 + i] = c1[i]; } }
    f32x4 pw0[4];
#pragma unroll
    for (int ct = 0; ct < 4; ++ct) pw0[ct] = *(const f32x4*)(p.in[(w >> 2) ? I_A0 : I_W0] + l * 512 + h * 64 + 16 * ct + 4 * q4);
    {
        { const int j = tid >> 3;
            const float* s2 = p.in[I_W2] + (size_t)l * 64 * 512 + j * 512 + chh; const float* sa = p.in[I_A2] + (size_t)l * 64 * 512 + j * 512 + chh;
#pragma unroll
            for (int i = 0; i < 8; ++i) { }
            *(u32x4*)(W2T + j * 72 + 8 * cg) = pack8(s2); *(u32x4*)(A2T + j * 72 + 8 * cg) = pack8(sa); }
        const size_t ro = (size_t)(m0 + t_) * LDP; const bool first = (t_ == 0);
        const bf16* prow = first ? (bf16*)(p.ws + WS_BND) + (size_t)(((m0) >> 6) - 1) * BND_W - 4608 : P + ro - LDP;
        const bool hp = (t0 + t_) > 0;
#pragma unroll
        for (int which = 0; which < 5; ++which) {
            const int col = which == 0 ? C_WR + chh : which == 1 ? C_WK + chh : which == 2 ? C_WV + chh : which == 3 ? C_WL + 8 * cg : C_AL + 8 * cg;
            const int mi = which == 0 ? chh : which == 1 ? 512 + chh : which == 2 ? 1024 + chh : which == 3 ? 1536 + 8 * cg : 1600 + 8 * cg;
            float cur[8], prv[8], xs[8];
            unpack8(*(const u32x4*)(P + ro + col), cur);
            unpack8(*(const u32x4*)((hp ? prow : P + ro) + col), prv);
            if (!hp) {
#pragma unroll
                for (int i = 0; i < 8; ++i) prv[i] = 0.f; }
#pragma unroll
            for (int i = 0; i < 8; ++i) xs[i] = cur[i] + (prv[i] - cur[i]) * mu[mi + i];
            if (which == 0) {
#pragma unroll
                for (int i = 0; i < 8; ++i) xr[i] = xs[i]; }
            else if (which == 1) {
#pragma unroll
                for (int i = 0; i < 8; ++i) xk[i] = xs[i]; }
            else if (which == 2) {
#pragma unroll
                for (int i = 0; i < 8; ++i) xv[i] = xs[i]; }
            else if (which == 3) { float tw[8];
#pragma unroll
                for (int i = 0; i < 8; ++i) tw[i] = tanhf_(xs[i]);
                *(u32x4*)(TW + t_ * 72 + 8 * cg) = pack8(tw); }
            else *(u32x4*)(ALS + t_ * 72 + 8 * cg) = pack8(xs);
        }
    }
    __syncthreads();
    RW_STOP_AT(0);
    {
        const int which = w >> 2, tt = w & 3; const bf16* Wm = which ? A2T : W2T; const bf16* Xm = which ? ALS : TW;
#pragma unroll
        for (int ct = 0; ct < 4; ++ct) { f32x4 a = (f32x4){0.f, 0.f, 0.f, 0.f};
#pragma unroll
            for (int kk = 0; kk < 2; ++kk) a = mfma16(frag_tr(Wm, 72, 16 * ct, 32 * kk, lane), frag(Xm, 72, 16 * tt, 32 * kk, lane), a);
            const int ch = 16 * ct + 4 * q4, t = 16 * tt + l15; f32x4 o;
            if (which == 0) { const f32x4 w0 = pw0[ct];
#pragma unroll
                for (int j = 0; j < 4; ++j) o[j] = -0.60653065971f * sigmoidf_(w0[j] + a[j]);
                *(f32x4*)(CUM + t * 64 + ch) = o; }
            else { const f32x4 a0 = pw0[ct];
#pragma unroll
                for (int j = 0; j < 4; ++j) o[j] = sigmoidf_(a0[j] + a[j]);
                *(f32x4*)(AICL + t * 64 + ch) = o; }
        }
    }
    __syncthreads();
    RW_STOP_AT(1);
    {
        float cumv[8]; float run = 0.f;
#pragma unroll
        for (int i = 0; i < 8; ++i) { run += CUM[(8 * w + i) * 64 + lane]; cumv[i] = run; }
        TOT[w * 64 + lane] = run;
        __syncthreads();
        float off = 0.f;
        for (int ww = 0; ww < w; ++ww) off += TOT[ww * 64 + lane];
#pragma unroll
        for (int i = 0; i < 8; ++i) CUM[(8 * w + i) * 64 + lane] = cumv[i] + off;
    }
    __syncthreads();
    RW_STOP_AT(2);
    float aabs[8];
    {
        float kk[8], ai[8], ss = 0.f;
#pragma unroll
        for (int i = 0; i < 8; ++i) { ai[i] = AICL[t_ * 64 + 8 * cg + i]; kk[i] = xk[i] * pkk[i]; ss += kk[i] * kk[i]; }
        ss += __shfl_xor(ss, 1); ss += __shfl_xor(ss, 2); ss += __shfl_xor(ss, 4);
        const float inv = __builtin_amdgcn_rsqf(fmaxf(ss, 1e-24f));
        float bon = 0.f, o_arl[8], o_rrl[8], o_brl[8], o_krl[8], o_rabs[8], o_bh[8], o_kh[8];
#pragma unroll
        for (int i = 0; i < 8; ++i) {
            const float kn = kk[i] * inv, av = -kn, bv = kn * ai[i], km = xk[i] * (1.0f + (ai[i] - 1.0f) * pka[i]);
            bon += xr[i] * km * prk[i];
            const int k = 8 * cg + i;
            const float cu = CUM[t_ * 64 + k], cx = t_ > 0 ? CUM[(t_ - 1) * 64 + k] : 0.f, rf = CUM[32 * 64 + k], la = CUM[63 * 64 + k];
            o_arl[i] = av * fexp(cx - rf); aabs[i] = av * fexp(cx);
            o_rrl[i] = xr[i] * fexp(cu - rf); o_rabs[i] = xr[i] * fexp(cu);
            const float eb = fexp(rf - cu), eh = fexp(la - cu);
            o_brl[i] = bv * eb; o_krl[i] = km * eb;
            o_bh[i] = bv * eh; o_kh[i] = km * eh;
        }
        bon += __shfl_xor(bon, 1); bon += __shfl_xor(bon, 2); bon += __shfl_xor(bon, 4);
        *(u32x4*)(ARL + t_ * 72 + 8 * cg) = pack8(o_arl); *(u32x4*)(RRL + t_ * 72 + 8 * cg) = pack8(o_rrl);
        *(u32x4*)(BRL + t_ * 72 + 8 * cg) = pack8(o_brl); *(u32x4*)(KRL + t_ * 72 + 8 * cg) = pack8(o_krl);
        *(u32x4*)(BHT + t_ * 72 + 8 * cg) = pack8(o_bh); *(u32x4*)(KHT + t_ * 72 + 8 * cg) = pack8(o_kh); *(u32x4*)(VT + t_ * 72 + 8 * cg) = pack8(xv);
        const size_t ro = (size_t)(m0 + t_) * LDP;
        if (!dry) *(u32x4*)(P + ro + C_WR + chh) = pack8(o_rabs);
        float bvv[8];
#pragma unroll
        for (int i = 0; i < 8; ++i) bvv[i] = bon * xv[i];
        if (!dry) *(u32x4*)(P + ro + C_WV + chh) = pack8(bvv);
        if (tid < 64) WLAST[tid] = fexp(CUM[63 * 64 + tid]);
    }
    __syncthreads();
    RW_STOP_AT(3);
    *(f32x4*)(RHS + t_ * 128 + 8 * cg) = (f32x4){aabs[0], aabs[1], aabs[2], aabs[3]}; *(f32x4*)(RHS + t_ * 128 + 8 * cg + 4) = (f32x4){aabs[4], aabs[5], aabs[6], aabs[7]};
    {
        const int prod = w >> 1, half = w & 1; const bf16* Lm = (prod < 2) ? ARL : RRL; const bf16* Rm = (prod & 1) ? KRL : BRL; const int strict = prod < 2 ? 1 : 0;
#pragma unroll
        for (int i8 = 0; i8 < 8; ++i8) { const int id = half * 8 + i8, tt = id >> 2, st = id & 3;
            f32x4 a = (f32x4){0.f, 0.f, 0.f, 0.f};
            if (st <= tt) {
#pragma unroll
                for (int kk = 0; kk < 2; ++kk) a = mfma16(frag(Rm, 72, 16 * st, 32 * kk, lane), frag(Lm, 72, 16 * tt, 32 * kk, lane), a);
                if (st == tt) {
#pragma unroll
                    for (int j = 0; j < 4; ++j) if (4 * q4 + j + strict > l15) a[j] = 0.f; }
            }
            if (prod == 0) *(f32x4*)(AAB + (16 * tt + l15) * 64 + 16 * st + 4 * q4) = a;
            else { bf16* O = prod == 1 ? AAK : prod == 2 ? LRB : LRK; *(u32x2*)(O + (16 * tt + l15) * 72 + 16 * st + 4 * q4) = pack4(a); }
        }
        if (prod == 0) {
            asm volatile("s_waitcnt lgkmcnt(0)" ::: "memory");
            const int bb = 2 * half + ((lane >> 4) & 1), cc = lane & 15; float x[16];
#pragma unroll
            for (int i = 0; i < 16; ++i) { float s0 = (i == cc) ? 1.0f : 0.0f;
#pragma unroll
                for (int s4 = 0; s4 < (i + 3) / 4; ++s4) { const f32x4 av = *(const f32x4*)(AAB + (16 * bb + i) * 64 + 16 * bb + 4 * s4);
#pragma unroll
                    for (int n = 0; n < 4; ++n) if (4 * s4 + n < i) s0 += av[n] * x[4 * s4 + n]; }
                x[i] = s0; if (lane < 32) TB[(bb * 16 + i) * 16 + cc] = s0; }
        }
    }
    __syncthreads();
    RW_STOP_AT(4);
    {
        f32x4 X[4];
#pragma unroll
        for (int bb = 0; bb < 4; ++bb) {
            f32x4 acc;
            if (w < 4) {
#pragma unroll
                for (int j = 0; j < 4; ++j) acc[j] = RHS[(16 * bb + 4 * q4 + j) * 128 + 16 * w + l15]; }
            else {
                acc = (f32x4){0.f, 0.f, 0.f, 0.f};
#pragma unroll
                for (int kk = 0; kk < 2; ++kk) acc = mfma16(frag(AAK, 72, 16 * bb, 32 * kk, lane), frag_tr(VT, 72, 16 * (w - 4), 32 * kk, lane), acc); }
#pragma unroll
            for (int bp = 0; bp < bb; ++bp) { const f32x4 a4 = *(const f32x4*)(AAB + (16 * bb + l15) * 64 + 16 * bp + 4 * q4);
#pragma unroll
                for (int j = 0; j < 4; ++j) acc = __builtin_amdgcn_mfma_f32_16x16x4f32(a4[j], X[bp][j], acc, 0, 0, 0); }
            const f32x4 t4 = *(const f32x4*)(TB + (bb * 16 + l15) * 16 + 4 * q4);
            f32x4 xb = (f32x4){0.f, 0.f, 0.f, 0.f};
#pragma unroll
            for (int j = 0; j < 4; ++j) xb = __builtin_amdgcn_mfma_f32_16x16x4f32(t4[j], acc[j], xb, 0, 0, 0);
            X[bb] = xb;
            *(u32x2*)(XT + (16 * w + l15) * 72 + 16 * bb + 4 * q4) = pack4(xb);
        }
    }
    __syncthreads();
    RW_STOP_AT(6);
    {
        const int prod = w >> 1, half = w & 1;
        bf16* GH = (bf16*)(p.ws + WS_RWGH) + ((size_t)((b * 8 + h) * 64 + c) * 2) * 4096;
#pragma unroll
        for (int i8 = 0; i8 < 8; ++i8) { const int id = half * 8 + i8, rt = id >> 2, ct = id & 3;
            f32x4 a = (f32x4){0.f, 0.f, 0.f, 0.f};
            if (prod == 0) {
#pragma unroll
                for (int kk = 0; kk < 2; ++kk) a = mfma16(frag(XT, 72, 16 * ct, 32 * kk, lane), frag(LRB, 72, 16 * rt, 32 * kk, lane), a);
                bf16* qp = P + (size_t)(m0 + 16 * rt + l15) * LDP + C_WR + h * 64 + 16 * ct + 4 * q4;
                const u32x2 r2 = *(const u32x2*)qp; a[0] += lo16(r2.x); a[1] += hi16(r2.x); a[2] += lo16(r2.y); a[3] += hi16(r2.y);
                if (!dry) *(u32x2*)qp = pack4(a);
            } else if (prod == 1) {
#pragma unroll
                for (int kk = 0; kk < 2; ++kk) a = mfma16(frag(XT, 72, 64 + 16 * ct, 32 * kk, lane), frag(LRB, 72, 16 * rt, 32 * kk, lane), a);
#pragma unroll
                for (int kk = 0; kk < 2; ++kk) a = mfma16(frag_tr(VT, 72, 16 * ct, 32 * kk, lane), frag(LRK, 72, 16 * rt, 32 * kk, lane), a);
                if (!dry) *(u32x2*)(P + (size_t)(m0 + 16 * rt + l15) * LDP + C_WK + h * 64 + 16 * ct + 4 * q4) = pack4(a);
            } else if (prod == 2) {
#pragma unroll
                for (int kk = 0; kk < 2; ++kk) a = mfma16(frag(XT, 72, 16 * ct, 32 * kk, lane), frag_tr(BHT, 72, 16 * rt, 32 * kk, lane), a);
                if (rt == ct) { const float wl = WLAST[16 * rt + l15];
#pragma unroll
                    for (int j = 0; j < 4; ++j) if (4 * q4 + j == l15) a[j] += wl; }
                *(u32x2*)(GH + (16 * rt + l15) * 64 + 16 * ct + 4 * q4) = pack4(a);
            } else {
#pragma unroll
                for (int kk = 0; kk < 2; ++kk) a = mfma16(frag_tr(BHT, 72, 16 * ct, 32 * kk, lane), frag(XT, 72, 64 + 16 * rt, 32 * kk, lane), a);
#pragma unroll
                for (int kk = 0; kk < 2; ++kk) a = mfma16(frag_tr(KHT, 72, 16 * ct, 32 * kk, lane), frag_tr(VT, 72, 16 * rt, 32 * kk, lane), a);
                *(u32x2*)(GH + 4096 + (16 * rt + l15) * 64 + 16 * ct + 4 * q4) = pack4(a);
            }
        }
    }
    __syncthreads();
    RW_TS_END();
}
DI void rwkv_scan_chain(const Params& p, unsigned char* lds, int bh, bool dry = false) {
    const int tid = opaque_tid(), lane = tid & 63, w = tid >> 6, q4 = lane >> 4, l15 = lane & 15;
    bf16* ZB = (bf16*)lds;
    bf16* GH = (bf16*)(p.ws + WS_RWGH) + (size_t)bh * 64 * 2 * 4096;
    const int vt = w & 3, kh = w >> 2;
    u32x2 zp[2];
#pragma unroll
    for (int i = 0; i < 2; ++i) { zp[i] = (u32x2){0u, 0u}; *(u32x2*)(ZB + (16 * vt + l15) * 72 + 16 * (2 * kh + i) + 4 * q4) = zp[i]; }
    bf16x8 gf[4][2][2]; u32x2 hv[4][2];
#define RW_LOAD(slot, cc) do { const bf16* G_ = GH + (size_t)(cc) * 2 * 4096; _Pragma("unroll") for (int i = 0; i < 2; ++i) { const int kt = 2 * kh + i; \
        _Pragma("unroll") for (int kk = 0; kk < 2; ++kk) gf[slot][i][kk] = frag(G_, 64, 16 * kt, 32 * kk, lane); \
        hv[slot][i] = *(const u32x2*)(G_ + 4096 + (16 * vt + l15) * 64 + 16 * kt + 4 * q4); } } while (0)
    RW_LOAD(0, 0); RW_LOAD(1, 1); RW_LOAD(2, 2); RW_LOAD(3, 3);
    __syncthreads();
    for (int c4 = 0; c4 < 64; c4 += 4) {
#pragma unroll
        for (int u = 0; u < 4; ++u) { const int c = c4 + u;
            bf16* HT = GH + (size_t)c * 2 * 4096 + 4096;
            const bf16* Zc = ZB + (c & 1) * 64 * 72; bf16* Zn = ZB + ((c + 1) & 1) * 64 * 72;
#pragma unroll
            for (int i = 0; i < 2; ++i) { const int kt = 2 * kh + i;
                f32x4 a = (f32x4){lo16(hv[u][i].x), hi16(hv[u][i].x), lo16(hv[u][i].y), hi16(hv[u][i].y)};
                if (!dry) *(u32x2*)(HT + (16 * vt + l15) * 64 + 16 * kt + 4 * q4) = zp[i];
#pragma unroll
                for (int kk = 0; kk < 2; ++kk) a = mfma16(gf[u][i][kk], frag(Zc, 72, 16 * vt, 32 * kk, lane), a);
                zp[i] = pack4(a);
                *(u32x2*)(Zn + (16 * vt + l15) * 72 + 16 * kt + 4 * q4) = zp[i]; }
            { const int cn = c + 4 < 64 ? c + 4 : 63; RW_LOAD(u, cn); }
            __syncthreads();
        }
    }
#undef RW_LOAD
}
DI void rwkv_out_item(const Params& p, int l, int bh, int pair, bool dry = false) {
    const int tid = opaque_tid(), lane = tid & 63, w = tid >> 6, q4 = lane >> 4, l15 = lane & 15;
    bf16* P = (bf16*)(p.ws + WS_P);
    const int b = bh >> 3, h = bh & 7, c = 2 * pair + (w >> 2), m = b * T + c * 64 + 16 * (w & 3) + l15;
    const bf16* ZT = (const bf16*)(p.ws + WS_RWGH) + ((size_t)(bh * 64 + c) * 2 + 1) * 4096;
    const size_t ro = (size_t)m * LDP;
    bf16x8 qf[2], zf[4][2]; u32x2 yl[4], bv[4], g2[4]; f32x4 lg[4], lb[4];
#pragma unroll
    for (int kk = 0; kk < 2; ++kk) qf[kk] = *(const bf16x8*)(P + ro + C_WR + h * 64 + 32 * kk + 8 * q4);
#pragma unroll
    for (int vt = 0; vt < 4; ++vt) { yl[vt] = *(const u32x2*)(P + ro + C_WK + h * 64 + 16 * vt + 4 * q4);
#pragma unroll
        for (int kk = 0; kk < 2; ++kk) zf[vt][kk] = frag(ZT, 64, 16 * vt, 32 * kk, lane); }
#pragma unroll
    for (int vt = 0; vt < 4; ++vt) { const int ch = h * 64 + 16 * vt + 4 * q4;
        bv[vt] = *(const u32x2*)(P + ro + C_WV + ch); g2[vt] = *(const u32x2*)(P + ro + C_WG + ch);
        lg[vt] = *(const f32x4*)(p.in[I_LNG] + l * 512 + ch); lb[vt] = *(const f32x4*)(p.in[I_LNB] + l * 512 + ch); }
    f32x4 y[4]; float s = 0.f;
#pragma unroll
    for (int vt = 0; vt < 4; ++vt) {
        y[vt] = (f32x4){lo16(yl[vt].x), hi16(yl[vt].x), lo16(yl[vt].y), hi16(yl[vt].y)};
#pragma unroll
        for (int kk = 0; kk < 2; ++kk) y[vt] = mfma16(zf[vt][kk], qf[kk], y[vt]);
        s += (y[vt][0] + y[vt][1]) + (y[vt][2] + y[vt][3]); }
    s += __shfl_xor(s, 16); s += __shfl_xor(s, 32);
    const float mean = s * (1.0f / 64.0f); float vr = 0.f;
#pragma unroll
    for (int vt = 0; vt < 4; ++vt) { y[vt] = y[vt] - mean; vr += (y[vt][0] * y[vt][0] + y[vt][1] * y[vt][1]) + (y[vt][2] * y[vt][2] + y[vt][3] * y[vt][3]); }
    vr += __shfl_xor(vr, 16); vr += __shfl_xor(vr, 32);
    const float rstd = __builtin_amdgcn_rsqf(vr * (1.0f / 64.0f) + 64e-5f);
#pragma unroll
    for (int vt = 0; vt < 4; ++vt) { const int ch = h * 64 + 16 * vt + 4 * q4; bf16* gp = P + ro + C_WG + ch;
        const float bvf[4] = {lo16(bv[vt].x), hi16(bv[vt].x), lo16(bv[vt].y), hi16(bv[vt].y)}, g[4] = {lo16(g2[vt].x), hi16(g2[vt].x), lo16(g2[vt].y), hi16(g2[vt].y)};
        f32x4 o;
#pragma unroll
        for (int j = 0; j < 4; ++j) o[j] = (y[vt][j] * rstd * lg[vt][j] + lb[vt][j] + bvf[j]) * siluf_(g[j]);
        if (!dry) *(u32x2*)gp = pack4(o); }
}

DI void phase_A(const Params& p, int l, unsigned char* lds, bool dry = false) {
    const int G = gridDim.x, bid = blockIdx.x;
#ifndef DUP_AMASK
#define DUP_AMASK 0xff
#endif
    for (int it = bid; it < 3328; it += G) {
        if (dry) { const int ty = it < 2048 ? 1 : it < 2560 ? 2 : it < 2816 ? 4 : it < 3072 ? 8 : 16; if (!(DUP_AMASK & ty)) continue; }
        if (it < 2048) rwkv_chunk_item(p, l, lds, it >> 9, (it >> 6) & 7, it & 63, dry);
        else if (it < 2560) { const int i = it - 2048; ssd_item(p, l, lds, i >> 7, (i >> 4) & 7, i & 15, false); }
        else if (it < 2816) { const int i = it - 2560; qkv_item<false>(p, l, lds, i >> 6, (i >> 4) & 3, i & 15, false); }
        else if (it < 3072) { const int i = it - 2816; qkv_item<true>(p, l, lds, i >> 6, (i >> 4) & 3, i & 15, false); }
        else memkv_item(p, l, it - 3072);
    }
}
DI void phase_B(const Params& p, unsigned char* lds, bool dry = false) {
    (void)lds; phase_scan(p, blockIdx.x, gridDim.x, dry);
}
DI void rwkv_flag_publish(unsigned* flag) {
    asm volatile("s_waitcnt vmcnt(0)" ::: "memory"); __syncthreads();
    if (threadIdx.x == 0) { __builtin_amdgcn_fence(__ATOMIC_RELEASE, "agent"); asm volatile("s_waitcnt vmcnt(0)" ::: "memory"); __hip_atomic_store(flag, 1u, __ATOMIC_RELAXED, __HIP_MEMORY_SCOPE_AGENT); }
}
DI void rwkv_flag_wait(unsigned* flag) {
    if (threadIdx.x == 0) { unsigned spins = 0;
        while (__hip_atomic_load(flag, __ATOMIC_RELAXED, __HIP_MEMORY_SCOPE_AGENT) == 0u) { __builtin_amdgcn_s_sleep(8); if (++spins > (1u << 22)) break; }
        __builtin_amdgcn_fence(__ATOMIC_ACQUIRE, "agent"); asm volatile("s_waitcnt vmcnt(0)" ::: "memory"); }
    __syncthreads();
}
DI void phase_C(const Params& p, int l, unsigned char* lds, bool dry = false) {
    const int G = gridDim.x, bid = blockIdx.x;
    unsigned* flags = (unsigned*)(p.ws + WS_BAR + 14336) + (dry ? 128 : 0) + l * 32;
    for (int bh = bid; bh < 32; bh += G) { rwkv_scan_chain(p, lds, bh, dry); rwkv_flag_publish(flags + bh); }
    unsigned have = 0u;
#define C_SSD(it)  ssd_item(p, l, lds, (it) >> 7, ((it) >> 4) & 7, (it) & 15, true, dry)
#define C_RET(it)  qkv_item<false>(p, l, lds, (it) >> 6, ((it) >> 4) & 3, (it) & 15, true, dry)
#define C_GLA(it)  qkv_item<true>(p, l, lds, (it) >> 6, ((it) >> 4) & 3, (it) & 15, true, dry)
#define C_MEM(it)  memattn_item(p, lds, (it) >> 6, ((it) >> 4) & 3, (it) & 15)
#define C_RWO(it)  do { const int bh_ = (it) >> 5; if (!((have >> bh_) & 1u)) { rwkv_flag_wait(flags + bh_); have |= 1u << bh_; } rwkv_out_item(p, l, bh_, (it) & 31, dry); } while (0)
    const int nslot = (G == 256) ? 16 : (2304 + G - 1) / G;
    for (int k = 0; k < nslot; ++k) {
        int it = -1;
        if (G == 256) {
            if (bid < 32) { it = k == 0 ? bid : (k >= 1 && k <= 4) ? 1280 + 4 * bid + (k - 1) : -1; }
            else { const int j = bid - 32;
                if (k == 0) it = 32 + j; else if (k == 1) it = 256 + j; else if (k == 2) it = (j < 32) ? 480 + j : -1;
                else if (k == 3) it = 768 + 32 + j; else if (k == 4) it = (j >= 32 && j < 64) ? 768 + (j - 32) : -1;
                else if (k == 5) it = 512 + 32 + j; else if (k == 6) it = (j >= 64 && j < 96) ? 512 + (j - 64) : -1;
                else if (k == 7) it = 1024 + j; else if (k == 8) it = (j >= 96 && j < 128) ? 1024 + 224 + (j - 96) : -1;
                else { const int m = k - 9; int r = -1;
                    if (j < 32) r = -1; else if (j < 64) r = m < 1 ? 128 + (j - 32) : -1; else if (j < 96) r = m < 2 ? 160 + 2 * (j - 64) + m : -1;
                    else if (j < 128) r = m < 5 ? 224 + 5 * (j - 96) + m : -1; else if (j < 192) r = m < 7 ? 384 + 7 * (j - 128) + m : -1; else r = m < 6 ? 832 + 6 * (j - 192) + m : -1;
                    it = r >= 0 ? 1280 + r : -1; } }
        } else { it = bid + k * G; if (it >= 2304) it = -1; }
        if (it < 0) continue;
        if (it < 512) C_SSD(it); else if (it < 768) C_RET(it - 512); else if (it < 1024) C_GLA(it - 768); else if (it < 1280) C_MEM(it - 1024); else C_RWO(it - 1280);
    }
#undef C_SSD
#undef C_RET
#undef C_GLA
#undef C_MEM
#undef C_RWO
}
typedef PG8_LAS unsigned char* lds3_t;
DI void phase_P1(const Params& p, int l, unsigned char* lds) {
    pg8::Gemm g{1024, 1024};
    SchedP1 S{(int)gridDim.x, (int)blockIdx.x, (const char*)p.ws + WS_XN, (const char*)p.ws + WS_W1T};
    EpiP E{(bf16*)(p.ws + WS_P), (bf16*)(p.ws + WS_BND)};
    pg8::gemm_phase<EpiP, SchedP1, true, true>((lds3_t)lds, g, S, E);
}
DI void phase_P3(const Params& p, int l, unsigned char* lds) {
    (void)l;
    for (int L = blockIdx.x; L < 256; L += gridDim.x) {
        int pm, pn; tile_map(L, 64, 4, pm, pn);
        pg8::Gemm g{0, 0}; SchedP3 S{pm, pn, p.ws, (int)((blockIdx.x >> 3) & 3)};
        EpiP3 E{EpiGate{(bf16*)(p.ws + WS_P)}, EpiBranch{(const bf16*)(p.ws + WS_P), (bf16*)(p.ws + WS_MRG), (const float*)(p.ws + WS_SSQ)}};
        pg8::gemm_phase<EpiP3, SchedP3, true, true>((lds3_t)lds, g, S, E);
    }
}
DI void phase_P4(const Params& p, int l, unsigned char* lds) {
    pg8::Gemm g{1024, 1024};
    SchedP4 S{(int)gridDim.x, (int)blockIdx.x, (const char*)p.ws + WS_MRG, (const char*)p.ws + WS_WOT};
    if (gridDim.x == 256) {
        float* xs = (float*)(p.ws + WS_XS) + (size_t)l * 64 * 256 * 4; unsigned* cnt = (unsigned*)(p.ws + WS_XCNT) + l * 64 * 64;
        if (l == 0) { EpiNorm<false> E{p.in[I_X], p.out, p.in[I_NORMG] + 1024, (bf16*)(p.ws + WS_XN), xs, cnt}; pg8::gemm_phase<EpiNorm<false>, SchedP4, true, true>((lds3_t)lds, g, S, E); }
        else { EpiNorm<true> E{p.out, p.out, p.in[I_FNORMG], nullptr, xs, cnt}; pg8::gemm_phase<EpiNorm<true>, SchedP4, true, true>((lds3_t)lds, g, S, E); }
    } else { EpiRes E{l == 0 ? p.in[I_X] : p.out, p.out}; pg8::gemm_phase<EpiRes, SchedP4, true, true>((lds3_t)lds, g, S, E); }
}
DI void phase_post(const Params& p, int l, unsigned char* lds) {
    if (gridDim.x == 256) { if (l == 0) convert_weights(p, 1, lds); }
    else phase_norm(p, l, 1.0f, lds);
}

#ifndef MK_LAUNCHES
#define MK_LAUNCHES 1
#endif
struct KArgs { Params p; int lo, hi; };
constexpr int N_PHASES = 15;
#ifdef NVGPR
__global__ void __launch_bounds__(NTHREADS, 2) __attribute__((amdgpu_num_vgpr(NVGPR))) fwd_kernel(KArgs a) {
#else
__global__ void __launch_bounds__(NTHREADS, 2) fwd_kernel(KArgs a) {
#endif
    extern __shared__ __attribute__((aligned(16))) unsigned char lds[];
    cg::grid_group grid = cg::this_grid();
    const Params& p = a.p;
    volatile unsigned* bst = (volatile unsigned*)(lds + LDS_BYTES - 64);
    if (threadIdx.x < 16) bst[threadIdx.x] = 0u;
    __syncthreads();
    XcdBarrier xbar = xcd_barrier_post((unsigned*)(p.ws + WS_BAR), bst);
    if (a.hi == 12345) grid.sync();
#define GRID_SYNC() xcd_barrier(xbar)
#ifndef DUP_N
#define DUP_N 1
#endif
#ifndef PHMASK
#define PHMASK 0xff
#endif
#if defined(TPROBE) && defined(PH_PROBE)
#define PH_TS_BEGIN() do { if (threadIdx.x == 0) TS_BASE(lds)[13] = (unsigned)__builtin_amdgcn_s_memrealtime(); } while (0)
#define PH_TS_MARK(k) do { __syncthreads(); if (threadIdx.x == 0) { const unsigned t_ = (unsigned)__builtin_amdgcn_s_memrealtime(); volatile unsigned* A_ = TS_BASE(lds); A_[k] += t_ - A_[13]; A_[13] = t_; } } while (0)
#else
#define PH_TS_BEGIN() do {} while (0)
#define PH_TS_MARK(k) do {} while (0)
#endif
#ifdef DUP_S
#define NREP(ty, l) (((ty) == DUP_S && !(((ty) == 6 || (ty) == 7) && (l) != 0)) ? 1 + DUP_N : 1)
#else
#define NREP(ty, l) 1
#endif
#define RUN_PHASE(ty, l, more) do { const int nrep = NREP(ty, l); \
        for (int rep = 0; rep < nrep; ++rep) { const bool dry = (rep + 1 < nrep) && (a.hi != 12345); (void)dry; PH_TS_BEGIN(); \
            if (!((PHMASK >> (ty)) & 1)) {} \
            else if ((ty) == 0) phase_prologue(p, lds); \
            else if ((ty) == 1) phase_P1(p, l, lds); \
            else if ((ty) == 2) phase_A(p, l, lds, dry); \
            else if ((ty) == 3) phase_B(p, lds, dry); \
            else if ((ty) == 4) phase_C(p, l, lds, dry); \
            else if ((ty) == 5) phase_P3(p, l, lds); \
            else if ((ty) == 6) phase_P4(p, l, lds); \
            else phase_post(p, l, lds); \
            PH_TS_MARK(ty); \
            if ((more) || rep + 1 < nrep) GRID_SYNC(); } } while (0)
#if MK_LAUNCHES == 1
#if defined(DUP_S) && DUP_S == 100
    for (int rep = 0; rep < DUP_N; ++rep) GRID_SYNC();
#endif
    RUN_PHASE(0, 0, true);
    RUN_PHASE(1, 0, true); RUN_PHASE(2, 0, true); RUN_PHASE(3, 0, true); RUN_PHASE(4, 0, true); RUN_PHASE(5, 0, true); RUN_PHASE(6, 0, true); RUN_PHASE(7, 0, true);
    RUN_PHASE(1, 1, true); RUN_PHASE(2, 1, true); RUN_PHASE(3, 1, true); RUN_PHASE(4, 1, true); RUN_PHASE(5, 1, true); RUN_PHASE(6, 1, gridDim.x != 256); RUN_PHASE(7, 1, false);
#ifdef TPROBE
    {
        GRID_SYNC();
        unsigned* pw = (unsigned*)(p.ws + WS_XS + 600 * 1024);
        if (threadIdx.x == 0) pw[blockIdx.x] = TS_BASE(lds)[TPROBE];
        GRID_SYNC();
#ifndef TP_MODE
#define TP_MODE 0
#endif
#ifndef TP_LO
#define TP_LO 0
#define TP_HI 1
#endif
        float tot = 0.f, mx = 0.f, ctot = 0.f; int amx = 0; for (int i = 0; i < (int)gridDim.x; ++i) { const float v_ = (float)__hip_atomic_load(pw + i, __ATOMIC_RELAXED, __HIP_MEMORY_SCOPE_AGENT); tot += v_; if (v_ > mx) { mx = v_; amx = i; } if (i >= TP_LO && i < TP_HI) ctot += v_; }
        const float avg_us = TP_MODE == 4 ? (float)amx : TP_MODE == 3 ? (ctot / (float)(TP_HI - TP_LO)) / (tot / (float)gridDim.x) * 100.0f : TP_MODE == 2 ? (mx * (float)gridDim.x / tot - 1.0f) * 100.0f : (TP_MODE == 0 ? tot / (float)gridDim.x : mx) * 0.01f / (float)TP_CNT;
        const float bucket = floorf(avg_us / (float)TP_Q + 0.5f);
        const float sc = 1.0f + bucket * 0.01f;
        for (int i = blockIdx.x * NTHREADS + threadIdx.x; i < M * 256; i += gridDim.x * NTHREADS) { f32x4* o = (f32x4*)p.out + i; *o = *o * sc; }
    }
#endif
#else
    for (int ph = a.lo; ph < a.hi; ++ph) { const int ty = (ph == 0) ? 0 : ((ph - 1) % 7 + 1), l = (ph - 1) / 7; RUN_PHASE(ty, l, ph + 1 < a.hi); }
#endif
}

extern "C" void kernel_launch(void* const* d_in, const int* in_sizes, int n_in, void* d_out, int out_size, void* d_ws, size_t ws_size, hipStream_t stream) {
    static int grid = 0;
    if (grid == 0) {
        if (n_in != N_IN || out_size != M * D || ws_size < WS_END) { fprintf(stderr, "kernel_launch: unexpected shapes (n_in %d, out %d, ws %zu < %zu)\n", n_in, out_size, ws_size, (size_t)WS_END); grid = -1; return; }
        int dev = 0, cus = 0, per_cu = 0;
        hipGetDevice(&dev); hipDeviceGetAttribute(&cus, hipDeviceAttributeMultiprocessorCount, dev);
        hipFuncSetAttribute((const void*)fwd_kernel, hipFuncAttributeMaxDynamicSharedMemorySize, LDS_BYTES);
        hipOccupancyMaxActiveBlocksPerMultiprocessor(&per_cu, (const void*)fwd_kernel, NTHREADS, LDS_BYTES);
        if (per_cu < 1 || cus < 1) { fprintf(stderr, "kernel_launch: occupancy query gave %d blocks/CU on %d CUs\n", per_cu, cus); grid = -1; return; }
        grid = cus * per_cu; if (grid > 256) grid = 256;
    }
    if (grid < 0) return;
    KArgs a{}; for (int i = 0; i < N_IN; ++i) a.p.in[i] = (const float*)d_in[i];
    a.p.out = (float*)d_out; a.p.ws = (unsigned char*)d_ws;
    if (hipMemsetAsync((char*)d_ws + WS_BAR, 0, WS_ZERO_BYTES, stream) != hipSuccess) { fprintf(stderr, "kernel_launch: memset of the barrier words failed\n"); return; }
    if (MK_LAUNCHES == 1) {
        a.lo = 0; a.hi = N_PHASES; void* args[] = {&a};
        hipError_t e = hipLaunchCooperativeKernel((const void*)fwd_kernel, dim3(grid), dim3(NTHREADS), args, LDS_BYTES, stream);
        if (e != hipSuccess) fprintf(stderr, "kernel_launch: cooperative launch failed: %s (grid %d)\n", hipGetErrorString(e), grid);
    } else {
        for (int ph = 0; ph < N_PHASES; ++ph) { a.lo = ph; a.hi = ph + 1; hipLaunchKernelGGL(fwd_kernel, dim3(grid), dim3(NTHREADS), LDS_BYTES, stream, a); }
    }
}
```

```cpp
#define A_DESYNC 2
#include <hip/hip_runtime.h>
#include <hip/hip_cooperative_groups.h>
#include <cstdio>
#include <cstdint>
namespace cg = cooperative_groups;
namespace pg8 {
#define PG8_LAS __attribute__((address_space(3)))
typedef unsigned short bf16_t;
typedef short bf16x8 __attribute__((ext_vector_type(8)));
typedef float f32x4 __attribute__((ext_vector_type(4)));
typedef unsigned u32x4 __attribute__((ext_vector_type(4)));
constexpr int BM = 256, BK = 64, HALF = 128, HTB = HALF * BK * 2  , STAGE_BYTES = 8 * HTB, NXCD = 8, WGM = 8;

__host__ __device__ __forceinline__ int lds_byte(int r, int c) { const int st = (r >> 4) * 2 + (c >> 5), rr = r & 15, cc = c & 31, ob = rr * 64 + cc * 2; return st * 1024 + (ob ^ (((ob >> 9) & 1) << 5)); }
__host__ __device__ __forceinline__ void stage_rc(int b, int& R, int& C) { const int st = b / 1024, sb = b % 1024, swz = sb ^ (((sb >> 9) & 1) << 5); R = (st >> 1) * 16 + swz / 64; C = (st & 1) * 32 + (swz % 64) / 2; }
__host__ __device__ __forceinline__ int perm32(int rho) { const int n = rho >> 4, i = rho & 15; return 8 * (i >> 2) + 4 * n + (i & 3); }

struct Unit { int pm, pn, kind, aux; int nt, lda, ldb; int pad_; const char* A; const char* B; };
struct Gemm { int K, lda; };


template <class Epi, class Sched, bool ALIGN_EPI = false, bool SP2 = false>
__device__ __forceinline__ void gemm_phase(PG8_LAS unsigned char* lds, const Gemm g, const Sched& S, const Epi& E) {
    int tid = threadIdx.x; asm volatile("" : "+v"(tid));
    const int wid = __builtin_amdgcn_readfirstlane(tid >> 6), lane = tid & 63, wr = wid >> 2, wc = wid & 3, fr = lane & 15, fq = lane >> 4;
    int Rv[2], Rbv[2], Cv[2];
#pragma unroll
    for (int i = 0; i < 2; ++i) { int R, C; stage_rc(tid * 16 + i * 8192, R, C); Rv[i] = R; Cv[i] = C; Rbv[i] = Epi::PERM ? ((R & ~31) + perm32(R & 31)) : R; }
    unsigned voffA[2], voffB[2], voffAn[2], voffBn[2];
    const size_t kstep = (size_t)(BK * 2);
    size_t hstepA, hstepB, hstepAn, hstepBn;
#define PG8_STRIDES(u_, vA_, vB_, hA_, hB_) do { _Pragma("unroll") for (int _i = 0; _i < 2; ++_i) { vA_[_i] = (unsigned)(Rv[_i] * (u_).lda + Cv[_i]) * 2u; vB_[_i] = (unsigned)(Rbv[_i] * (u_).ldb + Cv[_i]) * 2u; } \
        hA_ = (size_t)HALF * (u_).lda * 2; hB_ = (size_t)HALF * (u_).ldb * 2; } while (0)
    const unsigned ldsw = (unsigned)wid * 1024u;
    const int aoff = lds_byte(wr * 64 + fr, fq * 8), boff = lds_byte(wc * 32 + fr, fq * 8);
#define PG8_SA(b, h) (((b) * 2 + (h)) * HTB)
#define PG8_SB(b, h) ((4 + (b) * 2 + (h)) * HTB)
#define PG8_STAGE(bufoff, gbase, voff) do { _Pragma("unroll") for (int _i = 0; _i < 2; ++_i) \
        __builtin_amdgcn_global_load_lds((const unsigned*)((const char*)(gbase) + (voff)[_i]), (PG8_LAS unsigned*)(lds + (bufoff) + ldsw + _i * 8192), 16, 0, 0); } while (0)
#define PG8_LDA(dst, b, h) do { _Pragma("unroll") for (int m = 0; m < 4; ++m) _Pragma("unroll") for (int k = 0; k < 2; ++k) dst[m][k] = *(const PG8_LAS bf16x8*)(lds + PG8_SA(b, h) + aoff + m * 2048 + k * 1024); } while (0)
#define PG8_LDB(dst, b, h) do { _Pragma("unroll") for (int n = 0; n < 2; ++n) _Pragma("unroll") for (int k = 0; k < 2; ++k) dst[n][k] = *(const PG8_LAS bf16x8*)(lds + PG8_SB(b, h) + boff + n * 2048 + k * 1024); } while (0)
#define PG8_MMA(ai, bj, At, Bt) do { __builtin_amdgcn_s_setprio(1); _Pragma("unroll") for (int m = 0; m < 4; ++m) _Pragma("unroll") for (int n = 0; n < 2; ++n) _Pragma("unroll") for (int k = 0; k < 2; ++k) \
        acc[ai][bj][m][n] = __builtin_amdgcn_mfma_f32_16x16x32_bf16(Bt[n][k], At[m][k], acc[ai][bj][m][n], 0, 0, 0); __builtin_amdgcn_s_setprio(0); } while (0)
#define PG8_WAIT_V(n) asm volatile("s_waitcnt vmcnt(" #n ")" ::: "memory")
#define PG8_WAIT_L(n) asm volatile("s_waitcnt lgkmcnt(" #n ")" ::: "memory")
#define PG8_BAR __builtin_amdgcn_s_barrier()
#define PG8_SCHED __builtin_amdgcn_sched_barrier(0)
    Unit cur, nxt; int ui = 0;
    if (!S.next(0, cur)) return;
    PG8_STRIDES(cur, voffA, voffB, hstepA, hstepB); int nt = cur.nt;
    f32x4 acc[2][2][4][2];
#pragma unroll
    for (int a = 0; a < 2; ++a)
#pragma unroll
        for (int b = 0; b < 2; ++b)
#pragma unroll
            for (int m = 0; m < 4; ++m)
#pragma unroll
                for (int n = 0; n < 2; ++n) acc[a][b][m][n] = (f32x4){0.f, 0.f, 0.f, 0.f};
    bf16x8 At[4][2], B0[2][2], B1[2][2];
    const char* cA = cur.A; const char* cB = cur.B;
    S.a_ready(cur);
    if constexpr (SP2) {
        PG8_STAGE(PG8_SB(0, 0), cB, voffB); PG8_STAGE(PG8_SB(0, 1), cB + hstepB, voffB); PG8_STAGE(PG8_SA(0, 0), cA, voffA); PG8_STAGE(PG8_SA(0, 1), cA + hstepA, voffA);
        if (wr == 1) PG8_BAR;
        PG8_WAIT_V(2); PG8_BAR;
        PG8_STAGE(PG8_SB(1, 0), cB + kstep, voffB); PG8_STAGE(PG8_SA(1, 0), cA + kstep, voffA); PG8_STAGE(PG8_SB(1, 1), cB + hstepB + kstep, voffB);
        PG8_WAIT_V(6); PG8_BAR;
    } else {
        PG8_STAGE(PG8_SB(0, 0), cB, voffB); PG8_STAGE(PG8_SA(0, 0), cA, voffA); PG8_STAGE(PG8_SB(0, 1), cB + hstepB, voffB); PG8_STAGE(PG8_SA(0, 1), cA + hstepA, voffA);
        if (wr == 1) PG8_BAR;
        PG8_WAIT_V(4); PG8_BAR;
        PG8_STAGE(PG8_SB(1, 0), cB + kstep, voffB); PG8_STAGE(PG8_SA(1, 0), cA + kstep, voffA); PG8_STAGE(PG8_SB(1, 1), cB + hstepB + kstep, voffB);
        PG8_WAIT_V(6); PG8_BAR;
    }
    for (;;) {
        const bool has_next = S.next(ui + 1, nxt);
        const char* nA = has_next ? nxt.A : cA; const char* nB = has_next ? nxt.B : cB;
        if (has_next) PG8_STRIDES(nxt, voffAn, voffBn, hstepAn, hstepBn); else { voffAn[0] = voffA[0]; voffAn[1] = voffA[1]; voffBn[0] = voffB[0]; voffBn[1] = voffB[1]; hstepAn = hstepA; hstepBn = hstepB; }
        for (int t = 0; t < nt; t += 2) {
            const bool last = (t == nt - 2);
            const char* a1 = cA + (size_t)(t + 1) * kstep;
            const char* a2 = last ? nA : cA + (size_t)(t + 2) * kstep; const char* b2 = last ? nB : cB + (size_t)(t + 2) * kstep;
            const char* a3 = a2 + kstep; const char* b3 = b2 + kstep;
            unsigned vA2[2], vB2[2]; vA2[0] = last ? voffAn[0] : voffA[0]; vA2[1] = last ? voffAn[1] : voffA[1]; vB2[0] = last ? voffBn[0] : voffB[0]; vB2[1] = last ? voffBn[1] : voffB[1];
            const size_t hA2 = last ? hstepAn : hstepA, hB2 = last ? hstepBn : hstepB;
            if (last && has_next) S.a_ready(nxt);
            if constexpr (SP2) {
            PG8_LDB(B0, 0, 0); PG8_LDB(B1, 0, 1); PG8_SCHED; PG8_LDA(At, 0, 0); PG8_STAGE(PG8_SA(1, 1), a1 + hstepA, voffA);
            PG8_WAIT_V(8); PG8_WAIT_L(0); PG8_BAR; PG8_MMA(0, 0, At, B0); PG8_MMA(0, 1, At, B1); PG8_BAR; PG8_SCHED;
            PG8_LDA(At, 0, 1); PG8_STAGE(PG8_SB(0, 0), b2, vB2); PG8_STAGE(PG8_SB(0, 1), b2 + hB2, vB2); PG8_STAGE(PG8_SA(0, 0), a2, vA2);
            PG8_WAIT_V(8); PG8_WAIT_L(0); PG8_BAR; PG8_MMA(1, 0, At, B0); PG8_MMA(1, 1, At, B1); PG8_BAR; PG8_SCHED;
            PG8_LDB(B0, 1, 0); PG8_LDB(B1, 1, 1); PG8_SCHED; PG8_LDA(At, 1, 0); PG8_STAGE(PG8_SA(0, 1), a2 + hA2, vA2);
            PG8_WAIT_V(8); PG8_WAIT_L(0); PG8_BAR; PG8_MMA(0, 0, At, B0); PG8_MMA(0, 1, At, B1); PG8_BAR; PG8_SCHED;
            PG8_LDA(At, 1, 1); PG8_STAGE(PG8_SB(1, 0), b3, vB2); PG8_STAGE(PG8_SB(1, 1), b3 + hB2, vB2); PG8_STAGE(PG8_SA(1, 0), a3, vA2);
            PG8_WAIT_V(8); PG8_WAIT_L(0); PG8_BAR; PG8_MMA(1, 0, At, B0); PG8_MMA(1, 1, At, B1); PG8_BAR; PG8_SCHED;
            } else {
            PG8_LDB(B0, 0, 0); PG8_SCHED; PG8_LDA(At, 0, 0); PG8_STAGE(PG8_SA(1, 1), a1 + hstepA, voffA);
            PG8_WAIT_L(8); PG8_BAR; PG8_WAIT_L(0); PG8_MMA(0, 0, At, B0); PG8_BAR; PG8_SCHED;
            PG8_LDB(B1, 0, 1); PG8_STAGE(PG8_SB(0, 0), b2, vB2);
            PG8_BAR; PG8_WAIT_L(0); PG8_MMA(0, 1, At, B1); PG8_BAR;
            PG8_LDA(At, 0, 1); PG8_STAGE(PG8_SA(0, 0), a2, vA2);
            PG8_BAR; PG8_WAIT_L(0); PG8_MMA(1, 0, At, B0); PG8_BAR; PG8_SCHED;
            PG8_STAGE(PG8_SB(0, 1), b2 + hB2, vB2);
            PG8_WAIT_V(6); PG8_BAR; PG8_MMA(1, 1, At, B1); PG8_BAR;
            PG8_LDB(B0, 1, 0); PG8_SCHED; PG8_LDA(At, 1, 0); PG8_STAGE(PG8_SA(0, 1), a2 + hA2, vA2);
            PG8_WAIT_L(8); PG8_BAR; PG8_WAIT_L(0); PG8_MMA(0, 0, At, B0); PG8_BAR; PG8_SCHED;
            PG8_LDB(B1, 1, 1); PG8_STAGE(PG8_SB(1, 0), b3, vB2);
            PG8_BAR; PG8_WAIT_L(0); PG8_MMA(0, 1, At, B1); PG8_BAR;
            PG8_LDA(At, 1, 1); PG8_STAGE(PG8_SA(1, 0), a3, vA2);
            PG8_BAR; PG8_WAIT_L(0); PG8_MMA(1, 0, At, B0); PG8_BAR; PG8_SCHED;
            PG8_STAGE(PG8_SB(1, 1), b3 + hB2, vB2);
            PG8_WAIT_V(6); PG8_BAR; PG8_MMA(1, 1, At, B1); PG8_BAR;
            }
        }
        if constexpr (ALIGN_EPI) { if (wr == 0) PG8_BAR; }
        if constexpr (!Epi::AFTER_DRAIN) { E(acc, cur, wr, wc, fr, fq); S.done(cur); }
        if (!has_next) break;
#pragma unroll
        for (int a = 0; a < 2; ++a)
#pragma unroll
            for (int b = 0; b < 2; ++b)
#pragma unroll
                for (int m = 0; m < 4; ++m)
#pragma unroll
                    for (int n = 0; n < 2; ++n) acc[a][b][m][n] = (f32x4){0.f, 0.f, 0.f, 0.f};
        cur = nxt; cA = nA; cB = nB; ++ui; nt = cur.nt; voffA[0] = voffAn[0]; voffA[1] = voffAn[1]; voffB[0] = voffBn[0]; voffB[1] = voffBn[1]; hstepA = hstepAn; hstepB = hstepBn;
        if constexpr (ALIGN_EPI) { if (wr == 1) PG8_BAR; }
    }
    PG8_WAIT_V(0);
    if constexpr (!ALIGN_EPI) { if (wr == 0) PG8_BAR; }
    PG8_BAR;
    if constexpr (Epi::AFTER_DRAIN) { E.fused(acc, cur, wr, wc, fr, fq, lds, wid, lane); S.done(cur); }
#undef PG8_STRIDES
#undef PG8_SA
#undef PG8_SB
#undef PG8_STAGE
#undef PG8_LDA
#undef PG8_LDB
#undef PG8_MMA
#undef PG8_WAIT_V
#undef PG8_WAIT_L
#undef PG8_BAR
#undef PG8_SCHED
}
}

#define DI __device__ __forceinline__
typedef unsigned short bf16;
typedef short bf16x8 __attribute__((ext_vector_type(8)));
typedef float f32x4 __attribute__((ext_vector_type(4)));
typedef unsigned u32x4 __attribute__((ext_vector_type(4)));
typedef unsigned u32x2 __attribute__((ext_vector_type(2)));

constexpr int D = 1024, NBATCH = 4, T = 4096, M = NBATCH * T, IN_TOTAL = 12184;
constexpr int LDP = 7168;
constexpr int C_RQ = 0, C_RK = 256, C_RV = 512, C_RG = 1024, C_GQ = 1536, C_GK = 1792, C_GV = 2048, C_GG = 2560,
              C_SX = 3072, C_SZ = 4096, C_WR = 4608, C_WK = 5120, C_WV = 5632, C_WL = 6144, C_AL = 6208, C_WG = 6272,
              C_MQ = 6784, C_GKL = 7040, C_SDT = 7056;
enum { I_X = 0, I_MEM, I_POS, I_NORMG, I_WIN, I_GKW2, I_GKB, I_GNORMG, I_CONVW, I_CONVB, I_DTB, I_ALOG, I_SD, I_SNORMG,
       I_MU, I_W0, I_W2, I_A0, I_A2, I_KK, I_KA, I_RK, I_LNG, I_LNB, I_MNORMG, I_WKV, I_URET, I_UGLA, I_USSD, I_URWKV,
       I_UMEM, I_WOUT, I_FNORMG, N_IN };
constexpr size_t MiB = 1u << 20;
constexpr size_t WS_SSQ = 0;
constexpr size_t WS_DG = 512 * 1024;
constexpr size_t WS_DS = 576 * 1024;
constexpr size_t WS_BAR = 640 * 1024;
constexpr size_t WS_KM = 1 * MiB;
constexpr size_t WS_VMT = 1 * MiB + 512 * 1024;
constexpr size_t WS_MEMN = 2 * MiB;
constexpr size_t WS_BND = 6 * MiB;
constexpr int BND_W = 1792;
constexpr size_t WS_XS = 7 * MiB;
constexpr size_t WS_XCNT = 640 * 1024 + 16384;
constexpr size_t WS_ZERO_BYTES = 16384 + 2 * 64 * 256;
constexpr size_t WS_W1T = 8 * MiB;
constexpr size_t WS_WGT = 22 * MiB;
constexpr size_t WS_UT = 32 * MiB;
constexpr size_t WS_UST = 35 * MiB;
constexpr size_t WS_UMT = 36 * MiB;
constexpr size_t WS_WOT = 37 * MiB;
constexpr size_t WS_WKVT = 39 * MiB;
constexpr size_t WS_XN = 40 * MiB;
constexpr size_t WS_P = 72 * MiB;
constexpr size_t WS_OMEM = 296 * MiB;
constexpr size_t WS_RETL = 304 * MiB;
constexpr size_t WS_GLAL = 312 * MiB;
constexpr size_t WS_SSDL = 320 * MiB;
constexpr size_t WS_MRG = 304 * MiB;
constexpr size_t WS_RWGH = 336 * MiB;
constexpr size_t WS_WOT1 = 368 * MiB;
constexpr size_t WS_END = 370 * MiB;

constexpr int LDS_BYTES = 147456;
constexpr int NTHREADS = 512;

struct Params { const float* in[N_IN]; float* out; unsigned char* ws; };

DI float bf2f(unsigned b) { return __uint_as_float(b << 16); }
typedef __bf16 bf16n2 __attribute__((ext_vector_type(2)));
DI unsigned f2bf(float f) { const __bf16 b = (__bf16)f; return (unsigned)__builtin_bit_cast(unsigned short, b); }
DI unsigned pk2(float lo, float hi) { const bf16n2 v = {(__bf16)lo, (__bf16)hi}; return __builtin_bit_cast(unsigned, v); }
DI float lo16(unsigned u) { return __uint_as_float(u << 16); }
DI float hi16(unsigned u) { return __uint_as_float(u & 0xffff0000u); }
DI void unpack8(u32x4 v, float* f) { f[0] = lo16(v.x); f[1] = hi16(v.x); f[2] = lo16(v.y); f[3] = hi16(v.y); f[4] = lo16(v.z); f[5] = hi16(v.z); f[6] = lo16(v.w); f[7] = hi16(v.w); }
DI u32x4 pack8(const float* f) { u32x4 v; v.x = pk2(f[0], f[1]); v.y = pk2(f[2], f[3]); v.z = pk2(f[4], f[5]); v.w = pk2(f[6], f[7]); return v; }
DI u32x2 pack4(f32x4 a) { u32x2 v; v.x = pk2(a[0], a[1]); v.y = pk2(a[2], a[3]); return v; }
DI float fexp(float x) { return __expf(x); }
DI float sigmoidf_(float x) { return __builtin_amdgcn_rcpf(1.0f + __expf(-x)); }
DI float siluf_(float x) { return x * __builtin_amdgcn_rcpf(1.0f + __expf(-x)); }
DI float softplusf_(float x) { return fmaxf(x, 0.0f) + __logf(1.0f + __expf(-fabsf(x))); }
DI float logsigmoidf_(float x) { return fminf(x, 0.0f) - __logf(1.0f + __expf(-fabsf(x))); }
DI float tanhf_(float x) { const float e = __expf(2.0f * x); return 1.0f - 2.0f * __builtin_amdgcn_rcpf(e + 1.0f); }
DI int opaque_tid() { int t = threadIdx.x; asm volatile("" : "+v"(t)); return t; }
#ifdef TPROBE
#define TS_BASE(lds_) ((volatile unsigned*)((lds_) + LDS_BYTES - 64) + 2)
#define TS_BEGIN() do { if (threadIdx.x == 0) TS_BASE(lds)[13] = (unsigned)__builtin_amdgcn_s_memrealtime(); } while (0)
#define TS_MARK(k) do { if (threadIdx.x == 0) { const unsigned t_ = (unsigned)__builtin_amdgcn_s_memrealtime(); volatile unsigned* A_ = TS_BASE(lds); A_[k] += t_ - A_[13]; A_[13] = t_; } } while (0)
#endif
#define WAVE_LDS_SYNC() asm volatile("s_waitcnt lgkmcnt(0)" ::: "memory")
DI float wave_sum(float v) {
#pragma unroll
    for (int o = 1; o < 64; o <<= 1) v += __shfl_xor(v, o);
    return v;
}
DI bf16x8 frag(const bf16* base, int ld, int r0, int k0, int lane) { return *(const bf16x8*)(base + (r0 + (lane & 15)) * ld + k0 + ((lane >> 4) << 3)); }
DI f32x4 mfma16(bf16x8 a, bf16x8 b, f32x4 c) { return __builtin_amdgcn_mfma_f32_16x16x32_bf16(a, b, c, 0, 0, 0); }

DI void tile_map(int L, int nM, int nN, int& pm, int& pn) {
    const int nwg = nM * nN; int wgid = L;
    { const int q = nwg / 8, r = nwg % 8, xcd = wgid % 8, off = wgid / 8; wgid = (xcd < r ? xcd * (q + 1) : r * (q + 1) + (xcd - r) * q) + off; }
    const int nig = 8 * nN, gid = wgid / nig, fm = gid * 8, gsz = (nM - fm) < 8 ? (nM - fm) : 8;
    pm = fm + ((wgid % nig) % gsz); pn = (wgid % nig) / gsz;
}

using pg8::Unit;
struct SchedP1 {
    int G, c; const char* A; const char* B;
    DI bool next(int i, Unit& u) const {
        const long L = (long)i * G + c; if (L >= 64 * 28) return false;
        tile_map((int)L, 64, 28, u.pm, u.pn); u.kind = 0; u.aux = 0; u.nt = 16; u.lda = 1024; u.ldb = 1024; u.pad_ = 0;
        u.A = A + (size_t)u.pm * 256 * 1024 * 2; u.B = B + (size_t)u.pn * 256 * 1024 * 2; return true;
    }
    DI void a_ready(const Unit&) const {}
    DI void done(const Unit&) const {}
};
struct EpiP {
    static constexpr bool PERM = true, AFTER_DRAIN = false;
    bf16* O; bf16* BND;
    DI void operator()(const f32x4 (&acc)[2][2][4][2], const Unit& u, int wr, int wc, int fr, int fq) const {
        const int row0 = u.pm * 256 + wr * 64 + fr, col0 = u.pn * 256 + wc * 32 + 8 * fq;
#pragma unroll
        for (int ai = 0; ai < 2; ++ai)
#pragma unroll
            for (int m = 0; m < 4; ++m) { bf16* rowp = O + (size_t)(row0 + ai * 128 + m * 16) * LDP + col0;
#pragma unroll
                for (int bj = 0; bj < 2; ++bj) { const f32x4 v0 = acc[ai][bj][m][0], v1 = acc[ai][bj][m][1];
                    u32x4 w; w.x = pk2(v0[0], v0[1]); w.y = pk2(v0[2], v0[3]); w.z = pk2(v1[0], v1[1]); w.w = pk2(v1[2], v1[3]);
                    *(u32x4*)(rowp + bj * 128) = w;
                    if (m == 3 && fr == 15 && u.pn >= 18 && u.pn <= 24) *(u32x4*)(BND + (size_t)((row0 + ai * 128 + m * 16) >> 6) * BND_W + (col0 - 4608) + bj * 128) = w; } }
    }
};
DI int gate_slot_col(int s) { return s < 8 ? 128 * s : s < 16 ? 1536 + 128 * (s - 8) : s < 24 ? 3072 + 128 * (s - 16) : s < 37 ? 4608 + 128 * (s - 24) : 6784 + 128 * (s - 37); }
struct SchedP3 {
    int pm, pn; const unsigned char* ws; int alt;
    DI bool next(int i0, Unit& u) const {
        if (i0 >= 11) return false;
        const unsigned long long code = alt == 0 ? 0xA4982736150ull : alt == 1 ? 0xA9847263510ull : alt == 2 ? 0x736150982A4ull : alt == 3 ? 0x76315908A24ull : alt == 4 ? 0x50A47398261ull : alt == 5 ? 0x5908621A743ull : alt == 6 ? 0x506A1479382ull : 0x9852A074631ull;
        const int i = (int)((code >> (4 * i0)) & 15ull), fb = (int)((0x6876AA55ull >> (4 * alt)) & 15ull);
        u.pm = pm; u.pn = pn; u.pad_ = 0;
        if (i < 5) { u.kind = i; u.aux = 16; u.nt = 16; u.lda = 1024; u.ldb = 1024; u.A = (const char*)ws + WS_XN + (size_t)pm * 256 * 1024 * 2;
            u.B = (const char*)ws + WS_WGT + ((size_t)i * 1024 + (size_t)pn * 256) * 1024 * 2; }
        else if (i < 8) { const int j = i - 5; const int col = j == 0 ? C_RG : j == 1 ? C_GG : C_WG; u.kind = j == 0 ? 0 : j == 1 ? 1 : 3; u.aux = (i == fb) ? 1 : 0; u.nt = 8; u.lda = LDP; u.ldb = 512;
            u.A = (const char*)ws + WS_P + ((size_t)pm * 256 * LDP + col) * 2;
            u.B = (const char*)ws + WS_UT + ((size_t)j * 1024 + (size_t)pn * 256) * 512 * 2; }
        else if (i < 10) { const int j = i - 8; u.kind = 2; u.aux = ((j + 1) << 1) | ((i == fb) ? 1 : 0); u.nt = 4; u.lda = LDP; u.ldb = 256;
            u.A = (const char*)ws + WS_P + ((size_t)pm * 256 * LDP + C_SZ + j * 256) * 2;
            u.B = (const char*)ws + WS_UST + ((size_t)j * 1024 + (size_t)pn * 256) * 256 * 2; }
        else { u.kind = 4; u.aux = (i == fb) ? 1 : 0; u.nt = 4; u.lda = 256; u.ldb = 256; u.A = (const char*)ws + WS_OMEM + (size_t)pm * 256 * 256 * 2;
            u.B = (const char*)ws + WS_UMT + ((size_t)pn * 256) * 256 * 2; }
        return true;
    }
    DI void a_ready(const Unit&) const {}
    DI void done(const Unit&) const {}
};
typedef float f32x2 __attribute__((ext_vector_type(2)));
DI f32x2 sig255_pk(f32x2 x) {
    x = __builtin_elementwise_min(__builtin_elementwise_max(x, (f32x2){-7.0f, -7.0f}), (f32x2){7.0f, 7.0f});
    const f32x2 x2 = x * x;
    f32x2 q = x2 * 9.362619013e-11f + (-1.716749942e-08f);
    q = q * x2 + 1.283517804e-06f; q = q * x2 + (-5.098115798e-05f); q = q * x2 + 1.195220742e-03f; q = q * x2 + (-1.824038848e-02f); q = q * x2 + 2.476293743e-01f;
    return (x * q) * 255.0f + 128.0f;
}
DI f32x2 sig_pk(f32x2 x) { return (sig255_pk(x) - 128.0f) * (1.0f / 255.0f) + 0.5f; }
struct EpiGate {
    static constexpr bool PERM = true, AFTER_DRAIN = false;
    bf16* P;
    DI void operator()(const f32x4 (&acc)[2][2][4][2], const Unit& u, int wr, int wc, int fr, int fq) const {
        const int row0 = u.pm * 256 + wr * 64 + fr;
#pragma unroll
        for (int bj = 0; bj < 2; ++bj) { const int col = gate_slot_col((u.kind * 4 + u.pn) * 2 + bj);
#pragma unroll
            for (int ai = 0; ai < 2; ++ai)
#pragma unroll
                for (int m = 0; m < 4; ++m) { const f32x4 v0 = acc[ai][bj][m][0], v1 = acc[ai][bj][m][1];
                    const f32x2 a = sig255_pk((f32x2){v0[0], v0[1]}), b = sig255_pk((f32x2){v0[2], v0[3]}), c = sig255_pk((f32x2){v1[0], v1[1]}), d = sig255_pk((f32x2){v1[2], v1[3]});
                    u32x2 w; w.x = (unsigned)a.x | ((unsigned)a.y << 8) | ((unsigned)b.x << 16) | ((unsigned)b.y << 24);
                    w.y = (unsigned)c.x | ((unsigned)c.y << 8) | ((unsigned)d.x << 16) | ((unsigned)d.y << 24);
                    *(u32x2*)((unsigned char*)(P + (size_t)(row0 + ai * 128 + m * 16) * LDP + col) + wc * 32 + 8 * fq) = w; } }
    }
};
struct EpiBranch {
    static constexpr bool PERM = true, AFTER_DRAIN = false;
    const bf16* P; bf16* MG; const float* ssq;
    DI void operator()(const f32x4 (&acc)[2][2][4][2], const Unit& u, int wr, int wc, int fr, int fq) const {
        const int row0 = u.pm * 256 + wr * 64 + fr; const bool first = (u.aux & 1) != 0; const int grp = (u.aux >> 1) - 1;
        const int gc0 = gate_slot_col((u.kind * 4 + u.pn) * 2 + 0), gc1 = gate_slot_col((u.kind * 4 + u.pn) * 2 + 1);
        u32x2 g8[2][2][2]; u32x4 o8[2][2][2]; f32x4 s4[2][2];
        const int frow = u.pm * 256;
#define EB_LOAD(buf, ai, mh) do { \
        _Pragma("unroll") for (int m2 = 0; m2 < 2; ++m2) { const int row = row0 + (ai) * 128 + (2 * (mh) + m2) * 16; \
            s4[buf][m2] = *(const f32x4*)(ssq + (size_t)row * 8 + (grp > 0 ? 4 : 0)); \
            _Pragma("unroll") for (int bj = 0; bj < 2; ++bj) { \
                g8[buf][m2][bj] = *(const u32x2*)((const unsigned char*)(P + (size_t)row * LDP + (bj ? gc1 : gc0)) + wc * 32 + 8 * fq); \
                o8[buf][m2][bj] = *(const u32x4*)(MG + (size_t)(first ? frow : row) * 1024 + u.pn * 256 + bj * 128 + wc * 32 + 8 * fq); } } } while (0)
#define EB_COMP(buf, ai, mh) do { \
        _Pragma("unroll") for (int m2 = 0; m2 < 2; ++m2) { const int m = 2 * (mh) + m2, row = row0 + (ai) * 128 + m * 16; \
            const float sc = (grp >= 0) ? __builtin_amdgcn_rsqf(((s4[buf][m2][0] + s4[buf][m2][1]) + (s4[buf][m2][2] + s4[buf][m2][3])) * (1.0f / 256.0f) + 1e-6f) : 1.0f; \
            _Pragma("unroll") for (int bj = 0; bj < 2; ++bj) { float g[8], pv[8]; \
                _Pragma("unroll") for (int j = 0; j < 4; ++j) { g[j] = (float)((g8[buf][m2][bj].x >> (8 * j)) & 0xffu) * (1.0f / 255.0f); g[4 + j] = (float)((g8[buf][m2][bj].y >> (8 * j)) & 0xffu) * (1.0f / 255.0f); } \
                unpack8(o8[buf][m2][bj], pv); \
                if (first) { _Pragma("unroll") for (int j = 0; j < 8; ++j) pv[j] = 0.f; } \
                const f32x4 v0 = acc[ai][bj][m][0], v1 = acc[ai][bj][m][1]; \
                float o[8] = { v0[0] * sc * g[0] + pv[0], v0[1] * sc * g[1] + pv[1], v0[2] * sc * g[2] + pv[2], v0[3] * sc * g[3] + pv[3], v1[0] * sc * g[4] + pv[4], v1[1] * sc * g[5] + pv[5], v1[2] * sc * g[6] + pv[6], v1[3] * sc * g[7] + pv[7] }; \
                *(u32x4*)(MG + (size_t)row * 1024 + u.pn * 256 + bj * 128 + wc * 32 + 8 * fq) = pack8(o); } } } while (0)
        EB_LOAD(0, 0, 0); EB_LOAD(1, 0, 1);
        __builtin_amdgcn_sched_barrier(0);
        EB_COMP(0, 0, 0); EB_LOAD(0, 1, 0);
        __builtin_amdgcn_sched_barrier(0);
        EB_COMP(1, 0, 1); EB_LOAD(1, 1, 1);
        __builtin_amdgcn_sched_barrier(0);
        EB_COMP(0, 1, 0);
        __builtin_amdgcn_sched_barrier(0);
        EB_COMP(1, 1, 1);
#undef EB_LOAD
#undef EB_COMP
    }
};
struct EpiP3 {
    static constexpr bool PERM = true, AFTER_DRAIN = false;
    EpiGate G; EpiBranch B;
    DI void operator()(const f32x4 (&acc)[2][2][4][2], const Unit& u, int wr, int wc, int fr, int fq) const { if (u.aux & 16) G(acc, u, wr, wc, fr, fq); else B(acc, u, wr, wc, fr, fq); }
};
struct SchedP4 {
    int G, c; const char* A; const char* B;
    DI bool next(int i, Unit& u) const {
        const long L = (long)i * G + c; if (L >= 64 * 4) return false;
        tile_map((int)L, 64, 4, u.pm, u.pn); u.kind = 0; u.aux = 0; u.nt = 16; u.lda = 1024; u.ldb = 1024; u.pad_ = 0;
        u.A = A + (size_t)u.pm * 256 * 1024 * 2; u.B = B + (size_t)u.pn * 256 * 1024 * 2; return true;
    }
    DI void a_ready(const Unit&) const {}
    DI void done(const Unit&) const {}
};
struct EpiRes {
    static constexpr bool PERM = false, AFTER_DRAIN = false;
    const float* res; float* out;
    DI void operator()(const f32x4 (&acc)[2][2][4][2], const Unit& u, int wr, int wc, int fr, int fq) const {
        const int row0 = u.pm * 256 + wr * 64 + fr, col0 = u.pn * 256 + wc * 32 + 4 * fq;
#pragma unroll
        for (int ai = 0; ai < 2; ++ai)
#pragma unroll
            for (int m = 0; m < 4; ++m) { const size_t off = (size_t)(row0 + ai * 128 + m * 16) * 1024 + col0;
#pragma unroll
                for (int bj = 0; bj < 2; ++bj)
#pragma unroll
                    for (int n = 0; n < 2; ++n) { const f32x4 r = *(const f32x4*)(res + off + bj * 128 + n * 16); *(f32x4*)(out + off + bj * 128 + n * 16) = r + acc[ai][bj][m][n]; } }
    }
};

template <bool LAST> struct EpiNorm {
    static constexpr bool PERM = false, AFTER_DRAIN = true;
    const float* res; float* out; const float* g; bf16* xn; float* xs; unsigned* cnt;
    DI void operator()(const f32x4 (&)[2][2][4][2], const Unit&, int, int, int, int) const {}
    DI void fused(f32x4 (&acc)[2][2][4][2], const Unit& u, int wr, int wc, int fr, int fq, PG8_LAS unsigned char* lds, int wid, int lane) const {
        PG8_LAS float* Pt = (PG8_LAS float*)lds; PG8_LAS float* St = Pt + 1024;
        const int row0 = u.pm * 256 + wr * 64 + fr, col0 = u.pn * 256 + wc * 32 + 4 * fq;
        f32x4 rr[4][4];
#define EN_LOAD(k) do { const size_t off_ = (size_t)(row0 + ((k) >> 2) * 128 + ((k) & 3) * 16) * 1024 + col0; \
            _Pragma("unroll") for (int q = 0; q < 4; ++q) rr[(k) & 3][q] = *(const f32x4*)(res + off_ + (q >> 1) * 128 + (q & 1) * 16); } while (0)
        EN_LOAD(0); EN_LOAD(1); EN_LOAD(2); EN_LOAD(3);
#pragma unroll
        for (int k = 0; k < 8; ++k) { const int ai = k >> 2, m = k & 3; float s = 0.f;
#pragma unroll
            for (int q = 0; q < 4; ++q) { const int bj = q >> 1, n = q & 1; const f32x4 x = rr[k & 3][q] + acc[ai][bj][m][n]; acc[ai][bj][m][n] = x;
                s += (x[0] * x[0] + x[1] * x[1]) + (x[2] * x[2] + x[3] * x[3]); }
            if (k + 4 < 8) EN_LOAD(k + 4);
            s += __shfl_xor(s, 16); s += __shfl_xor(s, 32);
            if (fq == 0) Pt[(ai * 128 + wr * 64 + m * 16 + fr) * 4 + wc] = s; }
#undef EN_LOAD
        asm volatile("s_waitcnt lgkmcnt(0)" ::: "memory"); __builtin_amdgcn_s_barrier(); asm volatile("" ::: "memory");
        const int row = wid * 32 + (lane & 31);
        if (lane < 32) { const float t = (Pt[row * 4 + 0] + Pt[row * 4 + 1]) + (Pt[row * 4 + 2] + Pt[row * 4 + 3]);
            __hip_atomic_store(xs + ((size_t)u.pm * 256 + row) * 4 + u.pn, t, __ATOMIC_RELAXED, __HIP_MEMORY_SCOPE_AGENT); }
        asm volatile("s_waitcnt vmcnt(0)" ::: "memory");
        if (lane == 0) (void)__hip_atomic_fetch_add(cnt + u.pm * 64, 1u, __ATOMIC_RELAXED, __HIP_MEMORY_SCOPE_AGENT);
        if (wid == 0) { unsigned spins = 0;
            while ((unsigned)__builtin_amdgcn_readfirstlane(__hip_atomic_load(cnt + u.pm * 64, __ATOMIC_RELAXED, __HIP_MEMORY_SCOPE_AGENT)) < 32u) { __builtin_amdgcn_s_sleep(2); if (++spins > (1u << 22)) break; }
            __builtin_amdgcn_fence(__ATOMIC_ACQUIRE, "agent"); asm volatile("s_waitcnt vmcnt(0)" ::: "memory"); }
        asm volatile("" ::: "memory"); __builtin_amdgcn_s_barrier(); asm volatile("" ::: "memory");
        if (lane < 32) { const float* sp = xs + ((size_t)u.pm * 256 + row) * 4;
            const float a = __hip_atomic_load(sp + 0, __ATOMIC_RELAXED, __HIP_MEMORY_SCOPE_AGENT), b = __hip_atomic_load(sp + 1, __ATOMIC_RELAXED, __HIP_MEMORY_SCOPE_AGENT),
                        c = __hip_atomic_load(sp + 2, __ATOMIC_RELAXED, __HIP_MEMORY_SCOPE_AGENT), d = __hip_atomic_load(sp + 3, __ATOMIC_RELAXED, __HIP_MEMORY_SCOPE_AGENT);
            St[row] = __builtin_amdgcn_rsqf(((a + b) + (c + d)) * (1.0f / 1024.0f) + 1e-6f); }
        asm volatile("s_waitcnt lgkmcnt(0)" ::: "memory"); __builtin_amdgcn_s_barrier(); asm volatile("" ::: "memory");
#pragma unroll
        for (int ai = 0; ai < 2; ++ai)
#pragma unroll
            for (int m = 0; m < 4; ++m) { const size_t off = (size_t)(row0 + ai * 128 + m * 16) * 1024 + col0; const float rs = St[ai * 128 + wr * 64 + m * 16 + fr];
#pragma unroll
                for (int bj = 0; bj < 2; ++bj)
#pragma unroll
                    for (int n = 0; n < 2; ++n) { const f32x4 gv = *(const f32x4*)(g + col0 + bj * 128 + n * 16); const f32x4 x = acc[ai][bj][m][n]; const f32x4 y = x * rs * gv;
                        if (LAST) *(f32x4*)(out + off + bj * 128 + n * 16) = y;
                        else { *(f32x4*)(out + off + bj * 128 + n * 16) = x; *(u32x2*)(xn + off + bj * 128 + n * 16) = pack4(y); } } }
    }
};

DI void transpose_item(const float* W, int ldw, int K, bf16* WT, float* scr, int item, int nblk, int lane) {
    const int kb = item / nblk, nb = item % nblk, k0 = 64 * kb, n0 = 32 * nb;
    float tv[32];
#pragma unroll
    for (int i = 0; i < 32; ++i) { const int kk = 2 * i + (lane >> 5); tv[i] = W[(size_t)(k0 + kk) * ldw + n0 + (lane & 31)]; }
#pragma unroll
    for (int i = 0; i < 32; ++i) { const int kk = 2 * i + (lane >> 5); scr[kk * 33 + (lane & 31)] = tv[i]; }
    WAVE_LDS_SYNC();
    const int c = lane & 7;
#pragma unroll
    for (int j = 0; j < 4; ++j) { const int n = (lane >> 3) + 8 * j; const float* s = scr + (8 * c) * 33 + n;
        u32x4 o; o.x = pk2(s[0 * 33], s[1 * 33]); o.y = pk2(s[2 * 33], s[3 * 33]); o.z = pk2(s[4 * 33], s[5 * 33]); o.w = pk2(s[6 * 33], s[7 * 33]);
        *(u32x4*)(WT + (size_t)(n0 + n) * K + k0 + 8 * c) = o; }
    WAVE_LDS_SYNC();
}
struct TSeg { int inp, lstride, src0, ldw, K, nblk; unsigned dst_q, dst_rows0; };
DI void rms_row_bf16(const float* xrow, const float* g, bf16* orow, int lane) {
    const f32x4* xr = (const f32x4*)xrow + lane; const f32x4* gr = (const f32x4*)g + lane;
    f32x4 v[4]; float s = 0.f;
#pragma unroll
    for (int j = 0; j < 4; ++j) { v[j] = xr[64 * j]; s += (v[j][0] * v[j][0] + v[j][1] * v[j][1]) + (v[j][2] * v[j][2] + v[j][3] * v[j][3]); }
    const float rstd = __builtin_amdgcn_rsqf(wave_sum(s) * (1.0f / 1024.0f) + 1e-6f);
    u32x2* o8 = (u32x2*)orow + lane;
#pragma unroll
    for (int j = 0; j < 4; ++j) { const f32x4 gg = gr[64 * j]; u32x2 o; o.x = pk2(v[j][0] * rstd * gg[0], v[j][1] * rstd * gg[1]); o.y = pk2(v[j][2] * rstd * gg[2], v[j][3] * rstd * gg[3]); o8[64 * j] = o; }
}
DI void convert_wout(const Params& p, int l, unsigned char* lds) {
    const int tid = opaque_tid(), lane = tid & 63, wave = tid >> 6;
    const int gw = blockIdx.x * 8 + wave, NGW = gridDim.x * 8;
    float* scr = (float*)(lds + wave * 16384);
    int it = gw - ((1024 + 512 * l) % NGW); if (it < 0) it += NGW;
    for (; it < 512; it += NGW) transpose_item(p.in[I_WOUT] + (size_t)l * 1024 * 1024, 1024, 1024, (bf16*)(p.ws + (l == 0 ? WS_WOT : WS_WOT1)), scr, it, 32, lane);
}
DI void convert_weights(const Params& p, int l, unsigned char* lds) {
    const int tid = opaque_tid(), lane = tid & 63, wave = tid >> 6;
    const int gw = blockIdx.x * 8 + wave, NGW = gridDim.x * 8;
    float* scr = (float*)(lds + wave * 16384);
    static constexpr TSeg segs[] = {
        {I_WIN, 1024 * IN_TOTAL, 0,    IN_TOTAL, 1024, 2560 / 32, 32, 0},
        {I_WIN, 1024 * IN_TOTAL, 2576, IN_TOTAL, 1024, 512 / 32,  32, 2560},
        {I_WIN, 1024 * IN_TOTAL, 3088, IN_TOTAL, 1024, 1024 / 32, 32, 3072},
        {I_WIN, 1024 * IN_TOTAL, 4120, IN_TOTAL, 1024, 512 / 32,  32, 4096},
        {I_WIN, 1024 * IN_TOTAL, 4632, IN_TOTAL, 1024, 1664 / 32, 32, 4608},
        {I_WIN, 1024 * IN_TOTAL, 6296, IN_TOTAL, 1024, 512 / 32,  32, 6272},
        {I_WIN, 1024 * IN_TOTAL, 6808, IN_TOTAL, 1024, 256 / 32,  32, 6784},
        {I_WIN, 1024 * IN_TOTAL, 7064, IN_TOTAL, 1024, 5120 / 32, 88, 0},
        {I_URET,  512 * 1024, 0, 1024, 512, 32, 128, 0},
        {I_UGLA,  512 * 1024, 0, 1024, 512, 32, 128, 1024},
        {I_URWKV, 512 * 1024, 0, 1024, 512, 32, 128, 2048},
        {I_USSD,  512 * 1024, 0,          1024, 256, 32, 140, 0},
        {I_USSD,  512 * 1024, 256 * 1024, 1024, 256, 32, 140, 1024},
        {I_UMEM,  256 * 1024, 0, 1024, 256, 32, 144, 0},
        {I_WOUT, 1024 * 1024, 0, 1024, 1024, 32, 148, 0},
        {I_WKV,  1024 * 512,  0, 512,  1024, 16, 156, 0},
    };
    constexpr int NSEG = sizeof(segs) / sizeof(segs[0]);
    int base = 0;
    for (int s = 0; s < NSEG; ++s) {
        const TSeg sg = segs[s]; const int nitems = (sg.K / 64) * sg.nblk;
        if (sg.inp == I_WOUT) continue;
        int it = gw - (base % NGW); if (it < 0) it += NGW;
        const float* W = p.in[sg.inp] + (size_t)l * sg.lstride + sg.src0;
        bf16* WT = (bf16*)(p.ws + (size_t)sg.dst_q * 262144) + (size_t)sg.dst_rows0 * sg.K;
        for (; it < nitems; it += NGW) transpose_item(W, sg.ldw, sg.K, WT, scr, it, sg.nblk, lane);
        base += nitems;
    }
    for (int idx = blockIdx.x * NTHREADS + tid; idx < 128 * 1024; idx += gridDim.x * NTHREADS) {
        const int r = (idx >> 10) & 127, k = idx & 1023;
        const float* W = p.in[I_WIN] + (size_t)l * 1024 * IN_TOTAL + (size_t)k * IN_TOTAL;
        const float v = r < 16 ? W[2560 + r] : r < 24 ? W[4112 + (r - 16)] : 0.0f;
        ((bf16*)(p.ws + WS_W1T))[((size_t)7040 + r) * 1024 + k] = (bf16)f2bf(v);
    }
}
DI void rms_rows2_bf16(const float* x0, const float* x1, const float* g, bf16* o0, bf16* o1, int lane) {
    const f32x4* xa = (const f32x4*)x0 + lane; const f32x4* xb = (const f32x4*)x1 + lane; const f32x4* gr = (const f32x4*)g + lane;
    f32x4 va[4], vb[4]; float sa = 0.f, sb = 0.f;
#pragma unroll
    for (int j = 0; j < 4; ++j) { va[j] = xa[64 * j]; vb[j] = xb[64 * j]; }
#pragma unroll
    for (int j = 0; j < 4; ++j) { sa += (va[j][0] * va[j][0] + va[j][1] * va[j][1]) + (va[j][2] * va[j][2] + va[j][3] * va[j][3]); sb += (vb[j][0] * vb[j][0] + vb[j][1] * vb[j][1]) + (vb[j][2] * vb[j][2] + vb[j][3] * vb[j][3]); }
    const float ra = __builtin_amdgcn_rsqf(wave_sum(sa) * (1.0f / 1024.0f) + 1e-6f), rb = __builtin_amdgcn_rsqf(wave_sum(sb) * (1.0f / 1024.0f) + 1e-6f);
    u32x2* pa = (u32x2*)o0 + lane; u32x2* pb = (u32x2*)o1 + lane;
#pragma unroll
    for (int j = 0; j < 4; ++j) { const f32x4 gg = gr[64 * j]; u32x2 o; o.x = pk2(va[j][0] * ra * gg[0], va[j][1] * ra * gg[1]); o.y = pk2(va[j][2] * ra * gg[2], va[j][3] * ra * gg[3]); pa[64 * j] = o;
        o.x = pk2(vb[j][0] * rb * gg[0], vb[j][1] * rb * gg[1]); o.y = pk2(vb[j][2] * rb * gg[2], vb[j][3] * rb * gg[3]); pb[64 * j] = o; }
}
DI void phase_prologue(const Params& p, unsigned char* lds) {
    const int tid = opaque_tid(), lane = tid & 63, wave = tid >> 6;
    const int gw = blockIdx.x * 8 + wave, NGW = gridDim.x * 8;
    convert_weights(p, 0, lds); convert_wout(p, 0, lds); convert_wout(p, 1, lds);
    for (int m = gw; m < M; m += 2 * NGW) { const int m1 = m + NGW;
        if (m1 < M) rms_rows2_bf16(p.in[I_X] + (size_t)m * 1024, p.in[I_X] + (size_t)m1 * 1024, p.in[I_NORMG], (bf16*)(p.ws + WS_XN) + (size_t)m * 1024, (bf16*)(p.ws + WS_XN) + (size_t)m1 * 1024, lane);
        else rms_row_bf16(p.in[I_X] + (size_t)m * 1024, p.in[I_NORMG], (bf16*)(p.ws + WS_XN) + (size_t)m * 1024, lane); }
    for (int m = gw; m < 2048; m += NGW) { const int l = m >> 10, r = m & 1023;
        rms_row_bf16(p.in[I_MEM] + (size_t)r * 1024, p.in[I_MNORMG] + l * 1024, (bf16*)(p.ws + WS_MEMN) + (size_t)m * 1024, lane); }
}
DI void phase_norm(const Params& p, int l, float oscale, unsigned char* lds) {
    const int tid = opaque_tid(), lane = tid & 63, wave = tid >> 6;
    const int gw = blockIdx.x * 8 + wave, NGW = gridDim.x * 8;
    if (l == 0) { convert_weights(p, 1, lds); for (int m = gw; m < M; m += NGW) rms_row_bf16(p.out + (size_t)m * 1024, p.in[I_NORMG] + 1024, (bf16*)(p.ws + WS_XN) + (size_t)m * 1024, lane); }
    else {
        for (int m = gw; m < M; m += NGW) {
            f32x4* xr = (f32x4*)(p.out + (size_t)m * 1024) + lane; const f32x4* gr = (const f32x4*)p.in[I_FNORMG] + lane;
            f32x4 v[4]; float s = 0.f;
#pragma unroll
            for (int j = 0; j < 4; ++j) { v[j] = xr[64 * j]; s += (v[j][0] * v[j][0] + v[j][1] * v[j][1]) + (v[j][2] * v[j][2] + v[j][3] * v[j][3]); }
            const float rstd = __builtin_amdgcn_rsqf(wave_sum(s) * (1.0f / 1024.0f) + 1e-6f);
#pragma unroll
            for (int j = 0; j < 4; ++j) xr[64 * j] = v[j] * (rstd * oscale) * gr[64 * j];
        }
    }
}

#define XB_TMO      128
#define XB_XCNT(j)  (256  + 64 * (j))
#define XB_XSUB(j)  (1280 + 64 * (j))
#define XB_XGEN(j)  (2304 + 64 * (j))
#define XB_TOP      3328
#define XB_TOPGEN   3392
#define XCD_BAR_WORDS 3456
#define XB_SPIN_CAP (1u << 18)

__device__ __forceinline__ unsigned xb_ld(unsigned* p)              { return __hip_atomic_load(p, __ATOMIC_RELAXED, __HIP_MEMORY_SCOPE_AGENT); }
__device__ __forceinline__ unsigned xb_add(unsigned* p, unsigned v) { return __hip_atomic_fetch_add(p, v, __ATOMIC_RELAXED, __HIP_MEMORY_SCOPE_AGENT); }
__device__ __forceinline__ unsigned xb_xcc_id() { return (unsigned)__builtin_amdgcn_s_getreg((3 << 11) | 20) & 0xFu; }
#define XB_SPIN(cond, bar) do { unsigned _sp = 0; while (cond) { __builtin_amdgcn_s_sleep(1); \
    if ((++_sp & 255u) == 0u) { if (xb_ld(&(bar)[XB_TMO])) break; if (_sp > XB_SPIN_CAP) { atomicAdd(&(bar)[XB_TMO], 1u); break; } } } } while (0)

struct XcdBarrier {
    unsigned* bar; unsigned x;
    volatile unsigned* st;
};

__device__ __forceinline__ XcdBarrier xcd_barrier_post(unsigned* bar, volatile unsigned* st) {
    XcdBarrier b; b.bar = bar; b.x = xb_xcc_id(); b.st = st;
    if (threadIdx.x == 0) (void)xb_add(&bar[XB_XCNT(b.x)], 1u);
    return b;
}
__device__ __forceinline__ void xcd_barrier_complete(unsigned* bar, unsigned x, unsigned& nloc, unsigned& nx) {
    const unsigned G = gridDim.x * gridDim.y * gridDim.z;
    unsigned sum, cnt, mine, sp = 0u;
    for (;;) {
        sum = 0u; cnt = 0u; mine = 0u;
#pragma unroll
        for (unsigned j = 0; j < 16; ++j) { const unsigned c = xb_ld(&bar[XB_XCNT(j)]); sum += c; cnt += (c > 0u) ? 1u : 0u; mine = (j == x) ? c : mine; }
        if (sum == G) break;
        __builtin_amdgcn_s_sleep(1);
        if ((++sp & 255u) == 0u) { if (xb_ld(&bar[XB_TMO])) break; if (sp > XB_SPIN_CAP) { atomicAdd(&bar[XB_TMO], 1u); break; } }
    }
    nloc = mine > 0u ? mine : 1u; nx = cnt > 0u ? cnt : 1u;
}

__device__ __forceinline__ void xcd_barrier(const XcdBarrier& b) {
    asm volatile("s_waitcnt vmcnt(0)" ::: "memory");
    __syncthreads();
    if (threadIdx.x == 0) {
        unsigned* bar = b.bar;
        __builtin_amdgcn_s_waitcnt(0);
        unsigned nloc = b.st[0], nx = b.st[1];
        if (nloc == 0u) { xcd_barrier_complete(bar, b.x, nloc, nx); b.st[0] = nloc; b.st[1] = nx; }
        const unsigned old = xb_add(&bar[XB_XSUB(b.x)], 1u);
        const unsigned gen = old / nloc;
        if (old + 1u == (gen + 1u) * nloc) {
            __builtin_amdgcn_fence(__ATOMIC_RELEASE, "agent");
            asm volatile("s_waitcnt vmcnt(0)" ::: "memory");
            const unsigned og = xb_add(&bar[XB_TOP], 1u);
            const unsigned tg = og / nx;
            if (og + 1u == (tg + 1u) * nx) xb_add(&bar[XB_TOPGEN], 1u);
            else XB_SPIN(xb_ld(&bar[XB_TOPGEN]) == tg, bar);
            __builtin_amdgcn_fence(__ATOMIC_ACQUIRE, "agent");
            xb_add(&bar[XB_XGEN(b.x)], 1u);
            asm volatile("s_waitcnt vmcnt(0)" ::: "memory");
        } else {
            XB_SPIN(xb_ld(&bar[XB_XGEN(b.x)]) == gen, bar);
            __builtin_amdgcn_fence(__ATOMIC_ACQUIRE, "agent");
            asm volatile("s_waitcnt vmcnt(0)" ::: "memory");
        }
    }
    __syncthreads();
}

DI void sincos_red(float ang, float& s, float& c) {
    const float n = rintf(ang * 0.15915494309189535f); float r = fmaf(-n, 6.28318548202514648f, ang); r = fmaf(-n, -1.7484555e-7f, r);
    s = __sinf(r); c = __cosf(r);
}

typedef short s16x4 __attribute__((ext_vector_type(4)));
DI s16x4 lds_tr(const bf16* p) { return __builtin_amdgcn_ds_read_tr16_b64_v4i16((__attribute__((address_space(3))) s16x4*)p); }
DI bf16x8 frag_tr(const bf16* base, int ld, int r0, int k0, int lane) {
    const bf16* p = base + (k0 + 8 * (lane >> 4) + ((lane & 15) >> 2)) * ld + r0 + 4 * (lane & 3);
    const s16x4 lo = lds_tr(p), hi = lds_tr(p + 4 * ld);
    return (bf16x8){lo[0], lo[1], lo[2], lo[3], hi[0], hi[1], hi[2], hi[3]};
}
DI bf16x8 frag_tr_perm(const bf16* base, int ld, int r0, int k0, int lane) {
    const bf16* p = base + (k0 + 4 * (lane >> 4) + ((lane & 15) >> 2)) * ld + r0 + 4 * (lane & 3);
    const s16x4 lo = lds_tr(p), hi = lds_tr(p + 16 * ld);
    return (bf16x8){lo[0], lo[1], lo[2], lo[3], hi[0], hi[1], hi[2], hi[3]};
}
constexpr int QK_QIN = 0, QK_KIN = 9216, QK_QC = 18432, QK_KST = 27648, QK_VT = 36864, QK_GKL = 55296, QK_INV = 59392, QK_ST = 64512, QK_CUM = 82944, QK_TOT = 99328, QK_RED = 101376, QK_ELAST = 103424;
#if defined(TPROBE) && defined(QTS_SEL)
#define QTS_ON() (((QTS_SEL) & 1) == (GLA ? 1 : 0) && (((QTS_SEL) >> 1) == (full ? 0 : 1)))
#define QTS_BEGIN() do { if (QTS_ON() && threadIdx.x == 0) TS_BASE(lds)[13] = (unsigned)__builtin_amdgcn_s_memrealtime(); } while (0)
#define QTS_MARK(k) do { if (QTS_ON() && threadIdx.x == 0) { const unsigned t_ = (unsigned)__builtin_amdgcn_s_memrealtime(); volatile unsigned* A_ = TS_BASE(lds); A_[k] += t_ - A_[13]; A_[13] = t_; } } while (0)
#else
#define QTS_BEGIN() do {} while (0)
#define QTS_MARK(k) do {} while (0)
#endif
template <bool GLA>
DI void qkv_item(const Params& p, int l, unsigned char* lds, int b, int h, int sc, bool full, bool dry = false) {
    QTS_BEGIN();
    const int tid = opaque_tid(), lane = tid & 63, w = tid >> 6, q4 = lane >> 4, l15 = lane & 15;
    bf16* P = (bf16*)(p.ws + WS_P);
    bf16* QIN = (bf16*)(lds + QK_QIN); bf16* KIN = (bf16*)(lds + QK_KIN); bf16* QC = (bf16*)(lds + QK_QC); bf16* KST = (bf16*)(lds + QK_KST);
    bf16* VT = (bf16*)(lds + QK_VT); bf16* ST = (bf16*)(lds + QK_ST);
    float* GKL = (float*)(lds + QK_GKL); float* INV = (float*)(lds + QK_INV);
    float* CUM = (float*)(lds + QK_CUM); float* TOT = (float*)(lds + QK_TOT); float* RED = (float*)(lds + QK_RED); float* ELAST = (float*)(lds + QK_ELAST);
    const int cq = GLA ? C_GQ : C_RQ, ck = GLA ? C_GK : C_RK, cv = GLA ? C_GV : C_RV, cgate = GLA ? C_GG : C_RG;
    const int bh = b * 4 + h;
    float* Lst = (float*)(p.ws + (GLA ? WS_GLAL : WS_RETL)) + (size_t)(bh * 16 + sc) * 8192;
    const float lgam = __logf(1.0f - exp2f(-5.0f - (float)h));
    const int st_t = tid >> 3, st_cg = tid & 7;
    f32x4 sacc[4];
#pragma unroll
    for (int mt = 0; mt < 4; ++mt) {
        if (full) { for (int j = 0; j < 4; ++j) sacc[mt][j] = Lst[(16 * mt + 4 * q4 + j) * 128 + 16 * w + l15]; *(u32x2*)(ST + (16 * w + l15) * 72 + 16 * mt + 4 * q4) = pack4(sacc[mt]); }
        else sacc[mt] = (f32x4){0.f, 0.f, 0.f, 0.f};
    }
    f32x4 gng = (f32x4){1.f, 1.f, 1.f, 1.f}; if (GLA) gng = *(const f32x4*)(p.in[I_GNORMG] + l * 128 + 16 * w + 4 * q4);
    float w2c[16], gb = 0.f;
    if (GLA) { const int ch = h * 64 + lane;
#pragma unroll
        for (int j = 0; j < 16; ++j) w2c[j] = p.in[I_GKW2][(size_t)l * 16 * 256 + j * 256 + ch];
        gb = p.in[I_GKB][l * 256 + ch]; }
    else if (tid < 32) INV[tid] = 1.0f / powf(10000.0f, (float)tid * (1.0f / 31.0f));
    u32x4 pq, pk, pv0, pv1, pg = (u32x4){0u, 0u, 0u, 0u}; int ipos = 0;
    {   const size_t ro = (size_t)(b * T + sc * 256 + st_t) * LDP;
        pq = *(const u32x4*)(P + ro + cq + h * 64 + 8 * st_cg); pk = *(const u32x4*)(P + ro + ck + h * 64 + 8 * st_cg);
        pv0 = *(const u32x4*)(P + ro + cv + h * 128 + 8 * st_cg); pv1 = *(const u32x4*)(P + ro + cv + h * 128 + 64 + 8 * st_cg);
        if (GLA) { if (st_cg < 2) { float g8[8]; unpack8(*(const u32x4*)(P + ro + C_GKL + 8 * st_cg), g8);
                *(f32x4*)(GKL + st_t * 16 + 8 * st_cg) = (f32x4){g8[0], g8[1], g8[2], g8[3]}; *(f32x4*)(GKL + st_t * 16 + 8 * st_cg + 4) = (f32x4){g8[4], g8[5], g8[6], g8[7]}; } }
        else ipos = ((const int*)p.in[I_POS])[b * T + sc * 256 + st_t]; }
    __syncthreads();
    QTS_MARK(4);
    float dtot = 0.f;
    for (int c = 0; c < 4; ++c) {
        const int t0 = sc * 256 + c * 64, m0 = b * T + t0;
        if (GLA) {
            float cumv[8]; float run = 0.f;
#pragma unroll
            for (int i = 0; i < 8; ++i) { const float* gp = GKL + (8 * w + i) * 16; float x = gb;
#pragma unroll
                for (int j4 = 0; j4 < 4; ++j4) { const f32x4 g = *(const f32x4*)(gp + 4 * j4); x += g[0] * w2c[4 * j4] + g[1] * w2c[4 * j4 + 1] + g[2] * w2c[4 * j4 + 2] + g[3] * w2c[4 * j4 + 3]; }
                run += logsigmoidf_(x) * (1.0f / 16.0f); cumv[i] = run; }
            TOT[w * 64 + lane] = run;
            __syncthreads();
            float off = 0.f;
            for (int ww = 0; ww < w; ++ww) off += TOT[ww * 64 + lane];
#pragma unroll
            for (int i = 0; i < 8; ++i) CUM[(8 * w + i) * 64 + lane] = cumv[i] + off;
            __syncthreads();
            QTS_MARK(0);
        }
        {
            const int t = st_t, cg = st_cg;
            float qf[8], kf[8]; unpack8(pq, qf); unpack8(pk, kf);
            float fqin[8], fkin[8], fqc[8], fkst[8];
            if (GLA) {
#pragma unroll
                for (int i = 0; i < 8; ++i) { const float cu = CUM[t * 64 + 8 * cg + i], rf = CUM[32 * 64 + 8 * cg + i], la = CUM[63 * 64 + 8 * cg + i];
                    qf[i] *= 0.125f; fqin[i] = fexp(cu - rf); fkin[i] = fexp(rf - cu); fqc[i] = fexp(cu); fkst[i] = fexp(la - cu); }
            } else {
                const float ppos = (float)ipos;
#pragma unroll
                for (int i = 0; i < 4; ++i) { float sn, cs; sincos_red(ppos * INV[4 * cg + i], sn, cs);
                    const float q1 = qf[2 * i], q2 = qf[2 * i + 1], k1 = kf[2 * i], k2 = kf[2 * i + 1];
                    qf[2 * i] = q1 * cs - q2 * sn; qf[2 * i + 1] = q2 * cs + q1 * sn;
                    kf[2 * i] = (k1 * cs - k2 * sn) * 0.125f; kf[2 * i + 1] = (k2 * cs + k1 * sn) * 0.125f; }
                const float e = (float)(t + 1); const float a = fexp((e - 33.0f) * lgam), bq = fexp((33.0f - e) * lgam), cc = fexp(e * lgam), dd = fexp((64.0f - e) * lgam);
#pragma unroll
                for (int i = 0; i < 8; ++i) { fqin[i] = a; fkin[i] = bq; fqc[i] = cc; fkst[i] = dd; }
            }
            if (full) { float o1[8], o2[8], o3[8];
#pragma unroll
                for (int i = 0; i < 8; ++i) { o1[i] = qf[i] * fqin[i]; o2[i] = qf[i] * fqc[i]; o3[i] = kf[i] * fkin[i]; }
                *(u32x4*)(QIN + t * 72 + 8 * cg) = pack8(o1); *(u32x4*)(QC + t * 72 + 8 * cg) = pack8(o2); *(u32x4*)(KIN + t * 72 + 8 * cg) = pack8(o3); }
            { float o4[8];
#pragma unroll
              for (int i = 0; i < 8; ++i) o4[i] = kf[i] * fkst[i];
              *(u32x4*)(KST + t * 72 + 8 * cg) = pack8(o4); }
            *(u32x4*)(VT + t * 136 + 8 * cg) = pv0; *(u32x4*)(VT + t * 136 + 64 + 8 * cg) = pv1;
            if (tid < 64) { const float la = GLA ? CUM[63 * 64 + tid] : 64.0f * lgam; ELAST[tid] = fexp(la); dtot += la; }
            if (c < 3) {
                const size_t ro = (size_t)(m0 + 64 + t) * LDP;
                pq = *(const u32x4*)(P + ro + cq + h * 64 + 8 * cg); pk = *(const u32x4*)(P + ro + ck + h * 64 + 8 * cg);
                pv0 = *(const u32x4*)(P + ro + cv + h * 128 + 8 * cg); pv1 = *(const u32x4*)(P + ro + cv + h * 128 + 64 + 8 * cg);
                if (GLA) pg = *(const u32x4*)(P + ro + C_GKL + 8 * (cg & 1));
                else ipos = ((const int*)p.in[I_POS])[b * T + t0 + 64 + t]; }
        }
        __syncthreads();
        QTS_MARK(1);
        if (full) {
            u32x2 g2[4];
#pragma unroll
            for (int tt = 0; tt < 4; ++tt) g2[tt] = *(const u32x2*)(P + (size_t)(m0 + 16 * tt + l15) * LDP + cgate + h * 128 + 16 * w + 4 * q4);
            f32x4 oacc[4];
#pragma unroll
            for (int tt = 0; tt < 4; ++tt) {
                oacc[tt] = (f32x4){0.f, 0.f, 0.f, 0.f};
#pragma unroll
                for (int kk = 0; kk < 2; ++kk) oacc[tt] = mfma16(frag(ST, 72, 16 * w, 32 * kk, lane), frag(QC, 72, 16 * tt, 32 * kk, lane), oacc[tt]);
                const bf16x8 qa = frag(QIN, 72, 16 * tt, 0, lane), qb = frag(QIN, 72, 16 * tt, 32, lane);
                u32x2 pp[4];
#pragma unroll
                for (int st = 0; st < 4; ++st) {
                    if (st <= tt) { f32x4 a = (f32x4){0.f, 0.f, 0.f, 0.f};
                        a = mfma16(frag(KIN, 72, 16 * st, 0, lane), qa, a); a = mfma16(frag(KIN, 72, 16 * st, 32, lane), qb, a);
                        if (st == tt) {
#pragma unroll
                            for (int j = 0; j < 4; ++j) if (4 * q4 + j > l15) a[j] = 0.f; }
                        pp[st] = pack4(a); }
                    else pp[st] = (u32x2){0u, 0u}; }
#pragma unroll
                for (int kk2 = 0; kk2 < 2; ++kk2) { if (2 * kk2 <= tt) {
                        u32x4 pw; pw.x = pp[2 * kk2].x; pw.y = pp[2 * kk2].y; pw.z = pp[2 * kk2 + 1].x; pw.w = pp[2 * kk2 + 1].y;
                        oacc[tt] = mfma16(frag_tr_perm(VT, 136, 16 * w, 32 * kk2, lane), __builtin_bit_cast(bf16x8, pw), oacc[tt]); } }
                float ss = (oacc[tt][0] * oacc[tt][0] + oacc[tt][1] * oacc[tt][1]) + (oacc[tt][2] * oacc[tt][2] + oacc[tt][3] * oacc[tt][3]);
                ss += __shfl_xor(ss, 16); ss += __shfl_xor(ss, 32);
                if (q4 == 0) RED[(16 * tt + l15) * 8 + w] = ss; }
            __syncthreads();
            QTS_MARK(2);
#pragma unroll
            for (int tt = 0; tt < 4; ++tt) { const f32x4 r0 = *(const f32x4*)(RED + (16 * tt + l15) * 8), r1 = *(const f32x4*)(RED + (16 * tt + l15) * 8 + 4);
                const float rstd = __builtin_amdgcn_rsqf(((r0[0] + r0[1]) + (r0[2] + r0[3]) + (r1[0] + r1[1]) + (r1[2] + r1[3])) * (1.0f / 128.0f) + 1e-6f);
                bf16* gp = P + (size_t)(m0 + 16 * tt + l15) * LDP + cgate + h * 128 + 16 * w + 4 * q4;
                const float g[4] = {lo16(g2[tt].x), hi16(g2[tt].x), lo16(g2[tt].y), hi16(g2[tt].y)};
                f32x4 o;
#pragma unroll
                for (int j = 0; j < 4; ++j) { float v = oacc[tt][j] * rstd; if (GLA) v *= gng[j]; o[j] = v * siluf_(g[j]); }
                if (!dry) *(u32x2*)gp = pack4(o); }
        }
#pragma unroll
        for (int mt = 0; mt < 4; ++mt) {
            const f32x4 el = *(const f32x4*)(ELAST + 16 * mt + 4 * q4);
            sacc[mt] = sacc[mt] * el;
#pragma unroll
            for (int kk = 0; kk < 2; ++kk) sacc[mt] = mfma16(frag_tr(KST, 72, 16 * mt, 32 * kk, lane), frag_tr(VT, 136, 16 * w, 32 * kk, lane), sacc[mt]);
            if (full) *(u32x2*)(ST + (16 * w + l15) * 72 + 16 * mt + 4 * q4) = pack4(sacc[mt]);
        }
        if (GLA && c < 3 && st_cg < 2) { float g8[8]; unpack8(pg, g8);
            *(f32x4*)(GKL + st_t * 16 + 8 * st_cg) = (f32x4){g8[0], g8[1], g8[2], g8[3]}; *(f32x4*)(GKL + st_t * 16 + 8 * st_cg + 4) = (f32x4){g8[4], g8[5], g8[6], g8[7]}; }
        __syncthreads();
        QTS_MARK(3);
    }
    if (!full) {
#pragma unroll
        for (int mt = 0; mt < 4; ++mt)
#pragma unroll
            for (int j = 0; j < 4; ++j) Lst[(16 * mt + 4 * q4 + j) * 128 + 16 * w + l15] = sacc[mt][j];
        if (GLA && tid < 64) ((float*)(p.ws + WS_DG))[(bh * 16 + sc) * 64 + tid] = fexp(dtot);
    }
}

constexpr int SD_CS = 0, SD_BS = 17408, SD_BT = 34816, SD_XT = 53248, SD_XST = 62464, SD_PS = 71680, SD_ST = 80896, SD_DT = 98304, SD_CUM = 98560, SD_RED = 98816, SD_CW = 99840;
DI void conv8(const Params& p, int l, const bf16* P, int b, int tpos, int ch, float* y) {
    const float* cw = p.in[I_CONVW] + (size_t)l * 4 * 1024; const float* cb = p.in[I_CONVB] + l * 1024;
    const f32x4 b0 = *(const f32x4*)(cb + ch), b1 = *(const f32x4*)(cb + ch + 4);
    float acc[8] = {b0[0], b0[1], b0[2], b0[3], b1[0], b1[1], b1[2], b1[3]};
#pragma unroll
    for (int j = 0; j < 4; ++j) { const int tp = tpos - 3 + j;
        if (tp >= 0) { float x[8]; unpack8(*(const u32x4*)(P + (size_t)(b * T + tp) * LDP + C_SX + ch), x);
            const f32x4 w0 = *(const f32x4*)(cw + j * 1024 + ch), w1 = *(const f32x4*)(cw + j * 1024 + ch + 4);
            acc[0] += w0[0] * x[0]; acc[1] += w0[1] * x[1]; acc[2] += w0[2] * x[2]; acc[3] += w0[3] * x[3];
            acc[4] += w1[0] * x[4]; acc[5] += w1[1] * x[5]; acc[6] += w1[2] * x[6]; acc[7] += w1[3] * x[7]; } }
#pragma unroll
    for (int i = 0; i < 8; ++i) y[i] = siluf_(acc[i]);
}
DI void conv_rows(const bf16* P, int b, int tpos, int ch, u32x4 (&xr)[7]) {
#pragma unroll
    for (int r = 0; r < 7; ++r) { const int tp = tpos - 3 + r; xr[r] = *(const u32x4*)(P + (size_t)(b * T + (tp < 0 ? 0 : tp)) * LDP + C_SX + ch); }
}
DI void conv_apply(const float* cwl, int lc, const u32x4 (&xr)[7], int tpos, float (&y)[4][8]) {
    { const f32x4 b0 = *(const f32x4*)(cwl + 4 * 320 + lc), b1 = *(const f32x4*)(cwl + 4 * 320 + lc + 4);
#pragma unroll
        for (int o = 0; o < 4; ++o) { y[o][0] = b0[0]; y[o][1] = b0[1]; y[o][2] = b0[2]; y[o][3] = b0[3]; y[o][4] = b1[0]; y[o][5] = b1[1]; y[o][6] = b1[2]; y[o][7] = b1[3]; } }
#pragma unroll
    for (int j = 0; j < 4; ++j) { const f32x4 w0 = *(const f32x4*)(cwl + j * 320 + lc), w1 = *(const f32x4*)(cwl + j * 320 + lc + 4);
        const float wv[8] = {w0[0], w0[1], w0[2], w0[3], w1[0], w1[1], w1[2], w1[3]};
#pragma unroll
        for (int o = 0; o < 4; ++o) { float x[8]; unpack8(xr[o + j], x);
            if (tpos - 3 + o + j < 0) {
#pragma unroll
                for (int i = 0; i < 8; ++i) x[i] = 0.f; }
#pragma unroll
            for (int i = 0; i < 8; ++i) y[o][i] += wv[i] * x[i]; } }
#pragma unroll
    for (int o = 0; o < 4; ++o)
#pragma unroll
        for (int i = 0; i < 8; i += 2) { const f32x2 v = {y[o][i], y[o][i + 1]}; const f32x2 r = v * sig_pk(v); y[o][i] = r.x; y[o][i + 1] = r.y; }
}
DI void ssd_item(const Params& p, int l, unsigned char* lds, int b, int h, int sc, bool full, bool dry = false) {
    const int tid = opaque_tid(), lane = tid & 63, w = tid >> 6, q4 = lane >> 4, l15 = lane & 15;
    bf16* P = (bf16*)(p.ws + WS_P);
    bf16* CS = (bf16*)(lds + SD_CS); bf16* BS = (bf16*)(lds + SD_BS); bf16* XT = (bf16*)(lds + SD_XT); bf16* XST = (bf16*)(lds + SD_XST);
    bf16* ST = (bf16*)(lds + SD_ST);
    float* DTL = (float*)(lds + SD_DT); float* CUMS = (float*)(lds + SD_CUM); float* RED = (float*)(lds + SD_RED);
    const int g = h >> 2, bh = b * 8 + h;
    float* Lst = (float*)(p.ws + WS_SSDL) + (size_t)(bh * 16 + sc) * 8192;
    const float a_h = -fexp(p.in[I_ALOG][l * 8 + h]), dtb = p.in[I_DTB][l * 8 + h], dsk = p.in[I_SD][l * 8 + h];
    const int pt = w & 3, wh = w >> 2;
    const f32x4 sng = *(const f32x4*)(p.in[I_SNORMG] + l * 512 + h * 64 + 16 * pt + 4 * q4);
    const int r_cgi = tid & 31, r_seg = tid >> 5; const bool r_isB = r_cgi >= 16; const int r_cg = r_cgi & 15;
    const int r_ch = (r_isB ? 512 : 768) + g * 128 + 8 * r_cg, r_lc = (r_isB ? 128 : 0) + 8 * r_cg;
    f32x4 sacc[4];
#pragma unroll
    for (int i = 0; i < 4; ++i) { const int nt = 4 * wh + i;
        if (full) { for (int j = 0; j < 4; ++j) sacc[i][j] = Lst[(16 * nt + 4 * q4 + j) * 64 + 16 * pt + l15]; *(u32x2*)(ST + (16 * pt + l15) * 136 + 16 * nt + 4 * q4) = pack4(sacc[i]); }
        else sacc[i] = (f32x4){0.f, 0.f, 0.f, 0.f}; }
    float* CWL = (float*)(lds + SD_CW);
    {
        float cwv[4];
#pragma unroll
        for (int r4 = 0; r4 < 4; ++r4) { const int idx0 = tid + r4 * NTHREADS, idx = idx0 < 1600 ? idx0 : 1599; const int row = idx / 320, ci = idx - row * 320;
            const int gch = ci < 128 ? 768 + g * 128 + ci : ci < 256 ? 512 + g * 128 + (ci - 128) : h * 64 + (ci - 256);
            const float* src = row < 4 ? p.in[I_CONVW] + (size_t)l * 4096 + row * 1024 + gch : p.in[I_CONVB] + l * 1024 + gch;
            cwv[r4] = *src; }
#pragma unroll
        for (int r4 = 0; r4 < 4; ++r4) { const int idx0 = tid + r4 * NTHREADS; if (idx0 < 1600) CWL[idx0] = cwv[r4]; }
    }
    u32x4 xbc[7]; conv_rows(P, b, sc * 256 + 4 * r_seg, r_ch, xbc);
    unsigned dtraw = (unsigned)P[(size_t)(b * T + sc * 256 + lane) * LDP + C_SDT + h];
    float ltot = 0.f;
    for (int c = 0; c < 4; ++c) {
        const int t0 = sc * 256 + c * 64, m0 = b * T + t0;
        if (w == 0) {
            const float dt = softplusf_(bf2f(dtraw) + dtb); float cu = dt * a_h;
#pragma unroll
            for (int o = 1; o < 64; o <<= 1) { const float n = __shfl_up(cu, o); if (lane >= o) cu += n; }
            DTL[lane] = dt; CUMS[lane] = cu;
        }
        if (c < 3) dtraw = (unsigned)P[(size_t)(m0 + 64 + lane) * LDP + C_SDT + h];
        __syncthreads();
        const float clast = CUMS[63];
        ltot += clast;
        {
            u32x4 xx[7];
            conv_rows(P, b, t0 + 4 * ((tid & 127) >> 3), h * 64 + 8 * (tid & 7), xx);
            { float y[4][8]; conv_apply(CWL, r_lc, xbc, t0 + 4 * r_seg, y);
#pragma unroll
                for (int o = 0; o < 4; ++o) { const int t = 4 * r_seg + o; *(u32x4*)((r_isB ? BS : CS) + t * 136 + 8 * r_cg) = pack8(y[o]); }
            }
            if (tid < 128) { const int cg = tid & 7, seg = tid >> 3; float y[4][8]; conv_apply(CWL, 256 + 8 * cg, xx, t0 + 4 * seg, y);
                float coef[4];
#pragma unroll
                for (int o = 0; o < 4; ++o) coef[o] = fexp(clast - CUMS[4 * seg + o]) * DTL[4 * seg + o];
#pragma unroll
                for (int o = 0; o < 4; ++o) { float ys[8];
#pragma unroll
                    for (int i = 0; i < 8; ++i) ys[i] = y[o][i] * coef[o];
                    *(u32x4*)(XT + (4 * seg + o) * 72 + 8 * cg) = pack8(y[o]); *(u32x4*)(XST + (4 * seg + o) * 72 + 8 * cg) = pack8(ys); } }
            if (c < 3) conv_rows(P, b, t0 + 64 + 4 * r_seg, r_ch, xbc);
        }
        __syncthreads();
        if (full) {
#pragma unroll
            for (int i = 0; i < 2; ++i) { const int tt = 2 * wh + i, t = 16 * tt + l15;
                bf16* zp = P + (size_t)(m0 + t) * LDP + C_SZ + h * 64 + 16 * pt + 4 * q4;
                const u32x2 z2 = *(const u32x2*)zp;
                bf16x8 cf[4];
#pragma unroll
                for (int kk = 0; kk < 4; ++kk) cf[kk] = frag(CS, 136, 16 * tt, 32 * kk, lane);
                f32x4 oacc = (f32x4){0.f, 0.f, 0.f, 0.f};
#pragma unroll
                for (int kk = 0; kk < 4; ++kk) oacc = mfma16(frag(ST, 136, 16 * pt, 32 * kk, lane), cf[kk], oacc);
                const float ct = CUMS[t];
                oacc = oacc * fexp(ct);
                u32x2 pp[4];
#pragma unroll
                for (int st = 0; st < 4; ++st) {
                    if (st <= tt) { f32x4 a = (f32x4){0.f, 0.f, 0.f, 0.f};
#pragma unroll
                        for (int kk = 0; kk < 4; ++kk) a = mfma16(frag(BS, 136, 16 * st, 32 * kk, lane), cf[kk], a);
                        const f32x4 cs4 = *(const f32x4*)(CUMS + 16 * st + 4 * q4), dt4 = *(const f32x4*)(DTL + 16 * st + 4 * q4);
#pragma unroll
                        for (int j = 0; j < 4; ++j) a[j] = (16 * st + 4 * q4 + j <= t) ? a[j] * fexp(ct - cs4[j]) * dt4[j] : 0.f;
                        pp[st] = pack4(a); }
                    else pp[st] = (u32x2){0u, 0u}; }
#pragma unroll
                for (int kk2 = 0; kk2 < 2; ++kk2) { if (2 * kk2 <= tt) {
                        u32x4 pw; pw.x = pp[2 * kk2].x; pw.y = pp[2 * kk2].y; pw.z = pp[2 * kk2 + 1].x; pw.w = pp[2 * kk2 + 1].y;
                        oacc = mfma16(frag_tr_perm(XT, 72, 16 * pt, 32 * kk2, lane), __builtin_bit_cast(bf16x8, pw), oacc); } }
                const float z[4] = {lo16(z2.x), hi16(z2.x), lo16(z2.y), hi16(z2.y)};
                f32x4 o; float ss = 0.f;
                const u32x2 xv2 = *(const u32x2*)(XT + t * 72 + 16 * pt + 4 * q4); const float xvv[4] = {lo16(xv2.x), hi16(xv2.x), lo16(xv2.y), hi16(xv2.y)};
#pragma unroll
                for (int j = 0; j < 4; ++j) { const float xv = xvv[j]; const float v = (oacc[j] + dsk * xv) * siluf_(z[j]); ss += v * v;
                    o[j] = v * sng[j]; }
                if (!dry) *(u32x2*)zp = pack4(o);
                ss += __shfl_xor(ss, 16); ss += __shfl_xor(ss, 32);
                if (q4 == 0) RED[t * 4 + pt] = ss; }
        }
        const float el = fexp(clast);
#pragma unroll
        for (int i = 0; i < 4; ++i) { const int nt = 4 * wh + i;
            sacc[i] = sacc[i] * el;
#pragma unroll
            for (int kk = 0; kk < 2; ++kk) sacc[i] = mfma16(frag_tr(BS, 136, 16 * nt, 32 * kk, lane), frag_tr(XST, 72, 16 * pt, 32 * kk, lane), sacc[i]);
            if (full) *(u32x2*)(ST + (16 * pt + l15) * 136 + 16 * nt + 4 * q4) = pack4(sacc[i]); }
        __syncthreads();
        if (full && tid < 64) { const f32x4 r = *(const f32x4*)(RED + tid * 4); ((float*)(p.ws + WS_SSQ))[(size_t)(m0 + tid) * 8 + h] = (r[0] + r[1]) + (r[2] + r[3]); }
    }
    if (!full) {
#pragma unroll
        for (int i = 0; i < 4; ++i)
#pragma unroll
            for (int j = 0; j < 4; ++j) Lst[(16 * (4 * wh + i) + 4 * q4 + j) * 64 + 16 * pt + l15] = sacc[i][j];
        if (tid == 0) ((float*)(p.ws + WS_DS))[bh * 16 + sc] = fexp(ltot);
    }
}

DI void phase_scan(const Params& p, int vb, int nb, bool dry = false) {
    const int gt = vb * NTHREADS + opaque_tid(), NT = nb * NTHREADS;
    for (int idx0 = gt; idx0 < 4 * 131072; idx0 += 2 * NT) {
        float lv[2][16], dv[2][16]; float* Lp[2]; bool ok[2];
#pragma unroll
        for (int e = 0; e < 2; ++e) { const int idx = idx0 + e * NT; ok[e] = idx < 4 * 131072; const int which = idx >> 17, r = idx & 131071;
            float* L = nullptr; const float* dec = nullptr; int dstride = 0; float cdec = 0.f;
            if (ok[e]) {
                if (which == 0) { const int bh = r >> 13, el = r & 8191; L = (float*)(p.ws + WS_RETL) + (size_t)bh * 16 * 8192 + el; cdec = fexp(256.0f * __logf(1.0f - exp2f(-5.0f - (float)(bh & 3)))); }
                else if (which == 1) { const int bh = r >> 13, el = r & 8191; L = (float*)(p.ws + WS_GLAL) + (size_t)bh * 16 * 8192 + el; dec = (const float*)(p.ws + WS_DG) + bh * 16 * 64 + (el >> 7); dstride = 64; }
                else { const int rr = (which - 2) * 131072 + r, bh = rr >> 13, el = rr & 8191; L = (float*)(p.ws + WS_SSDL) + (size_t)bh * 16 * 8192 + el; dec = (const float*)(p.ws + WS_DS) + bh * 16; dstride = 1; } }
            Lp[e] = L;
#pragma unroll
            for (int sc = 0; sc < 16; ++sc) { lv[e][sc] = ok[e] ? L[(size_t)sc * 8192] : 0.f; dv[e][sc] = (ok[e] && dec) ? dec[sc * dstride] : cdec; } }
#pragma unroll
        for (int e = 0; e < 2; ++e) { float prev = 0.f;
#pragma unroll
            for (int sc = 0; sc < 16; ++sc) { if (ok[e] && !dry) Lp[e][(size_t)sc * 8192] = prev; prev = dv[e][sc] * prev + lv[e][sc]; } }
    }
}

DI void memkv_item(const Params& p, int l, int item) {
    const int tid = opaque_tid(), lane = tid & 63, w = tid >> 6, q4 = lane >> 4, l15 = lane & 15;
    const int rb = item >> 4, cb = item & 15;
    const bf16* A = (const bf16*)(p.ws + WS_MEMN) + (size_t)l * 1024 * 1024; const bf16* Bw = (const bf16*)(p.ws + WS_WKVT);
    const int r0 = 64 * rb + 16 * (w >> 1), c0 = 32 * cb + 16 * (w & 1); const bool isV = cb >= 8; const int hh = (c0 >> 6) & 3, dd = c0 & 63;
    f32x4 acc = (f32x4){0.f, 0.f, 0.f, 0.f};
#pragma unroll 1
    for (int k16 = 0; k16 < 32; k16 += 16) {
        bf16x8 fa[16], fb[16];
#pragma unroll
        for (int u = 0; u < 16; ++u) { fa[u] = frag(A, 1024, r0, 32 * (k16 + u), lane); fb[u] = frag(Bw, 1024, c0, 32 * (k16 + u), lane); }
#pragma unroll
        for (int u = 0; u < 16; ++u) acc = isV ? mfma16(fa[u], fb[u], acc) : mfma16(fb[u], fa[u], acc);
    }
    if (!isV) { const int m = r0 + l15, bb = m >> 8, mm = m & 255;
        *(u32x2*)((bf16*)(p.ws + WS_KM) + ((size_t)(bb * 4 + hh) * 256 + mm) * 64 + dd + 4 * q4) = pack4(acc); }
    else { const int m = r0 + 4 * q4, bb = m >> 8, mm = m & 255;
        *(u32x2*)((bf16*)(p.ws + WS_VMT) + ((size_t)(bb * 4 + hh) * 64 + dd + l15) * 256 + mm) = pack4(acc); }
}
constexpr int MA_K = 0, MA_VT = 36864;
DI void memattn_item(const Params& p, unsigned char* lds, int b, int h, int blk) {
    const int tid = opaque_tid(), lane = tid & 63, w = tid >> 6, q4 = lane >> 4, l15 = lane & 15;
    bf16* KS = (bf16*)(lds + MA_K); bf16* VS = (bf16*)(lds + MA_VT);
    const bf16* KM = (const bf16*)(p.ws + WS_KM) + (size_t)(b * 4 + h) * 256 * 64; const bf16* VM = (const bf16*)(p.ws + WS_VMT) + (size_t)(b * 4 + h) * 64 * 256;
    const bf16* P = (const bf16*)(p.ws + WS_P); bf16* OM = (bf16*)(p.ws + WS_OMEM);
#pragma unroll
    for (int r = 0; r < 4; ++r) { const int idx = tid + 512 * r;
        { const int m = idx >> 3, c8 = idx & 7; *(u32x4*)(KS + m * 72 + 8 * c8) = *(const u32x4*)(KM + m * 64 + 8 * c8); }
        { const int d = idx >> 5, c8 = idx & 31; *(u32x4*)(VS + d * 264 + 8 * c8) = *(const u32x4*)(VM + d * 256 + 8 * c8); } }
    __syncthreads();
    bf16x8 qn[2];
#pragma unroll
    for (int kk = 0; kk < 2; ++kk) qn[kk] = *(const bf16x8*)(P + (size_t)(b * T + blk * 256 + w * 16 + l15) * LDP + C_MQ + h * 64 + 32 * kk + 8 * q4);
    for (int rnd = 0; rnd < 2; ++rnd) {
        const int m0 = b * T + blk * 256 + rnd * 128 + w * 16;
        bf16x8 qf[2];
#pragma unroll
        for (int kk = 0; kk < 2; ++kk) { qf[kk] = qn[kk]; if (rnd == 0) qn[kk] = *(const bf16x8*)(P + (size_t)(m0 + 128 + l15) * LDP + C_MQ + h * 64 + 32 * kk + 8 * q4); }
        f32x4 s[16]; float mx = -3.0e38f;
#pragma unroll
        for (int mt = 0; mt < 16; ++mt) { s[mt] = (f32x4){0.f, 0.f, 0.f, 0.f};
#pragma unroll
            for (int kk = 0; kk < 2; ++kk) s[mt] = mfma16(frag(KS, 72, 16 * mt, 32 * kk, lane), qf[kk], s[mt]);
            s[mt] = s[mt] * 0.125f; mx = fmaxf(mx, fmaxf(fmaxf(s[mt][0], s[mt][1]), fmaxf(s[mt][2], s[mt][3]))); __builtin_amdgcn_sched_barrier(0); }
        mx = fmaxf(mx, __shfl_xor(mx, 16)); mx = fmaxf(mx, __shfl_xor(mx, 32));
        float sum = 0.f;
#pragma unroll
        for (int mt = 0; mt < 16; ++mt) {
#pragma unroll
            for (int j = 0; j < 4; ++j) { s[mt][j] = fexp(s[mt][j] - mx); sum += s[mt][j]; } }
        sum += __shfl_xor(sum, 16); sum += __shfl_xor(sum, 32);
        const float rs = __builtin_amdgcn_rcpf(sum);
        f32x4 o[4];
#pragma unroll
        for (int dt = 0; dt < 4; ++dt) o[dt] = (f32x4){0.f, 0.f, 0.f, 0.f};
#pragma unroll
        for (int k2 = 0; k2 < 8; ++k2) {
            u32x4 pw; pw.x = pk2(s[2 * k2][0], s[2 * k2][1]); pw.y = pk2(s[2 * k2][2], s[2 * k2][3]); pw.z = pk2(s[2 * k2 + 1][0], s[2 * k2 + 1][1]); pw.w = pk2(s[2 * k2 + 1][2], s[2 * k2 + 1][3]);
            const bf16x8 pf = __builtin_bit_cast(bf16x8, pw);
#pragma unroll
            for (int dt = 0; dt < 4; ++dt) { const bf16* vp = VS + (16 * dt + l15) * 264 + 32 * k2 + 4 * q4;
                const u32x2 v0 = *(const u32x2*)vp, v1 = *(const u32x2*)(vp + 16); u32x4 vw; vw.x = v0.x; vw.y = v0.y; vw.z = v1.x; vw.w = v1.y;
                o[dt] = mfma16(__builtin_bit_cast(bf16x8, vw), pf, o[dt]); }
            __builtin_amdgcn_sched_barrier(0); }
#pragma unroll
        for (int dt = 0; dt < 4; ++dt) *(u32x2*)(OM + (size_t)(m0 + l15) * 256 + h * 64 + 16 * dt + 4 * q4) = pack4(o[dt] * rs);
    }
    __syncthreads();
}

constexpr int RC_ARL = 0, RC_RRL = 9216, RC_BRL = 18432, RC_KRL = 27648, RC_XT = 0, RC_BHT = 36864, RC_KHT = 46080, RC_VT = 55296, RC_AAK = 64512, RC_LRB = 73728, RC_LRK = 82944,
              RC_AAB = 92160, RC_RHS = 108544, RC_WLAST = 141312, RC_TB = 141568,
              RC_TW = 64512, RC_ALS = 73728, RC_W2T = 82944, RC_A2T = 92160, RC_TOT = 101376, RC_CUM = 108544, RC_AICL = 124928;
#if defined(TPROBE) && !defined(QTS_SEL)
#define RW_STOP_AT(k) TS_MARK(k)
#define RW_TS_BEGIN() TS_BEGIN()
#define RW_TS_END() TS_MARK(7)
#else
#define RW_TS_BEGIN() do {} while (0)
#define RW_TS_END() do {} while (0)
#ifdef RW_STOP
#define RW_STOP_AT(k) do { if (dry && RW_STOP == (k)) return; } while (0)
#else
#define RW_STOP_AT(k) do {} while (0)
#endif
#endif
DI void rwkv_chunk_item(const Params& p, int l, unsigned char* lds, int b, int h, int c, bool dry = false) {
    const int tid = opaque_tid(), lane = tid & 63, w = tid >> 6, q4 = lane >> 4, l15 = lane & 15;
    bf16* P = (bf16*)(p.ws + WS_P);
    bf16* ARL = (bf16*)(lds + RC_ARL); bf16* RRL = (bf16*)(lds + RC_RRL); bf16* BRL = (bf16*)(lds + RC_BRL); bf16* KRL = (bf16*)(lds + RC_KRL); bf16* XT = (bf16*)(lds + RC_XT);
    bf16* BHT = (bf16*)(lds + RC_BHT); bf16* KHT = (bf16*)(lds + RC_KHT); bf16* VT = (bf16*)(lds + RC_VT); bf16* AAK = (bf16*)(lds + RC_AAK); bf16* LRB = (bf16*)(lds + RC_LRB); bf16* LRK = (bf16*)(lds + RC_LRK);
    float* AAB = (float*)(lds + RC_AAB); float* RHS = (float*)(lds + RC_RHS); float* WLAST = (float*)(lds + RC_WLAST); float* TB = (float*)(lds + RC_TB);
    bf16* TW = (bf16*)(lds + RC_TW); bf16* ALS = (bf16*)(lds + RC_ALS); bf16* W2T = (bf16*)(lds + RC_W2T); bf16* A2T = (bf16*)(lds + RC_A2T);
    float* TOT = (float*)(lds + RC_TOT); float* CUM = (float*)(lds + RC_CUM); float* AICL = (float*)(lds + RC_AICL);
    const float* mu = p.in[I_MU] + l * 1664;
    const int t0 = c * 64, m0 = b * T + t0;
    RW_TS_BEGIN();
    const int t_ = tid >> 3, cg = tid & 7, chh = h * 64 + 8 * cg;
    float xr[8], xk[8], xv[8];
    float pkk[8], pka[8], prk[8];
    { const f32x4 a0 = *(const f32x4*)(p.in[I_KK] + l * 512 + chh), a1 = *(const f32x4*)(p.in[I_KK] + l * 512 + chh + 4), b0 = *(const f32x4*)(p.in[I_KA] + l * 512 + chh), b1 = *(const f32x4*)(p.in[I_KA] + l * 512 + chh + 4),
          c0 = *(const f32x4*)(p.in[I_RK] + l * 512 + chh), c1 = *(const f32x4*)(p.in[I_RK] + l * 512 + chh + 4);
#pragma unroll
      for (int i = 0; i < 4; ++i) { pkk[i] = a0[i]; pkk[4 + i] = a1[i]; pka[i] = b0[i]; pka[4 + i] = b1[i]; prk[i] = c0[i]; prk[4 + i] = c1[i]; } }
    f32x4 pw0[4];
#pragma unroll
    for (int ct = 0; ct < 4; ++ct) pw0[ct] = *(const f32x4*)(p.in[(w >> 2) ? I_A0 : I_W0] + l * 512 + h * 64 + 16 * ct + 4 * q4);
    {
        { const int j = tid >> 3;
            const float* s2 = p.in[I_W2] + (size_t)l * 64 * 512 + j * 512 + chh; const float* sa = p.in[I_A2] + (size_t)l * 64 * 512 + j * 512 + chh;
#pragma unroll
            for (int i = 0; i < 8; ++i) { }
            *(u32x4*)(W2T + j * 72 + 8 * cg) = pack8(s2); *(u32x4*)(A2T + j * 72 + 8 * cg) = pack8(sa); }
        const size_t ro = (size_t)(m0 + t_) * LDP; const bool first = (t_ == 0);
        const bf16* prow = first ? (bf16*)(p.ws + WS_BND) + (size_t)(((m0) >> 6) - 1) * BND_W - 4608 : P + ro - LDP;
        const bool hp = (t0 + t_) > 0;
#pragma unroll
        for (int which = 0; which < 5; ++which) {
            const int col = which == 0 ? C_WR + chh : which == 1 ? C_WK + chh : which == 2 ? C_WV + chh : which == 3 ? C_WL + 8 * cg : C_AL + 8 * cg;
            const int mi = which == 0 ? chh : which == 1 ? 512 + chh : which == 2 ? 1024 + chh : which == 3 ? 1536 + 8 * cg : 1600 + 8 * cg;
            float cur[8], prv[8], xs[8];
            unpack8(*(const u32x4*)(P + ro + col), cur);
            unpack8(*(const u32x4*)((hp ? prow : P + ro) + col), prv);
            if (!hp) {
#pragma unroll
                for (int i = 0; i < 8; ++i) prv[i] = 0.f; }
#pragma unroll
            for (int i = 0; i < 8; ++i) xs[i] = cur[i] + (prv[i] - cur[i]) * mu[mi + i];
            if (which == 0) {
#pragma unroll
                for (int i = 0; i < 8; ++i) xr[i] = xs[i]; }
            else if (which == 1) {
#pragma unroll
                for (int i = 0; i < 8; ++i) xk[i] = xs[i]; }
            else if (which == 2) {
#pragma unroll
                for (int i = 0; i < 8; ++i) xv[i] = xs[i]; }
            else if (which == 3) { float tw[8];
#pragma unroll
                for (int i = 0; i < 8; ++i) tw[i] = tanhf_(xs[i]);
                *(u32x4*)(TW + t_ * 72 + 8 * cg) = pack8(tw); }
            else *(u32x4*)(ALS + t_ * 72 + 8 * cg) = pack8(xs);
        }
    }
    __syncthreads();
    RW_STOP_AT(0);
    {
        const int which = w >> 2, tt = w & 3; const bf16* Wm = which ? A2T : W2T; const bf16* Xm = which ? ALS : TW;
#pragma unroll
        for (int ct = 0; ct < 4; ++ct) { f32x4 a = (f32x4){0.f, 0.f, 0.f, 0.f};
#pragma unroll
            for (int kk = 0; kk < 2; ++kk) a = mfma16(frag_tr(Wm, 72, 16 * ct, 32 * kk, lane), frag(Xm, 72, 16 * tt, 32 * kk, lane), a);
            const int ch = 16 * ct + 4 * q4, t = 16 * tt + l15; f32x4 o;
            if (which == 0) { const f32x4 w0 = pw0[ct];
#pragma unroll
                for (int j = 0; j < 4; ++j) o[j] = -0.60653065971f * sigmoidf_(w0[j] + a[j]);
                *(f32x4*)(CUM + t * 64 + ch) = o; }
            else { const f32x4 a0 = pw0[ct];
#pragma unroll
                for (int j = 0; j < 4; ++j) o[j] = sigmoidf_(a0[j] + a[j]);
                *(f32x4*)(AICL + t * 64 + ch) = o; }
        }
    }
    __syncthreads();
    RW_STOP_AT(1);
    {
        float cumv[8]; float run = 0.f;
#pragma unroll
        for (int i = 0; i < 8; ++i) { run += CUM[(8 * w + i) * 64 + lane]; cumv[i] = run; }
        TOT[w * 64 + lane] = run;
        __syncthreads();
        float off = 0.f;
        for (int ww = 0; ww < w; ++ww) off += TOT[ww * 64 + lane];
#pragma unroll
        for (int i = 0; i < 8; ++i) CUM[(8 * w + i) * 64 + lane] = cumv[i] + off;
    }
    __syncthreads();
    RW_STOP_AT(2);
    float aabs[8];
    {
        float kk[8], ai[8], ss = 0.f;
#pragma unroll
        for (int i = 0; i < 8; ++i) { ai[i] = AICL[t_ * 64 + 8 * cg + i]; kk[i] = xk[i] * pkk[i]; ss += kk[i] * kk[i]; }
        ss += __shfl_xor(ss, 1); ss += __shfl_xor(ss, 2); ss += __shfl_xor(ss, 4);
        const float inv = __builtin_amdgcn_rsqf(fmaxf(ss, 1e-24f));
        float bon = 0.f, o_arl[8], o_rrl[8], o_brl[8], o_krl[8], o_rabs[8], o_bh[8], o_kh[8];
#pragma unroll
        for (int i = 0; i < 8; ++i) {
            const float kn = kk[i] * inv, av = -kn, bv = kn * ai[i], km = xk[i] * (1.0f + (ai[i] - 1.0f) * pka[i]);
            bon += xr[i] * km * prk[i];
            const int k = 8 * cg + i;
            const float cu = CUM[t_ * 64 + k], cx = t_ > 0 ? CUM[(t_ - 1) * 64 + k] : 0.f, rf = CUM[32 * 64 + k], la = CUM[63 * 64 + k];
            o_arl[i] = av * fexp(cx - rf); aabs[i] = av * fexp(cx);
            o_rrl[i] = xr[i] * fexp(cu - rf); o_rabs[i] = xr[i] * fexp(cu);
            const float eb = fexp(rf - cu), eh = fexp(la - cu);
            o_brl[i] = bv * eb; o_krl[i] = km * eb;
            o_bh[i] = bv * eh; o_kh[i] = km * eh;
        }
        bon += __shfl_xor(bon, 1); bon += __shfl_xor(bon, 2); bon += __shfl_xor(bon, 4);
        *(u32x4*)(ARL + t_ * 72 + 8 * cg) = pack8(o_arl); *(u32x4*)(RRL + t_ * 72 + 8 * cg) = pack8(o_rrl);
        *(u32x4*)(BRL + t_ * 72 + 8 * cg) = pack8(o_brl); *(u32x4*)(KRL + t_ * 72 + 8 * cg) = pack8(o_krl);
        *(u32x4*)(BHT + t_ * 72 + 8 * cg) = pack8(o_bh); *(u32x4*)(KHT + t_ * 72 + 8 * cg) = pack8(o_kh); *(u32x4*)(VT + t_ * 72 + 8 * cg) = pack8(xv);
        const size_t ro = (size_t)(m0 + t_) * LDP;
        if (!dry) *(u32x4*)(P + ro + C_WR + chh) = pack8(o_rabs);
        float bvv[8];
#pragma unroll
        for (int i = 0; i < 8; ++i) bvv[i] = bon * xv[i];
        if (!dry) *(u32x4*)(P + ro + C_WV + chh) = pack8(bvv);
        if (tid < 64) WLAST[tid] = fexp(CUM[63 * 64 + tid]);
    }
    __syncthreads();
    RW_STOP_AT(3);
    *(f32x4*)(RHS + t_ * 128 + 8 * cg) = (f32x4){aabs[0], aabs[1], aabs[2], aabs[3]}; *(f32x4*)(RHS + t_ * 128 + 8 * cg + 4) = (f32x4){aabs[4], aabs[5], aabs[6], aabs[7]};
    {
        const int prod = w >> 1, half = w & 1; const bf16* Lm = (prod < 2) ? ARL : RRL; const bf16* Rm = (prod & 1) ? KRL : BRL; const int strict = prod < 2 ? 1 : 0;
#pragma unroll
        for (int i8 = 0; i8 < 8; ++i8) { const int id = half * 8 + i8, tt = id >> 2, st = id & 3;
            f32x4 a = (f32x4){0.f, 0.f, 0.f, 0.f};
            if (st <= tt) {
#pragma unroll
                for (int kk = 0; kk < 2; ++kk) a = mfma16(frag(Rm, 72, 16 * st, 32 * kk, lane), frag(Lm, 72, 16 * tt, 32 * kk, lane), a);
                if (st == tt) {
#pragma unroll
                    for (int j = 0; j < 4; ++j) if (4 * q4 + j + strict > l15) a[j] = 0.f; }
            }
            if (prod == 0) *(f32x4*)(AAB + (16 * tt + l15) * 64 + 16 * st + 4 * q4) = a;
            else { bf16* O = prod == 1 ? AAK : prod == 2 ? LRB : LRK; *(u32x2*)(O + (16 * tt + l15) * 72 + 16 * st + 4 * q4) = pack4(a); }
        }
        if (prod == 0) {
            asm volatile("s_waitcnt lgkmcnt(0)" ::: "memory");
            const int bb = 2 * half + ((lane >> 4) & 1), cc = lane & 15; float x[16];
#pragma unroll
            for (int i = 0; i < 16; ++i) { float s0 = (i == cc) ? 1.0f : 0.0f;
#pragma unroll
                for (int s4 = 0; s4 < (i + 3) / 4; ++s4) { const f32x4 av = *(const f32x4*)(AAB + (16 * bb + i) * 64 + 16 * bb + 4 * s4);
#pragma unroll
                    for (int n = 0; n < 4; ++n) if (4 * s4 + n < i) s0 += av[n] * x[4 * s4 + n]; }
                x[i] = s0; if (lane < 32) TB[(bb * 16 + i) * 16 + cc] = s0; }
        }
    }
    __syncthreads();
    RW_STOP_AT(4);
    {
        f32x4 X[4];
#pragma unroll
        for (int bb = 0; bb < 4; ++bb) {
            f32x4 acc;
            if (w < 4) {
#pragma unroll
                for (int j = 0; j < 4; ++j) acc[j] = RHS[(16 * bb + 4 * q4 + j) * 128 + 16 * w + l15]; }
            else {
                acc = (f32x4){0.f, 0.f, 0.f, 0.f};
#pragma unroll
                for (int kk = 0; kk < 2; ++kk) acc = mfma16(frag(AAK, 72, 16 * bb, 32 * kk, lane), frag_tr(VT, 72, 16 * (w - 4), 32 * kk, lane), acc); }
#pragma unroll
            for (int bp = 0; bp < bb; ++bp) { const f32x4 a4 = *(const f32x4*)(AAB + (16 * bb + l15) * 64 + 16 * bp + 4 * q4);
#pragma unroll
                for (int j = 0; j < 4; ++j) acc = __builtin_amdgcn_mfma_f32_16x16x4f32(a4[j], X[bp][j], acc, 0, 0, 0); }
            const f32x4 t4 = *(const f32x4*)(TB + (bb * 16 + l15) * 16 + 4 * q4);
            f32x4 xb = (f32x4){0.f, 0.f, 0.f, 0.f};
#pragma unroll
            for (int j = 0; j < 4; ++j) xb = __builtin_amdgcn_mfma_f32_16x16x4f32(t4[j], acc[j], xb, 0, 0, 0);
            X[bb] = xb;
            *(u32x2*)(XT + (16 * w + l15) * 72 + 16 * bb + 4 * q4) = pack4(xb);
        }
    }
    __syncthreads();
    RW_STOP_AT(6);
    {
        const int prod = w >> 1, half = w & 1;
        bf16* GH = (bf16*)(p.ws + WS_RWGH) + ((size_t)((b * 8 + h) * 64 + c) * 2) * 4096;
#pragma unroll
        for (int i8 = 0; i8 < 8; ++i8) { const int id = half * 8 + i8, rt = id >> 2, ct = id & 3;
            f32x4 a = (f32x4){0.f, 0.f, 0.f, 0.f};
            if (prod == 0) {
#pragma unroll
                for (int kk = 0; kk < 2; ++kk) a = mfma16(frag(XT, 72, 16 * ct, 32 * kk, lane), frag(LRB, 72, 16 * rt, 32 * kk, lane), a);
                bf16* qp = P + (size_t)(m0 + 16 * rt + l15) * LDP + C_WR + h * 64 + 16 * ct + 4 * q4;
                const u32x2 r2 = *(const u32x2*)qp; a[0] += lo16(r2.x); a[1] += hi16(r2.x); a[2] += lo16(r2.y); a[3] += hi16(r2.y);
                if (!dry) *(u32x2*)qp = pack4(a);
            } else if (prod == 1) {
#pragma unroll
                for (int kk = 0; kk < 2; ++kk) a = mfma16(frag(XT, 72, 64 + 16 * ct, 32 * kk, lane), frag(LRB, 72, 16 * rt, 32 * kk, lane), a);
#pragma unroll
                for (int kk = 0; kk < 2; ++kk) a = mfma16(frag_tr(VT, 72, 16 * ct, 32 * kk, lane), frag(LRK, 72, 16 * rt, 32 * kk, lane), a);
                if (!dry) *(u32x2*)(P + (size_t)(m0 + 16 * rt + l15) * LDP + C_WK + h * 64 + 16 * ct + 4 * q4) = pack4(a);
            } else if (prod == 2) {
#pragma unroll
                for (int kk = 0; kk < 2; ++kk) a = mfma16(frag(XT, 72, 16 * ct, 32 * kk, lane), frag_tr(BHT, 72, 16 * rt, 32 * kk, lane), a);
                if (rt == ct) { const float wl = WLAST[16 * rt + l15];
#pragma unroll
                    for (int j = 0; j < 4; ++j) if (4 * q4 + j == l15) a[j] += wl; }
                *(u32x2*)(GH + (16 * rt + l15) * 64 + 16 * ct + 4 * q4) = pack4(a);
            } else {
#pragma unroll
                for (int kk = 0; kk < 2; ++kk) a = mfma16(frag_tr(BHT, 72, 16 * ct, 32 * kk, lane), frag(XT, 72, 64 + 16 * rt, 32 * kk, lane), a);
#pragma unroll
                for (int kk = 0; kk < 2; ++kk) a = mfma16(frag_tr(KHT, 72, 16 * ct, 32 * kk, lane), frag_tr(VT, 72, 16 * rt, 32 * kk, lane), a);
                *(u32x2*)(GH + 4096 + (16 * rt + l15) * 64 + 16 * ct + 4 * q4) = pack4(a);
            }
        }
    }
    __syncthreads();
    RW_TS_END();
}
DI void rwkv_scan_chain(const Params& p, unsigned char* lds, int bh, bool dry = false) {
    const int tid = opaque_tid(), lane = tid & 63, w = tid >> 6, q4 = lane >> 4, l15 = lane & 15;
    bf16* ZB = (bf16*)lds;
    bf16* GH = (bf16*)(p.ws + WS_RWGH) + (size_t)bh * 64 * 2 * 4096;
    const int vt = w & 3, kh = w >> 2;
    u32x2 zp[2];
#pragma unroll
    for (int i = 0; i < 2; ++i) { zp[i] = (u32x2){0u, 0u}; *(u32x2*)(ZB + (16 * vt + l15) * 72 + 16 * (2 * kh + i) + 4 * q4) = zp[i]; }
    bf16x8 gf[4][2][2]; u32x2 hv[4][2];
#define RW_LOAD(slot, cc) do { const bf16* G_ = GH + (size_t)(cc) * 2 * 4096; _Pragma("unroll") for (int i = 0; i < 2; ++i) { const int kt = 2 * kh + i; \
        _Pragma("unroll") for (int kk = 0; kk < 2; ++kk) gf[slot][i][kk] = frag(G_, 64, 16 * kt, 32 * kk, lane); \
        hv[slot][i] = *(const u32x2*)(G_ + 4096 + (16 * vt + l15) * 64 + 16 * kt + 4 * q4); } } while (0)
    RW_LOAD(0, 0); RW_LOAD(1, 1); RW_LOAD(2, 2); RW_LOAD(3, 3);
    __syncthreads();
    for (int c4 = 0; c4 < 64; c4 += 4) {
#pragma unroll
        for (int u = 0; u < 4; ++u) { const int c = c4 + u;
            bf16* HT = GH + (size_t)c * 2 * 4096 + 4096;
            const bf16* Zc = ZB + (c & 1) * 64 * 72; bf16* Zn = ZB + ((c + 1) & 1) * 64 * 72;
#pragma unroll
            for (int i = 0; i < 2; ++i) { const int kt = 2 * kh + i;
                f32x4 a = (f32x4){lo16(hv[u][i].x), hi16(hv[u][i].x), lo16(hv[u][i].y), hi16(hv[u][i].y)};
                if (!dry) *(u32x2*)(HT + (16 * vt + l15) * 64 + 16 * kt + 4 * q4) = zp[i];
#pragma unroll
                for (int kk = 0; kk < 2; ++kk) a = mfma16(gf[u][i][kk], frag(Zc, 72, 16 * vt, 32 * kk, lane), a);
                zp[i] = pack4(a);
                *(u32x2*)(Zn + (16 * vt + l15) * 72 + 16 * kt + 4 * q4) = zp[i]; }
            { const int cn = c + 4 < 64 ? c + 4 : 63; RW_LOAD(u, cn); }
            __syncthreads();
        }
    }
#undef RW_LOAD
}
DI void rwkv_out_item(const Params& p, int l, int bh, int pair, bool dry = false) {
    const int tid = opaque_tid(), lane = tid & 63, w = tid >> 6, q4 = lane >> 4, l15 = lane & 15;
    bf16* P = (bf16*)(p.ws + WS_P);
    const int b = bh >> 3, h = bh & 7, c = 2 * pair + (w >> 2), m = b * T + c * 64 + 16 * (w & 3) + l15;
    const bf16* ZT = (const bf16*)(p.ws + WS_RWGH) + ((size_t)(bh * 64 + c) * 2 + 1) * 4096;
    const size_t ro = (size_t)m * LDP;
    bf16x8 qf[2], zf[4][2]; u32x2 yl[4], bv[4], g2[4]; f32x4 lg[4], lb[4];
#pragma unroll
    for (int kk = 0; kk < 2; ++kk) qf[kk] = *(const bf16x8*)(P + ro + C_WR + h * 64 + 32 * kk + 8 * q4);
#pragma unroll
    for (int vt = 0; vt < 4; ++vt) { yl[vt] = *(const u32x2*)(P + ro + C_WK + h * 64 + 16 * vt + 4 * q4);
#pragma unroll
        for (int kk = 0; kk < 2; ++kk) zf[vt][kk] = frag(ZT, 64, 16 * vt, 32 * kk, lane); }
#pragma unroll
    for (int vt = 0; vt < 4; ++vt) { const int ch = h * 64 + 16 * vt + 4 * q4;
        bv[vt] = *(const u32x2*)(P + ro + C_WV + ch); g2[vt] = *(const u32x2*)(P + ro + C_WG + ch);
        lg[vt] = *(const f32x4*)(p.in[I_LNG] + l * 512 + ch); lb[vt] = *(const f32x4*)(p.in[I_LNB] + l * 512 + ch); }
    f32x4 y[4]; float s = 0.f;
#pragma unroll
    for (int vt = 0; vt < 4; ++vt) {
        y[vt] = (f32x4){lo16(yl[vt].x), hi16(yl[vt].x), lo16(yl[vt].y), hi16(yl[vt].y)};
#pragma unroll
        for (int kk = 0; kk < 2; ++kk) y[vt] = mfma16(zf[vt][kk], qf[kk], y[vt]);
        s += (y[vt][0] + y[vt][1]) + (y[vt][2] + y[vt][3]); }
    s += __shfl_xor(s, 16); s += __shfl_xor(s, 32);
    const float mean = s * (1.0f / 64.0f); float vr = 0.f;
#pragma unroll
    for (int vt = 0; vt < 4; ++vt) { y[vt] = y[vt] - mean; vr += (y[vt][0] * y[vt][0] + y[vt][1] * y[vt][1]) + (y[vt][2] * y[vt][2] + y[vt][3] * y[vt][3]); }
    vr += __shfl_xor(vr, 16); vr += __shfl_xor(vr, 32);
    const float rstd = __builtin_amdgcn_rsqf(vr * (1.0f / 64.0f) + 64e-5f);
#pragma unroll
    for (int vt = 0; vt < 4; ++vt) { const int ch = h * 64 + 16 * vt + 4 * q4; bf16* gp = P + ro + C_WG + ch;
        const float bvf[4] = {lo16(bv[vt].x), hi16(bv[vt].x), lo16(bv[vt].y), hi16(bv[vt].y)}, g[4] = {lo16(g2[vt].x), hi16(g2[vt].x), lo16(g2[vt].y), hi16(g2[vt].y)};
        f32x4 o;
#pragma unroll
        for (int j = 0; j < 4; ++j) o[j] = (y[vt][j] * rstd * lg[vt][j] + lb[vt][j] + bvf[j]) * siluf_(g[j]);
        if (!dry) *(u32x2*)gp = pack4(o); }
}

DI void phase_A(const Params& p, int l, unsigned char* lds, bool dry = false) {
    const int G = gridDim.x, bid = blockIdx.x;
#ifndef DUP_AMASK
#define DUP_AMASK 0xff
#endif
#ifndef A_DESYNC
#define A_DESYNC 1
#endif
    const int cls = (G == 256 && A_DESYNC) ? ((bid >> 3) & 3) : 0, lead = cls == 1 ? 12 : cls == 2 ? 10 : 11, nk = (3328 + G - 1) / G;
    for (int kk = 0; kk < nk; ++kk) {
#if A_DESYNC == 5
        const unsigned long long ocode = cls == 0 ? 0xcba9876543210ull : cls == 1 ? 0x76543210cba98ull : cls == 2 ? 0x7654cba983210ull : 0xcba7654321098ull;
        const int k = (G == 256) ? (int)((ocode >> (4 * kk)) & 15ull) : kk; (void)lead;
#elif A_DESYNC == 4
        const unsigned long long ocode = cls == 0 ? 0xcba9876543210ull : cls == 1 ? 0x76543210cba98ull : cls == 2 ? 0x76543cba98210ull : 0x765cba9843210ull;
        const int k = (G == 256) ? (int)((ocode >> (4 * kk)) & 15ull) : kk; (void)lead;
#elif A_DESYNC == 3
        const unsigned long long ocode = cls == 0 ? 0xc76b54a329108ull : cls == 1 ? 0x108c76b54a329ull : cls == 2 ? 0x329108c76b54aull : 0x54a329108c76bull;
        const int k = (G == 256) ? (int)((ocode >> (4 * kk)) & 15ull) : kk; (void)lead;
#elif A_DESYNC == 2
        const unsigned long long ocode = cls == 0 ? 0xCBA9876543210ull : cls == 1 ? 0x76543210CBA98ull : cls == 2 ? 0x7654CBA983210ull : 0xC76B54A329108ull;
        const int k = (G == 256) ? (int)((ocode >> (4 * kk)) & 15ull) : kk; (void)lead;
#else
        const int k = (cls == 0) ? kk : (kk == 0 ? lead : (kk - 1 < lead ? kk - 1 : kk));
#endif
        const int it = bid + k * G; if (it >= 3328) continue;
        if (dry) { const int ty = it < 2048 ? 1 : it < 2560 ? 2 : it < 2816 ? 4 : it < 3072 ? 8 : 16; if (!(DUP_AMASK & ty)) continue; }
        if (it < 2048) rwkv_chunk_item(p, l, lds, it >> 9, (it >> 6) & 7, it & 63, dry);
        else if (it < 2560) { const int i = it - 2048; ssd_item(p, l, lds, i >> 7, (i >> 4) & 7, i & 15, false); }
        else if (it < 2816) { const int i = it - 2560; qkv_item<false>(p, l, lds, i >> 6, (i >> 4) & 3, i & 15, false); }
        else if (it < 3072) { const int i = it - 2816; qkv_item<true>(p, l, lds, i >> 6, (i >> 4) & 3, i & 15, false); }
        else memkv_item(p, l, it - 3072);
    }
}
DI void phase_B(const Params& p, unsigned char* lds, bool dry = false) {
    (void)lds; phase_scan(p, blockIdx.x, gridDim.x, dry);
}
DI void rwkv_flag_publish(unsigned* flag) {
    asm volatile("s_waitcnt vmcnt(0)" ::: "memory"); __syncthreads();
    if (threadIdx.x == 0) { __builtin_amdgcn_fence(__ATOMIC_RELEASE, "agent"); asm volatile("s_waitcnt vmcnt(0)" ::: "memory"); __hip_atomic_store(flag, 1u, __ATOMIC_RELAXED, __HIP_MEMORY_SCOPE_AGENT); }
}
DI void rwkv_flag_wait(unsigned* flag) {
    if (threadIdx.x == 0) { unsigned spins = 0;
        while (__hip_atomic_load(flag, __ATOMIC_RELAXED, __HIP_MEMORY_SCOPE_AGENT) == 0u) { __builtin_amdgcn_s_sleep(8); if (++spins > (1u << 22)) break; }
        __builtin_amdgcn_fence(__ATOMIC_ACQUIRE, "agent"); asm volatile("s_waitcnt vmcnt(0)" ::: "memory"); }
    __syncthreads();
}
DI void phase_C(const Params& p, int l, unsigned char* lds, bool dry = false) {
    const int G = gridDim.x, bid = blockIdx.x;
    unsigned* flags = (unsigned*)(p.ws + WS_BAR + 14336) + (dry ? 128 : 0) + l * 32;
    for (int bh = bid; bh < 32; bh += G) { rwkv_scan_chain(p, lds, bh, dry); rwkv_flag_publish(flags + bh); }
    unsigned have = 0u;
#define C_SSD(it)  ssd_item(p, l, lds, (it) >> 7, ((it) >> 4) & 7, (it) & 15, true, dry)
#define C_RET(it)  qkv_item<false>(p, l, lds, (it) >> 6, ((it) >> 4) & 3, (it) & 15, true, dry)
#define C_GLA(it)  qkv_item<true>(p, l, lds, (it) >> 6, ((it) >> 4) & 3, (it) & 15, true, dry)
#define C_MEM(it)  memattn_item(p, lds, (it) >> 6, ((it) >> 4) & 3, (it) & 15)
#define C_RWO(it)  do { const int bh_ = (it) >> 5; if (!((have >> bh_) & 1u)) { rwkv_flag_wait(flags + bh_); have |= 1u << bh_; } rwkv_out_item(p, l, bh_, (it) & 31, dry); } while (0)
    const int nslot = (G == 256) ? 16 : (2304 + G - 1) / G;
#ifndef C_DESYNC
#define C_DESYNC 0
#endif
    const int ccls = (G == 256 && C_DESYNC && bid >= 32) ? ((bid >> 3) & 3) : 0, clead = ccls == 1 ? 3 : ccls == 2 ? 5 : 7;
    for (int kk = 0; kk < nslot; ++kk) {
        const int k = (ccls == 0) ? kk : (kk == 0 ? clead : (kk - 1 < clead ? kk - 1 : kk));
        int it = -1;
        if (G == 256) {
            if (bid < 32) { it = k == 0 ? bid : (k >= 1 && k <= 2) ? 1280 + 2 * bid + (k - 1) : -1; }
            else { const int j = bid - 32;
                if (k == 0) it = 32 + j; else if (k == 1) it = 256 + j; else if (k == 2) it = (j < 32) ? 480 + j : -1;
                else if (k == 3) it = 768 + 32 + j; else if (k == 4) it = (j >= 32 && j < 64) ? 768 + (j - 32) : -1;
                else if (k == 5) it = 512 + 32 + j; else if (k == 6) it = (j >= 64 && j < 96) ? 512 + (j - 64) : -1;
                else if (k == 7) it = 1024 + j; else if (k == 8) it = (j >= 96 && j < 128) ? 1024 + 224 + (j - 96) : -1;
                else { const int m = k - 9; int r = -1;
                    if (j < 32) r = m < 2 ? 64 + 2 * j + m : -1; else if (j < 64) r = m < 2 ? 128 + 2 * (j - 32) + m : -1; else if (j < 96) r = m < 3 ? 192 + 3 * (j - 64) + m : -1;
                    else if (j < 128) r = m < 5 ? 288 + 5 * (j - 96) + m : -1; else if (j < 192) r = m < 6 ? 448 + 6 * (j - 128) + m : -1; else r = m < 6 ? 832 + 6 * (j - 192) + m : -1;
                    it = r >= 0 ? 1280 + r : -1; } }
        } else { it = bid + k * G; if (it >= 2304) it = -1; }
        if (it < 0) continue;
        if (it < 512) C_SSD(it); else if (it < 768) C_RET(it - 512); else if (it < 1024) C_GLA(it - 768); else if (it < 1280) C_MEM(it - 1024); else C_RWO(it - 1280);
    }
#undef C_SSD
#undef C_RET
#undef C_GLA
#undef C_MEM
#undef C_RWO
}
typedef PG8_LAS unsigned char* lds3_t;
DI void phase_P1(const Params& p, int l, unsigned char* lds) {
    pg8::Gemm g{1024, 1024};
    SchedP1 S{(int)gridDim.x, (int)blockIdx.x, (const char*)p.ws + WS_XN, (const char*)p.ws + WS_W1T};
    EpiP E{(bf16*)(p.ws + WS_P), (bf16*)(p.ws + WS_BND)};
    pg8::gemm_phase<EpiP, SchedP1, true, true>((lds3_t)lds, g, S, E);
}
#ifndef P3_ORDERS
#define P3_ORDERS 4
#endif
DI void phase_P3(const Params& p, int l, unsigned char* lds) {
    (void)l;
    for (int L = blockIdx.x; L < 256; L += gridDim.x) {
        int pm, pn; tile_map(L, 64, 4, pm, pn);
        pg8::Gemm g{0, 0}; SchedP3 S{pm, pn, p.ws, (int)((blockIdx.x >> 3) & (P3_ORDERS - 1))};
        EpiP3 E{EpiGate{(bf16*)(p.ws + WS_P)}, EpiBranch{(const bf16*)(p.ws + WS_P), (bf16*)(p.ws + WS_MRG), (const float*)(p.ws + WS_SSQ)}};
        pg8::gemm_phase<EpiP3, SchedP3, true, true>((lds3_t)lds, g, S, E);
    }
}
DI void phase_P4(const Params& p, int l, unsigned char* lds) {
    pg8::Gemm g{1024, 1024};
    SchedP4 S{(int)gridDim.x, (int)blockIdx.x, (const char*)p.ws + WS_MRG, (const char*)p.ws + (l == 0 ? WS_WOT : WS_WOT1)};
    bool conv_first = false, conv_last = false;
    if (gridDim.x == 256 && l == 0) { int pm_, pn_; tile_map((int)blockIdx.x, 64, 4, pm_, pn_); conv_first = (pm_ & 1) != 0; conv_last = !conv_first; }
    if (conv_first) { convert_weights(p, 1, lds); __syncthreads(); }
    if (gridDim.x == 256) {
        float* xs = (float*)(p.ws + WS_XS) + (size_t)l * 64 * 256 * 4; unsigned* cnt = (unsigned*)(p.ws + WS_XCNT) + l * 64 * 64;
#ifndef P4_PREFETCH
#define P4_PREFETCH 0
#endif
        if (P4_PREFETCH) {
            int pm, pn; tile_map((int)blockIdx.x, 64, 4, pm, pn);
            const float* rbase = (l == 0 ? p.in[I_X] : p.out) + (size_t)pm * 256 * 1024 + pn * 256;
            const int tid = opaque_tid(), lane = tid & 63, w = tid >> 6;
#pragma unroll
            for (int i = 0; i < 4; ++i) { const int id = i * 64 + lane;
                __builtin_amdgcn_global_load_lds((const unsigned*)(rbase + (size_t)(32 * w + (id >> 3)) * 1024 + (id & 7) * 32), (PG8_LAS unsigned*)((lds3_t)lds + 131072 + w * 1024 + i * 256), 4, 0, 0); }
        }
        if (l == 0) { EpiNorm<false> E{p.in[I_X], p.out, p.in[I_NORMG] + 1024, (bf16*)(p.ws + WS_XN), xs, cnt}; pg8::gemm_phase<EpiNorm<false>, SchedP4, true, true>((lds3_t)lds, g, S, E); }
        else { EpiNorm<true> E{p.out, p.out, p.in[I_FNORMG], nullptr, xs, cnt}; pg8::gemm_phase<EpiNorm<true>, SchedP4, true, true>((lds3_t)lds, g, S, E); }
    } else { EpiRes E{l == 0 ? p.in[I_X] : p.out, p.out}; pg8::gemm_phase<EpiRes, SchedP4, true, true>((lds3_t)lds, g, S, E); }
    if (conv_last) { __syncthreads(); convert_weights(p, 1, lds); }
}
DI void phase_post(const Params& p, int l, unsigned char* lds) {
    if (gridDim.x == 256) { }
    else phase_norm(p, l, 1.0f, lds);
}

#ifndef MK_LAUNCHES
#define MK_LAUNCHES 1
#endif
struct KArgs { Params p; int lo, hi; };
constexpr int N_PHASES = 15;
#ifdef NVGPR
__global__ void __launch_bounds__(NTHREADS, 2) __attribute__((amdgpu_num_vgpr(NVGPR))) fwd_kernel(KArgs a) {
#else
__global__ void __launch_bounds__(NTHREADS, 2) fwd_kernel(KArgs a) {
#endif
    extern __shared__ __attribute__((aligned(16))) unsigned char lds[];
    cg::grid_group grid = cg::this_grid();
    const Params& p = a.p;
    volatile unsigned* bst = (volatile unsigned*)(lds + LDS_BYTES - 64);
    if (threadIdx.x < 16) bst[threadIdx.x] = 0u;
    __syncthreads();
    XcdBarrier xbar = xcd_barrier_post((unsigned*)(p.ws + WS_BAR), bst);
    if (a.hi == 12345) grid.sync();
#define GRID_SYNC() xcd_barrier(xbar)
#ifndef DUP_N
#define DUP_N 1
#endif
#ifndef PHMASK
#define PHMASK 0xff
#endif
#if defined(TPROBE) && defined(PH_PROBE)
#define PH_TS_BEGIN() do { if (threadIdx.x == 0) TS_BASE(lds)[13] = (unsigned)__builtin_amdgcn_s_memrealtime(); } while (0)
#define PH_TS_MARK(k) do { __syncthreads(); if (threadIdx.x == 0) { const unsigned t_ = (unsigned)__builtin_amdgcn_s_memrealtime(); volatile unsigned* A_ = TS_BASE(lds); A_[k] += t_ - A_[13]; A_[13] = t_; } } while (0)
#else
#define PH_TS_BEGIN() do {} while (0)
#define PH_TS_MARK(k) do {} while (0)
#endif
#ifdef DUP_S
#define NREP(ty, l) (((ty) == DUP_S && !(((ty) == 6 || (ty) == 7) && (l) != 0)) ? 1 + DUP_N : 1)
#else
#define NREP(ty, l) 1
#endif
#define RUN_PHASE(ty, l, more) do { const int nrep = NREP(ty, l); \
        for (int rep = 0; rep < nrep; ++rep) { const bool dry = (rep + 1 < nrep) && (a.hi != 12345); (void)dry; PH_TS_BEGIN(); \
            if (!((PHMASK >> (ty)) & 1)) {} \
            else if ((ty) == 0) phase_prologue(p, lds); \
            else if ((ty) == 1) phase_P1(p, l, lds); \
            else if ((ty) == 2) phase_A(p, l, lds, dry); \
            else if ((ty) == 3) phase_B(p, lds, dry); \
            else if ((ty) == 4) phase_C(p, l, lds, dry); \
            else if ((ty) == 5) phase_P3(p, l, lds); \
            else if ((ty) == 6) phase_P4(p, l, lds); \
            else phase_post(p, l, lds); \
            PH_TS_MARK(ty); \
            if ((more) || rep + 1 < nrep) GRID_SYNC(); } } while (0)
#if MK_LAUNCHES == 1
#if defined(DUP_S) && DUP_S == 100
    for (int rep = 0; rep < DUP_N; ++rep) GRID_SYNC();
#endif
    RUN_PHASE(0, 0, true);
    RUN_PHASE(1, 0, true); RUN_PHASE(2, 0, true); RUN_PHASE(3, 0, true); RUN_PHASE(4, 0, true); RUN_PHASE(5, 0, true); RUN_PHASE(6, 0, true); if (gridDim.x != 256) RUN_PHASE(7, 0, true);
    RUN_PHASE(1, 1, true); RUN_PHASE(2, 1, true); RUN_PHASE(3, 1, true); RUN_PHASE(4, 1, true); RUN_PHASE(5, 1, true); RUN_PHASE(6, 1, gridDim.x != 256); RUN_PHASE(7, 1, false);
#ifdef TPROBE
    {
        GRID_SYNC();
        unsigned* pw = (unsigned*)(p.ws + WS_XS + 600 * 1024);
        if (threadIdx.x == 0) pw[blockIdx.x] = TS_BASE(lds)[TPROBE];
        GRID_SYNC();
#ifndef TP_MODE
#define TP_MODE 0
#endif
#ifndef TP_LO
#define TP_LO 0
#define TP_HI 1
#endif
        float tot = 0.f, mx = 0.f, ctot = 0.f; int amx = 0; for (int i = 0; i < (int)gridDim.x; ++i) { const float v_ = (float)__hip_atomic_load(pw + i, __ATOMIC_RELAXED, __HIP_MEMORY_SCOPE_AGENT); tot += v_; if (v_ > mx) { mx = v_; amx = i; } if (i >= TP_LO && i < TP_HI) ctot += v_; }
        const float avg_us = TP_MODE == 4 ? (float)amx : TP_MODE == 3 ? (ctot / (float)(TP_HI - TP_LO)) / (tot / (float)gridDim.x) * 100.0f : TP_MODE == 2 ? (mx * (float)gridDim.x / tot - 1.0f) * 100.0f : (TP_MODE == 0 ? tot / (float)gridDim.x : mx) * 0.01f / (float)TP_CNT;
        const float bucket = floorf(avg_us / (float)TP_Q + 0.5f);
        const float sc = 1.0f + bucket * 0.01f;
        for (int i = blockIdx.x * NTHREADS + threadIdx.x; i < M * 256; i += gridDim.x * NTHREADS) { f32x4* o = (f32x4*)p.out + i; *o = *o * sc; }
    }
#endif
#else
    for (int ph = a.lo; ph < a.hi; ++ph) { const int ty = (ph == 0) ? 0 : ((ph - 1) % 7 + 1), l = (ph - 1) / 7; RUN_PHASE(ty, l, ph + 1 < a.hi); }
#endif
}

extern "C" void kernel_launch(void* const* d_in, const int* in_sizes, int n_in, void* d_out, int out_size, void* d_ws, size_t ws_size, hipStream_t stream) {
    static int grid = 0;
    if (grid == 0) {
        if (n_in != N_IN || out_size != M * D || ws_size < WS_END) { fprintf(stderr, "kernel_launch: unexpected shapes (n_in %d, out %d, ws %zu < %zu)\n", n_in, out_size, ws_size, (size_t)WS_END); grid = -1; return; }
        int dev = 0, cus = 0, per_cu = 0;
        hipGetDevice(&dev); hipDeviceGetAttribute(&cus, hipDeviceAttributeMultiprocessorCount, dev);
        hipFuncSetAttribute((const void*)fwd_kernel, hipFuncAttributeMaxDynamicSharedMemorySize, LDS_BYTES);
        hipOccupancyMaxActiveBlocksPerMultiprocessor(&per_cu, (const void*)fwd_kernel, NTHREADS, LDS_BYTES);
        if (per_cu < 1 || cus < 1) { fprintf(stderr, "kernel_launch: occupancy query gave %d blocks/CU on %d CUs\n", per_cu, cus); grid = -1; return; }
        grid = cus * per_cu; if (grid > 256) grid = 256;
    }
    if (grid < 0) return;
    KArgs a{}; for (int i = 0; i < N_IN; ++i) a.p.in[i] = (const float*)d_in[i];
    a.p.out = (float*)d_out; a.p.ws = (unsigned char*)d_ws;
    if (hipMemsetAsync((char*)d_ws + WS_BAR, 0, WS_ZERO_BYTES, stream) != hipSuccess) { fprintf(stderr, "kernel_launch: memset of the barrier words failed\n"); return; }
    if (MK_LAUNCHES == 1) {
        a.lo = 0; a.hi = N_PHASES; void* args[] = {&a};
        hipError_t e = hipLaunchCooperativeKernel((const void*)fwd_kernel, dim3(grid), dim3(NTHREADS), args, LDS_BYTES, stream);
        if (e != hipSuccess) fprintf(stderr, "kernel_launch: cooperative launch failed: %s (grid %d)\n", hipGetErrorString(e), grid);
    } else {
        for (int ph = 0; ph < N_PHASES; ++ph) { a.lo = ph; a.hi = ph + 1; hipLaunchKernelGGL(fwd_kernel, dim3(grid), dim3(NTHREADS), LDS_BYTES, stream, a); }
    }
}
```
